# Optimizing an MI355X kernel written in HIP

```python
import jax, jax.numpy as jnp
from jax import lax
import numpy as np

D_MODEL = 2048
BATCH = 8
SEQ = 2048
DEPTH = 4

N_MIXERS = 2
N_HEADS = 16
HEAD_DIM = D_MODEL // N_HEADS
DILATED_BRANCHES = ((128, 1), (512, 4), (2048, 16))
BLOCK = 128
KV_LATENT = 256
IDX_HEADS = 16
IDX_DIM = 128
TOPK_MAX = 256
D_FF = -(-8 * D_MODEL // (3 * 256)) * 256
D_IN_A = 3 * N_HEADS * HEAD_DIM
D_IN_B = N_HEADS * HEAD_DIM + KV_LATENT + IDX_HEADS * IDX_DIM + IDX_DIM + IDX_HEADS
EPS = 1e-6
NEG_BIG = -1e30

kernel_name = 'hybrid_dilated_dsa_decoder'


def rms_norm(x, gain):
    xf = x.astype(jnp.float32)
    y = xf * lax.rsqrt(jnp.mean(xf * xf, axis=-1, keepdims=True) + EPS)
    return (y * gain.astype(jnp.float32)).astype(x.dtype)


def alibi_slopes(n_heads):
    return jnp.exp2(-8.0 * jnp.arange(1, n_heads + 1, dtype=jnp.float32) / n_heads)


def adaln_params(c, w_ada, b_ada):
    mod = jax.nn.silu(c) @ w_ada + b_ada
    return [m[:, None, :] for m in jnp.split(mod, 6, axis=-1)]


def modulate(x, gain, shift, scale):
    return rms_norm(x, gain) * (1 + scale) + shift


def swiglu(h, w_gate_up, w_down):
    gate, up = jnp.split(h @ w_gate_up, 2, axis=-1)
    return (jax.nn.silu(gate) * up) @ w_down


def dilated_branch(q, k, v, slopes, window, dilation):
    b, s, h, hd = q.shape
    span = window // dilation
    n = s // dilation
    n_pad = -(-n // BLOCK) * BLOCK
    nb = n_pad // BLOCK

    def to_blocks(t):
        t = t.reshape(b, n, dilation, h, hd)
        t = jnp.pad(t, ((0, 0), (0, n_pad - n), (0, 0), (0, 0), (0, 0)))
        return t.reshape(b, nb, BLOCK, dilation, h, hd)

    def with_prev(t):
        prev = jnp.pad(t[:, :-1], ((0, 0), (1, 0), (0, 0), (0, 0), (0, 0), (0, 0)))
        return jnp.concatenate([prev, t], axis=2)

    qb = to_blocks(q)
    kb = with_prev(to_blocks(k))
    vb = with_prev(to_blocks(v))
    k_off = jnp.arange(2 * BLOCK)
    rel = jnp.arange(BLOCK)[:, None] + BLOCK - k_off[None, :]
    key_sub = jnp.arange(nb)[:, None] * BLOCK - BLOCK + k_off[None, :]
    valid = ((rel >= 0) & (rel <= span))[None] & (key_sub >= 0)[:, None, :]
    bias = -slopes[:, None, None] * (rel * dilation).astype(jnp.float32)[None]
    scores = jnp.einsum('bnqrhd,bnkrhd->bnrhqk', qb, kb,
                        preferred_element_type=jnp.float32) * hd ** -0.5 + bias
    scores = jnp.where(valid[None, :, None, None], scores, -jnp.inf)
    m = jnp.max(scores, axis=-1, keepdims=True)
    p = jnp.exp(scores - m)
    den = jnp.sum(p, axis=-1, keepdims=True)
    o = jnp.einsum('bnrhqk,bnkrhd->bnqrhd', p / den, vb.astype(jnp.float32))
    lse = jnp.transpose((m + jnp.log(den))[..., 0], (0, 1, 4, 2, 3))
    o = o.reshape(b, n_pad, dilation, h, hd)[:, :n].reshape(b, s, h, hd)
    lse = lse.reshape(b, n_pad, dilation, h)[:, :n].reshape(b, s, h)
    return o, lse


def dilated_attention(h, w_in, w_out, slopes):
    b, s, _ = h.shape
    qkv = (h @ w_in).reshape(b, s, 3, N_HEADS, HEAD_DIM)
    q, k, v = qkv[:, :, 0], qkv[:, :, 1], qkv[:, :, 2]
    outs, lses = [], []
    for window, dilation in DILATED_BRANCHES:
        o, lse = dilated_branch(q, k, v, slopes, window, dilation)
        outs.append(o)
        lses.append(lse)
    alpha = jax.nn.softmax(jnp.stack(lses), axis=0)
    o = jnp.einsum('gbsh,gbshd->bshd', alpha, jnp.stack(outs))
    return o.reshape(b, s, N_HEADS * HEAD_DIM).astype(h.dtype) @ w_out


def dsa_attention(h, w_in, kv_norm, w_uk, w_uv, w_out, slopes, topk):
    b, s, _ = h.shape
    nb = s // BLOCK
    sizes = (N_HEADS * HEAD_DIM, KV_LATENT, IDX_HEADS * IDX_DIM, IDX_DIM)
    q, c_kv, q_idx, k_idx, w_idx = jnp.split(h @ w_in, [int(o) for o in np.cumsum(sizes)], axis=-1)
    q = q.reshape(b, s, N_HEADS, HEAD_DIM)
    c_kv = rms_norm(c_kv, kv_norm)
    q_idx = q_idx.reshape(b, s, IDX_HEADS, IDX_DIM)
    w_idx = w_idx * IDX_HEADS ** -0.5
    q_lat = jnp.einsum('bshd,hdc->bshc', q, w_uk)
    key_pos = jnp.arange(s)

    def blocks(t):
        return jnp.moveaxis(t.reshape(b, nb, BLOCK, *t.shape[2:]), 1, 0)

    def one_block(args):
        blk, ql, qi, wi = args
        q_pos = blk * BLOCK + jnp.arange(BLOCK)
        logits = jnp.einsum('bqhd,bsd->bqhs', qi, k_idx,
                            preferred_element_type=jnp.float32) * IDX_DIM ** -0.5
        index_score = jnp.einsum('bqh,bqhs->bqs', wi.astype(jnp.float32), jax.nn.relu(logits))
        causal = key_pos[None, :] <= q_pos[:, None]
        index_score = jnp.where(causal[None], index_score, NEG_BIG)
        _, sel = lax.top_k(index_score, topk)
        kv_sel = jax.vmap(lambda kv, ix: kv[ix])(c_kv, sel)
        scores = jnp.einsum('bqhc,bqkc->bqhk', ql, kv_sel,
                            preferred_element_type=jnp.float32) * HEAD_DIM ** -0.5
        dist = (q_pos[None, :, None] - sel).astype(jnp.float32)
        scores = scores - slopes[None, None, :, None] * dist[:, :, None, :]
        scores = jnp.where((dist >= 0)[:, :, None, :], scores, -jnp.inf)
        probs = jax.nn.softmax(scores, axis=-1)
        return jnp.einsum('bqhk,bqkc->bqhc', probs, kv_sel.astype(jnp.float32))

    o_lat = lax.map(one_block, (jnp.arange(nb), blocks(q_lat), blocks(q_idx), blocks(w_idx)))
    o_lat = jnp.moveaxis(o_lat, 0, 1).reshape(b, s, N_HEADS, KV_LATENT)
    o = jnp.einsum('bshc,hcd->bshd', o_lat, w_uv.astype(jnp.float32))
    return o.reshape(b, s, N_HEADS * HEAD_DIM).astype(h.dtype) @ w_out


def setup_inputs(seed: int = 0) -> dict:
    key = jax.random.key(seed)
    keys = jax.random.split(key, 128)
    counter = [0]

    def normal(shape, scale):
        k = keys[counter[0]]
        counter[0] += 1
        return jax.random.normal(k, shape, jnp.float32) * scale

    def gain(n):
        return 1.0 + normal((n,), 0.02)

    inputs = {'x': normal((BATCH, SEQ, D_MODEL), 1.0), 'c': normal((BATCH, D_MODEL), 1.0)}
    for i in range(DEPTH):
        p = 'l%d_' % i
        inputs[p + 'norm_attn'] = gain(D_MODEL)
        inputs[p + 'ada_w'] = normal((D_MODEL, 6 * D_MODEL), 0.5 * D_MODEL ** -0.5)
        inputs[p + 'ada_b'] = normal((6 * D_MODEL,), 0.02)
        if i % N_MIXERS == 0:
            inputs[p + 'w_in'] = normal((D_MODEL, D_IN_A), D_MODEL ** -0.5)
        else:
            inputs[p + 'w_in'] = normal((D_MODEL, D_IN_B), D_MODEL ** -0.5)
            inputs[p + 'kv_norm'] = gain(KV_LATENT)
            inputs[p + 'w_uk'] = normal((N_HEADS, HEAD_DIM, KV_LATENT), HEAD_DIM ** -0.5)
            inputs[p + 'w_uv'] = normal((N_HEADS, KV_LATENT, HEAD_DIM), KV_LATENT ** -0.5)
        inputs[p + 'w_out'] = normal((N_HEADS * HEAD_DIM, D_MODEL), (N_HEADS * HEAD_DIM) ** -0.5)
        inputs[p + 'norm_ffn'] = gain(D_MODEL)
        inputs[p + 'w_gate_up'] = normal((D_MODEL, 2 * D_FF), D_MODEL ** -0.5)
        inputs[p + 'w_down'] = normal((D_FF, D_MODEL), D_FF ** -0.5)
    inputs['final_norm'] = gain(D_MODEL)
    return inputs


def reference(x, c,
              l0_norm_attn, l0_ada_w, l0_ada_b, l0_w_in, l0_w_out, l0_norm_ffn, l0_w_gate_up, l0_w_down,
              l1_norm_attn, l1_ada_w, l1_ada_b, l1_w_in, l1_kv_norm, l1_w_uk, l1_w_uv, l1_w_out,
              l1_norm_ffn, l1_w_gate_up, l1_w_down,
              l2_norm_attn, l2_ada_w, l2_ada_b, l2_w_in, l2_w_out, l2_norm_ffn, l2_w_gate_up, l2_w_down,
              l3_norm_attn, l3_ada_w, l3_ada_b, l3_w_in, l3_kv_norm, l3_w_uk, l3_w_uv, l3_w_out,
              l3_norm_ffn, l3_w_gate_up, l3_w_down,
              final_norm):
    slopes = alibi_slopes(N_HEADS)
    topk = min(TOPK_MAX, x.shape[1] // 4)
    layers = (
        (l0_norm_attn, l0_ada_w, l0_ada_b, (l0_w_in, l0_w_out), l0_norm_ffn, l0_w_gate_up, l0_w_down),
        (l1_norm_attn, l1_ada_w, l1_ada_b, (l1_w_in, l1_kv_norm, l1_w_uk, l1_w_uv, l1_w_out),
         l1_norm_ffn, l1_w_gate_up, l1_w_down),
        (l2_norm_attn, l2_ada_w, l2_ada_b, (l2_w_in, l2_w_out), l2_norm_ffn, l2_w_gate_up, l2_w_down),
        (l3_norm_attn, l3_ada_w, l3_ada_b, (l3_w_in, l3_kv_norm, l3_w_uk, l3_w_uv, l3_w_out),
         l3_norm_ffn, l3_w_gate_up, l3_w_down),
    )
    for i in range(DEPTH):
        norm_attn, ada_w, ada_b, mixer_w, norm_ffn, w_gate_up, w_down = layers[i]
        shift_a, scale_a, gate_a, shift_f, scale_f, gate_f = adaln_params(c, ada_w, ada_b)
        h = modulate(x, norm_attn, shift_a, scale_a)
        if i % N_MIXERS == 0:
            y = dilated_attention(h, *mixer_w, slopes)
        else:
            y = dsa_attention(h, *mixer_w, slopes, topk)
        x = x + gate_a * y
        h = modulate(x, norm_ffn, shift_f, scale_f)
        x = x + gate_f * swiglu(h, w_gate_up, w_down)
    return rms_norm(x, final_norm)
```

```cpp
#include <hip/hip_runtime.h>
#include <cstdio>
#include <cstdint>
#define MK_MULTI 1
namespace pg8 {
#define PG8_LAS __attribute__((address_space(3)))
typedef unsigned short bf16_t;
typedef short bf16x8 __attribute__((ext_vector_type(8)));
typedef float f32x4 __attribute__((ext_vector_type(4)));
typedef unsigned u32x4 __attribute__((ext_vector_type(4)));
constexpr int BM = 256, BK = 64, HALF = 128, HTB = HALF * BK * 2  , STAGE_BYTES = 8 * HTB, NXCD = 8, WGM = 8;

__host__ __device__ __forceinline__ int lds_byte(int r, int c) { const int st = (r >> 4) * 2 + (c >> 5), rr = r & 15, cc = c & 31, ob = rr * 64 + cc * 2; return st * 1024 + (ob ^ (((ob >> 9) & 1) << 5)); }
__host__ __device__ __forceinline__ void stage_rc(int b, int& R, int& C) { const int st = b / 1024, sb = b % 1024, swz = sb ^ (((sb >> 9) & 1) << 5); R = (st >> 1) * 16 + swz / 64; C = (st & 1) * 32 + (swz % 64) / 2; }
__host__ __device__ __forceinline__ int perm32(int rho) { const int n = rho >> 4, i = rho & 15; return 8 * (i >> 2) + 4 * n + (i & 3); }

struct Unit { int pm, pn; };
struct Gemm { const bf16_t* A; const bf16_t* Bt; int M, N, K; };

struct StaticOrder {
    int nM, nN, nwg, G, c;
    __host__ __device__ void init(int M, int N, int G_, int c_) { nM = M / BM; nN = N / BM; nwg = nM * nN; G = G_; c = c_; }
    __host__ __device__ bool next(int i, Unit& u) const {
        const long L = (long)i * G + c; if (L >= nwg) return false;
        int wgid = (int)L; { const int q = nwg / NXCD, r = nwg % NXCD, xcd = wgid % NXCD, off = wgid / NXCD; wgid = (xcd < r ? xcd * (q + 1) : r * (q + 1) + (xcd - r) * q) + off; }
        const int nig = WGM * nN, gid = wgid / nig, fm = gid * WGM, gsz = (nM - fm) < WGM ? (nM - fm) : WGM;
        u.pm = fm + ((wgid % nig) % gsz); u.pn = (wgid % nig) / gsz; return true;
    }
    __device__ __forceinline__ void a_ready(const Unit&) const {}
    __device__ __forceinline__ void done(const Unit&) const {}
};
typedef __bf16 bf16x2_cv __attribute__((ext_vector_type(2)));
typedef float f32x2_cv __attribute__((ext_vector_type(2)));
__device__ __forceinline__ unsigned cvt_pk_bf16(float lo, float hi) { const f32x2_cv v = {lo, hi}; const bf16x2_cv r = __builtin_convertvector(v, bf16x2_cv); return __builtin_bit_cast(unsigned, r); }
typedef float f32x2 __attribute__((ext_vector_type(2)));
__device__ __forceinline__ u32x4 pack8(const f32x4 v0, const f32x4 v1) { u32x4 w; w.x = cvt_pk_bf16(v0[0], v0[1]); w.y = cvt_pk_bf16(v0[2], v0[3]); w.z = cvt_pk_bf16(v1[0], v1[1]); w.w = cvt_pk_bf16(v1[2], v1[3]); return w; }

struct EpiQKV {
    static constexpr bool PERM = true, AFTER_DRAIN = false;
    bf16_t* O; size_t split_stride; float qscale;
    __device__ __forceinline__ void operator()(const f32x4 (&acc)[2][2][4][2], const Unit& u, int wr, int wc, int fr, int fq) const {
        const int row0 = u.pm * BM + wr * 64 + fr; const int t = u.pn >> 3; const int col0 = (u.pn & 7) * BM + wc * 32 + 8 * fq;
        bf16_t* base = O + (size_t)t * split_stride; const float sc = (t == 0) ? qscale : 1.f;
#pragma unroll
        for (int ai = 0; ai < 2; ++ai)
#pragma unroll
            for (int m = 0; m < 4; ++m) { bf16_t* rowp = base + (size_t)(row0 + ai * HALF + m * 16) * 2048 + col0;
#pragma unroll
                for (int bj = 0; bj < 2; ++bj) *(u32x4*)(rowp + bj * HALF) = pack8(acc[ai][bj][m][0] * sc, acc[ai][bj][m][1] * sc); }
    }
};
struct EpiResid {
    static constexpr bool PERM = false, AFTER_DRAIN = false;
    const float* base; float* out; const float* gate; int gstride;
    __device__ __forceinline__ void operator()(const f32x4 (&acc)[2][2][4][2], const Unit& u, int wr, int wc, int fr, int fq) const {
        const int row0 = u.pm * BM + wr * 64 + fr, col0 = u.pn * BM + wc * 32 + 4 * fq;
        const float* gp = gate + (size_t)((u.pm * BM) >> 11) * gstride + col0;
        f32x4 gv[2][2];
#pragma unroll
        for (int bj = 0; bj < 2; ++bj)
#pragma unroll
            for (int n = 0; n < 2; ++n) gv[bj][n] = *(const f32x4*)(gp + bj * HALF + n * 16);
#pragma unroll
        for (int ai = 0; ai < 2; ++ai)
#pragma unroll
            for (int m = 0; m < 4; ++m) { const size_t off = (size_t)(row0 + ai * HALF + m * 16) * 2048 + col0;
#pragma unroll
                for (int bj = 0; bj < 2; ++bj)
#pragma unroll
                    for (int n = 0; n < 2; ++n) { const f32x4 bs = *(const f32x4*)(base + off + bj * HALF + n * 16); *(f32x4*)(out + off + bj * HALF + n * 16) = bs + gv[bj][n] * acc[ai][bj][m][n]; }
                asm volatile("" ::: "memory"); }
    }
};
struct EpiSwiglu {
    static constexpr bool PERM = true, AFTER_DRAIN = false;
    bf16_t* O;
    __device__ __forceinline__ static float silu(float x) { return x * __builtin_amdgcn_rcpf(1.0f + __builtin_amdgcn_exp2f(-1.44269504f * x)); }
    __device__ __forceinline__ void operator()(const f32x4 (&acc)[2][2][4][2], const Unit& u, int wr, int wc, int fr, int fq) const {
        const int row0 = u.pm * BM + wr * 64 + fr; const int col0 = u.pn * HALF + wc * 32 + 8 * fq;
#pragma unroll
        for (int ai = 0; ai < 2; ++ai)
#pragma unroll
            for (int m = 0; m < 4; ++m) { bf16_t* rowp = O + (size_t)(row0 + ai * HALF + m * 16) * 5632 + col0;
                f32x4 v0, v1;
#pragma unroll
                for (int j = 0; j < 4; ++j) { v0[j] = silu(acc[ai][0][m][0][j]) * acc[ai][1][m][0][j]; v1[j] = silu(acc[ai][0][m][1][j]) * acc[ai][1][m][1][j]; }
                *(u32x4*)rowp = pack8(v0, v1); }
    }
};
struct EpiDsaProj {
    static constexpr bool PERM = true, AFTER_DRAIN = false;
    bf16_t* Q; float* CKVR; bf16_t* QI; bf16_t* KI; float* WI;
    __device__ __forceinline__ void operator()(const f32x4 (&acc)[2][2][4][2], const Unit& u, int wr, int wc, int fr, int fq) const {
        const int row0 = u.pm * BM + wr * 64 + fr; const int lc0 = wc * 32 + 8 * fq;
        if (u.pn < 8 || (u.pn >= 9 && u.pn < 17)) {
            bf16_t* base = (u.pn < 8) ? Q : QI; const int col0 = ((u.pn < 8) ? u.pn : (u.pn - 9)) * BM + lc0;
#pragma unroll
            for (int ai = 0; ai < 2; ++ai)
#pragma unroll
                for (int m = 0; m < 4; ++m) { bf16_t* rowp = base + (size_t)(row0 + ai * HALF + m * 16) * 2048 + col0;
#pragma unroll
                    for (int bj = 0; bj < 2; ++bj) *(u32x4*)(rowp + bj * HALF) = pack8(acc[ai][bj][m][0], acc[ai][bj][m][1]); }
        } else if (u.pn == 8) {
#pragma unroll
            for (int ai = 0; ai < 2; ++ai)
#pragma unroll
                for (int m = 0; m < 4; ++m) { float* rowp = CKVR + (size_t)(row0 + ai * HALF + m * 16) * 256 + lc0;
#pragma unroll
                    for (int bj = 0; bj < 2; ++bj) { *(f32x4*)(rowp + bj * HALF) = acc[ai][bj][m][0]; *(f32x4*)(rowp + bj * HALF + 4) = acc[ai][bj][m][1]; } }
        } else {
#pragma unroll
            for (int ai = 0; ai < 2; ++ai)
#pragma unroll
                for (int m = 0; m < 4; ++m) { const size_t r = (size_t)(row0 + ai * HALF + m * 16);
                    *(u32x4*)(KI + r * 128 + lc0) = pack8(acc[ai][0][m][0], acc[ai][0][m][1]);
                    if (lc0 < 16) { *(f32x4*)(WI + r * 16 + lc0) = acc[ai][1][m][0]; *(f32x4*)(WI + r * 16 + lc0 + 4) = acc[ai][1][m][1]; } }
        }
    }
};
template <class Epi, class Sched, bool ALIGN_EPI = false, bool SP2 = false>
__device__ __forceinline__ void gemm_phase(PG8_LAS unsigned char* lds, const Gemm g, const Sched& S, const Epi& E) {
    int tid_ = threadIdx.x; asm volatile("" : "+v"(tid_));
    const int tid = tid_, wid = __builtin_amdgcn_readfirstlane(tid >> 6), lane = tid & 63, wr = wid >> 2, wc = wid & 3, fr = lane & 15, fq = lane >> 4;
    const int K = g.K, nt = K / BK;
    unsigned voffA[2], voffB[2];
#pragma unroll
    for (int i = 0; i < 2; ++i) { int R, C; stage_rc(tid * 16 + i * 8192, R, C); const int Rb = Epi::PERM ? ((R & ~31) + perm32(R & 31)) : R;
        voffA[i] = (unsigned)(R * K + C) * 2u; voffB[i] = (unsigned)(Rb * K + C) * 2u; }
    const size_t kstep = (size_t)(BK * 2);
    const size_t hstep = (size_t)HALF * K * 2;
    const size_t tstep = 2 * hstep;
    const unsigned ldsw = (unsigned)wid * 1024u;
    const int aoff = lds_byte(wr * 64 + fr, fq * 8), boff = lds_byte(wc * 32 + fr, fq * 8);
#define PG8_SA(b, h) (((b) * 2 + (h)) * HTB)
#define PG8_SB(b, h) ((4 + (b) * 2 + (h)) * HTB)
#define PG8_STAGE(bufoff, gbase, voff) do { _Pragma("unroll") for (int _i = 0; _i < 2; ++_i) \
        __builtin_amdgcn_global_load_lds((const unsigned*)((const char*)(gbase) + (voff)[_i]), (PG8_LAS unsigned*)(lds + (bufoff) + ldsw + _i * 8192), 16, 0, 0); } while (0)
#define PG8_LDA(dst, b, h) do { _Pragma("unroll") for (int m = 0; m < 4; ++m) _Pragma("unroll") for (int k = 0; k < 2; ++k) dst[m][k] = *(const PG8_LAS bf16x8*)(lds + PG8_SA(b, h) + aoff + m * 2048 + k * 1024); } while (0)
#define PG8_LDB(dst, b, h) do { _Pragma("unroll") for (int n = 0; n < 2; ++n) _Pragma("unroll") for (int k = 0; k < 2; ++k) dst[n][k] = *(const PG8_LAS bf16x8*)(lds + PG8_SB(b, h) + boff + n * 2048 + k * 1024); } while (0)
#define PG8_MMA(ai, bj, At, Bt) do { __builtin_amdgcn_s_setprio(1); _Pragma("unroll") for (int m = 0; m < 4; ++m) _Pragma("unroll") for (int n = 0; n < 2; ++n) _Pragma("unroll") for (int k = 0; k < 2; ++k) \
        acc[ai][bj][m][n] = __builtin_amdgcn_mfma_f32_16x16x32_bf16(Bt[n][k], At[m][k], acc[ai][bj][m][n], 0, 0, 0); __builtin_amdgcn_s_setprio(0); } while (0)
#define PG8_WAIT_V(n) asm volatile("s_waitcnt vmcnt(" #n ")" ::: "memory")
#define PG8_WAIT_L(n) asm volatile("s_waitcnt lgkmcnt(" #n ")" ::: "memory")
#define PG8_BAR __builtin_amdgcn_s_barrier()
#define PG8_SCHED __builtin_amdgcn_sched_barrier(0)
    Unit cur, nxt; int ui = 0;
    if (!S.next(0, cur)) return;
    f32x4 acc[2][2][4][2];
#pragma unroll
    for (int a = 0; a < 2; ++a)
#pragma unroll
        for (int b = 0; b < 2; ++b)
#pragma unroll
            for (int m = 0; m < 4; ++m)
#pragma unroll
                for (int n = 0; n < 2; ++n) acc[a][b][m][n] = (f32x4){0.f, 0.f, 0.f, 0.f};
    bf16x8 At[4][2], B0[2][2], B1[2][2];
    const char* cA = (const char*)g.A + (size_t)cur.pm * tstep; const char* cB = (const char*)g.Bt + (size_t)cur.pn * tstep;
    S.a_ready(cur);
    if constexpr (SP2) {
        PG8_STAGE(PG8_SB(0, 0), cB, voffB); PG8_STAGE(PG8_SB(0, 1), cB + hstep, voffB); PG8_STAGE(PG8_SA(0, 0), cA, voffA); PG8_STAGE(PG8_SA(0, 1), cA + hstep, voffA);
        if (wr == 1) PG8_BAR;
        PG8_WAIT_V(2); PG8_BAR;
        PG8_STAGE(PG8_SB(1, 0), cB + kstep, voffB); PG8_STAGE(PG8_SA(1, 0), cA + kstep, voffA); PG8_STAGE(PG8_SB(1, 1), cB + hstep + kstep, voffB);
        PG8_WAIT_V(6); PG8_BAR;
    } else {
        PG8_STAGE(PG8_SB(0, 0), cB, voffB); PG8_STAGE(PG8_SA(0, 0), cA, voffA); PG8_STAGE(PG8_SB(0, 1), cB + hstep, voffB); PG8_STAGE(PG8_SA(0, 1), cA + hstep, voffA);
        if (wr == 1) PG8_BAR;
        PG8_WAIT_V(4); PG8_BAR;
        PG8_STAGE(PG8_SB(1, 0), cB + kstep, voffB); PG8_STAGE(PG8_SA(1, 0), cA + kstep, voffA); PG8_STAGE(PG8_SB(1, 1), cB + hstep + kstep, voffB);
        PG8_WAIT_V(6); PG8_BAR;
    }
    for (;;) {
        const bool has_next = S.next(ui + 1, nxt);
        const char* nA = has_next ? (const char*)g.A + (size_t)nxt.pm * tstep : cA; const char* nB = has_next ? (const char*)g.Bt + (size_t)nxt.pn * tstep : cB;
        for (int t = 0; t < nt; t += 2) {
            const bool last = (t == nt - 2);
            const char* a1 = cA + (size_t)(t + 1) * kstep;
            const char* a2 = last ? nA : cA + (size_t)(t + 2) * kstep; const char* b2 = last ? nB : cB + (size_t)(t + 2) * kstep;
            const char* a3 = a2 + kstep; const char* b3 = b2 + kstep;
            if (last && has_next) S.a_ready(nxt);
            if constexpr (SP2) {
            PG8_LDB(B0, 0, 0); PG8_LDB(B1, 0, 1); PG8_SCHED; PG8_LDA(At, 0, 0); PG8_STAGE(PG8_SA(1, 1), a1 + hstep, voffA);
            PG8_WAIT_V(8); PG8_WAIT_L(0); PG8_BAR; PG8_MMA(0, 0, At, B0); PG8_MMA(0, 1, At, B1); PG8_BAR; PG8_SCHED;
            PG8_LDA(At, 0, 1); PG8_STAGE(PG8_SB(0, 0), b2, voffB); PG8_STAGE(PG8_SB(0, 1), b2 + hstep, voffB); PG8_STAGE(PG8_SA(0, 0), a2, voffA);
            PG8_WAIT_V(8); PG8_WAIT_L(0); PG8_BAR; PG8_MMA(1, 0, At, B0); PG8_MMA(1, 1, At, B1); PG8_BAR; PG8_SCHED;
            PG8_LDB(B0, 1, 0); PG8_LDB(B1, 1, 1); PG8_SCHED; PG8_LDA(At, 1, 0); PG8_STAGE(PG8_SA(0, 1), a2 + hstep, voffA);
            PG8_WAIT_V(8); PG8_WAIT_L(0); PG8_BAR; PG8_MMA(0, 0, At, B0); PG8_MMA(0, 1, At, B1); PG8_BAR; PG8_SCHED;
            PG8_LDA(At, 1, 1); PG8_STAGE(PG8_SB(1, 0), b3, voffB); PG8_STAGE(PG8_SB(1, 1), b3 + hstep, voffB); PG8_STAGE(PG8_SA(1, 0), a3, voffA);
            PG8_WAIT_V(8); PG8_WAIT_L(0); PG8_BAR; PG8_MMA(1, 0, At, B0); PG8_MMA(1, 1, At, B1); PG8_BAR; PG8_SCHED;
            } else {
            PG8_LDB(B0, 0, 0); PG8_SCHED; PG8_LDA(At, 0, 0); PG8_STAGE(PG8_SA(1, 1), a1 + hstep, voffA);
            PG8_WAIT_L(8); PG8_BAR; PG8_WAIT_L(0); PG8_MMA(0, 0, At, B0); PG8_BAR; PG8_SCHED;
            PG8_LDB(B1, 0, 1); PG8_STAGE(PG8_SB(0, 0), b2, voffB);
            PG8_BAR; PG8_WAIT_L(0); PG8_MMA(0, 1, At, B1); PG8_BAR;
            PG8_LDA(At, 0, 1); PG8_STAGE(PG8_SA(0, 0), a2, voffA);
            PG8_BAR; PG8_WAIT_L(0); PG8_MMA(1, 0, At, B0); PG8_BAR; PG8_SCHED;
            PG8_STAGE(PG8_SB(0, 1), b2 + hstep, voffB);
            PG8_WAIT_V(6); PG8_BAR; PG8_MMA(1, 1, At, B1); PG8_BAR;
            PG8_LDB(B0, 1, 0); PG8_SCHED; PG8_LDA(At, 1, 0); PG8_STAGE(PG8_SA(0, 1), a2 + hstep, voffA);
            PG8_WAIT_L(8); PG8_BAR; PG8_WAIT_L(0); PG8_MMA(0, 0, At, B0); PG8_BAR; PG8_SCHED;
            PG8_LDB(B1, 1, 1); PG8_STAGE(PG8_SB(1, 0), b3, voffB);
            PG8_BAR; PG8_WAIT_L(0); PG8_MMA(0, 1, At, B1); PG8_BAR;
            PG8_LDA(At, 1, 1); PG8_STAGE(PG8_SA(1, 0), a3, voffA);
            PG8_BAR; PG8_WAIT_L(0); PG8_MMA(1, 0, At, B0); PG8_BAR; PG8_SCHED;
            PG8_STAGE(PG8_SB(1, 1), b3 + hstep, voffB);
            PG8_WAIT_V(6); PG8_BAR; PG8_MMA(1, 1, At, B1); PG8_BAR;
            }
        }
        if constexpr (ALIGN_EPI) { if (wr == 0) PG8_BAR; }
        if constexpr (!Epi::AFTER_DRAIN) { E(acc, cur, wr, wc, fr, fq); S.done(cur); }
        if (!has_next) break;
#pragma unroll
        for (int a = 0; a < 2; ++a)
#pragma unroll
            for (int b = 0; b < 2; ++b)
#pragma unroll
                for (int m = 0; m < 4; ++m)
#pragma unroll
                    for (int n = 0; n < 2; ++n) acc[a][b][m][n] = (f32x4){0.f, 0.f, 0.f, 0.f};
        cur = nxt; cA = nA; cB = nB; ++ui;
        if constexpr (ALIGN_EPI) { if (wr == 1) PG8_BAR; }
    }
    PG8_WAIT_V(0);
    if constexpr (!ALIGN_EPI) { if (wr == 0) PG8_BAR; }
    PG8_BAR;
    if constexpr (Epi::AFTER_DRAIN) { E.fused(acc, cur, wr, wc, fr, fq, lds, wid, lane); S.done(cur); }
#undef PG8_SA
#undef PG8_SB
#undef PG8_STAGE
#undef PG8_LDA
#undef PG8_LDB
#undef PG8_MMA
#undef PG8_WAIT_V
#undef PG8_WAIT_L
#undef PG8_BAR
#undef PG8_SCHED
}
}
#ifndef PG8_SP2
#define PG8_SP2 true
#endif
#ifndef PG8_ALIGN
#define PG8_ALIGN true
#endif
#ifndef MK_MULTI
#define MK_MULTI 0
#endif

constexpr int NWAVES = 8;
constexpr int BATCH = 8, SEQ = 2048, D = 2048, M = BATCH * SEQ, NH = 16, HD = 128, DFF = 5632, KVL = 256, TOPK = 256, DEPTH = 4;
constexpr int NIN_A = 6144, NIN_B = 4496, NIN_BP = 4608, NMOD = 6 * D;
constexpr float EPS = 1e-6f;
constexpr float LOG2E = 1.4426950408889634f;
constexpr float QSCALE = 0.08838834764831845f * LOG2E;

constexpr size_t MiB = 1u << 20;
constexpr size_t WS_CTL = 0, CTL_ZERO_BYTES = 1 * MiB;
constexpr size_t WS_MOD = 1 * MiB;
constexpr size_t WS_W = 4 * MiB, W_LAYER = 100 * MiB;
constexpr size_t WO_IN = 0, WO_OUT = 24 * MiB, WO_GU = 32 * MiB, WO_DN = 76 * MiB, WO_UK = 98 * MiB, WO_UV = 99 * MiB;
constexpr size_t WS_H = 404 * MiB;
constexpr size_t WS_R1 = 468 * MiB;
constexpr size_t WS_ATT = 660 * MiB;
constexpr size_t WS_R2 = 724 * MiB;
constexpr size_t WS_END = 900 * MiB;
constexpr size_t R1_Q = 0, R1_QI = 64 * MiB, R1_OLAT = 0, R1_CKVR = 128 * MiB, R1_KI = 144 * MiB, R1_WI = 148 * MiB, R1_CKV = 149 * MiB, R1_SEL = 157 * MiB;
constexpr int CW_BAR = 4096;

constexpr int RING_BYTES = 139264;
constexpr int MISC_OFF = RING_BYTES;
constexpr int LDS_BYTES = RING_BYTES + 256;

#define GAS __attribute__((address_space(1)))
#define LAS __attribute__((address_space(3)))
typedef unsigned short bf16;
typedef unsigned short u16;
typedef unsigned v4u __attribute__((ext_vector_type(4)));
typedef unsigned v2u __attribute__((ext_vector_type(2)));
typedef float f32x4 __attribute__((ext_vector_type(4)));
typedef short bf16x8 __attribute__((ext_vector_type(8)));
typedef short s16x4 __attribute__((ext_vector_type(4)));
typedef short v4i16_t __attribute__((ext_vector_type(4)));
typedef GAS unsigned gu32;
template <class T> __device__ __forceinline__ T* as_global(T* p) { return (T*)(GAS T*)p; }
#define RLX_AGENT __ATOMIC_RELAXED, __HIP_MEMORY_SCOPE_AGENT
#define LDS_WAIT() asm volatile("s_waitcnt lgkmcnt(0)" ::: "memory")
#define VM_WAIT() asm volatile("s_waitcnt vmcnt(0)" ::: "memory")
__device__ __forceinline__ unsigned cvtpk(float lo, float hi) { return pg8::cvt_pk_bf16(lo, hi); }
__device__ __forceinline__ float wave_sum(float v) {
#pragma unroll
    for (int o = 1; o < 64; o <<= 1) v += __shfl_xor(v, o);
    return v;
}
__device__ __forceinline__ s16x4 tr_read(LAS const unsigned char* p) { return __builtin_bit_cast(s16x4, __builtin_amdgcn_ds_read_tr16_b64_v4i16((LAS v4i16_t*)p)); }
__device__ __forceinline__ bf16x8 cat8(s16x4 a, s16x4 b) { bf16x8 r; r[0] = a[0]; r[1] = a[1]; r[2] = a[2]; r[3] = a[3]; r[4] = b[0]; r[5] = b[1]; r[6] = b[2]; r[7] = b[3]; return r; }
__device__ __forceinline__ unsigned mbcnt64(unsigned long long m) { return __builtin_amdgcn_mbcnt_hi((unsigned)(m >> 32), __builtin_amdgcn_mbcnt_lo((unsigned)m, 0u)); }

#define XB_TMO      128
#define XB_XCNT(j)  (256  + 64 * (j))
#define XB_XSUB(j)  (1280 + 64 * (j))
#define XB_XGEN(j)  (2304 + 64 * (j))
#define XB_TOP      3328
#define XB_TOPGEN   3392
#define XCD_BAR_WORDS 3456
#define XB_SPIN_CAP (1u << 18)

__device__ __forceinline__ unsigned xb_ld(unsigned* p)              { return __hip_atomic_load(p, __ATOMIC_RELAXED, __HIP_MEMORY_SCOPE_AGENT); }
__device__ __forceinline__ unsigned xb_add(unsigned* p, unsigned v) { return __hip_atomic_fetch_add(p, v, __ATOMIC_RELAXED, __HIP_MEMORY_SCOPE_AGENT); }
__device__ __forceinline__ unsigned xb_xcc_id() { return (unsigned)__builtin_amdgcn_s_getreg((3 << 11) | 20) & 0xFu; }
#define XB_SPIN(cond, bar) do { unsigned _sp = 0; while (cond) { __builtin_amdgcn_s_sleep(1); \
    if ((++_sp & 255u) == 0u) { if (xb_ld(&(bar)[XB_TMO])) break; if (_sp > XB_SPIN_CAP) { atomicAdd(&(bar)[XB_TMO], 1u); break; } } } } while (0)

struct XcdBarrier {
    unsigned* bar; unsigned x;
    volatile LAS unsigned* st;
};

__device__ __forceinline__ XcdBarrier xcd_barrier_post(unsigned* bar, volatile LAS unsigned* st) {
    XcdBarrier b; b.bar = bar; b.x = xb_xcc_id(); b.st = st;
    if (threadIdx.x == 0) (void)xb_add(&bar[XB_XCNT(b.x)], 1u);
    return b;
}
__device__ __forceinline__ void xcd_barrier_complete(unsigned* bar, unsigned x, unsigned& nloc, unsigned& nx) {
    const unsigned G = gridDim.x * gridDim.y * gridDim.z;
    unsigned sum, cnt, mine, sp = 0u;
    for (;;) {
        sum = 0u; cnt = 0u; mine = 0u;
#pragma unroll
        for (unsigned j = 0; j < 16; ++j) { const unsigned c = xb_ld(&bar[XB_XCNT(j)]); sum += c; cnt += (c > 0u) ? 1u : 0u; mine = (j == x) ? c : mine; }
        if (sum == G) break;
        __builtin_amdgcn_s_sleep(1);
        if ((++sp & 255u) == 0u) { if (xb_ld(&bar[XB_TMO])) break; if (sp > XB_SPIN_CAP) { atomicAdd(&bar[XB_TMO], 1u); break; } }
    }
    nloc = mine > 0u ? mine : 1u; nx = cnt > 0u ? cnt : 1u;
}

__device__ __forceinline__ void xcd_barrier(const XcdBarrier& b) {
    asm volatile("s_waitcnt vmcnt(0)" ::: "memory");
    __syncthreads();
    if (threadIdx.x == 0) {
        unsigned* bar = b.bar;
        __builtin_amdgcn_s_waitcnt(0);
        unsigned nloc = b.st[0], nx = b.st[1];
        if (nloc == 0u) { xcd_barrier_complete(bar, b.x, nloc, nx); b.st[0] = nloc; b.st[1] = nx; }
        const unsigned old = xb_add(&bar[XB_XSUB(b.x)], 1u);
        const unsigned gen = old / nloc;
        if (old + 1u == (gen + 1u) * nloc) {
            __builtin_amdgcn_fence(__ATOMIC_RELEASE, "agent");
            asm volatile("s_waitcnt vmcnt(0)" ::: "memory");
            const unsigned og = xb_add(&bar[XB_TOP], 1u);
            const unsigned tg = og / nx;
            if (og + 1u == (tg + 1u) * nx) xb_add(&bar[XB_TOPGEN], 1u);
            else XB_SPIN(xb_ld(&bar[XB_TOPGEN]) == tg, bar);
            __builtin_amdgcn_fence(__ATOMIC_ACQUIRE, "agent");
            xb_add(&bar[XB_XGEN(b.x)], 1u);
            asm volatile("s_waitcnt vmcnt(0)" ::: "memory");
        } else {
            XB_SPIN(xb_ld(&bar[XB_XGEN(b.x)]) == gen, bar);
            __builtin_amdgcn_fence(__ATOMIC_ACQUIRE, "agent");
            asm volatile("s_waitcnt vmcnt(0)" ::: "memory");
        }
    }
    __syncthreads();
}
struct LayerW { const float *norm_attn, *ada_w, *ada_b, *w_in, *kv_norm, *w_uk, *w_uv, *w_out, *norm_ffn, *w_gu, *w_down; };
struct Args { const float* x; const float* c; const float* final_norm; LayerW L[DEPTH]; float* out; unsigned char* ws; int ph_lo, ph_hi; };

__device__ __forceinline__ void tr_item(const float* W, int ldw, int srccol0, int nvalid, int k0, bf16* WT, int K, int destrow0, LAS float* scr, int lane) {
    const int n = lane & 31;
#pragma unroll 8
    for (int i = 0; i < 32; ++i) { const int kk = 2 * i + (lane >> 5); float v = 0.f; if (n < nvalid) v = W[(size_t)(k0 + kk) * ldw + srccol0 + n]; scr[kk * 33 + n] = v; }
    LDS_WAIT(); asm volatile("" ::: "memory");
    const int c = lane & 7;
#pragma unroll
    for (int j = 0; j < 4; ++j) { const int nn = (lane >> 3) + 8 * j; const LAS float* s = scr + (8 * c) * 33 + nn;
        v4u o; o.x = cvtpk(s[0 * 33], s[1 * 33]); o.y = cvtpk(s[2 * 33], s[3 * 33]); o.z = cvtpk(s[4 * 33], s[5 * 33]); o.w = cvtpk(s[6 * 33], s[7 * 33]);
        *(v4u*)(WT + (size_t)(destrow0 + nn) * K + k0 + 8 * c) = o; }
    LDS_WAIT(); asm volatile("" ::: "memory");
}
__device__ __forceinline__ void tr_plain(const float* W, int K, int N, int Ndest, bf16* WT, int item, LAS float* scr, int lane) {
    const int nnb = Ndest / 32, kb = item / nnb, nb = item % nnb, n0 = 32 * nb; int nv = N - n0; nv = nv < 0 ? 0 : (nv > 32 ? 32 : nv);
    tr_item(W, N, n0, nv, 64 * kb, WT, K, n0, scr, lane);
}
__device__ __forceinline__ void tr_gu(const float* W, bf16* WT, int item, LAS float* scr, int lane) {
    const int nnb = (2 * DFF) / 32, kb = item / nnb, nb = item % nnb, n0 = 32 * nb, pn = n0 >> 8, lc = n0 & 255;
    const int src = ((lc < 128) ? 0 : DFF) + 128 * pn + (lc & 127);
    tr_item(W, 2 * DFF, src, 32, 64 * kb, WT, D, n0, scr, lane);
}
constexpr int IT_INA = (D / 64) * (NIN_A / 32), IT_INB = (D / 64) * (NIN_BP / 32), IT_OUT = (D / 64) * (D / 32), IT_GU = (D / 64) * (2 * DFF / 32), IT_DN = (DFF / 64) * (D / 32), IT_UK = 16 * 16, IT_UV = 16 * 16;
constexpr int IT_DIL = IT_INA + IT_OUT + IT_GU + IT_DN, IT_DSA = IT_INB + IT_OUT + IT_GU + IT_DN + IT_UK + IT_UV;
constexpr int IT_ALL = 2 * IT_DIL + 2 * IT_DSA;

__device__ __forceinline__ void p0_transposes(const Args& a, LAS unsigned char* lds, int gw, int NGW, int wave, int lane) {
    LAS float* scr = (LAS float*)(lds + wave * 8704);
    for (int it = gw; it < IT_ALL; it += NGW) {
        int r = it; int l;
        if (r < IT_DIL) l = 0; else { r -= IT_DIL; if (r < IT_DSA) l = 1; else { r -= IT_DSA; if (r < IT_DIL) l = 2; else { r -= IT_DIL; l = 3; } } }
        const LayerW& w = a.L[l]; unsigned char* wb = as_global(a.ws) + WS_W + (size_t)l * W_LAYER;
        if (!(l & 1)) { if (r < IT_INA) { tr_plain(as_global(w.w_in), D, NIN_A, NIN_A, (bf16*)(wb + WO_IN), r, scr, lane); continue; } r -= IT_INA; }
        else { if (r < IT_INB) { tr_plain(as_global(w.w_in), D, NIN_B, NIN_BP, (bf16*)(wb + WO_IN), r, scr, lane); continue; } r -= IT_INB; }
        if (r < IT_OUT) { tr_plain(as_global(w.w_out), D, D, D, (bf16*)(wb + WO_OUT), r, scr, lane); continue; } r -= IT_OUT;
        if (r < IT_GU) { tr_gu(as_global(w.w_gu), (bf16*)(wb + WO_GU), r, scr, lane); continue; } r -= IT_GU;
        if (r < IT_DN) { tr_plain(as_global(w.w_down), DFF, D, D, (bf16*)(wb + WO_DN), r, scr, lane); continue; } r -= IT_DN;
        if (r < IT_UK) { const int h = r >> 4; tr_plain(as_global(w.w_uk) + (size_t)h * HD * KVL, HD, KVL, KVL, (bf16*)(wb + WO_UK) + (size_t)h * KVL * HD, r & 15, scr, lane); continue; } r -= IT_UK;
        { const int h = r >> 4; tr_plain(as_global(w.w_uv) + (size_t)h * KVL * HD, KVL, HD, HD, (bf16*)(wb + WO_UV) + (size_t)h * HD * KVL, r & 15, scr, lane); }
    }
}
constexpr int SC_STRIDE = 2112;
__device__ __forceinline__ void p0_adaln(const Args& a, LAS unsigned char* lds, int G, int tid, int wave, int lane) {
    LAS float* sc = (LAS float*)lds;
    LAS float* red = (LAS float*)(lds + 8 * SC_STRIDE * 4);
    float* mod = (float*)(as_global(a.ws) + WS_MOD); const float* cin = as_global(a.c);
    for (int i = tid; i < BATCH * D; i += NWAVES * 64) { const int b = i >> 11, k = i & 2047; const float v = cin[i]; sc[b * SC_STRIDE + k + (k >> 6)] = v / (1.0f + __expf(-v)); }
    __syncthreads();
    const int cg = tid & 15, ks = tid >> 4;
    for (int u = blockIdx.x; u < DEPTH * (NMOD / 64); u += G) {
        const int l = u / (NMOD / 64), col0 = 64 * (u % (NMOD / 64));
        const float* wp = as_global(a.L[l].ada_w) + (size_t)(64 * ks) * NMOD + col0 + 4 * cg;
        f32x4 acc[8];
#pragma unroll
        for (int b = 0; b < 8; ++b) acc[b] = (f32x4){0.f, 0.f, 0.f, 0.f};
#pragma unroll 4
        for (int kk = 0; kk < 64; ++kk) { const f32x4 w4 = *(const f32x4*)(wp + (size_t)kk * NMOD); const int kx = 64 * ks + kk + ks;
#pragma unroll
            for (int b = 0; b < 8; ++b) acc[b] += sc[b * SC_STRIDE + kx] * w4; }
#pragma unroll
        for (int b = 0; b < 8; ++b)
#pragma unroll
            for (int j = 0; j < 4; ++j) { float v = acc[b][j]; v += __shfl_xor(v, 16); v += __shfl_xor(v, 32); acc[b][j] = v; }
        if (lane < 16) {
#pragma unroll
            for (int b = 0; b < 8; ++b) *(LAS f32x4*)(red + (wave * 8 + b) * 64 + 4 * cg) = acc[b]; }
        __syncthreads();
        { const int b = tid >> 6, col = tid & 63; float s = as_global(a.L[l].ada_b)[col0 + col];
#pragma unroll
          for (int w = 0; w < 8; ++w) s += red[(w * 8 + b) * 64 + col];
          mod[((size_t)l * BATCH + b) * NMOD + col0 + col] = s; }
        __syncthreads();
    }
}
__device__ __forceinline__ void norm_mod_phase(const float* x, const float* gain, const float* shift, const float* scale, bf16* h, int gw, int NGW, int lane) {
    for (int grp = gw; grp < M / 8; grp += NGW) {
        const int b = (grp * 8) >> 11;
        f32x4 A[8], B[8];
#pragma unroll
        for (int j = 0; j < 4; ++j)
#pragma unroll
            for (int e = 0; e < 2; ++e) { const int col = 8 * lane + 512 * j + 4 * e;
                const f32x4 g = *(const f32x4*)(gain + col), sc = *(const f32x4*)(scale + (size_t)b * NMOD + col); A[2 * j + e] = g * (sc + 1.0f); B[2 * j + e] = *(const f32x4*)(shift + (size_t)b * NMOD + col); }
        for (int rr = 0; rr < 8; ++rr) { const size_t row = (size_t)grp * 8 + rr; const float* xr = x + row * D;
            f32x4 v[8]; float ss = 0.f;
#pragma unroll
            for (int j = 0; j < 4; ++j)
#pragma unroll
                for (int e = 0; e < 2; ++e) { const f32x4 t = *(const f32x4*)(xr + 8 * lane + 512 * j + 4 * e); v[2 * j + e] = t; ss += (t[0] * t[0] + t[1] * t[1]) + (t[2] * t[2] + t[3] * t[3]); }
            const float rstd = __builtin_amdgcn_rsqf(wave_sum(ss) * (1.0f / D) + EPS);
#pragma unroll
            for (int j = 0; j < 4; ++j) { const f32x4 y0 = v[2 * j] * rstd * A[2 * j] + B[2 * j], y1 = v[2 * j + 1] * rstd * A[2 * j + 1] + B[2 * j + 1];
                v4u o; o.x = cvtpk(y0[0], y0[1]); o.y = cvtpk(y0[2], y0[3]); o.z = cvtpk(y1[0], y1[1]); o.w = cvtpk(y1[2], y1[3]);
                *(v4u*)(h + row * D + 8 * lane + 512 * j) = o; }
        }
    }
}
__device__ __forceinline__ void final_norm_phase(float* x, const float* gain, int gw, int NGW, int lane) {
    for (int row = gw; row < M; row += NGW) { float* xr = x + (size_t)row * D;
        f32x4 v[8]; float ss = 0.f;
#pragma unroll
        for (int j = 0; j < 8; ++j) { const f32x4 t = *(const f32x4*)(xr + 4 * lane + 256 * j); v[j] = t; ss += (t[0] * t[0] + t[1] * t[1]) + (t[2] * t[2] + t[3] * t[3]); }
        const float tot = wave_sum(ss); const float rstd = __builtin_amdgcn_rsqf(tot * (1.0f / D) + EPS);
#pragma unroll
        for (int j = 0; j < 8; ++j) { const f32x4 g = *(const f32x4*)(gain + 4 * lane + 256 * j); f32x4 y = v[j] * rstd * g;
#ifdef DIAG_SANITIZE
            if (!(tot < 3.0e38f)) y = (f32x4){0.f, 0.f, 0.f, 0.f};
#endif
            *(f32x4*)(xr + 4 * lane + 256 * j) = y; }
    }
}
constexpr int VROW = 272;
__device__ __forceinline__ void dil_chunk(const bf16* Kb, const bf16* Vb, const bf16x8 (&qf)[4], float& m, float& l, f32x4 (&o)[8], LAS unsigned char* vl,
                                          int pbase, int pstride, int wmax, int par, int tq, float slope2, int lane) {
    const int i = lane & 15, g = lane >> 4;
#pragma unroll
    for (int it = 0; it < 8; ++it) { const int kr = 4 * it + g; int p = pbase + pstride * kr; p = p < 0 ? 0 : (p > SEQ - 1 ? SEQ - 1 : p);
        const v4u v = *(const v4u*)(Vb + (size_t)p * D + 8 * i); *(LAS v4u*)(vl + kr * VROW + 16 * i) = v; }
    f32x4 s[2];
#pragma unroll
    for (int T = 0; T < 2; ++T) { int p = pbase + pstride * (16 * T + i); p = p < 0 ? 0 : (p > SEQ - 1 ? SEQ - 1 : p); const bf16* kp = Kb + (size_t)p * D + 8 * g;
        f32x4 acc = (f32x4){0.f, 0.f, 0.f, 0.f};
#pragma unroll
        for (int kk = 0; kk < 4; ++kk) { const bf16x8 kf = *(const bf16x8*)(kp + 32 * kk); acc = __builtin_amdgcn_mfma_f32_16x16x32_bf16(kf, qf[kk], acc, 0, 0, 0); }
        s[T] = acc; }
    float cmax = -INFINITY;
#pragma unroll
    for (int T = 0; T < 2; ++T)
#pragma unroll
        for (int r = 0; r < 4; ++r) { const int p = pbase + pstride * (16 * T + 4 * g + r); const int dl = tq - p;
            const bool ok = (p >= 0) && (dl >= 0) && (dl <= wmax) && (par < 0 || (i & 1) == par);
            const float v = ok ? (s[T][r] - slope2 * (float)dl) : -INFINITY; s[T][r] = v; cmax = fmaxf(cmax, v); }
    cmax = fmaxf(cmax, __shfl_xor(cmax, 16)); cmax = fmaxf(cmax, __shfl_xor(cmax, 32));
    const float mn = fmaxf(m, cmax), alpha = __builtin_amdgcn_exp2f(m - mn); m = mn;
    float rs = 0.f;
#pragma unroll
    for (int T = 0; T < 2; ++T)
#pragma unroll
        for (int r = 0; r < 4; ++r) { const float pv = __builtin_amdgcn_exp2f(s[T][r] - mn); s[T][r] = pv; rs += pv; }
    rs += __shfl_xor(rs, 16); rs += __shfl_xor(rs, 32);
    l = l * alpha + rs;
    bf16x8 pf; { const unsigned a0 = cvtpk(s[0][0], s[0][1]), a1 = cvtpk(s[0][2], s[0][3]), a2 = cvtpk(s[1][0], s[1][1]), a3 = cvtpk(s[1][2], s[1][3]); const v4u t = (v4u){a0, a1, a2, a3}; pf = __builtin_bit_cast(bf16x8, t); }
    LDS_WAIT();
    const LAS unsigned char* vb = vl + (4 * g + (i >> 2)) * VROW + 8 * (i & 3);
#pragma unroll
    for (int c = 0; c < 8; ++c) { const s16x4 lo = tr_read(vb + 32 * c), hi = tr_read(vb + 16 * VROW + 32 * c);
        o[c] = o[c] * alpha; o[c] = __builtin_amdgcn_mfma_f32_16x16x32_bf16(cat8(lo, hi), pf, o[c], 0, 0, 0); }
}
__device__ __forceinline__ void dil_attn_unit(const bf16* Q, const bf16* K, const bf16* V, bf16* O, int b, int h, int qb, LAS unsigned char* vl, int w, int lane) {
    const int i = lane & 15, g = lane >> 4, t0 = qb * 128, tq = t0 + 8 * i + w;
    const size_t rb = (size_t)b * SEQ;
    const bf16* Kb = K + rb * D + h * HD; const bf16* Vb = V + rb * D + h * HD;
    bf16x8 qf[4];
#pragma unroll
    for (int kk = 0; kk < 4; ++kk) qf[kk] = *(const bf16x8*)(Q + (rb + tq) * D + h * HD + 32 * kk + 8 * g);
    float m = -1e30f, l = 0.f; f32x4 o[8];
#pragma unroll
    for (int c = 0; c < 8; ++c) o[c] = (f32x4){0.f, 0.f, 0.f, 0.f};
    const float slope2 = __builtin_amdgcn_exp2f(-0.5f * (float)(h + 1)) * LOG2E;
    { const int kb = t0 + w - 128;
      for (int c = 0; c < 8; ++c) { if (kb + 32 * c + 31 < 0) continue; dil_chunk(Kb, Vb, qf, m, l, o, vl, kb + 32 * c, 1, 128, -1, tq, slope2, lane); } }
    { const int kb = t0 + w - 512;
      for (int c = 0; c < 5; ++c) { if (kb + 4 * (32 * c + 31) < 0) continue; dil_chunk(Kb, Vb, qf, m, l, o, vl, kb + 128 * c, 4, 512, -1, tq, slope2, lane); } }
    { const int nch = ((t0 >> 4) + 8 + 31) >> 5;
      for (int e = 0; e < 2; ++e) for (int c = 0; c < nch; ++c) dil_chunk(Kb, Vb, qf, m, l, o, vl, w + 8 * e + 512 * c, 16, 4096, e, tq, slope2, lane); }
    const float inv = 1.0f / l;
    bf16* op = O + (rb + tq) * D + h * HD + 4 * g;
#pragma unroll
    for (int c = 0; c < 8; ++c) { v2u w2; w2.x = cvtpk(o[c][0] * inv, o[c][1] * inv); w2.y = cvtpk(o[c][2] * inv, o[c][3] * inv); *(v2u*)(op + 16 * c) = w2; }
}
__device__ __forceinline__ void dil_attn_phase(const bf16* Q, const bf16* K, const bf16* V, bf16* O, LAS unsigned char* lds, int vcu, int G, int wave, int lane) {
    LAS unsigned char* vl = lds + wave * (32 * VROW);
    for (int u = vcu; u < BATCH * NH * (SEQ / 128); u += G) { const int qb = u & 15, bh = u >> 4; dil_attn_unit(Q, K, V, O, bh >> 4, bh & 15, qb, vl, wave, lane); }
}

template <int KK  , int NT  , int TT  >
__device__ __forceinline__ void head_gemm(const bf16* X, int ldx, int xcol0, const bf16* WT, bf16* Out, int ldo, int ocol0, int tok0, float scale, int lane) {
    const int i = lane & 15, g = lane >> 4;
    bf16x8 xf[TT][KK];
#pragma unroll
    for (int tt = 0; tt < TT; ++tt)
#pragma unroll
        for (int kk = 0; kk < KK; ++kk) xf[tt][kk] = *(const bf16x8*)(X + (size_t)(tok0 + 16 * tt + i) * ldx + xcol0 + 32 * kk + 8 * g);
    for (int nt = 0; nt < NT; ++nt) {
        bf16x8 af[KK];
#pragma unroll
        for (int kk = 0; kk < KK; ++kk) af[kk] = *(const bf16x8*)(WT + (size_t)(16 * nt + i) * (32 * KK) + 32 * kk + 8 * g);
#pragma unroll
        for (int tt = 0; tt < TT; ++tt) { f32x4 acc = (f32x4){0.f, 0.f, 0.f, 0.f};
#pragma unroll
            for (int kk = 0; kk < KK; ++kk) acc = __builtin_amdgcn_mfma_f32_16x16x32_bf16(af[kk], xf[tt][kk], acc, 0, 0, 0);
            v2u w2; w2.x = cvtpk(acc[0] * scale, acc[1] * scale); w2.y = cvtpk(acc[2] * scale, acc[3] * scale);
            *(v2u*)(Out + (size_t)(tok0 + 16 * tt + i) * ldo + ocol0 + 16 * nt + 4 * g) = w2; }
    }
}
__device__ __forceinline__ void ckv_norm_phase(const float* raw, const float* gain, bf16* out, int gw, int NGW, int lane) {
    const f32x4 gv = *(const f32x4*)(gain + 4 * lane);
    for (int row = gw; row < M; row += NGW) { const f32x4 t = *(const f32x4*)(raw + (size_t)row * KVL + 4 * lane);
        const float ss = (t[0] * t[0] + t[1] * t[1]) + (t[2] * t[2] + t[3] * t[3]);
        const float rstd = __builtin_amdgcn_rsqf(wave_sum(ss) * (1.0f / KVL) + EPS); const f32x4 y = t * rstd * gv;
        v2u w2; w2.x = cvtpk(y[0], y[1]); w2.y = cvtpk(y[2], y[3]); *(v2u*)(out + (size_t)row * KVL + 4 * lane) = w2; }
}
__device__ __forceinline__ void dsa_index_query(const bf16* QI, const bf16* KI, const float* WI, u16* SEL, LAS float* sc, int b, int t, int lane) {
    const int i = lane & 15, g = lane >> 4; const size_t row = (size_t)b * SEQ + t;
    u16* selr = SEL + row * TOPK;
    if (t < TOPK) { for (int j = lane; j < TOPK; j += 64) selr[j] = (u16)(j <= t ? j : 0xFFFF); return; }
    bf16x8 af[4];
#pragma unroll
    for (int kk = 0; kk < 4; ++kk) af[kk] = *(const bf16x8*)(QI + row * D + i * 128 + 32 * kk + 8 * g);
    const f32x4 wv = *(const f32x4*)(WI + row * 16 + 4 * g);
    const int ntiles = (t >> 4) + 1;
    const bf16* kb = KI + ((size_t)b * SEQ + i) * 128 + 8 * g;
    for (int tile = 0; tile < ntiles; ++tile) { const bf16* kp = kb + (size_t)tile * 16 * 128;
        f32x4 acc = (f32x4){0.f, 0.f, 0.f, 0.f};
#pragma unroll
        for (int kk = 0; kk < 4; ++kk) { const bf16x8 bfr = *(const bf16x8*)(kp + 32 * kk); acc = __builtin_amdgcn_mfma_f32_16x16x32_bf16(af[kk], bfr, acc, 0, 0, 0); }
        float s = wv[0] * fmaxf(acc[0], 0.f) + wv[1] * fmaxf(acc[1], 0.f) + wv[2] * fmaxf(acc[2], 0.f) + wv[3] * fmaxf(acc[3], 0.f);
        s += __shfl_xor(s, 16); s += __shfl_xor(s, 32);
        if (g == 0) sc[16 * tile + i] = s; }
    LDS_WAIT(); asm volatile("" ::: "memory");
    unsigned key[32];
#pragma unroll
    for (int u = 0; u < 32; ++u) { const int idx = 64 * u + lane; const unsigned bits = __float_as_uint(sc[idx]); const unsigned k = (bits & 0x80000000u) ? ~bits : (bits | 0x80000000u); key[u] = (idx <= t) ? k : 0u; }
    unsigned prefix = 0u;
    for (int bit = 31; bit >= 0; --bit) { const unsigned cand = prefix | (1u << bit); int cnt = 0;
#pragma unroll
        for (int u = 0; u < 32; ++u) cnt += __popcll(__ballot(key[u] >= cand));
        if (cnt >= TOPK) prefix = cand; }
    int cgt = 0;
#pragma unroll
    for (int u = 0; u < 32; ++u) cgt += __popcll(__ballot(key[u] > prefix));
    const int need_eq = TOPK - cgt; int base = 0, eqb = 0;
#pragma unroll
    for (int u = 0; u < 32; ++u) { const bool gt = key[u] > prefix, eq = key[u] == prefix; const unsigned long long meq = __ballot(eq);
        const bool take = gt || (eq && (int)(eqb + mbcnt64(meq)) < need_eq); const unsigned long long mt = __ballot(take);
        if (take) selr[base + mbcnt64(mt)] = (u16)(64 * u + lane);
        base += __popcll(mt); eqb += __popcll(meq); }
    LDS_WAIT(); asm volatile("" ::: "memory");
}
constexpr int CROW = 528;
constexpr int DSA_WAVE_LDS = 32 * CROW + 512;
__device__ __forceinline__ void dsa_attn_query(const bf16* QL, const bf16* CKV, const u16* SEL, bf16* OL, LAS unsigned char* wl, int b, int t, int lane) {
    const int i = lane & 15, g = lane >> 4; const size_t row = (size_t)b * SEQ + t;
    LAS u16* sl = (LAS u16*)(wl + 32 * CROW);
    *(LAS v2u*)(sl + 4 * lane) = *(const v2u*)(SEL + row * TOPK + 4 * lane);
    bf16x8 bq[8];
#pragma unroll
    for (int kk = 0; kk < 8; ++kk) bq[kk] = *(const bf16x8*)(QL + row * (NH * KVL) + i * KVL + 32 * kk + 8 * g);
    const float slope2 = __builtin_amdgcn_exp2f(-0.5f * (float)(i + 1)) * LOG2E;
    float m = -1e30f, l = 0.f; f32x4 o[16];
#pragma unroll
    for (int c = 0; c < 16; ++c) o[c] = (f32x4){0.f, 0.f, 0.f, 0.f};
    const int nvalid = (t + 1) < TOPK ? (t + 1) : TOPK, nch = (nvalid + 31) >> 5;
    const bf16* cb = CKV + (size_t)b * SEQ * KVL;
    LDS_WAIT(); asm volatile("" ::: "memory");
    for (int c = 0; c < nch; ++c) {
#pragma unroll
        for (int it = 0; it < 16; ++it) { const int r = 2 * it + (lane >> 5); unsigned key = sl[32 * c + r]; key = (key == 0xFFFFu) ? 0u : key;
            const v4u v = *(const v4u*)(cb + (size_t)key * KVL + 8 * (lane & 31)); *(LAS v4u*)(wl + r * CROW + 16 * (lane & 31)) = v; }
        LDS_WAIT(); asm volatile("" ::: "memory");
        f32x4 s[2];
#pragma unroll
        for (int T = 0; T < 2; ++T) { const LAS unsigned char* ap = wl + (16 * T + i) * CROW + 16 * g; f32x4 acc = (f32x4){0.f, 0.f, 0.f, 0.f};
#pragma unroll
            for (int kk = 0; kk < 8; ++kk) { const bf16x8 af = *(const LAS bf16x8*)(ap + 64 * kk); acc = __builtin_amdgcn_mfma_f32_16x16x32_bf16(af, bq[kk], acc, 0, 0, 0); }
            s[T] = acc; }
        float cmax = -INFINITY;
#pragma unroll
        for (int T = 0; T < 2; ++T) { const v2u kw = *(const LAS v2u*)(sl + 32 * c + 16 * T + 4 * g);
#pragma unroll
            for (int r = 0; r < 4; ++r) { const unsigned key = ((r < 2 ? kw.x : kw.y) >> (16 * (r & 1))) & 0xFFFFu; const int dl = t - (int)key;
                const float v = (key != 0xFFFFu && dl >= 0) ? (s[T][r] - slope2 * (float)dl) : -INFINITY; s[T][r] = v; cmax = fmaxf(cmax, v); } }
        cmax = fmaxf(cmax, __shfl_xor(cmax, 16)); cmax = fmaxf(cmax, __shfl_xor(cmax, 32));
        const float mn = fmaxf(m, cmax), alpha = __builtin_amdgcn_exp2f(m - mn); m = mn;
        float rs = 0.f;
#pragma unroll
        for (int T = 0; T < 2; ++T)
#pragma unroll
            for (int r = 0; r < 4; ++r) { const float pv = __builtin_amdgcn_exp2f(s[T][r] - mn); s[T][r] = pv; rs += pv; }
        rs += __shfl_xor(rs, 16); rs += __shfl_xor(rs, 32);
        l = l * alpha + rs;
        bf16x8 pf; { const unsigned a0 = cvtpk(s[0][0], s[0][1]), a1 = cvtpk(s[0][2], s[0][3]), a2 = cvtpk(s[1][0], s[1][1]), a3 = cvtpk(s[1][2], s[1][3]); const v4u tt = (v4u){a0, a1, a2, a3}; pf = __builtin_bit_cast(bf16x8, tt); }
        const LAS unsigned char* vb = wl + (4 * g + (i >> 2)) * CROW + 8 * (i & 3);
#pragma unroll
        for (int ct = 0; ct < 16; ++ct) { const s16x4 lo = tr_read(vb + 32 * ct), hi = tr_read(vb + 16 * CROW + 32 * ct);
            o[ct] = o[ct] * alpha; o[ct] = __builtin_amdgcn_mfma_f32_16x16x32_bf16(cat8(lo, hi), pf, o[ct], 0, 0, 0); }
        LDS_WAIT(); asm volatile("" ::: "memory");
    }
    const float inv = 1.0f / l;
    bf16* op = OL + row * (NH * KVL) + i * KVL + 4 * g;
#pragma unroll
    for (int ct = 0; ct < 16; ++ct) { v2u w2; w2.x = cvtpk(o[ct][0] * inv, o[ct][1] * inv); w2.y = cvtpk(o[ct][2] * inv, o[ct][3] * inv); *(v2u*)(op + 16 * ct) = w2; }
}
constexpr int PH_PER_LAYER = 9, PH_FINAL = 1 + PH_PER_LAYER * DEPTH, PH_COUNT = PH_FINAL + 1;
__global__ void __launch_bounds__(NWAVES * 64, 2) mk_fwd(Args args) {
    extern __shared__ __attribute__((aligned(16))) unsigned char lds_raw[];
    LAS unsigned char* lds = (LAS unsigned char*)lds_raw;
    volatile LAS unsigned* MISC = (volatile LAS unsigned*)(lds + MISC_OFF);
    const int tid = threadIdx.x, lane = tid & 63, wave = __builtin_amdgcn_readfirstlane(tid >> 6);
    const int G = gridDim.x; const int bx = blockIdx.x; const int vcu = (G % 8 == 0) ? (bx % 8) * (G / 8) + bx / 8 : bx;
    const int gw = vcu * NWAVES + wave, NGW = G * NWAVES;
    unsigned char* ws = as_global(args.ws);
    gu32* ctl = (gu32*)(ws + WS_CTL);
    if (tid < 64) MISC[tid] = 0u;
    __syncthreads();
    const int lo = args.ph_lo, hi = args.ph_hi;
    XcdBarrier bar; bar.bar = (unsigned*)(ctl + CW_BAR); bar.x = 0; bar.st = nullptr;
    if (hi - lo > 1) bar = xcd_barrier_post((unsigned*)(ctl + CW_BAR), MISC + 8);
#define IN(k) (lo <= (k) && (k) < hi)
#define SEAM(k) do { if ((k) + 1 < hi) xcd_barrier(bar); } while (0)

    if (IN(0)) {
        p0_transposes(args, lds, gw, NGW, wave, lane);
        __syncthreads();
        p0_adaln(args, lds, G, tid, wave, lane);
        SEAM(0);
    }
    for (int l = 0; l < DEPTH; ++l) {
        const int pb = 1 + PH_PER_LAYER * l;
        if (hi <= pb || lo >= pb + PH_PER_LAYER) continue;
        const LayerW& W = args.L[l];
        int Gv = G, bxv = bx, Kd = D, Kf = DFF, lanev = lane, gwv = gw, vcuv = vcu;
        asm volatile("" : "+s"(Gv), "+s"(bxv), "+s"(Kd), "+s"(Kf), "+v"(lanev), "+s"(gwv), "+s"(vcuv));
        GAS unsigned char* wsg = (GAS unsigned char*)ws; asm volatile("" : "+s"(wsg));
        unsigned char* wsv = (unsigned char*)wsg;
        unsigned char* wb = wsv + WS_W + (size_t)l * W_LAYER;
        float* mod = (float*)(wsv + WS_MOD);
        bf16* Hb = (bf16*)(wsv + WS_H); bf16* ATT = (bf16*)(wsv + WS_ATT);
        unsigned char* r1 = wsv + WS_R1; unsigned char* r2 = wsv + WS_R2;
        const float* modl = mod + (size_t)l * BATCH * NMOD;
        const float* xin = as_global((l == 0) ? args.x : args.out); float* xout = as_global(args.out);
        const bool dsa = (l & 1) != 0;
        if (IN(pb + 0)) { norm_mod_phase(xin, as_global(W.norm_attn), modl + 0 * D, modl + 1 * D, Hb, gwv, NGW, lanev); SEAM(pb + 0); }
        if (IN(pb + 1)) {
            if (!dsa) { pg8::Gemm g{Hb, (const bf16*)(wb + WO_IN), M, NIN_A, Kd}; pg8::StaticOrder S; S.init(M, NIN_A, Gv, bxv);
                pg8::EpiQKV E{(bf16*)r1, (size_t)M * D, QSCALE};
                pg8::gemm_phase<pg8::EpiQKV, pg8::StaticOrder, PG8_ALIGN, PG8_SP2>(lds, g, S, E); }
            else { pg8::Gemm g{Hb, (const bf16*)(wb + WO_IN), M, NIN_BP, Kd}; pg8::StaticOrder S; S.init(M, NIN_BP, Gv, bxv);
                pg8::EpiDsaProj E{(bf16*)(r1 + R1_Q), (float*)(r1 + R1_CKVR), (bf16*)(r1 + R1_QI), (bf16*)(r1 + R1_KI), (float*)(r1 + R1_WI)};
                pg8::gemm_phase<pg8::EpiDsaProj, pg8::StaticOrder, PG8_ALIGN, PG8_SP2>(lds, g, S, E); }
            SEAM(pb + 1);
        }
        if (dsa && IN(pb + 2)) {
            ckv_norm_phase((const float*)(r1 + R1_CKVR), as_global(W.kv_norm), (bf16*)(r1 + R1_CKV), gwv, NGW, lanev);
            for (int wu = gwv; wu < (M / 64) * NH; wu += NGW) { const int h = wu & 15, tg = wu >> 4;
                head_gemm<4, 16, 4>((const bf16*)(r1 + R1_Q), D, h * HD, (const bf16*)(wb + WO_UK) + (size_t)h * KVL * HD, (bf16*)r2, NH * KVL, h * KVL, 64 * tg, QSCALE, lanev); }
            { LAS float* sc = (LAS float*)(lds + wave * 8192);
              for (int pi = gwv; pi < M / 2; pi += NGW) { const int b = pi >> 10, tl = pi & 1023;
                  dsa_index_query((const bf16*)(r1 + R1_QI), (const bf16*)(r1 + R1_KI), (const float*)(r1 + R1_WI), (u16*)(r1 + R1_SEL), sc, b, tl, lanev);
                  dsa_index_query((const bf16*)(r1 + R1_QI), (const bf16*)(r1 + R1_KI), (const float*)(r1 + R1_WI), (u16*)(r1 + R1_SEL), sc, b, SEQ - 1 - tl, lanev); } }
            SEAM(pb + 2);
        }
        if (IN(pb + 3)) {
            if (!dsa) dil_attn_phase((const bf16*)r1, (const bf16*)r1 + (size_t)M * D, (const bf16*)r1 + 2 * (size_t)M * D, ATT, lds, vcuv, Gv, wave, lanev);
            else { LAS unsigned char* wl = lds + wave * DSA_WAVE_LDS;
                for (int q = gwv; q < M; q += NGW) dsa_attn_query((const bf16*)r2, (const bf16*)(r1 + R1_CKV), (const u16*)(r1 + R1_SEL), (bf16*)(r1 + R1_OLAT), wl, q >> 11, q & (SEQ - 1), lanev); }
            SEAM(pb + 3);
        }
        if (dsa && IN(pb + 4)) {
            for (int wu = gwv; wu < (M / 32) * NH; wu += NGW) { const int h = wu & 15, tg = wu >> 4;
                head_gemm<8, 8, 2>((const bf16*)(r1 + R1_OLAT), NH * KVL, h * KVL, (const bf16*)(wb + WO_UV) + (size_t)h * HD * KVL, ATT, D, h * HD, 32 * tg, 1.0f, lanev); }
            SEAM(pb + 4);
        }
        if (IN(pb + 5)) { pg8::Gemm g{ATT, (const bf16*)(wb + WO_OUT), M, D, Kd}; pg8::StaticOrder S; S.init(M, D, Gv, bxv);
            pg8::EpiResid E{xin, xout, modl + 2 * D, NMOD};
            pg8::gemm_phase<pg8::EpiResid, pg8::StaticOrder, PG8_ALIGN, PG8_SP2>(lds, g, S, E); SEAM(pb + 5); }
        if (IN(pb + 6)) { norm_mod_phase(xout, as_global(W.norm_ffn), modl + 3 * D, modl + 4 * D, Hb, gwv, NGW, lanev); SEAM(pb + 6); }
        if (IN(pb + 7)) { pg8::Gemm g{Hb, (const bf16*)(wb + WO_GU), M, 2 * DFF, Kd}; pg8::StaticOrder S; S.init(M, 2 * DFF, Gv, bxv);
            pg8::EpiSwiglu E{(bf16*)r2};
            pg8::gemm_phase<pg8::EpiSwiglu, pg8::StaticOrder, PG8_ALIGN, PG8_SP2>(lds, g, S, E); SEAM(pb + 7); }
        if (IN(pb + 8)) { pg8::Gemm g{(const bf16*)r2, (const bf16*)(wb + WO_DN), M, D, Kf}; pg8::StaticOrder S; S.init(M, D, Gv, bxv);
            pg8::EpiResid E{xout, xout, modl + 5 * D, NMOD};
            pg8::gemm_phase<pg8::EpiResid, pg8::StaticOrder, PG8_ALIGN, PG8_SP2>(lds, g, S, E); SEAM(pb + 8); }
    }
    if (IN(PH_FINAL)) final_norm_phase(as_global(args.out), as_global(args.final_norm), gw, NGW, lane);
#undef IN
#undef SEAM
}


#ifdef DIAG_PROBE
struct ProbeArgs { const unsigned* buf[4]; unsigned long long nwords[4]; int is_bf16[4]; int pad[4]; unsigned* cnt; float* out; };
__global__ void probe_kernel(ProbeArgs a) {
    for (int k = 0; k < 4; ++k) { if (!a.buf[k]) continue; unsigned bad = 0;
        for (unsigned long long i = (unsigned long long)blockIdx.x * blockDim.x + threadIdx.x; i < a.nwords[k]; i += (unsigned long long)gridDim.x * blockDim.x) { const unsigned w = a.buf[k][i];
            const int md = a.is_bf16[k];
            if (md == 1) { if ((w & 0x7F80u) == 0x7F80u || (w & 0x7F800000u) == 0x7F800000u) bad++; } else if (md == 0) { if ((w & 0x7F800000u) == 0x7F800000u) bad++; }
            else if (md == 4) { const unsigned lo = w & 0xFFFFu, hi = w >> 16; if ((lo > 2047u && lo != 0xFFFFu) || (hi > 2047u && hi != 0xFFFFu)) bad++; }
            else if (md == 2) { if ((w & 0x7F80u) >= 0x4680u || (w & 0x7F800000u) >= 0x46800000u) bad++; } else { if ((w & 0x7F800000u) >= 0x46000000u) bad++; } }
        if (bad) atomicAdd(a.cnt + k, bad); }
}
__global__ void probe_fill(ProbeArgs a) {
    float c = 0.f; for (int k = 0; k < 4; ++k) if (a.cnt[k]) c += 0.5f * (float)(1 << k);
    for (size_t i = (size_t)blockIdx.x * blockDim.x + threadIdx.x; i < (size_t)M * D; i += (size_t)gridDim.x * blockDim.x) a.out[i] = c;
}
#endif
extern "C" void kernel_launch(void* const* d_in, const int* in_sizes, int n_in, void* d_out, int out_size, void* d_ws, size_t ws_size, hipStream_t stream) {
    static int grid = 0;
    if (grid == 0) {
        if (n_in != 41 || in_sizes[0] != M * D || out_size != M * D || ws_size < WS_END) { fprintf(stderr, "kernel_launch: unexpected shapes (n_in %d, in0 %d, out %d, ws %zu)\n", n_in, n_in > 0 ? in_sizes[0] : -1, out_size, ws_size); grid = -1; return; }
        int dev = 0, cus = 0;
        if (hipGetDevice(&dev) != hipSuccess || hipDeviceGetAttribute(&cus, hipDeviceAttributeMultiprocessorCount, dev) != hipSuccess) { grid = -1; return; }
        if (hipFuncSetAttribute((const void*)mk_fwd, hipFuncAttributeMaxDynamicSharedMemorySize, LDS_BYTES) != hipSuccess) { fprintf(stderr, "kernel_launch: hipFuncSetAttribute failed\n"); grid = -1; return; }
        int per_cu = 0;
        if (hipOccupancyMaxActiveBlocksPerMultiprocessor(&per_cu, (const void*)mk_fwd, NWAVES * 64, LDS_BYTES) != hipSuccess || per_cu < 1) fprintf(stderr, "kernel_launch: occupancy query reports %d\n", per_cu);
        (void)hipGetLastError();
        grid = cus;
    }
    if (grid < 0) return;
    if (hipMemsetAsync((char*)d_ws + WS_CTL, 0, CTL_ZERO_BYTES, stream) != hipSuccess) return;
    Args a{};
    a.x = (const float*)d_in[0]; a.c = (const float*)d_in[1]; a.final_norm = (const float*)d_in[40];
    int k = 2;
    for (int l = 0; l < DEPTH; ++l) { LayerW& w = a.L[l];
        w.norm_attn = (const float*)d_in[k++]; w.ada_w = (const float*)d_in[k++]; w.ada_b = (const float*)d_in[k++]; w.w_in = (const float*)d_in[k++];
        if (l & 1) { w.kv_norm = (const float*)d_in[k++]; w.w_uk = (const float*)d_in[k++]; w.w_uv = (const float*)d_in[k++]; }
        else { w.kv_norm = nullptr; w.w_uk = nullptr; w.w_uv = nullptr; }
        w.w_out = (const float*)d_in[k++]; w.norm_ffn = (const float*)d_in[k++]; w.w_gu = (const float*)d_in[k++]; w.w_down = (const float*)d_in[k++]; }
    a.out = (float*)d_out; a.ws = (unsigned char*)d_ws;
#if MK_MULTI
    for (int p = 0; p < PH_COUNT; ++p) {
        if (p >= 1 && p < PH_FINAL) { const int l = (p - 1) / PH_PER_LAYER, k2 = (p - 1) % PH_PER_LAYER; if (!(l & 1) && (k2 == 2 || k2 == 4)) continue; }
        a.ph_lo = p; a.ph_hi = p + 1;
#ifdef DIAG_PROBE
        if (p > DIAG_LAST) break;
#endif
        hipLaunchKernelGGL(mk_fwd, dim3(grid), dim3(NWAVES * 64), LDS_BYTES, stream, a);
    }
#ifdef DIAG_PROBE
    { ProbeArgs pa{}; unsigned char* ws = (unsigned char*)d_ws; DIAG_SETUP; pa.cnt = (unsigned*)(ws + WS_CTL) + 64; pa.out = (float*)d_out;
      hipLaunchKernelGGL(probe_kernel, dim3(1024), dim3(256), 0, stream, pa); hipLaunchKernelGGL(probe_fill, dim3(1024), dim3(256), 0, stream, pa); }
#endif
#else
    a.ph_lo = 0; a.ph_hi = PH_COUNT;
    hipLaunchKernelGGL(mk_fwd, dim3(grid), dim3(NWAVES * 64), LDS_BYTES, stream, a);
#endif
    const hipError_t le = hipPeekAtLastError();
    if (le != hipSuccess) fprintf(stderr, "kernel_launch: launch failed: %s\n", hipGetErrorName(le));
}
```

```cpp
#include <hip/hip_runtime.h>
#include <cstdio>
#include <cstdint>
#define MK_MULTI 0
namespace pg8 {
#define PG8_LAS __attribute__((address_space(3)))
typedef unsigned short bf16_t;
typedef short bf16x8 __attribute__((ext_vector_type(8)));
typedef float f32x4 __attribute__((ext_vector_type(4)));
typedef unsigned u32x4 __attribute__((ext_vector_type(4)));
constexpr int BM = 256, BK = 64, HALF = 128, HTB = HALF * BK * 2  , STAGE_BYTES = 8 * HTB, NXCD = 8, WGM = 8;

__host__ __device__ __forceinline__ int lds_byte(int r, int c) { const int st = (r >> 4) * 2 + (c >> 5), rr = r & 15, cc = c & 31, ob = rr * 64 + cc * 2; return st * 1024 + (ob ^ (((ob >> 9) & 1) << 5)); }
__host__ __device__ __forceinline__ void stage_rc(int b, int& R, int& C) { const int st = b / 1024, sb = b % 1024, swz = sb ^ (((sb >> 9) & 1) << 5); R = (st >> 1) * 16 + swz / 64; C = (st & 1) * 32 + (swz % 64) / 2; }
__host__ __device__ __forceinline__ int perm32(int rho) { const int n = rho >> 4, i = rho & 15; return 8 * (i >> 2) + 4 * n + (i & 3); }

struct Unit { int pm, pn; };
struct Gemm { const bf16_t* A; const bf16_t* Bt; int M, N, K; };

struct StaticOrder {
    int nM, nN, nwg, G, c;
    __host__ __device__ void init(int M, int N, int G_, int c_) { nM = M / BM; nN = N / BM; nwg = nM * nN; G = G_; c = c_; }
    __host__ __device__ bool next(int i, Unit& u) const {
        const long L = (long)i * G + c; if (L >= nwg) return false;
        int wgid = (int)L; { const int q = nwg / NXCD, r = nwg % NXCD, xcd = wgid % NXCD, off = wgid / NXCD; wgid = (xcd < r ? xcd * (q + 1) : r * (q + 1) + (xcd - r) * q) + off; }
        const int nig = WGM * nN, gid = wgid / nig, fm = gid * WGM, gsz = (nM - fm) < WGM ? (nM - fm) : WGM;
        u.pm = fm + ((wgid % nig) % gsz); u.pn = (wgid % nig) / gsz; return true;
    }
    __device__ __forceinline__ void a_ready(const Unit&) const {}
    __device__ __forceinline__ void done(const Unit&) const {}
};
typedef __bf16 bf16x2_cv __attribute__((ext_vector_type(2)));
typedef float f32x2_cv __attribute__((ext_vector_type(2)));
__device__ __forceinline__ unsigned cvt_pk_bf16(float lo, float hi) { const f32x2_cv v = {lo, hi}; const bf16x2_cv r = __builtin_convertvector(v, bf16x2_cv); return __builtin_bit_cast(unsigned, r); }
typedef float f32x2 __attribute__((ext_vector_type(2)));
__device__ __forceinline__ u32x4 pack8(const f32x4 v0, const f32x4 v1) { u32x4 w; w.x = cvt_pk_bf16(v0[0], v0[1]); w.y = cvt_pk_bf16(v0[2], v0[3]); w.z = cvt_pk_bf16(v1[0], v1[1]); w.w = cvt_pk_bf16(v1[2], v1[3]); return w; }

struct EpiQKV {
    static constexpr bool PERM = true, AFTER_DRAIN = false;
    bf16_t* O; size_t split_stride; float qscale;
    __device__ __forceinline__ void operator()(const f32x4 (&acc)[2][2][4][2], const Unit& u, int wr, int wc, int fr, int fq) const {
        const int row0 = u.pm * BM + wr * 64 + fr; const int t = u.pn >> 3; const int col0 = (u.pn & 7) * BM + wc * 32 + 8 * fq;
        bf16_t* base = O + (size_t)t * split_stride; const float sc = (t == 0) ? qscale : 1.f;
#pragma unroll
        for (int ai = 0; ai < 2; ++ai)
#pragma unroll
            for (int m = 0; m < 4; ++m) { bf16_t* rowp = base + (size_t)(row0 + ai * HALF + m * 16) * 2048 + col0;
#pragma unroll
                for (int bj = 0; bj < 2; ++bj) *(u32x4*)(rowp + bj * HALF) = pack8(acc[ai][bj][m][0] * sc, acc[ai][bj][m][1] * sc); }
    }
};
struct EpiResid {
    static constexpr bool PERM = false, AFTER_DRAIN = false;
    const float* base; float* out; const float* gate; int gstride;
    __device__ __forceinline__ void operator()(const f32x4 (&acc)[2][2][4][2], const Unit& u, int wr, int wc, int fr, int fq) const {
        const int row0 = u.pm * BM + wr * 64 + fr, col0 = u.pn * BM + wc * 32 + 4 * fq;
        const float* gp = gate + (size_t)((u.pm * BM) >> 11) * gstride + col0;
        f32x4 gv[2][2];
#pragma unroll
        for (int bj = 0; bj < 2; ++bj)
#pragma unroll
            for (int n = 0; n < 2; ++n) gv[bj][n] = *(const f32x4*)(gp + bj * HALF + n * 16);
#pragma unroll
        for (int ai = 0; ai < 2; ++ai)
#pragma unroll
            for (int m = 0; m < 4; ++m) { const size_t off = (size_t)(row0 + ai * HALF + m * 16) * 2048 + col0;
#pragma unroll
                for (int bj = 0; bj < 2; ++bj)
#pragma unroll
                    for (int n = 0; n < 2; ++n) { const f32x4 bs = *(const f32x4*)(base + off + bj * HALF + n * 16); *(f32x4*)(out + off + bj * HALF + n * 16) = bs + gv[bj][n] * acc[ai][bj][m][n]; }
                asm volatile("" ::: "memory"); }
    }
};
struct EpiSwiglu {
    static constexpr bool PERM = true, AFTER_DRAIN = false;
    bf16_t* O;
    __device__ __forceinline__ static float silu(float x) { return x * __builtin_amdgcn_rcpf(1.0f + __builtin_amdgcn_exp2f(-1.44269504f * x)); }
    __device__ __forceinline__ void operator()(const f32x4 (&acc)[2][2][4][2], const Unit& u, int wr, int wc, int fr, int fq) const {
        const int row0 = u.pm * BM + wr * 64 + fr; const int col0 = u.pn * HALF + wc * 32 + 8 * fq;
#pragma unroll
        for (int ai = 0; ai < 2; ++ai)
#pragma unroll
            for (int m = 0; m < 4; ++m) { bf16_t* rowp = O + (size_t)(row0 + ai * HALF + m * 16) * 5632 + col0;
                f32x4 v0, v1;
#pragma unroll
                for (int j = 0; j < 4; ++j) { v0[j] = silu(acc[ai][0][m][0][j]) * acc[ai][1][m][0][j]; v1[j] = silu(acc[ai][0][m][1][j]) * acc[ai][1][m][1][j]; }
                *(u32x4*)rowp = pack8(v0, v1); }
    }
};
struct EpiDsaProj {
    static constexpr bool PERM = true, AFTER_DRAIN = false;
    bf16_t* Q; float* CKVR; bf16_t* QI; bf16_t* KI; float* WI;
    __device__ __forceinline__ void operator()(const f32x4 (&acc)[2][2][4][2], const Unit& u, int wr, int wc, int fr, int fq) const {
        const int row0 = u.pm * BM + wr * 64 + fr; const int lc0 = wc * 32 + 8 * fq;
        if (u.pn < 8 || (u.pn >= 9 && u.pn < 17)) {
            bf16_t* base = (u.pn < 8) ? Q : QI; const int col0 = ((u.pn < 8) ? u.pn : (u.pn - 9)) * BM + lc0;
#pragma unroll
            for (int ai = 0; ai < 2; ++ai)
#pragma unroll
                for (int m = 0; m < 4; ++m) { bf16_t* rowp = base + (size_t)(row0 + ai * HALF + m * 16) * 2048 + col0;
#pragma unroll
                    for (int bj = 0; bj < 2; ++bj) *(u32x4*)(rowp + bj * HALF) = pack8(acc[ai][bj][m][0], acc[ai][bj][m][1]); }
        } else if (u.pn == 8) {
#pragma unroll
            for (int ai = 0; ai < 2; ++ai)
#pragma unroll
                for (int m = 0; m < 4; ++m) { float* rowp = CKVR + (size_t)(row0 + ai * HALF + m * 16) * 256 + lc0;
#pragma unroll
                    for (int bj = 0; bj < 2; ++bj) { *(f32x4*)(rowp + bj * HALF) = acc[ai][bj][m][0]; *(f32x4*)(rowp + bj * HALF + 4) = acc[ai][bj][m][1]; } }
        } else {
#pragma unroll
            for (int ai = 0; ai < 2; ++ai)
#pragma unroll
                for (int m = 0; m < 4; ++m) { const size_t r = (size_t)(row0 + ai * HALF + m * 16);
                    *(u32x4*)(KI + r * 128 + lc0) = pack8(acc[ai][0][m][0], acc[ai][0][m][1]);
                    if (lc0 < 16) { *(f32x4*)(WI + r * 16 + lc0) = acc[ai][1][m][0]; *(f32x4*)(WI + r * 16 + lc0 + 4) = acc[ai][1][m][1]; } }
        }
    }
};
template <class Epi, class Sched, bool ALIGN_EPI = false, bool SP2 = false>
__device__ __forceinline__ void gemm_phase(PG8_LAS unsigned char* lds, const Gemm g, const Sched& S, const Epi& E) {
    int tid_ = threadIdx.x; asm volatile("" : "+v"(tid_));
    const int tid = tid_, wid = __builtin_amdgcn_readfirstlane(tid >> 6), lane = tid & 63, wr = wid >> 2, wc = wid & 3, fr = lane & 15, fq = lane >> 4;
    const int K = g.K, nt = K / BK;
    unsigned voffA[2], voffB[2];
#pragma unroll
    for (int i = 0; i < 2; ++i) { int R, C; stage_rc(tid * 16 + i * 8192, R, C); const int Rb = Epi::PERM ? ((R & ~31) + perm32(R & 31)) : R;
        voffA[i] = (unsigned)(R * K + C) * 2u; voffB[i] = (unsigned)(Rb * K + C) * 2u; }
    const size_t kstep = (size_t)(BK * 2);
    const size_t hstep = (size_t)HALF * K * 2;
    const size_t tstep = 2 * hstep;
    const unsigned ldsw = (unsigned)wid * 1024u;
    const int aoff = lds_byte(wr * 64 + fr, fq * 8), boff = lds_byte(wc * 32 + fr, fq * 8);
#define PG8_SA(b, h) (((b) * 2 + (h)) * HTB)
#define PG8_SB(b, h) ((4 + (b) * 2 + (h)) * HTB)
#define PG8_STAGE(bufoff, gbase, voff) do { _Pragma("unroll") for (int _i = 0; _i < 2; ++_i) \
        __builtin_amdgcn_global_load_lds((const unsigned*)((const char*)(gbase) + (voff)[_i]), (PG8_LAS unsigned*)(lds + (bufoff) + ldsw + _i * 8192), 16, 0, 0); } while (0)
#define PG8_LDA(dst, b, h) do { _Pragma("unroll") for (int m = 0; m < 4; ++m) _Pragma("unroll") for (int k = 0; k < 2; ++k) dst[m][k] = *(const PG8_LAS bf16x8*)(lds + PG8_SA(b, h) + aoff + m * 2048 + k * 1024); } while (0)
#define PG8_LDB(dst, b, h) do { _Pragma("unroll") for (int n = 0; n < 2; ++n) _Pragma("unroll") for (int k = 0; k < 2; ++k) dst[n][k] = *(const PG8_LAS bf16x8*)(lds + PG8_SB(b, h) + boff + n * 2048 + k * 1024); } while (0)
#define PG8_MMA(ai, bj, At, Bt) do { __builtin_amdgcn_s_setprio(1); _Pragma("unroll") for (int m = 0; m < 4; ++m) _Pragma("unroll") for (int n = 0; n < 2; ++n) _Pragma("unroll") for (int k = 0; k < 2; ++k) \
        acc[ai][bj][m][n] = __builtin_amdgcn_mfma_f32_16x16x32_bf16(Bt[n][k], At[m][k], acc[ai][bj][m][n], 0, 0, 0); __builtin_amdgcn_s_setprio(0); } while (0)
#define PG8_WAIT_V(n) asm volatile("s_waitcnt vmcnt(" #n ")" ::: "memory")
#define PG8_WAIT_L(n) asm volatile("s_waitcnt lgkmcnt(" #n ")" ::: "memory")
#define PG8_BAR __builtin_amdgcn_s_barrier()
#define PG8_SCHED __builtin_amdgcn_sched_barrier(0)
    Unit cur, nxt; int ui = 0;
    if (!S.next(0, cur)) return;
    f32x4 acc[2][2][4][2];
#pragma unroll
    for (int a = 0; a < 2; ++a)
#pragma unroll
        for (int b = 0; b < 2; ++b)
#pragma unroll
            for (int m = 0; m < 4; ++m)
#pragma unroll
                for (int n = 0; n < 2; ++n) acc[a][b][m][n] = (f32x4){0.f, 0.f, 0.f, 0.f};
    bf16x8 At[4][2], B0[2][2], B1[2][2];
    const char* cA = (const char*)g.A + (size_t)cur.pm * tstep; const char* cB = (const char*)g.Bt + (size_t)cur.pn * tstep;
    S.a_ready(cur);
    if constexpr (SP2) {
        PG8_STAGE(PG8_SB(0, 0), cB, voffB); PG8_STAGE(PG8_SB(0, 1), cB + hstep, voffB); PG8_STAGE(PG8_SA(0, 0), cA, voffA); PG8_STAGE(PG8_SA(0, 1), cA + hstep, voffA);
        if (wr == 1) PG8_BAR;
        PG8_WAIT_V(2); PG8_BAR;
        PG8_STAGE(PG8_SB(1, 0), cB + kstep, voffB); PG8_STAGE(PG8_SA(1, 0), cA + kstep, voffA); PG8_STAGE(PG8_SB(1, 1), cB + hstep + kstep, voffB);
        PG8_WAIT_V(6); PG8_BAR;
    } else {
        PG8_STAGE(PG8_SB(0, 0), cB, voffB); PG8_STAGE(PG8_SA(0, 0), cA, voffA); PG8_STAGE(PG8_SB(0, 1), cB + hstep, voffB); PG8_STAGE(PG8_SA(0, 1), cA + hstep, voffA);
        if (wr == 1) PG8_BAR;
        PG8_WAIT_V(4); PG8_BAR;
        PG8_STAGE(PG8_SB(1, 0), cB + kstep, voffB); PG8_STAGE(PG8_SA(1, 0), cA + kstep, voffA); PG8_STAGE(PG8_SB(1, 1), cB + hstep + kstep, voffB);
        PG8_WAIT_V(6); PG8_BAR;
    }
    for (;;) {
        const bool has_next = S.next(ui + 1, nxt);
        const char* nA = has_next ? (const char*)g.A + (size_t)nxt.pm * tstep : cA; const char* nB = has_next ? (const char*)g.Bt + (size_t)nxt.pn * tstep : cB;
        for (int t = 0; t < nt; t += 2) {
            const bool last = (t == nt - 2);
            const char* a1 = cA + (size_t)(t + 1) * kstep;
            const char* a2 = last ? nA : cA + (size_t)(t + 2) * kstep; const char* b2 = last ? nB : cB + (size_t)(t + 2) * kstep;
            const char* a3 = a2 + kstep; const char* b3 = b2 + kstep;
            if (last && has_next) S.a_ready(nxt);
            if constexpr (SP2) {
            PG8_LDB(B0, 0, 0); PG8_LDB(B1, 0, 1); PG8_SCHED; PG8_LDA(At, 0, 0); PG8_STAGE(PG8_SA(1, 1), a1 + hstep, voffA);
            PG8_WAIT_V(8); PG8_WAIT_L(0); PG8_BAR; PG8_MMA(0, 0, At, B0); PG8_MMA(0, 1, At, B1); PG8_BAR; PG8_SCHED;
            PG8_LDA(At, 0, 1); PG8_STAGE(PG8_SB(0, 0), b2, voffB); PG8_STAGE(PG8_SB(0, 1), b2 + hstep, voffB); PG8_STAGE(PG8_SA(0, 0), a2, voffA);
            PG8_WAIT_V(8); PG8_WAIT_L(0); PG8_BAR; PG8_MMA(1, 0, At, B0); PG8_MMA(1, 1, At, B1); PG8_BAR; PG8_SCHED;
            PG8_LDB(B0, 1, 0); PG8_LDB(B1, 1, 1); PG8_SCHED; PG8_LDA(At, 1, 0); PG8_STAGE(PG8_SA(0, 1), a2 + hstep, voffA);
            PG8_WAIT_V(8); PG8_WAIT_L(0); PG8_BAR; PG8_MMA(0, 0, At, B0); PG8_MMA(0, 1, At, B1); PG8_BAR; PG8_SCHED;
            PG8_LDA(At, 1, 1); PG8_STAGE(PG8_SB(1, 0), b3, voffB); PG8_STAGE(PG8_SB(1, 1), b3 + hstep, voffB); PG8_STAGE(PG8_SA(1, 0), a3, voffA);
            PG8_WAIT_V(8); PG8_WAIT_L(0); PG8_BAR; PG8_MMA(1, 0, At, B0); PG8_MMA(1, 1, At, B1); PG8_BAR; PG8_SCHED;
            } else {
            PG8_LDB(B0, 0, 0); PG8_SCHED; PG8_LDA(At, 0, 0); PG8_STAGE(PG8_SA(1, 1), a1 + hstep, voffA);
            PG8_WAIT_L(8); PG8_BAR; PG8_WAIT_L(0); PG8_MMA(0, 0, At, B0); PG8_BAR; PG8_SCHED;
            PG8_LDB(B1, 0, 1); PG8_STAGE(PG8_SB(0, 0), b2, voffB);
            PG8_BAR; PG8_WAIT_L(0); PG8_MMA(0, 1, At, B1); PG8_BAR;
            PG8_LDA(At, 0, 1); PG8_STAGE(PG8_SA(0, 0), a2, voffA);
            PG8_BAR; PG8_WAIT_L(0); PG8_MMA(1, 0, At, B0); PG8_BAR; PG8_SCHED;
            PG8_STAGE(PG8_SB(0, 1), b2 + hstep, voffB);
            PG8_WAIT_V(6); PG8_BAR; PG8_MMA(1, 1, At, B1); PG8_BAR;
            PG8_LDB(B0, 1, 0); PG8_SCHED; PG8_LDA(At, 1, 0); PG8_STAGE(PG8_SA(0, 1), a2 + hstep, voffA);
            PG8_WAIT_L(8); PG8_BAR; PG8_WAIT_L(0); PG8_MMA(0, 0, At, B0); PG8_BAR; PG8_SCHED;
            PG8_LDB(B1, 1, 1); PG8_STAGE(PG8_SB(1, 0), b3, voffB);
            PG8_BAR; PG8_WAIT_L(0); PG8_MMA(0, 1, At, B1); PG8_BAR;
            PG8_LDA(At, 1, 1); PG8_STAGE(PG8_SA(1, 0), a3, voffA);
            PG8_BAR; PG8_WAIT_L(0); PG8_MMA(1, 0, At, B0); PG8_BAR; PG8_SCHED;
            PG8_STAGE(PG8_SB(1, 1), b3 + hstep, voffB);
            PG8_WAIT_V(6); PG8_BAR; PG8_MMA(1, 1, At, B1); PG8_BAR;
            }
        }
        if constexpr (ALIGN_EPI) { if (wr == 0) PG8_BAR; }
        if constexpr (!Epi::AFTER_DRAIN) { E(acc, cur, wr, wc, fr, fq); S.done(cur); }
        if (!has_next) break;
#pragma unroll
        for (int a = 0; a < 2; ++a)
#pragma unroll
            for (int b = 0; b < 2; ++b)
#pragma unroll
                for (int m = 0; m < 4; ++m)
#pragma unroll
                    for (int n = 0; n < 2; ++n) acc[a][b][m][n] = (f32x4){0.f, 0.f, 0.f, 0.f};
        cur = nxt; cA = nA; cB = nB; ++ui;
        if constexpr (ALIGN_EPI) { if (wr == 1) PG8_BAR; }
    }
    PG8_WAIT_V(0);
    if constexpr (!ALIGN_EPI) { if (wr == 0) PG8_BAR; }
    PG8_BAR;
    if constexpr (Epi::AFTER_DRAIN) { E.fused(acc, cur, wr, wc, fr, fq, lds, wid, lane); S.done(cur); }
#undef PG8_SA
#undef PG8_SB
#undef PG8_STAGE
#undef PG8_LDA
#undef PG8_LDB
#undef PG8_MMA
#undef PG8_WAIT_V
#undef PG8_WAIT_L
#undef PG8_BAR
#undef PG8_SCHED
}
}
#ifndef PG8_SP2
#define PG8_SP2 true
#endif
#ifndef PG8_ALIGN
#define PG8_ALIGN true
#endif
#ifndef MK_MULTI
#define MK_MULTI 0
#endif

constexpr int NWAVES = 8;
constexpr int BATCH = 8, SEQ = 2048, D = 2048, M = BATCH * SEQ, NH = 16, HD = 128, DFF = 5632, KVL = 256, TOPK = 256, DEPTH = 4;
constexpr int NIN_A = 6144, NIN_B = 4496, NIN_BP = 4608, NMOD = 6 * D;
constexpr float EPS = 1e-6f;
constexpr float LOG2E = 1.4426950408889634f;
constexpr float QSCALE = 0.08838834764831845f * LOG2E;

constexpr size_t MiB = 1u << 20;
constexpr size_t WS_CTL = 0, CTL_ZERO_BYTES = 1 * MiB;
constexpr size_t WS_MOD = 1 * MiB;
constexpr size_t WS_W = 4 * MiB, W_LAYER = 100 * MiB;
constexpr size_t WO_IN = 0, WO_OUT = 24 * MiB, WO_GU = 32 * MiB, WO_DN = 76 * MiB, WO_UK = 98 * MiB, WO_UV = 99 * MiB;
constexpr size_t WS_H = 404 * MiB;
constexpr size_t WS_R1 = 468 * MiB;
constexpr size_t WS_ATT = 660 * MiB;
constexpr size_t WS_R2 = 724 * MiB;
constexpr size_t WS_END = 900 * MiB;
constexpr size_t R1_Q = 0, R1_QI = 64 * MiB, R1_OLAT = 0, R1_CKVR = 128 * MiB, R1_KI = 144 * MiB, R1_WI = 148 * MiB, R1_CKV = 149 * MiB, R1_SEL = 157 * MiB;
constexpr int CW_BAR = 4096;

constexpr int RING_BYTES = 139264;
constexpr int MISC_OFF = RING_BYTES;
constexpr int LDS_BYTES = RING_BYTES + 256;

#define GAS __attribute__((address_space(1)))
#define LAS __attribute__((address_space(3)))
typedef unsigned short bf16;
typedef unsigned short u16;
typedef unsigned v4u __attribute__((ext_vector_type(4)));
typedef unsigned v2u __attribute__((ext_vector_type(2)));
typedef float f32x4 __attribute__((ext_vector_type(4)));
typedef short bf16x8 __attribute__((ext_vector_type(8)));
typedef short s16x4 __attribute__((ext_vector_type(4)));
typedef short v4i16_t __attribute__((ext_vector_type(4)));
typedef GAS unsigned gu32;
template <class T> __device__ __forceinline__ T* as_global(T* p) { return (T*)(GAS T*)p; }
#define RLX_AGENT __ATOMIC_RELAXED, __HIP_MEMORY_SCOPE_AGENT
#define LDS_WAIT() asm volatile("s_waitcnt lgkmcnt(0)" ::: "memory")
#define VM_WAIT() asm volatile("s_waitcnt vmcnt(0)" ::: "memory")
__device__ __forceinline__ unsigned cvtpk(float lo, float hi) { return pg8::cvt_pk_bf16(lo, hi); }
__device__ __forceinline__ float wave_sum(float v) {
#pragma unroll
    for (int o = 1; o < 64; o <<= 1) v += __shfl_xor(v, o);
    return v;
}
__device__ __forceinline__ s16x4 tr_read(LAS const unsigned char* p) { return __builtin_bit_cast(s16x4, __builtin_amdgcn_ds_read_tr16_b64_v4i16((LAS v4i16_t*)p)); }
__device__ __forceinline__ bf16x8 cat8(s16x4 a, s16x4 b) { bf16x8 r; r[0] = a[0]; r[1] = a[1]; r[2] = a[2]; r[3] = a[3]; r[4] = b[0]; r[5] = b[1]; r[6] = b[2]; r[7] = b[3]; return r; }
__device__ __forceinline__ unsigned mbcnt64(unsigned long long m) { return __builtin_amdgcn_mbcnt_hi((unsigned)(m >> 32), __builtin_amdgcn_mbcnt_lo((unsigned)m, 0u)); }

#define XB_TMO      128
#define XB_XCNT(j)  (256  + 64 * (j))
#define XB_XSUB(j)  (1280 + 64 * (j))
#define XB_XGEN(j)  (2304 + 64 * (j))
#define XB_TOP      3328
#define XB_TOPGEN   3392
#define XCD_BAR_WORDS 3456
#define XB_SPIN_CAP (1u << 18)

__device__ __forceinline__ unsigned xb_ld(unsigned* p)              { return __hip_atomic_load(p, __ATOMIC_RELAXED, __HIP_MEMORY_SCOPE_AGENT); }
__device__ __forceinline__ unsigned xb_add(unsigned* p, unsigned v) { return __hip_atomic_fetch_add(p, v, __ATOMIC_RELAXED, __HIP_MEMORY_SCOPE_AGENT); }
__device__ __forceinline__ unsigned xb_xcc_id() { return (unsigned)__builtin_amdgcn_s_getreg((3 << 11) | 20) & 0xFu; }
#define XB_SPIN(cond, bar) do { unsigned _sp = 0; while (cond) { __builtin_amdgcn_s_sleep(1); \
    if ((++_sp & 255u) == 0u) { if (xb_ld(&(bar)[XB_TMO])) break; if (_sp > XB_SPIN_CAP) { atomicAdd(&(bar)[XB_TMO], 1u); break; } } } } while (0)

struct XcdBarrier {
    unsigned* bar; unsigned x;
    volatile LAS unsigned* st;
};

__device__ __forceinline__ XcdBarrier xcd_barrier_post(unsigned* bar, volatile LAS unsigned* st) {
    XcdBarrier b; b.bar = bar; b.x = xb_xcc_id(); b.st = st;
    if (threadIdx.x == 0) (void)xb_add(&bar[XB_XCNT(b.x)], 1u);
    return b;
}
__device__ __forceinline__ void xcd_barrier_complete(unsigned* bar, unsigned x, unsigned& nloc, unsigned& nx) {
    const unsigned G = gridDim.x * gridDim.y * gridDim.z;
    unsigned sum, cnt, mine, sp = 0u;
    for (;;) {
        sum = 0u; cnt = 0u; mine = 0u;
#pragma unroll
        for (unsigned j = 0; j < 16; ++j) { const unsigned c = xb_ld(&bar[XB_XCNT(j)]); sum += c; cnt += (c > 0u) ? 1u : 0u; mine = (j == x) ? c : mine; }
        if (sum == G) break;
        __builtin_amdgcn_s_sleep(1);
        if ((++sp & 255u) == 0u) { if (xb_ld(&bar[XB_TMO])) break; if (sp > XB_SPIN_CAP) { atomicAdd(&bar[XB_TMO], 1u); break; } }
    }
    nloc = mine > 0u ? mine : 1u; nx = cnt > 0u ? cnt : 1u;
}

__device__ __forceinline__ void xcd_barrier(const XcdBarrier& b) {
    asm volatile("s_waitcnt vmcnt(0)" ::: "memory");
    __syncthreads();
    if (threadIdx.x == 0) {
        unsigned* bar = b.bar;
        __builtin_amdgcn_s_waitcnt(0);
        unsigned nloc = b.st[0], nx = b.st[1];
        if (nloc == 0u) { xcd_barrier_complete(bar, b.x, nloc, nx); b.st[0] = nloc; b.st[1] = nx; }
        const unsigned old = xb_add(&bar[XB_XSUB(b.x)], 1u);
        const unsigned gen = old / nloc;
        if (old + 1u == (gen + 1u) * nloc) {
            __builtin_amdgcn_fence(__ATOMIC_RELEASE, "agent");
            asm volatile("s_waitcnt vmcnt(0)" ::: "memory");
            const unsigned og = xb_add(&bar[XB_TOP], 1u);
            const unsigned tg = og / nx;
            if (og + 1u == (tg + 1u) * nx) xb_add(&bar[XB_TOPGEN], 1u);
            else XB_SPIN(xb_ld(&bar[XB_TOPGEN]) == tg, bar);
            __builtin_amdgcn_fence(__ATOMIC_ACQUIRE, "agent");
            xb_add(&bar[XB_XGEN(b.x)], 1u);
            asm volatile("s_waitcnt vmcnt(0)" ::: "memory");
        } else {
            XB_SPIN(xb_ld(&bar[XB_XGEN(b.x)]) == gen, bar);
            __builtin_amdgcn_fence(__ATOMIC_ACQUIRE, "agent");
            asm volatile("s_waitcnt vmcnt(0)" ::: "memory");
        }
    }
    __syncthreads();
}
struct LayerW { const float *norm_attn, *ada_w, *ada_b, *w_in, *kv_norm, *w_uk, *w_uv, *w_out, *norm_ffn, *w_gu, *w_down; };
struct Args { const float* x; const float* c; const float* final_norm; LayerW L[DEPTH]; float* out; unsigned char* ws; int ph_lo, ph_hi; };

__device__ __forceinline__ void tr_item(const float* W, int ldw, int srccol0, int nvalid, int k0, bf16* WT, int K, int destrow0, LAS float* scr, int lane) {
    const int n = lane & 31;
#pragma unroll 8
    for (int i = 0; i < 32; ++i) { const int kk = 2 * i + (lane >> 5); float v = 0.f; if (n < nvalid) v = W[(size_t)(k0 + kk) * ldw + srccol0 + n]; scr[kk * 33 + n] = v; }
    LDS_WAIT(); asm volatile("" ::: "memory");
    const int c = lane & 7;
#pragma unroll
    for (int j = 0; j < 4; ++j) { const int nn = (lane >> 3) + 8 * j; const LAS float* s = scr + (8 * c) * 33 + nn;
        v4u o; o.x = cvtpk(s[0 * 33], s[1 * 33]); o.y = cvtpk(s[2 * 33], s[3 * 33]); o.z = cvtpk(s[4 * 33], s[5 * 33]); o.w = cvtpk(s[6 * 33], s[7 * 33]);
        *(v4u*)(WT + (size_t)(destrow0 + nn) * K + k0 + 8 * c) = o; }
    LDS_WAIT(); asm volatile("" ::: "memory");
}
__device__ __forceinline__ void tr_plain(const float* W, int K, int N, int Ndest, bf16* WT, int item, LAS float* scr, int lane) {
    const int nnb = Ndest / 32, kb = item / nnb, nb = item % nnb, n0 = 32 * nb; int nv = N - n0; nv = nv < 0 ? 0 : (nv > 32 ? 32 : nv);
    tr_item(W, N, n0, nv, 64 * kb, WT, K, n0, scr, lane);
}
__device__ __forceinline__ void tr_gu(const float* W, bf16* WT, int item, LAS float* scr, int lane) {
    const int nnb = (2 * DFF) / 32, kb = item / nnb, nb = item % nnb, n0 = 32 * nb, pn = n0 >> 8, lc = n0 & 255;
    const int src = ((lc < 128) ? 0 : DFF) + 128 * pn + (lc & 127);
    tr_item(W, 2 * DFF, src, 32, 64 * kb, WT, D, n0, scr, lane);
}
constexpr int IT_INA = (D / 64) * (NIN_A / 32), IT_INB = (D / 64) * (NIN_BP / 32), IT_OUT = (D / 64) * (D / 32), IT_GU = (D / 64) * (2 * DFF / 32), IT_DN = (DFF / 64) * (D / 32), IT_UK = 16 * 16, IT_UV = 16 * 16;
constexpr int IT_DIL = IT_INA + IT_OUT + IT_GU + IT_DN, IT_DSA = IT_INB + IT_OUT + IT_GU + IT_DN + IT_UK + IT_UV;
constexpr int IT_ALL = 2 * IT_DIL + 2 * IT_DSA;

__device__ __forceinline__ void p0_transposes(const Args& a, LAS unsigned char* lds, int gw, int NGW, int wave, int lane) {
    LAS float* scr = (LAS float*)(lds + wave * 8704);
    for (int it = gw; it < IT_ALL; it += NGW) {
        int r = it; int l;
        if (r < IT_DIL) l = 0; else { r -= IT_DIL; if (r < IT_DSA) l = 1; else { r -= IT_DSA; if (r < IT_DIL) l = 2; else { r -= IT_DIL; l = 3; } } }
        const LayerW& w = a.L[l]; unsigned char* wb = as_global(a.ws) + WS_W + (size_t)l * W_LAYER;
        if (!(l & 1)) { if (r < IT_INA) { tr_plain(as_global(w.w_in), D, NIN_A, NIN_A, (bf16*)(wb + WO_IN), r, scr, lane); continue; } r -= IT_INA; }
        else { if (r < IT_INB) { tr_plain(as_global(w.w_in), D, NIN_B, NIN_BP, (bf16*)(wb + WO_IN), r, scr, lane); continue; } r -= IT_INB; }
        if (r < IT_OUT) { tr_plain(as_global(w.w_out), D, D, D, (bf16*)(wb + WO_OUT), r, scr, lane); continue; } r -= IT_OUT;
        if (r < IT_GU) { tr_gu(as_global(w.w_gu), (bf16*)(wb + WO_GU), r, scr, lane); continue; } r -= IT_GU;
        if (r < IT_DN) { tr_plain(as_global(w.w_down), DFF, D, D, (bf16*)(wb + WO_DN), r, scr, lane); continue; } r -= IT_DN;
        if (r < IT_UK) { const int h = r >> 4; tr_plain(as_global(w.w_uk) + (size_t)h * HD * KVL, HD, KVL, KVL, (bf16*)(wb + WO_UK) + (size_t)h * KVL * HD, r & 15, scr, lane); continue; } r -= IT_UK;
        { const int h = r >> 4; tr_plain(as_global(w.w_uv) + (size_t)h * KVL * HD, KVL, HD, HD, (bf16*)(wb + WO_UV) + (size_t)h * HD * KVL, r & 15, scr, lane); }
    }
}
constexpr int SC_STRIDE = 2112;
__device__ __forceinline__ void p0_adaln(const Args& a, LAS unsigned char* lds, int G, int tid, int wave, int lane) {
    LAS float* sc = (LAS float*)lds;
    LAS float* red = (LAS float*)(lds + 8 * SC_STRIDE * 4);
    float* mod = (float*)(as_global(a.ws) + WS_MOD); const float* cin = as_global(a.c);
    for (int i = tid; i < BATCH * D; i += NWAVES * 64) { const int b = i >> 11, k = i & 2047; const float v = cin[i]; sc[b * SC_STRIDE + k + (k >> 6)] = v / (1.0f + __expf(-v)); }
    __syncthreads();
    const int cg = tid & 15, ks = tid >> 4;
    for (int u = blockIdx.x; u < DEPTH * (NMOD / 64); u += G) {
        const int l = u / (NMOD / 64), col0 = 64 * (u % (NMOD / 64));
        const float* wp = as_global(a.L[l].ada_w) + (size_t)(64 * ks) * NMOD + col0 + 4 * cg;
        f32x4 acc[8];
#pragma unroll
        for (int b = 0; b < 8; ++b) acc[b] = (f32x4){0.f, 0.f, 0.f, 0.f};
#pragma unroll 4
        for (int kk = 0; kk < 64; ++kk) { const f32x4 w4 = *(const f32x4*)(wp + (size_t)kk * NMOD); const int kx = 64 * ks + kk + ks;
#pragma unroll
            for (int b = 0; b < 8; ++b) acc[b] += sc[b * SC_STRIDE + kx] * w4; }
#pragma unroll
        for (int b = 0; b < 8; ++b)
#pragma unroll
            for (int j = 0; j < 4; ++j) { float v = acc[b][j]; v += __shfl_xor(v, 16); v += __shfl_xor(v, 32); acc[b][j] = v; }
        if (lane < 16) {
#pragma unroll
            for (int b = 0; b < 8; ++b) *(LAS f32x4*)(red + (wave * 8 + b) * 64 + 4 * cg) = acc[b]; }
        __syncthreads();
        { const int b = tid >> 6, col = tid & 63; float s = as_global(a.L[l].ada_b)[col0 + col];
#pragma unroll
          for (int w = 0; w < 8; ++w) s += red[(w * 8 + b) * 64 + col];
          mod[((size_t)l * BATCH + b) * NMOD + col0 + col] = s; }
        __syncthreads();
    }
}
__device__ __forceinline__ void norm_mod_phase(const float* x, const float* gain, const float* shift, const float* scale, bf16* h, int gw, int NGW, int lane) {
    for (int grp = gw; grp < M / 8; grp += NGW) {
        const int b = (grp * 8) >> 11;
        f32x4 A[8], B[8];
#pragma unroll
        for (int j = 0; j < 4; ++j)
#pragma unroll
            for (int e = 0; e < 2; ++e) { const int col = 8 * lane + 512 * j + 4 * e;
                const f32x4 g = *(const f32x4*)(gain + col), sc = *(const f32x4*)(scale + (size_t)b * NMOD + col); A[2 * j + e] = g * (sc + 1.0f); B[2 * j + e] = *(const f32x4*)(shift + (size_t)b * NMOD + col); }
        for (int rr = 0; rr < 8; ++rr) { const size_t row = (size_t)grp * 8 + rr; const float* xr = x + row * D;
            f32x4 v[8]; float ss = 0.f;
#pragma unroll
            for (int j = 0; j < 4; ++j)
#pragma unroll
                for (int e = 0; e < 2; ++e) { const f32x4 t = *(const f32x4*)(xr + 8 * lane + 512 * j + 4 * e); v[2 * j + e] = t; ss += (t[0] * t[0] + t[1] * t[1]) + (t[2] * t[2] + t[3] * t[3]); }
            const float rstd = __builtin_amdgcn_rsqf(wave_sum(ss) * (1.0f / D) + EPS);
#pragma unroll
            for (int j = 0; j < 4; ++j) { const f32x4 y0 = v[2 * j] * rstd * A[2 * j] + B[2 * j], y1 = v[2 * j + 1] * rstd * A[2 * j + 1] + B[2 * j + 1];
                v4u o; o.x = cvtpk(y0[0], y0[1]); o.y = cvtpk(y0[2], y0[3]); o.z = cvtpk(y1[0], y1[1]); o.w = cvtpk(y1[2], y1[3]);
                *(v4u*)(h + row * D + 8 * lane + 512 * j) = o; }
        }
    }
}
__device__ __forceinline__ void final_norm_phase(float* x, const float* gain, int gw, int NGW, int lane) {
    for (int row = gw; row < M; row += NGW) { float* xr = x + (size_t)row * D;
        f32x4 v[8]; float ss = 0.f;
#pragma unroll
        for (int j = 0; j < 8; ++j) { const f32x4 t = *(const f32x4*)(xr + 4 * lane + 256 * j); v[j] = t; ss += (t[0] * t[0] + t[1] * t[1]) + (t[2] * t[2] + t[3] * t[3]); }
        const float tot = wave_sum(ss); const float rstd = __builtin_amdgcn_rsqf(tot * (1.0f / D) + EPS);
#pragma unroll
        for (int j = 0; j < 8; ++j) { const f32x4 g = *(const f32x4*)(gain + 4 * lane + 256 * j); f32x4 y = v[j] * rstd * g;
#ifdef DIAG_SANITIZE
            if (!(tot < 3.0e38f)) y = (f32x4){0.f, 0.f, 0.f, 0.f};
#endif
            *(f32x4*)(xr + 4 * lane + 256 * j) = y; }
    }
}
constexpr int VROW = 272;
__device__ __forceinline__ void dil_chunk(const bf16* Kb, const bf16* Vb, const bf16x8 (&qf)[4], float& m, float& l, f32x4 (&o)[8], LAS unsigned char* vl,
                                          int pbase, int pstride, int wmax, int par, int tq, float slope2, int lane) {
    const int i = lane & 15, g = lane >> 4;
#pragma unroll
    for (int it = 0; it < 8; ++it) { const int kr = 4 * it + g; int p = pbase + pstride * kr; p = p < 0 ? 0 : (p > SEQ - 1 ? SEQ - 1 : p);
        const v4u v = *(const v4u*)(Vb + (size_t)p * D + 8 * i); *(LAS v4u*)(vl + kr * VROW + 16 * i) = v; }
    f32x4 s[2];
#pragma unroll
    for (int T = 0; T < 2; ++T) { int p = pbase + pstride * (16 * T + i); p = p < 0 ? 0 : (p > SEQ - 1 ? SEQ - 1 : p); const bf16* kp = Kb + (size_t)p * D + 8 * g;
        f32x4 acc = (f32x4){0.f, 0.f, 0.f, 0.f};
#pragma unroll
        for (int kk = 0; kk < 4; ++kk) { const bf16x8 kf = *(const bf16x8*)(kp + 32 * kk); acc = __builtin_amdgcn_mfma_f32_16x16x32_bf16(kf, qf[kk], acc, 0, 0, 0); }
        s[T] = acc; }
    float cmax = -INFINITY;
#pragma unroll
    for (int T = 0; T < 2; ++T)
#pragma unroll
        for (int r = 0; r < 4; ++r) { const int p = pbase + pstride * (16 * T + 4 * g + r); const int dl = tq - p;
            const bool ok = (p >= 0) && (dl >= 0) && (dl <= wmax) && (par < 0 || (i & 1) == par);
            const float v = ok ? (s[T][r] - slope2 * (float)dl) : -INFINITY; s[T][r] = v; cmax = fmaxf(cmax, v); }
    cmax = fmaxf(cmax, __shfl_xor(cmax, 16)); cmax = fmaxf(cmax, __shfl_xor(cmax, 32));
    const float mn = fmaxf(m, cmax), alpha = __builtin_amdgcn_exp2f(m - mn); m = mn;
    float rs = 0.f;
#pragma unroll
    for (int T = 0; T < 2; ++T)
#pragma unroll
        for (int r = 0; r < 4; ++r) { const float pv = __builtin_amdgcn_exp2f(s[T][r] - mn); s[T][r] = pv; rs += pv; }
    rs += __shfl_xor(rs, 16); rs += __shfl_xor(rs, 32);
    l = l * alpha + rs;
    bf16x8 pf; { const unsigned a0 = cvtpk(s[0][0], s[0][1]), a1 = cvtpk(s[0][2], s[0][3]), a2 = cvtpk(s[1][0], s[1][1]), a3 = cvtpk(s[1][2], s[1][3]); const v4u t = (v4u){a0, a1, a2, a3}; pf = __builtin_bit_cast(bf16x8, t); }
    LDS_WAIT();
    const LAS unsigned char* vb = vl + (4 * g + (i >> 2)) * VROW + 8 * (i & 3);
#pragma unroll
    for (int c = 0; c < 8; ++c) { const s16x4 lo = tr_read(vb + 32 * c), hi = tr_read(vb + 16 * VROW + 32 * c);
        o[c] = o[c] * alpha; o[c] = __builtin_amdgcn_mfma_f32_16x16x32_bf16(cat8(lo, hi), pf, o[c], 0, 0, 0); }
}
__device__ __forceinline__ void dil_attn_unit(const bf16* Q, const bf16* K, const bf16* V, bf16* O, int b, int h, int qb, LAS unsigned char* vl, int w, int lane) {
    const int i = lane & 15, g = lane >> 4, t0 = qb * 128, tq = t0 + 8 * i + w;
    const size_t rb = (size_t)b * SEQ;
    const bf16* Kb = K + rb * D + h * HD; const bf16* Vb = V + rb * D + h * HD;
    bf16x8 qf[4];
#pragma unroll
    for (int kk = 0; kk < 4; ++kk) qf[kk] = *(const bf16x8*)(Q + (rb + tq) * D + h * HD + 32 * kk + 8 * g);
    float m = -1e30f, l = 0.f; f32x4 o[8];
#pragma unroll
    for (int c = 0; c < 8; ++c) o[c] = (f32x4){0.f, 0.f, 0.f, 0.f};
    const float slope2 = __builtin_amdgcn_exp2f(-0.5f * (float)(h + 1)) * LOG2E;
    { const int kb = t0 + w - 128;
      for (int c = 0; c < 8; ++c) { if (kb + 32 * c + 31 < 0) continue; dil_chunk(Kb, Vb, qf, m, l, o, vl, kb + 32 * c, 1, 128, -1, tq, slope2, lane); } }
    { const int kb = t0 + w - 512;
      for (int c = 0; c < 5; ++c) { if (kb + 4 * (32 * c + 31) < 0) continue; dil_chunk(Kb, Vb, qf, m, l, o, vl, kb + 128 * c, 4, 512, -1, tq, slope2, lane); } }
    { const int nch = ((t0 >> 4) + 8 + 31) >> 5;
      for (int e = 0; e < 2; ++e) for (int c = 0; c < nch; ++c) dil_chunk(Kb, Vb, qf, m, l, o, vl, w + 8 * e + 512 * c, 16, 4096, e, tq, slope2, lane); }
    const float inv = 1.0f / l;
    bf16* op = O + (rb + tq) * D + h * HD + 4 * g;
#pragma unroll
    for (int c = 0; c < 8; ++c) { v2u w2; w2.x = cvtpk(o[c][0] * inv, o[c][1] * inv); w2.y = cvtpk(o[c][2] * inv, o[c][3] * inv); *(v2u*)(op + 16 * c) = w2; }
}
__device__ __forceinline__ void dil_attn_phase(const bf16* Q, const bf16* K, const bf16* V, bf16* O, LAS unsigned char* lds, int vcu, int G, int wave, int lane) {
    LAS unsigned char* vl = lds + wave * (32 * VROW);
    for (int u = vcu; u < BATCH * NH * (SEQ / 128); u += G) { const int qb = u & 15, bh = u >> 4; dil_attn_unit(Q, K, V, O, bh >> 4, bh & 15, qb, vl, wave, lane); }
}

template <int KK  , int NT  , int TT  >
__device__ __forceinline__ void head_gemm(const bf16* X, int ldx, int xcol0, const bf16* WT, bf16* Out, int ldo, int ocol0, int tok0, float scale, int lane) {
    const int i = lane & 15, g = lane >> 4;
    bf16x8 xf[TT][KK];
#pragma unroll
    for (int tt = 0; tt < TT; ++tt)
#pragma unroll
        for (int kk = 0; kk < KK; ++kk) xf[tt][kk] = *(const bf16x8*)(X + (size_t)(tok0 + 16 * tt + i) * ldx + xcol0 + 32 * kk + 8 * g);
    for (int nt = 0; nt < NT; ++nt) {
        bf16x8 af[KK];
#pragma unroll
        for (int kk = 0; kk < KK; ++kk) af[kk] = *(const bf16x8*)(WT + (size_t)(16 * nt + i) * (32 * KK) + 32 * kk + 8 * g);
#pragma unroll
        for (int tt = 0; tt < TT; ++tt) { f32x4 acc = (f32x4){0.f, 0.f, 0.f, 0.f};
#pragma unroll
            for (int kk = 0; kk < KK; ++kk) acc = __builtin_amdgcn_mfma_f32_16x16x32_bf16(af[kk], xf[tt][kk], acc, 0, 0, 0);
            v2u w2; w2.x = cvtpk(acc[0] * scale, acc[1] * scale); w2.y = cvtpk(acc[2] * scale, acc[3] * scale);
            *(v2u*)(Out + (size_t)(tok0 + 16 * tt + i) * ldo + ocol0 + 16 * nt + 4 * g) = w2; }
    }
}
__device__ __forceinline__ void ckv_norm_phase(const float* raw, const float* gain, bf16* out, int gw, int NGW, int lane) {
    const f32x4 gv = *(const f32x4*)(gain + 4 * lane);
    for (int row = gw; row < M; row += NGW) { const f32x4 t = *(const f32x4*)(raw + (size_t)row * KVL + 4 * lane);
        const float ss = (t[0] * t[0] + t[1] * t[1]) + (t[2] * t[2] + t[3] * t[3]);
        const float rstd = __builtin_amdgcn_rsqf(wave_sum(ss) * (1.0f / KVL) + EPS); const f32x4 y = t * rstd * gv;
        v2u w2; w2.x = cvtpk(y[0], y[1]); w2.y = cvtpk(y[2], y[3]); *(v2u*)(out + (size_t)row * KVL + 4 * lane) = w2; }
}
__device__ __forceinline__ void dsa_index_query(const bf16* QI, const bf16* KI, const float* WI, u16* SEL, LAS float* sc, int b, int t, int lane) {
    const int i = lane & 15, g = lane >> 4; const size_t row = (size_t)b * SEQ + t;
    u16* selr = SEL + row * TOPK;
    if (t < TOPK) { for (int j = lane; j < TOPK; j += 64) selr[j] = (u16)(j <= t ? j : 0xFFFF); return; }
    bf16x8 af[4];
#pragma unroll
    for (int kk = 0; kk < 4; ++kk) af[kk] = *(const bf16x8*)(QI + row * D + i * 128 + 32 * kk + 8 * g);
    const f32x4 wv = *(const f32x4*)(WI + row * 16 + 4 * g);
    const int ntiles = (t >> 4) + 1;
    const bf16* kb = KI + ((size_t)b * SEQ + i) * 128 + 8 * g;
    for (int tile = 0; tile < ntiles; ++tile) { const bf16* kp = kb + (size_t)tile * 16 * 128;
        f32x4 acc = (f32x4){0.f, 0.f, 0.f, 0.f};
#pragma unroll
        for (int kk = 0; kk < 4; ++kk) { const bf16x8 bfr = *(const bf16x8*)(kp + 32 * kk); acc = __builtin_amdgcn_mfma_f32_16x16x32_bf16(af[kk], bfr, acc, 0, 0, 0); }
        float s = wv[0] * fmaxf(acc[0], 0.f) + wv[1] * fmaxf(acc[1], 0.f) + wv[2] * fmaxf(acc[2], 0.f) + wv[3] * fmaxf(acc[3], 0.f);
        s += __shfl_xor(s, 16); s += __shfl_xor(s, 32);
        if (g == 0) sc[16 * tile + i] = s; }
    LDS_WAIT(); asm volatile("" ::: "memory");
    unsigned key[32];
#pragma unroll
    for (int u = 0; u < 32; ++u) { const int idx = 64 * u + lane; const unsigned bits = __float_as_uint(sc[idx]); const unsigned k = (bits & 0x80000000u) ? ~bits : (bits | 0x80000000u); key[u] = (idx <= t) ? k : 0u; }
    unsigned prefix = 0u;
    for (int bit = 31; bit >= 0; --bit) { const unsigned cand = prefix | (1u << bit); int cnt = 0;
#pragma unroll
        for (int u = 0; u < 32; ++u) cnt += __popcll(__ballot(key[u] >= cand));
        if (cnt >= TOPK) prefix = cand; }
    int cgt = 0;
#pragma unroll
    for (int u = 0; u < 32; ++u) cgt += __popcll(__ballot(key[u] > prefix));
    const int need_eq = TOPK - cgt; int base = 0, eqb = 0;
#pragma unroll
    for (int u = 0; u < 32; ++u) { const bool gt = key[u] > prefix, eq = key[u] == prefix; const unsigned long long meq = __ballot(eq);
        const bool take = gt || (eq && (int)(eqb + mbcnt64(meq)) < need_eq); const unsigned long long mt = __ballot(take);
        if (take) selr[base + mbcnt64(mt)] = (u16)(64 * u + lane);
        base += __popcll(mt); eqb += __popcll(meq); }
    LDS_WAIT(); asm volatile("" ::: "memory");
}
constexpr int CROW = 528;
constexpr int DSA_WAVE_LDS = 32 * CROW + 512;
__device__ __forceinline__ void dsa_attn_query(const bf16* QL, const bf16* CKV, const u16* SEL, bf16* OL, LAS unsigned char* wl, int b, int t, int lane) {
    const int i = lane & 15, g = lane >> 4; const size_t row = (size_t)b * SEQ + t;
    LAS u16* sl = (LAS u16*)(wl + 32 * CROW);
    *(LAS v2u*)(sl + 4 * lane) = *(const v2u*)(SEL + row * TOPK + 4 * lane);
    bf16x8 bq[8];
#pragma unroll
    for (int kk = 0; kk < 8; ++kk) bq[kk] = *(const bf16x8*)(QL + row * (NH * KVL) + i * KVL + 32 * kk + 8 * g);
    const float slope2 = __builtin_amdgcn_exp2f(-0.5f * (float)(i + 1)) * LOG2E;
    float m = -1e30f, l = 0.f; f32x4 o[16];
#pragma unroll
    for (int c = 0; c < 16; ++c) o[c] = (f32x4){0.f, 0.f, 0.f, 0.f};
    const int nvalid = (t + 1) < TOPK ? (t + 1) : TOPK, nch = (nvalid + 31) >> 5;
    const bf16* cb = CKV + (size_t)b * SEQ * KVL;
    LDS_WAIT(); asm volatile("" ::: "memory");
    for (int c = 0; c < nch; ++c) {
#pragma unroll
        for (int it = 0; it < 16; ++it) { const int r = 2 * it + (lane >> 5); unsigned key = sl[32 * c + r]; key = (key == 0xFFFFu) ? 0u : key;
            const v4u v = *(const v4u*)(cb + (size_t)key * KVL + 8 * (lane & 31)); *(LAS v4u*)(wl + r * CROW + 16 * (lane & 31)) = v; }
        LDS_WAIT(); asm volatile("" ::: "memory");
        f32x4 s[2];
#pragma unroll
        for (int T = 0; T < 2; ++T) { const LAS unsigned char* ap = wl + (16 * T + i) * CROW + 16 * g; f32x4 acc = (f32x4){0.f, 0.f, 0.f, 0.f};
#pragma unroll
            for (int kk = 0; kk < 8; ++kk) { const bf16x8 af = *(const LAS bf16x8*)(ap + 64 * kk); acc = __builtin_amdgcn_mfma_f32_16x16x32_bf16(af, bq[kk], acc, 0, 0, 0); }
            s[T] = acc; }
        float cmax = -INFINITY;
#pragma unroll
        for (int T = 0; T < 2; ++T) { const v2u kw = *(const LAS v2u*)(sl + 32 * c + 16 * T + 4 * g);
#pragma unroll
            for (int r = 0; r < 4; ++r) { const unsigned key = ((r < 2 ? kw.x : kw.y) >> (16 * (r & 1))) & 0xFFFFu; const int dl = t - (int)key;
                const float v = (key != 0xFFFFu && dl >= 0) ? (s[T][r] - slope2 * (float)dl) : -INFINITY; s[T][r] = v; cmax = fmaxf(cmax, v); } }
        cmax = fmaxf(cmax, __shfl_xor(cmax, 16)); cmax = fmaxf(cmax, __shfl_xor(cmax, 32));
        const float mn = fmaxf(m, cmax), alpha = __builtin_amdgcn_exp2f(m - mn); m = mn;
        float rs = 0.f;
#pragma unroll
        for (int T = 0; T < 2; ++T)
#pragma unroll
            for (int r = 0; r < 4; ++r) { const float pv = __builtin_amdgcn_exp2f(s[T][r] - mn); s[T][r] = pv; rs += pv; }
        rs += __shfl_xor(rs, 16); rs += __shfl_xor(rs, 32);
        l = l * alpha + rs;
        bf16x8 pf; { const unsigned a0 = cvtpk(s[0][0], s[0][1]), a1 = cvtpk(s[0][2], s[0][3]), a2 = cvtpk(s[1][0], s[1][1]), a3 = cvtpk(s[1][2], s[1][3]); const v4u tt = (v4u){a0, a1, a2, a3}; pf = __builtin_bit_cast(bf16x8, tt); }
        const LAS unsigned char* vb = wl + (4 * g + (i >> 2)) * CROW + 8 * (i & 3);
#pragma unroll
        for (int ct = 0; ct < 16; ++ct) { const s16x4 lo = tr_read(vb + 32 * ct), hi = tr_read(vb + 16 * CROW + 32 * ct);
            o[ct] = o[ct] * alpha; o[ct] = __builtin_amdgcn_mfma_f32_16x16x32_bf16(cat8(lo, hi), pf, o[ct], 0, 0, 0); }
        LDS_WAIT(); asm volatile("" ::: "memory");
    }
    const float inv = 1.0f / l;
    bf16* op = OL + row * (NH * KVL) + i * KVL + 4 * g;
#pragma unroll
    for (int ct = 0; ct < 16; ++ct) { v2u w2; w2.x = cvtpk(o[ct][0] * inv, o[ct][1] * inv); w2.y = cvtpk(o[ct][2] * inv, o[ct][3] * inv); *(v2u*)(op + 16 * ct) = w2; }
}
constexpr int PH_PER_LAYER = 9, PH_FINAL = 1 + PH_PER_LAYER * DEPTH, PH_COUNT = PH_FINAL + 1;
__global__ void __launch_bounds__(NWAVES * 64, 2) mk_fwd(Args args) {
    extern __shared__ __attribute__((aligned(16))) unsigned char lds_raw[];
    LAS unsigned char* lds = (LAS unsigned char*)lds_raw;
    volatile LAS unsigned* MISC = (volatile LAS unsigned*)(lds + MISC_OFF);
    const int tid = threadIdx.x, lane = tid & 63, wave = __builtin_amdgcn_readfirstlane(tid >> 6);
    const int G = gridDim.x; const int bx = blockIdx.x; const int vcu = (G % 8 == 0) ? (bx % 8) * (G / 8) + bx / 8 : bx;
    const int gw = vcu * NWAVES + wave, NGW = G * NWAVES;
    unsigned char* ws = as_global(args.ws);
    gu32* ctl = (gu32*)(ws + WS_CTL);
    if (tid < 64) MISC[tid] = 0u;
    __syncthreads();
    const int lo = args.ph_lo, hi = args.ph_hi;
    XcdBarrier bar; bar.bar = (unsigned*)(ctl + CW_BAR); bar.x = 0; bar.st = nullptr;
    if (hi - lo > 1) bar = xcd_barrier_post((unsigned*)(ctl + CW_BAR), MISC + 8);
#define IN(k) (lo <= (k) && (k) < hi)
#define SEAM(k) do { if ((k) + 1 < hi) xcd_barrier(bar); } while (0)

    if (IN(0)) {
        p0_transposes(args, lds, gw, NGW, wave, lane);
        __syncthreads();
        p0_adaln(args, lds, G, tid, wave, lane);
        SEAM(0);
    }
    for (int l = 0; l < DEPTH; ++l) {
        const int pb = 1 + PH_PER_LAYER * l;
        if (hi <= pb || lo >= pb + PH_PER_LAYER) continue;
        const LayerW& W = args.L[l];
        int Gv = G, bxv = bx, Kd = D, Kf = DFF, lanev = lane, gwv = gw, vcuv = vcu;
        asm volatile("" : "+s"(Gv), "+s"(bxv), "+s"(Kd), "+s"(Kf), "+v"(lanev), "+s"(gwv), "+s"(vcuv));
        GAS unsigned char* wsg = (GAS unsigned char*)ws; asm volatile("" : "+s"(wsg));
        unsigned char* wsv = (unsigned char*)wsg;
        unsigned char* wb = wsv + WS_W + (size_t)l * W_LAYER;
        float* mod = (float*)(wsv + WS_MOD);
        bf16* Hb = (bf16*)(wsv + WS_H); bf16* ATT = (bf16*)(wsv + WS_ATT);
        unsigned char* r1 = wsv + WS_R1; unsigned char* r2 = wsv + WS_R2;
        const float* modl = mod + (size_t)l * BATCH * NMOD;
        const float* xin = as_global((l == 0) ? args.x : args.out); float* xout = as_global(args.out);
        const bool dsa = (l & 1) != 0;
        if (IN(pb + 0)) { norm_mod_phase(xin, as_global(W.norm_attn), modl + 0 * D, modl + 1 * D, Hb, gwv, NGW, lanev); SEAM(pb + 0); }
        if (IN(pb + 1)) {
            if (!dsa) { pg8::Gemm g{Hb, (const bf16*)(wb + WO_IN), M, NIN_A, Kd}; pg8::StaticOrder S; S.init(M, NIN_A, Gv, bxv);
                pg8::EpiQKV E{(bf16*)r1, (size_t)M * D, QSCALE};
                pg8::gemm_phase<pg8::EpiQKV, pg8::StaticOrder, PG8_ALIGN, PG8_SP2>(lds, g, S, E); }
            else { pg8::Gemm g{Hb, (const bf16*)(wb + WO_IN), M, NIN_BP, Kd}; pg8::StaticOrder S; S.init(M, NIN_BP, Gv, bxv);
                pg8::EpiDsaProj E{(bf16*)(r1 + R1_Q), (float*)(r1 + R1_CKVR), (bf16*)(r1 + R1_QI), (bf16*)(r1 + R1_KI), (float*)(r1 + R1_WI)};
                pg8::gemm_phase<pg8::EpiDsaProj, pg8::StaticOrder, PG8_ALIGN, PG8_SP2>(lds, g, S, E); }
            SEAM(pb + 1);
        }
        if (dsa && IN(pb + 2)) {
            ckv_norm_phase((const float*)(r1 + R1_CKVR), as_global(W.kv_norm), (bf16*)(r1 + R1_CKV), gwv, NGW, lanev);
            for (int wu = gwv; wu < (M / 64) * NH; wu += NGW) { const int h = wu & 15, tg = wu >> 4;
                head_gemm<4, 16, 4>((const bf16*)(r1 + R1_Q), D, h * HD, (const bf16*)(wb + WO_UK) + (size_t)h * KVL * HD, (bf16*)r2, NH * KVL, h * KVL, 64 * tg, QSCALE, lanev); }
            { LAS float* sc = (LAS float*)(lds + wave * 8192);
              for (int pi = gwv; pi < M / 2; pi += NGW) { const int b = pi >> 10, tl = pi & 1023;
                  dsa_index_query((const bf16*)(r1 + R1_QI), (const bf16*)(r1 + R1_KI), (const float*)(r1 + R1_WI), (u16*)(r1 + R1_SEL), sc, b, tl, lanev);
                  dsa_index_query((const bf16*)(r1 + R1_QI), (const bf16*)(r1 + R1_KI), (const float*)(r1 + R1_WI), (u16*)(r1 + R1_SEL), sc, b, SEQ - 1 - tl, lanev); } }
            SEAM(pb + 2);
        }
        if (IN(pb + 3)) {
            if (!dsa) dil_attn_phase((const bf16*)r1, (const bf16*)r1 + (size_t)M * D, (const bf16*)r1 + 2 * (size_t)M * D, ATT, lds, vcuv, Gv, wave, lanev);
            else { LAS unsigned char* wl = lds + wave * DSA_WAVE_LDS;
                for (int q = gwv; q < M; q += NGW) dsa_attn_query((const bf16*)r2, (const bf16*)(r1 + R1_CKV), (const u16*)(r1 + R1_SEL), (bf16*)(r1 + R1_OLAT), wl, q >> 11, q & (SEQ - 1), lanev); }
            SEAM(pb + 3);
        }
        if (dsa && IN(pb + 4)) {
            for (int wu = gwv; wu < (M / 32) * NH; wu += NGW) { const int h = wu & 15, tg = wu >> 4;
                head_gemm<8, 8, 2>((const bf16*)(r1 + R1_OLAT), NH * KVL, h * KVL, (const bf16*)(wb + WO_UV) + (size_t)h * HD * KVL, ATT, D, h * HD, 32 * tg, 1.0f, lanev); }
            SEAM(pb + 4);
        }
        if (IN(pb + 5)) { pg8::Gemm g{ATT, (const bf16*)(wb + WO_OUT), M, D, Kd}; pg8::StaticOrder S; S.init(M, D, Gv, bxv);
            pg8::EpiResid E{xin, xout, modl + 2 * D, NMOD};
            pg8::gemm_phase<pg8::EpiResid, pg8::StaticOrder, PG8_ALIGN, PG8_SP2>(lds, g, S, E); SEAM(pb + 5); }
        if (IN(pb + 6)) { norm_mod_phase(xout, as_global(W.norm_ffn), modl + 3 * D, modl + 4 * D, Hb, gwv, NGW, lanev); SEAM(pb + 6); }
        if (IN(pb + 7)) { pg8::Gemm g{Hb, (const bf16*)(wb + WO_GU), M, 2 * DFF, Kd}; pg8::StaticOrder S; S.init(M, 2 * DFF, Gv, bxv);
            pg8::EpiSwiglu E{(bf16*)r2};
            pg8::gemm_phase<pg8::EpiSwiglu, pg8::StaticOrder, PG8_ALIGN, PG8_SP2>(lds, g, S, E); SEAM(pb + 7); }
        if (IN(pb + 8)) { pg8::Gemm g{(const bf16*)r2, (const bf16*)(wb + WO_DN), M, D, Kf}; pg8::StaticOrder S; S.init(M, D, Gv, bxv);
            pg8::EpiResid E{xout, xout, modl + 5 * D, NMOD};
            pg8::gemm_phase<pg8::EpiResid, pg8::StaticOrder, PG8_ALIGN, PG8_SP2>(lds, g, S, E); SEAM(pb + 8); }
    }
    if (IN(PH_FINAL)) final_norm_phase(as_global(args.out), as_global(args.final_norm), gw, NGW, lane);
#undef IN
#undef SEAM
}


#ifdef DIAG_PROBE
struct ProbeArgs { const unsigned* buf[4]; unsigned long long nwords[4]; int is_bf16[4]; int pad[4]; unsigned* cnt; float* out; };
__global__ void probe_kernel(ProbeArgs a) {
    for (int k = 0; k < 4; ++k) { if (!a.buf[k]) continue; unsigned bad = 0;
        for (unsigned long long i = (unsigned long long)blockIdx.x * blockDim.x + threadIdx.x; i < a.nwords[k]; i += (unsigned long long)gridDim.x * blockDim.x) { const unsigned w = a.buf[k][i];
            const int md = a.is_bf16[k];
            if (md == 1) { if ((w & 0x7F80u) == 0x7F80u || (w & 0x7F800000u) == 0x7F800000u) bad++; } else if (md == 0) { if ((w & 0x7F800000u) == 0x7F800000u) bad++; }
            else if (md == 4) { const unsigned lo = w & 0xFFFFu, hi = w >> 16; if ((lo > 2047u && lo != 0xFFFFu) || (hi > 2047u && hi != 0xFFFFu)) bad++; }
            else if (md == 2) { if ((w & 0x7F80u) >= 0x4680u || (w & 0x7F800000u) >= 0x46800000u) bad++; } else { if ((w & 0x7F800000u) >= 0x46000000u) bad++; } }
        if (bad) atomicAdd(a.cnt + k, bad); }
}
__global__ void probe_fill(ProbeArgs a) {
    float c = 0.f; for (int k = 0; k < 4; ++k) if (a.cnt[k]) c += 0.5f * (float)(1 << k);
    for (size_t i = (size_t)blockIdx.x * blockDim.x + threadIdx.x; i < (size_t)M * D; i += (size_t)gridDim.x * blockDim.x) a.out[i] = c;
}
#endif
extern "C" void kernel_launch(void* const* d_in, const int* in_sizes, int n_in, void* d_out, int out_size, void* d_ws, size_t ws_size, hipStream_t stream) {
    static int grid = 0;
    if (grid == 0) {
        if (n_in != 41 || in_sizes[0] != M * D || out_size != M * D || ws_size < WS_END) { fprintf(stderr, "kernel_launch: unexpected shapes (n_in %d, in0 %d, out %d, ws %zu)\n", n_in, n_in > 0 ? in_sizes[0] : -1, out_size, ws_size); grid = -1; return; }
        int dev = 0, cus = 0;
        if (hipGetDevice(&dev) != hipSuccess || hipDeviceGetAttribute(&cus, hipDeviceAttributeMultiprocessorCount, dev) != hipSuccess) { grid = -1; return; }
        if (hipFuncSetAttribute((const void*)mk_fwd, hipFuncAttributeMaxDynamicSharedMemorySize, LDS_BYTES) != hipSuccess) { fprintf(stderr, "kernel_launch: hipFuncSetAttribute failed\n"); grid = -1; return; }
        int per_cu = 0;
        if (hipOccupancyMaxActiveBlocksPerMultiprocessor(&per_cu, (const void*)mk_fwd, NWAVES * 64, LDS_BYTES) != hipSuccess || per_cu < 1) fprintf(stderr, "kernel_launch: occupancy query reports %d\n", per_cu);
        (void)hipGetLastError();
        grid = cus;
    }
    if (grid < 0) return;
    if (hipMemsetAsync((char*)d_ws + WS_CTL, 0, CTL_ZERO_BYTES, stream) != hipSuccess) return;
    Args a{};
    a.x = (const float*)d_in[0]; a.c = (const float*)d_in[1]; a.final_norm = (const float*)d_in[40];
    int k = 2;
    for (int l = 0; l < DEPTH; ++l) { LayerW& w = a.L[l];
        w.norm_attn = (const float*)d_in[k++]; w.ada_w = (const float*)d_in[k++]; w.ada_b = (const float*)d_in[k++]; w.w_in = (const float*)d_in[k++];
        if (l & 1) { w.kv_norm = (const float*)d_in[k++]; w.w_uk = (const float*)d_in[k++]; w.w_uv = (const float*)d_in[k++]; }
        else { w.kv_norm = nullptr; w.w_uk = nullptr; w.w_uv = nullptr; }
        w.w_out = (const float*)d_in[k++]; w.norm_ffn = (const float*)d_in[k++]; w.w_gu = (const float*)d_in[k++]; w.w_down = (const float*)d_in[k++]; }
    a.out = (float*)d_out; a.ws = (unsigned char*)d_ws;
#if MK_MULTI
    for (int p = 0; p < PH_COUNT; ++p) {
        if (p >= 1 && p < PH_FINAL) { const int l = (p - 1) / PH_PER_LAYER, k2 = (p - 1) % PH_PER_LAYER; if (!(l & 1) && (k2 == 2 || k2 == 4)) continue; }
        a.ph_lo = p; a.ph_hi = p + 1;
#ifdef DIAG_PROBE
        if (p > DIAG_LAST) break;
#endif
        hipLaunchKernelGGL(mk_fwd, dim3(grid), dim3(NWAVES * 64), LDS_BYTES, stream, a);
    }
#ifdef DIAG_PROBE
    { ProbeArgs pa{}; unsigned char* ws = (unsigned char*)d_ws; DIAG_SETUP; pa.cnt = (unsigned*)(ws + WS_CTL) + 64; pa.out = (float*)d_out;
      hipLaunchKernelGGL(probe_kernel, dim3(1024), dim3(256), 0, stream, pa); hipLaunchKernelGGL(probe_fill, dim3(1024), dim3(256), 0, stream, pa); }
#endif
#else
    a.ph_lo = 0; a.ph_hi = PH_COUNT;
    hipLaunchKernelGGL(mk_fwd, dim3(grid), dim3(NWAVES * 64), LDS_BYTES, stream, a);
#endif
    const hipError_t le = hipPeekAtLastError();
    if (le != hipSuccess) fprintf(stderr, "kernel_launch: launch failed: %s\n", hipGetErrorName(le));
}
```

```cpp
#include <hip/hip_runtime.h>
#include <cstdio>
#include <cstdint>
#define MK_MULTI 0
#define I8_DSA false
namespace pg8 {
#define PG8_LAS __attribute__((address_space(3)))
typedef unsigned short bf16_t;
typedef short bf16x8 __attribute__((ext_vector_type(8)));
typedef float f32x4 __attribute__((ext_vector_type(4)));
typedef unsigned u32x4 __attribute__((ext_vector_type(4)));
constexpr int BM = 256, BK = 64, HALF = 128, HTB = HALF * BK * 2  , STAGE_BYTES = 8 * HTB, NXCD = 8, WGM = 8;

__host__ __device__ __forceinline__ int lds_byte(int r, int c) { const int st = (r >> 4) * 2 + (c >> 5), rr = r & 15, cc = c & 31, ob = rr * 64 + cc * 2; return st * 1024 + (ob ^ (((ob >> 9) & 1) << 5)); }
__host__ __device__ __forceinline__ void stage_rc(int b, int& R, int& C) { const int st = b / 1024, sb = b % 1024, swz = sb ^ (((sb >> 9) & 1) << 5); R = (st >> 1) * 16 + swz / 64; C = (st & 1) * 32 + (swz % 64) / 2; }
__host__ __device__ __forceinline__ int perm32(int rho) { const int n = rho >> 4, i = rho & 15; return 8 * (i >> 2) + 4 * n + (i & 3); }

struct Unit { int pm, pn; };
struct Gemm { const bf16_t* A; const bf16_t* Bt; int M, N, K; };

struct StaticOrder {
    int nM, nN, nwg, G, c, wgm;
    __host__ __device__ void init(int M, int N, int G_, int c_, int wgm_ = WGM) { nM = M / BM; nN = N / BM; nwg = nM * nN; G = G_; c = c_; wgm = wgm_; }
    __host__ __device__ bool next(int i, Unit& u) const {
        const long L = (long)i * G + c; if (L >= nwg) return false;
        int wgid = (int)L; { const int q = nwg / NXCD, r = nwg % NXCD, xcd = wgid % NXCD, off = wgid / NXCD; wgid = (xcd < r ? xcd * (q + 1) : r * (q + 1) + (xcd - r) * q) + off; }
        const int nig = wgm * nN, gid = wgid / nig, fm = gid * wgm, gsz = (nM - fm) < wgm ? (nM - fm) : wgm;
        u.pm = fm + ((wgid % nig) % gsz); u.pn = (wgid % nig) / gsz; return true;
    }
    __device__ __forceinline__ void a_ready(const Unit&) const {}
    __device__ __forceinline__ void done(const Unit&) const {}
};
typedef __bf16 bf16x2_cv __attribute__((ext_vector_type(2)));
typedef float f32x2_cv __attribute__((ext_vector_type(2)));
__device__ __forceinline__ unsigned cvt_pk_bf16(float lo, float hi) { const f32x2_cv v = {lo, hi}; const bf16x2_cv r = __builtin_convertvector(v, bf16x2_cv); return __builtin_bit_cast(unsigned, r); }
typedef float f32x2 __attribute__((ext_vector_type(2)));
__device__ __forceinline__ u32x4 pack8(const f32x4 v0, const f32x4 v1) { u32x4 w; w.x = cvt_pk_bf16(v0[0], v0[1]); w.y = cvt_pk_bf16(v0[2], v0[3]); w.z = cvt_pk_bf16(v1[0], v1[1]); w.w = cvt_pk_bf16(v1[2], v1[3]); return w; }

typedef int i32x4 __attribute__((ext_vector_type(4)));
template <bool I8_> struct AccT { typedef f32x4 type; };
template <> struct AccT<true> { typedef i32x4 type; };
template <bool I8_> __device__ __forceinline__ f32x4 deq(const typename AccT<I8_>::type a, float sa, const f32x4 sb) {
    if constexpr (I8_) { f32x4 r; r[0] = (float)a[0]; r[1] = (float)a[1]; r[2] = (float)a[2]; r[3] = (float)a[3]; return r * sa * sb; } else { (void)sa; (void)sb; return a; } }
template <bool I8_> __device__ __forceinline__ f32x4 deqg(const typename AccT<I8_>::type a, float sa, const f32x4 sb) { if constexpr (I8_) return deq<true>(a, sa, sb); else { (void)sa; return a * sb; } }
template <bool I8_> struct EpiQKV {
    static constexpr bool PERM = true, AFTER_DRAIN = false, I8 = I8_, FP8 = false; typedef typename AccT<I8_>::type acc_t;
    bf16_t* O; size_t split_stride; float qscale; const float* sA; const float* sB;
    __device__ __forceinline__ void operator()(const acc_t (&acc)[2][2][4][2], const Unit& u, int wr, int wc, int fr, int fq) const {
        const int row0 = u.pm * BM + wr * 64 + fr; const int t = u.pn >> 3; const int col0 = (u.pn & 7) * BM + wc * 32 + 8 * fq;
        bf16_t* base = O + (size_t)t * split_stride; const float sc = (t == 0) ? qscale : 1.f;
        f32x4 sb[2][2];
#pragma unroll
        for (int bj = 0; bj < 2; ++bj)
#pragma unroll
            for (int n = 0; n < 2; ++n) sb[bj][n] = I8_ ? *(const f32x4*)(sB + u.pn * BM + bj * HALF + wc * 32 + 8 * fq + 4 * n) : (f32x4){1.f, 1.f, 1.f, 1.f};
#pragma unroll
        for (int ai = 0; ai < 2; ++ai)
#pragma unroll
            for (int m = 0; m < 4; ++m) { const int r = row0 + ai * HALF + m * 16; bf16_t* rowp = base + (size_t)r * 2048 + col0; const float sa = (I8_ ? sA[r] : 1.f) * sc;
#pragma unroll
                for (int bj = 0; bj < 2; ++bj) { f32x4 v0 = deq<I8_>(acc[ai][bj][m][0], sa, sb[bj][0]), v1 = deq<I8_>(acc[ai][bj][m][1], sa, sb[bj][1]);
                    if (!I8_) { v0 = v0 * sc; v1 = v1 * sc; } *(u32x4*)(rowp + bj * HALF) = pack8(v0, v1); } }
    }
};
template <int MODE  > struct EpiResid {
    static constexpr bool PERM = false, AFTER_DRAIN = false, I8 = (MODE == 1), FP8 = (MODE == 2), I8_ = (MODE == 1); typedef typename AccT<(MODE == 1)>::type acc_t;
    const void* base; int base_f32; bf16_t* out; const float* gate; int gstride; const float* sA; const float* sB;
    __device__ __forceinline__ void operator()(const acc_t (&acc)[2][2][4][2], const Unit& u, int wr, int wc, int fr, int fq) const {
        typedef unsigned u32x2 __attribute__((ext_vector_type(2)));
        const int row0 = u.pm * BM + wr * 64 + fr, col0 = u.pn * BM + wc * 32 + 4 * fq;
        const float* gp = gate + (size_t)((u.pm * BM) >> 11) * gstride + col0;
        f32x4 gv[2][2];
#pragma unroll
        for (int bj = 0; bj < 2; ++bj)
#pragma unroll
            for (int n = 0; n < 2; ++n) { gv[bj][n] = *(const f32x4*)(gp + bj * HALF + n * 16); if (MODE != 0) gv[bj][n] = gv[bj][n] * *(const f32x4*)(sB + col0 + bj * HALF + n * 16); }
#pragma unroll
        for (int ai = 0; ai < 2; ++ai)
#pragma unroll
            for (int m = 0; m < 4; ++m) { const int r = row0 + ai * HALF + m * 16; const size_t off = (size_t)r * 2048 + col0; const float sa = I8_ ? sA[r] : 1.f;
                f32x4 bs[2][2];
                if (base_f32) {
#pragma unroll
                    for (int bj = 0; bj < 2; ++bj)
#pragma unroll
                        for (int n = 0; n < 2; ++n) bs[bj][n] = *(const f32x4*)((const float*)base + off + bj * HALF + n * 16);
                } else {
#pragma unroll
                    for (int bj = 0; bj < 2; ++bj)
#pragma unroll
                        for (int n = 0; n < 2; ++n) { const u32x2 w = *(const u32x2*)((const bf16_t*)base + off + bj * HALF + n * 16);
                            bs[bj][n] = (f32x4){__uint_as_float(w.x << 16), __uint_as_float(w.x & 0xFFFF0000u), __uint_as_float(w.y << 16), __uint_as_float(w.y & 0xFFFF0000u)}; }
                }
#pragma unroll
                for (int bj = 0; bj < 2; ++bj)
#pragma unroll
                    for (int n = 0; n < 2; ++n) { const f32x4 v = bs[bj][n] + deqg<I8_>(acc[ai][bj][m][n], sa, gv[bj][n]); *(u32x2*)(out + off + bj * HALF + n * 16) = (u32x2){cvt_pk_bf16(v[0], v[1]), cvt_pk_bf16(v[2], v[3])}; }
                asm volatile("" ::: "memory"); }
    }
};
template <bool I8_, bool OUT8  > struct EpiSwiglu {
    static constexpr bool PERM = true, AFTER_DRAIN = false, I8 = I8_, FP8 = false; typedef typename AccT<I8_>::type acc_t;
    bf16_t* O; const float* sA; const float* sB; unsigned* rmax;
    __device__ __forceinline__ static float silu(float x) { return x * __builtin_amdgcn_rcpf(1.0f + __builtin_amdgcn_exp2f(-1.44269504f * x)); }
    __device__ __forceinline__ void operator()(const acc_t (&acc)[2][2][4][2], const Unit& u, int wr, int wc, int fr, int fq) const {
        const int row0 = u.pm * BM + wr * 64 + fr; const int col0 = u.pn * HALF + wc * 32 + 8 * fq;
        f32x4 sb[2][2];
#pragma unroll
        for (int bj = 0; bj < 2; ++bj)
#pragma unroll
            for (int n = 0; n < 2; ++n) sb[bj][n] = I8_ ? *(const f32x4*)(sB + u.pn * BM + bj * HALF + wc * 32 + 8 * fq + 4 * n) : (f32x4){1.f, 1.f, 1.f, 1.f};
#pragma unroll
        for (int ai = 0; ai < 2; ++ai)
#pragma unroll
            for (int m = 0; m < 4; ++m) { const int r = row0 + ai * HALF + m * 16; bf16_t* rowp = O + (size_t)r * 5632 + col0; const float sa = I8_ ? sA[r] : 1.f;
                const f32x4 g0 = deq<I8_>(acc[ai][0][m][0], sa, sb[0][0]), g1 = deq<I8_>(acc[ai][0][m][1], sa, sb[0][1]), u0 = deq<I8_>(acc[ai][1][m][0], sa, sb[1][0]), u1 = deq<I8_>(acc[ai][1][m][1], sa, sb[1][1]);
                f32x4 v0, v1;
#pragma unroll
                for (int j = 0; j < 4; ++j) { v0[j] = silu(g0[j]) * u0[j]; v1[j] = silu(g1[j]) * u1[j]; }
                if constexpr (OUT8) { unsigned w0 = 0u, w1 = 0u; w0 = __builtin_amdgcn_cvt_pk_fp8_f32(v0[0], v0[1], w0, false); w0 = __builtin_amdgcn_cvt_pk_fp8_f32(v0[2], v0[3], w0, true);
                    w1 = __builtin_amdgcn_cvt_pk_fp8_f32(v1[0], v1[1], w1, false); w1 = __builtin_amdgcn_cvt_pk_fp8_f32(v1[2], v1[3], w1, true);
                    typedef unsigned u32x2 __attribute__((ext_vector_type(2))); *(u32x2*)((unsigned char*)O + (size_t)r * 5632 + col0) = (u32x2){w0, w1}; }
                else *(u32x4*)rowp = pack8(v0, v1);
                if (rmax) { float mx = fmaxf(fmaxf(fmaxf(fabsf(v0[0]), fabsf(v0[1])), fmaxf(fabsf(v0[2]), fabsf(v0[3]))), fmaxf(fmaxf(fabsf(v1[0]), fabsf(v1[1])), fmaxf(fabsf(v1[2]), fabsf(v1[3]))));
                    { unsigned uu = __float_as_uint(mx); auto r16 = __builtin_amdgcn_permlane16_swap(uu, uu, false, false); mx = fmaxf(__uint_as_float(r16[0]), __uint_as_float(r16[1])); uu = __float_as_uint(mx); auto r32 = __builtin_amdgcn_permlane32_swap(uu, uu, false, false); mx = fmaxf(__uint_as_float(r32[0]), __uint_as_float(r32[1])); }
                    if (fq == 0) atomicMax(rmax + r, __float_as_uint(mx)); } }
    }
};
template <bool I8_> struct EpiDsaProj {
    static constexpr bool PERM = true, AFTER_DRAIN = false, I8 = I8_, FP8 = false; typedef typename AccT<I8_>::type acc_t;
    bf16_t* Q; float* CKVR; bf16_t* QI; bf16_t* KI; float* WI; const float* sA; const float* sB;
    __device__ __forceinline__ void operator()(const acc_t (&acc)[2][2][4][2], const Unit& u, int wr, int wc, int fr, int fq) const {
        const int row0 = u.pm * BM + wr * 64 + fr; const int lc0 = wc * 32 + 8 * fq;
        f32x4 sb[2][2];
#pragma unroll
        for (int bj = 0; bj < 2; ++bj)
#pragma unroll
            for (int n = 0; n < 2; ++n) sb[bj][n] = I8_ ? *(const f32x4*)(sB + u.pn * BM + bj * HALF + lc0 + 4 * n) : (f32x4){1.f, 1.f, 1.f, 1.f};
#define DQ(ai, bj, m, n) deq<I8_>(acc[ai][bj][m][n], sa, sb[bj][n])
        if (u.pn < 8 || (u.pn >= 9 && u.pn < 17)) {
            bf16_t* base = (u.pn < 8) ? Q : QI; const int col0 = ((u.pn < 8) ? u.pn : (u.pn - 9)) * BM + lc0;
#pragma unroll
            for (int ai = 0; ai < 2; ++ai)
#pragma unroll
                for (int m = 0; m < 4; ++m) { const int r = row0 + ai * HALF + m * 16; const float sa = I8_ ? sA[r] : 1.f; bf16_t* rowp = base + (size_t)r * 2048 + col0;
#pragma unroll
                    for (int bj = 0; bj < 2; ++bj) *(u32x4*)(rowp + bj * HALF) = pack8(DQ(ai, bj, m, 0), DQ(ai, bj, m, 1)); }
        } else if (u.pn == 8) {
#pragma unroll
            for (int ai = 0; ai < 2; ++ai)
#pragma unroll
                for (int m = 0; m < 4; ++m) { const int r = row0 + ai * HALF + m * 16; const float sa = I8_ ? sA[r] : 1.f; float* rowp = CKVR + (size_t)r * 256 + lc0;
#pragma unroll
                    for (int bj = 0; bj < 2; ++bj) { *(f32x4*)(rowp + bj * HALF) = DQ(ai, bj, m, 0); *(f32x4*)(rowp + bj * HALF + 4) = DQ(ai, bj, m, 1); } }
        } else {
#pragma unroll
            for (int ai = 0; ai < 2; ++ai)
#pragma unroll
                for (int m = 0; m < 4; ++m) { const size_t r = (size_t)(row0 + ai * HALF + m * 16); const float sa = I8_ ? sA[r] : 1.f;
                    *(u32x4*)(KI + r * 128 + lc0) = pack8(DQ(ai, 0, m, 0), DQ(ai, 0, m, 1));
                    if (lc0 < 16) { *(f32x4*)(WI + r * 16 + lc0) = DQ(ai, 1, m, 0); *(f32x4*)(WI + r * 16 + lc0 + 4) = DQ(ai, 1, m, 1); } }
        }
#undef DQ
    }
};
template <class Epi, class Sched, bool ALIGN_EPI = false, bool SP2 = false>
__device__ __forceinline__ void gemm_phase(PG8_LAS unsigned char* lds, const Gemm g, const Sched& S, const Epi& E, int tid_in) {
    int tid_ = tid_in; asm volatile("" : "+v"(tid_));
    const int tid = tid_, wid = __builtin_amdgcn_readfirstlane(tid >> 6), lane = tid & 63, wr = wid >> 2, wc = wid & 3, fr = lane & 15, fq = lane >> 4;
    constexpr bool I8 = Epi::I8, F8 = Epi::FP8; typedef typename Epi::acc_t acc_t; typedef int i32x4_t __attribute__((ext_vector_type(4))); typedef int i32x8_t __attribute__((ext_vector_type(8)));
    const int K = g.K * ((I8 || F8) ? 1 : 2)  , nt = K / (BK * 2);
    unsigned voffA[2], voffB[2];
#pragma unroll
    for (int i = 0; i < 2; ++i) { int R, C; stage_rc(tid * 16 + i * 8192, R, C); const int Rb = Epi::PERM ? ((R & ~31) + perm32(R & 31)) : R;
        voffA[i] = (unsigned)(R * K + C * 2); voffB[i] = (unsigned)(Rb * K + C * 2); }
    const size_t kstep = (size_t)(BK * 2);
    const size_t hstep = (size_t)HALF * K;
    const size_t tstep = 2 * hstep;
    const unsigned ldsw = (unsigned)wid * 1024u;
    const int aoff = lds_byte(wr * 64 + fr, fq * 8), boff = lds_byte(wc * 32 + fr, fq * 8);
#define PG8_SA(b, h) (((b) * 2 + (h)) * HTB)
#define PG8_SB(b, h) ((4 + (b) * 2 + (h)) * HTB)
#define PG8_STAGE(bufoff, gbase, voff) do { _Pragma("unroll") for (int _i = 0; _i < 2; ++_i) \
        __builtin_amdgcn_global_load_lds((const unsigned*)((const char*)(gbase) + (voff)[_i]), (PG8_LAS unsigned*)(lds + (bufoff) + ldsw + _i * 8192), 16, 0, 0); } while (0)
#define PG8_LDA(dst, b, h) do { _Pragma("unroll") for (int m = 0; m < 4; ++m) _Pragma("unroll") for (int k = 0; k < 2; ++k) dst[m][k] = *(const PG8_LAS bf16x8*)(lds + PG8_SA(b, h) + aoff + m * 2048 + k * 1024); } while (0)
#define PG8_LDB(dst, b, h) do { _Pragma("unroll") for (int n = 0; n < 2; ++n) _Pragma("unroll") for (int k = 0; k < 2; ++k) dst[n][k] = *(const PG8_LAS bf16x8*)(lds + PG8_SB(b, h) + boff + n * 2048 + k * 1024); } while (0)
#define PG8_CAT8(x) ({ const i32x4_t lo_ = __builtin_bit_cast(i32x4_t, (x)[0]), hi_ = __builtin_bit_cast(i32x4_t, (x)[1]); (i32x8_t){lo_[0], lo_[1], lo_[2], lo_[3], hi_[0], hi_[1], hi_[2], hi_[3]}; })
#define PG8_MMA(ai, bj, At, Bt) do { __builtin_amdgcn_s_setprio(1); \
        if constexpr (F8) {   \
            _Pragma("unroll") for (int m = 0; m < 4; ++m) _Pragma("unroll") for (int n = 0; n < 2; ++n) \
                { const i32x8_t b8_ = PG8_CAT8(Bt[n]), a8_ = PG8_CAT8(At[m]); asm volatile("v_mfma_scale_f32_16x16x128_f8f6f4 %0, %1, %2, %0, %3, %3 op_sel_hi:[0,0,0]" : "+v"(acc[ai][bj][m][n]) : "v"(b8_), "v"(a8_), "v"(0x7F7F7F7F)); } \
        } else { _Pragma("unroll") for (int m = 0; m < 4; ++m) _Pragma("unroll") for (int n = 0; n < 2; ++n) _Pragma("unroll") for (int k = 0; k < 2; ++k) \
        { if constexpr (I8) acc[ai][bj][m][n] = __builtin_bit_cast(acc_t, __builtin_amdgcn_mfma_i32_16x16x64_i8(__builtin_bit_cast(i32x4_t, Bt[n][k]), __builtin_bit_cast(i32x4_t, At[m][k]), __builtin_bit_cast(i32x4_t, acc[ai][bj][m][n]), 0, 0, 0)); \
          else acc[ai][bj][m][n] = __builtin_bit_cast(acc_t, __builtin_amdgcn_mfma_f32_16x16x32_bf16(Bt[n][k], At[m][k], __builtin_bit_cast(f32x4, acc[ai][bj][m][n]), 0, 0, 0)); } } __builtin_amdgcn_s_setprio(0); } while (0)
#define PG8_WAIT_V(n) asm volatile("s_waitcnt vmcnt(" #n ")" ::: "memory")
#define PG8_WAIT_L(n) asm volatile("s_waitcnt lgkmcnt(" #n ")" ::: "memory")
#define PG8_BAR __builtin_amdgcn_s_barrier()
#define PG8_SCHED __builtin_amdgcn_sched_barrier(0)
    Unit cur, nxt; int ui = 0;
    if (!S.next(0, cur)) return;
    acc_t acc[2][2][4][2];
#pragma unroll
    for (int a = 0; a < 2; ++a)
#pragma unroll
        for (int b = 0; b < 2; ++b)
#pragma unroll
            for (int m = 0; m < 4; ++m)
#pragma unroll
                for (int n = 0; n < 2; ++n) acc[a][b][m][n] = acc_t{};
    bf16x8 At[4][2], B0[2][2], B1[2][2];
    const char* cA = (const char*)g.A + (size_t)cur.pm * tstep; const char* cB = (const char*)g.Bt + (size_t)cur.pn * tstep;
    S.a_ready(cur);
    if constexpr (SP2) {
        PG8_STAGE(PG8_SB(0, 0), cB, voffB); PG8_STAGE(PG8_SB(0, 1), cB + hstep, voffB); PG8_STAGE(PG8_SA(0, 0), cA, voffA); PG8_STAGE(PG8_SA(0, 1), cA + hstep, voffA);
        if (wr == 1) PG8_BAR;
        PG8_WAIT_V(2); PG8_BAR;
        PG8_STAGE(PG8_SB(1, 0), cB + kstep, voffB); PG8_STAGE(PG8_SA(1, 0), cA + kstep, voffA); PG8_STAGE(PG8_SB(1, 1), cB + hstep + kstep, voffB);
        PG8_WAIT_V(6); PG8_BAR;
    } else {
        PG8_STAGE(PG8_SB(0, 0), cB, voffB); PG8_STAGE(PG8_SA(0, 0), cA, voffA); PG8_STAGE(PG8_SB(0, 1), cB + hstep, voffB); PG8_STAGE(PG8_SA(0, 1), cA + hstep, voffA);
        if (wr == 1) PG8_BAR;
        PG8_WAIT_V(4); PG8_BAR;
        PG8_STAGE(PG8_SB(1, 0), cB + kstep, voffB); PG8_STAGE(PG8_SA(1, 0), cA + kstep, voffA); PG8_STAGE(PG8_SB(1, 1), cB + hstep + kstep, voffB);
        PG8_WAIT_V(6); PG8_BAR;
    }
    for (;;) {
        const bool has_next = S.next(ui + 1, nxt);
        const char* nA = has_next ? (const char*)g.A + (size_t)nxt.pm * tstep : cA; const char* nB = has_next ? (const char*)g.Bt + (size_t)nxt.pn * tstep : cB;
        for (int t = 0; t < nt; t += 2) {
            const bool last = (t == nt - 2);
            const char* a1 = cA + (size_t)(t + 1) * kstep;
            const char* a2 = last ? nA : cA + (size_t)(t + 2) * kstep; const char* b2 = last ? nB : cB + (size_t)(t + 2) * kstep;
            const char* a3 = a2 + kstep; const char* b3 = b2 + kstep;
            if (last && has_next) S.a_ready(nxt);
            if constexpr (SP2) {
            PG8_LDB(B0, 0, 0); PG8_LDB(B1, 0, 1); PG8_SCHED; PG8_LDA(At, 0, 0); PG8_STAGE(PG8_SA(1, 1), a1 + hstep, voffA);
            PG8_WAIT_V(8); PG8_WAIT_L(0); PG8_BAR; PG8_MMA(0, 0, At, B0); PG8_MMA(0, 1, At, B1); PG8_BAR; PG8_SCHED;
            PG8_LDA(At, 0, 1); PG8_STAGE(PG8_SB(0, 0), b2, voffB); PG8_STAGE(PG8_SB(0, 1), b2 + hstep, voffB); PG8_STAGE(PG8_SA(0, 0), a2, voffA);
            PG8_WAIT_V(8); PG8_WAIT_L(0); PG8_BAR; PG8_MMA(1, 0, At, B0); PG8_MMA(1, 1, At, B1); PG8_BAR; PG8_SCHED;
            PG8_LDB(B0, 1, 0); PG8_LDB(B1, 1, 1); PG8_SCHED; PG8_LDA(At, 1, 0); PG8_STAGE(PG8_SA(0, 1), a2 + hstep, voffA);
            PG8_WAIT_V(8); PG8_WAIT_L(0); PG8_BAR; PG8_MMA(0, 0, At, B0); PG8_MMA(0, 1, At, B1); PG8_BAR; PG8_SCHED;
            PG8_LDA(At, 1, 1); PG8_STAGE(PG8_SB(1, 0), b3, voffB); PG8_STAGE(PG8_SB(1, 1), b3 + hstep, voffB); PG8_STAGE(PG8_SA(1, 0), a3, voffA);
            PG8_WAIT_V(8); PG8_WAIT_L(0); PG8_BAR; PG8_MMA(1, 0, At, B0); PG8_MMA(1, 1, At, B1); PG8_BAR; PG8_SCHED;
            } else {
            PG8_LDB(B0, 0, 0); PG8_SCHED; PG8_LDA(At, 0, 0); PG8_STAGE(PG8_SA(1, 1), a1 + hstep, voffA);
            PG8_WAIT_L(8); PG8_BAR; PG8_WAIT_L(0); PG8_MMA(0, 0, At, B0); PG8_BAR; PG8_SCHED;
            PG8_LDB(B1, 0, 1); PG8_STAGE(PG8_SB(0, 0), b2, voffB);
            PG8_BAR; PG8_WAIT_L(0); PG8_MMA(0, 1, At, B1); PG8_BAR;
            PG8_LDA(At, 0, 1); PG8_STAGE(PG8_SA(0, 0), a2, voffA);
            PG8_BAR; PG8_WAIT_L(0); PG8_MMA(1, 0, At, B0); PG8_BAR; PG8_SCHED;
            PG8_STAGE(PG8_SB(0, 1), b2 + hstep, voffB);
            PG8_WAIT_V(6); PG8_BAR; PG8_MMA(1, 1, At, B1); PG8_BAR;
            PG8_LDB(B0, 1, 0); PG8_SCHED; PG8_LDA(At, 1, 0); PG8_STAGE(PG8_SA(0, 1), a2 + hstep, voffA);
            PG8_WAIT_L(8); PG8_BAR; PG8_WAIT_L(0); PG8_MMA(0, 0, At, B0); PG8_BAR; PG8_SCHED;
            PG8_LDB(B1, 1, 1); PG8_STAGE(PG8_SB(1, 0), b3, voffB);
            PG8_BAR; PG8_WAIT_L(0); PG8_MMA(0, 1, At, B1); PG8_BAR;
            PG8_LDA(At, 1, 1); PG8_STAGE(PG8_SA(1, 0), a3, voffA);
            PG8_BAR; PG8_WAIT_L(0); PG8_MMA(1, 0, At, B0); PG8_BAR; PG8_SCHED;
            PG8_STAGE(PG8_SB(1, 1), b3 + hstep, voffB);
            PG8_WAIT_V(6); PG8_BAR; PG8_MMA(1, 1, At, B1); PG8_BAR;
            }
        }
        if constexpr (ALIGN_EPI) { if (wr == 0) PG8_BAR; }
        if constexpr (!Epi::AFTER_DRAIN) { E(acc, cur, wr, wc, fr, fq);
#ifdef EPI_TWICE
            if constexpr (Epi::PERM) { asm volatile("" ::: "memory"); E(acc, cur, wr, wc, fr, fq); }
#endif
            S.done(cur); }
        if (!has_next) break;
#pragma unroll
        for (int a = 0; a < 2; ++a)
#pragma unroll
            for (int b = 0; b < 2; ++b)
#pragma unroll
                for (int m = 0; m < 4; ++m)
#pragma unroll
                    for (int n = 0; n < 2; ++n) acc[a][b][m][n] = acc_t{};
        cur = nxt; cA = nA; cB = nB; ++ui;
        if constexpr (ALIGN_EPI) { if (wr == 1) PG8_BAR; }
    }
    PG8_WAIT_V(0);
    if constexpr (!ALIGN_EPI) { if (wr == 0) PG8_BAR; }
    PG8_BAR;
    if constexpr (Epi::AFTER_DRAIN) { E.fused(acc, cur, wr, wc, fr, fq, lds, wid, lane); S.done(cur); }
#undef PG8_SA
#undef PG8_SB
#undef PG8_STAGE
#undef PG8_LDA
#undef PG8_LDB
#undef PG8_MMA
#undef PG8_CAT8
#undef PG8_WAIT_V
#undef PG8_WAIT_L
#undef PG8_BAR
#undef PG8_SCHED
}
}
#ifndef PG8_SP2
#define PG8_SP2 true
#endif
#ifndef PG8_ALIGN
#define PG8_ALIGN true
#endif
#ifndef USE_I8
#define USE_I8 true
#endif
#ifndef I8_QKV
#define I8_QKV USE_I8
#endif
#ifndef I8_DSA
#define I8_DSA true
#endif
#ifndef I8_GU
#define I8_GU USE_I8
#endif
#ifndef OUT_MODE
#define OUT_MODE 2
#endif
#ifndef DN_MODE
#define DN_MODE 2
#endif
#define I8_DN (DN_MODE == 1)
#ifndef WGM_QKV
#define WGM_QKV 2
#endif
#ifndef WGM_DSA
#define WGM_DSA 4
#endif
#ifndef WGM_OUT
#define WGM_OUT 4
#endif
#ifndef WGM_GU
#define WGM_GU 4
#endif
#ifndef WGM_DN
#define WGM_DN 4
#endif
#ifndef DSA_MERGE_POST
#define DSA_MERGE_POST 1
#endif
#ifndef PRO_SINGLE
#define PRO_SINGLE 1
#endif
#ifndef DIL_SPLIT
#define DIL_SPLIT 1
#endif
#ifndef DIL_FUSED
#define DIL_FUSED 0
#endif
#ifndef MK_MULTI
#define MK_MULTI 0
#endif

constexpr int NWAVES = 8;
constexpr int BATCH = 8, SEQ = 2048, D = 2048, M = BATCH * SEQ, NH = 16, HD = 128, DFF = 5632, KVL = 256, TOPK = 256, DEPTH = 4;
constexpr int NIN_A = 6144, NIN_B = 4496, NIN_BP = 4608, NMOD = 6 * D;
constexpr float EPS = 1e-6f;
constexpr float LOG2E = 1.4426950408889634f;
constexpr float QSCALE = 0.08838834764831845f * LOG2E;

constexpr size_t MiB = 1u << 20;
constexpr size_t WS_CTL = 0, CTL_ZERO_BYTES = 1 * MiB;
constexpr size_t WS_MOD = 1 * MiB;
constexpr size_t WS_W = 4 * MiB, W_LAYER = 100 * MiB;
constexpr size_t WO_IN = 0, WO_OUT = 24 * MiB, WO_GU = 32 * MiB, WO_DN = 76 * MiB, WO_UK = 98 * MiB, WO_UV = 99 * MiB;
constexpr size_t WS_H = 404 * MiB;
constexpr size_t WS_R1 = 468 * MiB;
constexpr size_t WS_ATT = 660 * MiB;
constexpr size_t WS_R2 = 724 * MiB;
constexpr size_t WS_X16 = 900 * MiB;
constexpr size_t WS_END = 964 * MiB;
constexpr size_t R2_ATT8 = 16 * MiB;
constexpr size_t R1_Q = 0, R1_QI = 64 * MiB, R1_OLAT = 0, R1_CKVR = 128 * MiB, R1_KI = 144 * MiB, R1_WI = 148 * MiB, R1_CKV = 149 * MiB, R1_SEL = 157 * MiB;
constexpr int CW_BAR = 4096;
constexpr size_t CTL_CMAX = 65536;
constexpr size_t CTL_DILCNT = 524288;
constexpr int CM_LAYER = 21504, CM_GU = 6144, CM_DN = 17408, CM_OUT = 19456;
constexpr size_t WS_SA = 2 * MiB + 512 * 1024;
constexpr size_t WS_RMAX = WS_SA + 65536;
constexpr size_t WS_SA2 = WS_SA + 131072;
constexpr size_t WS_SB = 3 * MiB;

constexpr int RING_BYTES = 143360;
constexpr int MISC_OFF = RING_BYTES;
constexpr int LDS_BYTES = RING_BYTES + 256;

#define GAS __attribute__((address_space(1)))
#define LAS __attribute__((address_space(3)))
typedef unsigned short bf16;
typedef unsigned short u16;
typedef unsigned v4u __attribute__((ext_vector_type(4)));
typedef unsigned v2u __attribute__((ext_vector_type(2)));
typedef float f32x4 __attribute__((ext_vector_type(4)));
typedef short bf16x8 __attribute__((ext_vector_type(8)));
typedef short s16x4 __attribute__((ext_vector_type(4)));
typedef short v4i16_t __attribute__((ext_vector_type(4)));
typedef GAS unsigned gu32;
template <class T> __device__ __forceinline__ T* as_global(T* p) { return (T*)(GAS T*)p; }
#define RLX_AGENT __ATOMIC_RELAXED, __HIP_MEMORY_SCOPE_AGENT
#define LDS_WAIT() asm volatile("s_waitcnt lgkmcnt(0)" ::: "memory")
#define VM_WAIT() asm volatile("s_waitcnt vmcnt(0)" ::: "memory")
__device__ __forceinline__ unsigned cvtpk(float lo, float hi) { return pg8::cvt_pk_bf16(lo, hi); }
#define DPPF(v, ctrl) __builtin_bit_cast(float, __builtin_amdgcn_update_dpp(0, __builtin_bit_cast(int, (v)), (ctrl), 0xF, 0xF, true))
__device__ __forceinline__ float xmax16(float v) { const unsigned u = __float_as_uint(v); auto r = __builtin_amdgcn_permlane16_swap(u, u, false, false); return fmaxf(__uint_as_float(r[0]), __uint_as_float(r[1])); }
__device__ __forceinline__ float xmax32(float v) { const unsigned u = __float_as_uint(v); auto r = __builtin_amdgcn_permlane32_swap(u, u, false, false); return fmaxf(__uint_as_float(r[0]), __uint_as_float(r[1])); }
__device__ __forceinline__ float xsum16(float v) { const unsigned u = __float_as_uint(v); auto r = __builtin_amdgcn_permlane16_swap(u, u, false, false); return __uint_as_float(r[0]) + __uint_as_float(r[1]); }
__device__ __forceinline__ float xsum32(float v) { const unsigned u = __float_as_uint(v); auto r = __builtin_amdgcn_permlane32_swap(u, u, false, false); return __uint_as_float(r[0]) + __uint_as_float(r[1]); }
__device__ __forceinline__ float wave_sum(float v) {
    v += DPPF(v, 0xB1); v += DPPF(v, 0x4E); v += DPPF(v, 0x141); v += DPPF(v, 0x140);
    return xsum32(xsum16(v));
}
__device__ __forceinline__ float wave_max(float v) {
    v = fmaxf(v, DPPF(v, 0xB1)); v = fmaxf(v, DPPF(v, 0x4E)); v = fmaxf(v, DPPF(v, 0x141)); v = fmaxf(v, DPPF(v, 0x140));
    return xmax32(xmax16(v));
}
__device__ __forceinline__ s16x4 tr_read(LAS const unsigned char* p) { return __builtin_bit_cast(s16x4, __builtin_amdgcn_ds_read_tr16_b64_v4i16((LAS v4i16_t*)p)); }
__device__ __forceinline__ bf16x8 cat8(s16x4 a, s16x4 b) { bf16x8 r; r[0] = a[0]; r[1] = a[1]; r[2] = a[2]; r[3] = a[3]; r[4] = b[0]; r[5] = b[1]; r[6] = b[2]; r[7] = b[3]; return r; }
__device__ __forceinline__ unsigned mbcnt64(unsigned long long m) { return __builtin_amdgcn_mbcnt_hi((unsigned)(m >> 32), __builtin_amdgcn_mbcnt_lo((unsigned)m, 0u)); }

#define XB_TMO      128
#define XB_XCNT(j)  (256  + 64 * (j))
#define XB_XSUB(j)  (1280 + 64 * (j))
#define XB_XGEN(j)  (2304 + 64 * (j))
#define XB_TOP      3328
#define XB_TOPGEN   3392
#define XCD_BAR_WORDS 3456
#define XB_SPIN_CAP (1u << 18)

__device__ __forceinline__ unsigned xb_ld(unsigned* p)              { return __hip_atomic_load(p, __ATOMIC_RELAXED, __HIP_MEMORY_SCOPE_AGENT); }
__device__ __forceinline__ unsigned xb_add(unsigned* p, unsigned v) { return __hip_atomic_fetch_add(p, v, __ATOMIC_RELAXED, __HIP_MEMORY_SCOPE_AGENT); }
__device__ __forceinline__ unsigned xb_xcc_id() { return (unsigned)__builtin_amdgcn_s_getreg((3 << 11) | 20) & 0xFu; }
#define XB_SPIN(cond, bar) do { unsigned _sp = 0; while (cond) { __builtin_amdgcn_s_sleep(1); \
    if ((++_sp & 255u) == 0u) { if (xb_ld(&(bar)[XB_TMO])) break; if (_sp > XB_SPIN_CAP) { atomicAdd(&(bar)[XB_TMO], 1u); break; } } } } while (0)

struct XcdBarrier {
    unsigned* bar; unsigned x;
    volatile LAS unsigned* st;
};

__device__ __forceinline__ XcdBarrier xcd_barrier_post(unsigned* bar, volatile LAS unsigned* st) {
    XcdBarrier b; b.bar = bar; b.x = xb_xcc_id(); b.st = st;
    if (threadIdx.x == 0) (void)xb_add(&bar[XB_XCNT(b.x)], 1u);
    return b;
}
__device__ __forceinline__ void xcd_barrier_complete(unsigned* bar, unsigned x, unsigned& nloc, unsigned& nx) {
    const unsigned G = gridDim.x * gridDim.y * gridDim.z;
    unsigned sum, cnt, mine, sp = 0u;
    for (;;) {
        sum = 0u; cnt = 0u; mine = 0u;
#pragma unroll
        for (unsigned j = 0; j < 16; ++j) { const unsigned c = xb_ld(&bar[XB_XCNT(j)]); sum += c; cnt += (c > 0u) ? 1u : 0u; mine = (j == x) ? c : mine; }
        if (sum == G) break;
        __builtin_amdgcn_s_sleep(1);
        if ((++sp & 255u) == 0u) { if (xb_ld(&bar[XB_TMO])) break; if (sp > XB_SPIN_CAP) { atomicAdd(&bar[XB_TMO], 1u); break; } }
    }
    nloc = mine > 0u ? mine : 1u; nx = cnt > 0u ? cnt : 1u;
}

__device__ __forceinline__ void xcd_barrier_census(const XcdBarrier& b) { unsigned nloc, nx; xcd_barrier_complete(b.bar, b.x, nloc, nx); b.st[0] = nloc; b.st[1] = nx; }
__device__ __forceinline__ void xcd_barrier(const XcdBarrier& b, const bool thread0  ) {
    asm volatile("s_waitcnt vmcnt(0)" ::: "memory");
    __syncthreads();
    if (thread0) {
        unsigned* bar = b.bar;
        __builtin_amdgcn_s_waitcnt(0);
        unsigned nloc = b.st[0], nx = b.st[1];
        const unsigned old = xb_add(&bar[XB_XSUB(b.x)], 1u);
        const unsigned gen = old / nloc;
        if (old + 1u == (gen + 1u) * nloc) {
            __builtin_amdgcn_fence(__ATOMIC_RELEASE, "agent");
            asm volatile("s_waitcnt vmcnt(0)" ::: "memory");
            const unsigned og = xb_add(&bar[XB_TOP], 1u);
            const unsigned tg = og / nx;
            if (og + 1u == (tg + 1u) * nx) xb_add(&bar[XB_TOPGEN], 1u);
            else XB_SPIN(xb_ld(&bar[XB_TOPGEN]) == tg, bar);
            __builtin_amdgcn_fence(__ATOMIC_ACQUIRE, "agent");
            xb_add(&bar[XB_XGEN(b.x)], 1u);
            asm volatile("s_waitcnt vmcnt(0)" ::: "memory");
        } else {
            XB_SPIN(xb_ld(&bar[XB_XGEN(b.x)]) == gen, bar);
            __builtin_amdgcn_fence(__ATOMIC_ACQUIRE, "agent");
            asm volatile("s_waitcnt vmcnt(0)" ::: "memory");
        }
    }
    __syncthreads();
}
struct LayerW { const float *norm_attn, *ada_w, *ada_b, *w_in, *kv_norm, *w_uk, *w_uv, *w_out, *norm_ffn, *w_gu, *w_down; };
struct Args { const float* x; const float* c; const float* final_norm; LayerW L[DEPTH]; float* out; unsigned char* ws; int ph_lo, ph_hi; };

__device__ __forceinline__ void colmax_item(const float* W, int N, unsigned* cmax, int item, int lane) {
    const int nnb = (N + 255) / 256, kb = item / nnb, nb = item % nnb, col = 256 * nb + 4 * lane;
    if (col < N) { const float* p = W + (size_t)(64 * kb) * N + col; f32x4 m = (f32x4){0.f, 0.f, 0.f, 0.f};
#pragma unroll 8
        for (int kk = 0; kk < 64; ++kk) { const f32x4 v = *(const f32x4*)(p + (size_t)kk * N); m[0] = fmaxf(m[0], fabsf(v[0])); m[1] = fmaxf(m[1], fabsf(v[1])); m[2] = fmaxf(m[2], fabsf(v[2])); m[3] = fmaxf(m[3], fabsf(v[3])); }
#pragma unroll
        for (int j = 0; j < 4; ++j) atomicMax(cmax + col + j, __float_as_uint(m[j])); }
}
constexpr int CI_INA = (D / 64) * (NIN_A / 256), CI_INB = I8_DSA ? (D / 64) * ((NIN_B + 255) / 256) : 0, CI_GU = (D / 64) * (2 * DFF / 256), CI_DN = (DFF / 64) * (D / 256), CI_OUT = OUT_MODE ? (D / 64) * (D / 256) : 0;
constexpr int CI_DIL = CI_INA + CI_GU + CI_DN + CI_OUT, CI_DSA = CI_INB + CI_GU + CI_DN + CI_OUT, CI_ALL = 2 * CI_DIL + 2 * CI_DSA;
__device__ __forceinline__ void p0_colmax(const Args& a, int gw, int NGW, int lane) {
    unsigned* cm = (unsigned*)(as_global(a.ws) + WS_CTL + CTL_CMAX);
    for (int it = gw; it < CI_ALL; it += NGW) {
        int r = it; int l;
        if (r < CI_DIL) l = 0; else { r -= CI_DIL; if (r < CI_DSA) l = 1; else { r -= CI_DSA; if (r < CI_DIL) l = 2; else { r -= CI_DIL; l = 3; } } }
        const LayerW& w = a.L[l]; unsigned* cml = cm + l * CM_LAYER; const int nin = (l & 1) ? NIN_B : NIN_A, ci_in = (l & 1) ? CI_INB : CI_INA;
        if (r < ci_in) colmax_item(as_global(w.w_in), nin, cml, r, lane); else if (r < ci_in + CI_GU) colmax_item(as_global(w.w_gu), 2 * DFF, cml + CM_GU, r - ci_in, lane); else if (r < ci_in + CI_GU + CI_DN) colmax_item(as_global(w.w_down), D, cml + CM_DN, r - ci_in - CI_GU, lane); else colmax_item(as_global(w.w_out), D, cml + CM_OUT, r - ci_in - CI_GU - CI_DN, lane);
    }
}
constexpr int TSCR = 64 * 65 * 4;
struct TrItem { const float* W; int ldw, srccol0, nvalid, k0, K, destrow0, mode; void* WT; const unsigned* cmax; float* sB; LAS const float* cml; };
__device__ __forceinline__ void tr_load(const TrItem& T, int lane, f32x4 (&v)[16]) {
    const int c4 = lane & 15, r4 = lane >> 4; const bool ok = 4 * c4 < T.nvalid; const float* p = T.W + (size_t)(T.k0 + r4) * T.ldw + T.srccol0 + 4 * c4;
#pragma unroll
    for (int it = 0; it < 16; ++it) { v[it] = (f32x4){0.f, 0.f, 0.f, 0.f}; if (ok) v[it] = *(const f32x4*)(p + (size_t)(4 * it) * T.ldw); }
}
__device__ __forceinline__ void tr_fill(LAS float* scr, int lane, const f32x4 (&v)[16]) {
    const int c4 = lane & 15, r4 = lane >> 4;
#pragma unroll
    for (int it = 0; it < 16; ++it) { LAS float* d = scr + (4 * it + r4) * 65 + 4 * c4; d[0] = v[it][0]; d[1] = v[it][1]; d[2] = v[it][2]; d[3] = v[it][3]; }
}
__device__ __forceinline__ void tr_emit(const TrItem& T, LAS float* scr, int lane) {
    const int q = lane & 3, rr = lane >> 2;
#pragma unroll
    for (int j = 0; j < 4; ++j) { const int n = rr + 16 * j; const LAS float* sp = scr + (16 * q) * 65 + n; float v[16];
#pragma unroll
        for (int e = 0; e < 16; ++e) v[e] = sp[e * 65];
        if (T.mode == 2) { const float cmx = (n < T.nvalid) ? (T.cml ? T.cml[n] : __uint_as_float(T.cmax[T.srccol0 + n])) : 0.f; const float inv = cmx > 0.f ? 256.0f / cmx : 0.f; unsigned w[4];
#pragma unroll
            for (int e = 0; e < 4; ++e) { unsigned ww = 0u; ww = __builtin_amdgcn_cvt_pk_fp8_f32(v[4 * e] * inv, v[4 * e + 1] * inv, ww, false); ww = __builtin_amdgcn_cvt_pk_fp8_f32(v[4 * e + 2] * inv, v[4 * e + 3] * inv, ww, true); w[e] = ww; }
            *(v4u*)((signed char*)T.WT + (size_t)(T.destrow0 + n) * T.K + T.k0 + 16 * q) = (v4u){w[0], w[1], w[2], w[3]}; }
        else if (T.mode) { const float cmx = (n < T.nvalid) ? (T.cml ? T.cml[n] : __uint_as_float(T.cmax[T.srccol0 + n])) : 0.f; const float inv = cmx > 0.f ? 127.0f / cmx : 0.f; unsigned b[16];
#pragma unroll
            for (int e = 0; e < 16; ++e) b[e] = (unsigned)(int)rintf(v[e] * inv) & 0xFFu;
            v4u o; o.x = b[0] | (b[1] << 8) | (b[2] << 16) | (b[3] << 24); o.y = b[4] | (b[5] << 8) | (b[6] << 16) | (b[7] << 24); o.z = b[8] | (b[9] << 8) | (b[10] << 16) | (b[11] << 24); o.w = b[12] | (b[13] << 8) | (b[14] << 16) | (b[15] << 24);
            *(v4u*)((signed char*)T.WT + (size_t)(T.destrow0 + n) * T.K + T.k0 + 16 * q) = o; }
        else { v4u o0, o1; o0.x = cvtpk(v[0], v[1]); o0.y = cvtpk(v[2], v[3]); o0.z = cvtpk(v[4], v[5]); o0.w = cvtpk(v[6], v[7]); o1.x = cvtpk(v[8], v[9]); o1.y = cvtpk(v[10], v[11]); o1.z = cvtpk(v[12], v[13]); o1.w = cvtpk(v[14], v[15]);
            bf16* dp = (bf16*)T.WT + (size_t)(T.destrow0 + n) * T.K + T.k0 + 16 * q; *(v4u*)dp = o0; *(v4u*)(dp + 8) = o1; } }
    if (T.mode && T.k0 == 0 && !T.cml) T.sB[T.destrow0 + lane] = (lane < T.nvalid) ? __uint_as_float(T.cmax[T.srccol0 + lane]) * (T.mode == 2 ? (1.0f / 256.0f) : (1.0f / 127.0f)) : 0.f;
}
__device__ __forceinline__ void tr_set(TrItem& T, const float* W, int K, int N, int Ndest, void* WT, int mode, const unsigned* cmax, float* sB, int item) {
    const int nnb = Ndest / 64, kb = item / nnb, nb = item % nnb, n0 = 64 * nb; int nv = N - n0; nv = nv < 0 ? 0 : (nv > 64 ? 64 : nv);
    T.W = W; T.ldw = N; T.srccol0 = n0; T.nvalid = nv; T.k0 = 64 * kb; T.K = K; T.destrow0 = n0; T.mode = mode; T.WT = WT; T.cmax = cmax; T.sB = sB; T.cml = nullptr;
}
constexpr int IT_INA = (D / 64) * (NIN_A / 64), IT_INB = (D / 64) * (NIN_BP / 64), IT_OUT = (D / 64) * (D / 64), IT_GU = (D / 64) * (2 * DFF / 64), IT_DN = (DFF / 64) * (D / 64), IT_UK = 16 * 8, IT_UV = 16 * 8;
constexpr int IT_DIL = IT_INA + IT_OUT + IT_GU + IT_DN, IT_DSA = IT_INB + IT_OUT + IT_GU + IT_DN + IT_UK + IT_UV;
constexpr int IT_ALL = 2 * IT_DIL + 2 * IT_DSA;
__device__ __forceinline__ void tr_decode(const Args& a, int it, TrItem& T) {
    int r = it; int l;
    if (r < IT_DIL) l = 0; else { r -= IT_DIL; if (r < IT_DSA) l = 1; else { r -= IT_DSA; if (r < IT_DIL) l = 2; else { r -= IT_DIL; l = 3; } } }
    const LayerW& w = a.L[l]; unsigned char* wb = as_global(a.ws) + WS_W + (size_t)l * W_LAYER;
    const unsigned* cml = (const unsigned*)(as_global(a.ws) + WS_CTL + CTL_CMAX) + l * CM_LAYER; float* sbl = (float*)(as_global(a.ws) + WS_SB) + l * CM_LAYER;
    if (!(l & 1)) { if (r < IT_INA) { tr_set(T, as_global(w.w_in), D, NIN_A, NIN_A, wb + WO_IN, I8_QKV, cml, sbl, r); return; } r -= IT_INA; }
    else { if (r < IT_INB) { tr_set(T, as_global(w.w_in), D, NIN_B, NIN_BP, wb + WO_IN, I8_DSA, cml, sbl, r); return; } r -= IT_INB; }
    if (r < IT_OUT) { tr_set(T, as_global(w.w_out), D, D, D, wb + WO_OUT, OUT_MODE, cml + CM_OUT, sbl + CM_OUT, r); return; } r -= IT_OUT;
    if (r < IT_GU) {
        const int nnb = (2 * DFF) / 64, kb = r / nnb, nb = r % nnb, n0 = 64 * nb, pn = n0 >> 8, lc = n0 & 255;
        T.W = as_global(w.w_gu); T.ldw = 2 * DFF; T.srccol0 = ((lc < 128) ? 0 : DFF) + 128 * pn + (lc & 127); T.nvalid = 64; T.k0 = 64 * kb; T.K = D; T.destrow0 = n0; T.mode = I8_GU; T.WT = wb + WO_GU; T.cmax = cml + CM_GU; T.sB = sbl + CM_GU; T.cml = nullptr; return; }
    r -= IT_GU;
    if (r < IT_DN) { tr_set(T, as_global(w.w_down), DFF, D, D, wb + WO_DN, DN_MODE, cml + CM_DN, sbl + CM_DN, r); return; } r -= IT_DN;
    if (r < IT_UK) { const int h = r >> 3; tr_set(T, as_global(w.w_uk) + (size_t)h * HD * KVL, HD, KVL, KVL, (bf16*)(wb + WO_UK) + (size_t)h * KVL * HD, 0, cml, sbl, r & 7); return; } r -= IT_UK;
    { const int h = r >> 3; tr_set(T, as_global(w.w_uv) + (size_t)h * KVL * HD, KVL, HD, HD, (bf16*)(wb + WO_UV) + (size_t)h * HD * KVL, 0, cml, sbl, r & 7); }
}
__device__ __forceinline__ void p0_transposes(const Args& a, LAS unsigned char* lds, int gw, int NGW, int wave, int lane) {
    LAS float* scr = (LAS float*)(lds + wave * TSCR);
    int it = gw; if (it >= IT_ALL) return;
    TrItem T, Tn; f32x4 v[16];
    tr_decode(a, it, T); tr_load(T, lane, v);
    for (;;) {
        tr_fill(scr, lane, v);
        LDS_WAIT(); asm volatile("" ::: "memory");
        const int itn = it + NGW; const bool has = itn < IT_ALL;
        tr_decode(a, has ? itn : it, Tn); tr_load(Tn, lane, v);
        tr_emit(T, scr, lane);
        LDS_WAIT(); asm volatile("" ::: "memory");
        if (!has) break;
        it = itn; T = Tn;
    }
}
constexpr int ST_INA = NIN_A / 64, ST_INB = NIN_BP / 64, ST_OUT = D / 64, ST_GU = 2 * DFF / 64, ST_DN = D / 64;
constexpr int ST_DIL = (I8_QKV ? ST_INA : 0) + (OUT_MODE ? ST_OUT : 0) + (I8_GU ? ST_GU : 0) + (DN_MODE ? ST_DN : 0), ST_DSA = (I8_DSA ? ST_INB : 0) + (OUT_MODE ? ST_OUT : 0) + (I8_GU ? ST_GU : 0) + (DN_MODE ? ST_DN : 0);
constexpr int ST_ALL = 2 * ST_DIL + 2 * ST_DSA;
__device__ __forceinline__ void strip_decode(const Args& a, int sidx, TrItem& T) {
    int r = sidx; int l;
    if (DN_MODE && r < 4 * ST_DN) { l = r / ST_DN; r = r % ST_DN; const LayerW& w = a.L[l]; unsigned char* wb = as_global(a.ws) + WS_W + (size_t)l * W_LAYER; float* sbl = (float*)(as_global(a.ws) + WS_SB) + l * CM_LAYER;
        T.W = as_global(w.w_down); T.ldw = D; T.srccol0 = 64 * r; T.nvalid = 64; T.K = DFF; T.destrow0 = 64 * r; T.mode = DN_MODE; T.WT = wb + WO_DN; T.cmax = nullptr; T.sB = sbl + CM_DN; return; }
    if (DN_MODE) r -= 4 * ST_DN;
    const int per_dil = ST_DIL - (DN_MODE ? ST_DN : 0), per_dsa = ST_DSA - (DN_MODE ? ST_DN : 0);
    if (r < per_dil) l = 0; else { r -= per_dil; if (r < per_dsa) l = 1; else { r -= per_dsa; if (r < per_dil) l = 2; else { r -= per_dil; l = 3; } } }
    const LayerW& w = a.L[l]; unsigned char* wb = as_global(a.ws) + WS_W + (size_t)l * W_LAYER; float* sbl = (float*)(as_global(a.ws) + WS_SB) + l * CM_LAYER;
    const bool dsa = l & 1; const int st_in = dsa ? (I8_DSA ? ST_INB : 0) : (I8_QKV ? ST_INA : 0);
    T.cmax = nullptr; T.K = D;
    if (r < st_in) { const int N = dsa ? NIN_B : NIN_A; int nv = N - 64 * r; nv = nv < 0 ? 0 : (nv > 64 ? 64 : nv);
        T.W = as_global(w.w_in); T.ldw = N; T.srccol0 = 64 * r; T.nvalid = nv; T.destrow0 = 64 * r; T.mode = 1; T.WT = wb + WO_IN; T.sB = sbl; return; }
    r -= st_in;
    if (OUT_MODE && r < ST_OUT) { T.W = as_global(w.w_out); T.ldw = D; T.srccol0 = 64 * r; T.nvalid = 64; T.destrow0 = 64 * r; T.mode = OUT_MODE; T.WT = wb + WO_OUT; T.sB = sbl + CM_OUT; return; }
    if (OUT_MODE) r -= ST_OUT;
    { const int n0 = 64 * r, pn = n0 >> 8, lc = n0 & 255;
      T.W = as_global(w.w_gu); T.ldw = 2 * DFF; T.srccol0 = ((lc < 128) ? 0 : DFF) + 128 * pn + (lc & 127); T.nvalid = 64; T.destrow0 = n0; T.mode = 1; T.WT = wb + WO_GU; T.sB = sbl + CM_GU; }
}
__device__ __forceinline__ void p0_strips(const Args& a, LAS unsigned char* lds, int vcu, int G, int tid, int wave, int lane) {
    LAS float* scr = (LAS float*)(lds + wave * TSCR); LAS float* wm = (LAS float*)(lds + 8 * TSCR); LAS float* cmx = wm + 8 * 64;
    constexpr int ST_LONG = DN_MODE ? 4 * ST_DN : 0, ST_SHORT = ST_ALL - ST_LONG;
    const bool bal = (G == 256) && (ST_LONG == 128) && (ST_SHORT >= 1152);
    for (int i = 0;; ++i) {
        int sidx;
        if (bal) { if (vcu < 128) { if (i == 0) sidx = vcu; else if (i <= 3) sidx = ST_LONG + 3 * vcu + (i - 1); else break; }
                   else { const int c = vcu - 128; if (i < 6) sidx = ST_LONG + 384 + 6 * c + i; else if (i == 6 && 1152 + c < ST_SHORT) sidx = ST_LONG + 1152 + c; else break; } }
        else { sidx = vcu + i * G; if (sidx >= ST_ALL) break; }
        TrItem T; strip_decode(a, sidx, T); T.cml = cmx;
        const int nkb = T.K / 64; f32x4 v[16];
        f32x4 mx = (f32x4){0.f, 0.f, 0.f, 0.f};
        { int kb = wave; T.k0 = 64 * kb; if (kb < nkb) tr_load(T, lane, v);
          while (kb < nkb) { f32x4 m2 = (f32x4){0.f, 0.f, 0.f, 0.f};
#pragma unroll
              for (int it = 0; it < 16; ++it) { m2[0] = fmaxf(m2[0], fabsf(v[it][0])); m2[1] = fmaxf(m2[1], fabsf(v[it][1])); m2[2] = fmaxf(m2[2], fabsf(v[it][2])); m2[3] = fmaxf(m2[3], fabsf(v[it][3])); }
              const int kn = kb + 8; T.k0 = 64 * (kn < nkb ? kn : kb); tr_load(T, lane, v);
              mx[0] = fmaxf(mx[0], m2[0]); mx[1] = fmaxf(mx[1], m2[1]); mx[2] = fmaxf(mx[2], m2[2]); mx[3] = fmaxf(mx[3], m2[3]); kb = kn; } }
#pragma unroll
        for (int j = 0; j < 4; ++j) mx[j] = xmax32(xmax16(mx[j]));
        if (lane < 16) *(LAS f32x4*)(wm + wave * 64 + 4 * lane) = mx;
        __syncthreads();
        if (tid < 64) { float m = wm[tid];
#pragma unroll
            for (int w8 = 1; w8 < 8; ++w8) m = fmaxf(m, wm[w8 * 64 + tid]);
            cmx[tid] = m; T.sB[T.destrow0 + tid] = (tid < T.nvalid) ? m * (T.mode == 2 ? (1.0f / 256.0f) : (1.0f / 127.0f)) : 0.f; }
        __syncthreads();
        { int kb = wave; if (kb < nkb) { T.k0 = 64 * kb; tr_load(T, lane, v);
            for (;;) { tr_fill(scr, lane, v); LDS_WAIT(); asm volatile("" ::: "memory");
                const int kn = kb + 8; TrItem Tn = T; Tn.k0 = 64 * (kn < nkb ? kn : kb); tr_load(Tn, lane, v);
                tr_emit(T, scr, lane); LDS_WAIT(); asm volatile("" ::: "memory");
                if (kn >= nkb) break; kb = kn; T.k0 = 64 * kb; } } }
        __syncthreads();
    }
}
__device__ __forceinline__ void p0_bf16_items(const Args& a, LAS unsigned char* lds, int gw, int NGW, int wave, int lane) {
    LAS float* scr = (LAS float*)(lds + wave * TSCR); f32x4 v[16];
    for (int it = gw; it < IT_ALL; it += NGW) { TrItem T; tr_decode(a, it, T); if (T.mode != 0) continue;
        tr_load(T, lane, v); tr_fill(scr, lane, v); LDS_WAIT(); asm volatile("" ::: "memory"); tr_emit(T, scr, lane); LDS_WAIT(); asm volatile("" ::: "memory"); }
}
constexpr int SC_STRIDE = 2112;
__device__ __forceinline__ void p0_adaln(const Args& a, LAS unsigned char* lds, int G, int tid, int wave, int lane) {
    LAS float* sc = (LAS float*)lds;
    LAS float* red = (LAS float*)(lds + 8 * SC_STRIDE * 4);
    float* mod = (float*)(as_global(a.ws) + WS_MOD); const float* cin = as_global(a.c);
    for (int i = tid; i < BATCH * D; i += NWAVES * 64) { const int b = i >> 11, k = i & 2047; const float v = cin[i]; sc[b * SC_STRIDE + k + (k >> 6)] = v / (1.0f + __expf(-v)); }
    __syncthreads();
    const int cg = tid & 15, ks = tid >> 4;
    for (int u = blockIdx.x; u < DEPTH * (NMOD / 64); u += G) {
        const int l = u / (NMOD / 64), col0 = 64 * (u % (NMOD / 64));
        const float* wp = as_global(a.L[l].ada_w) + (size_t)(64 * ks) * NMOD + col0 + 4 * cg;
        f32x4 acc[8];
#pragma unroll
        for (int b = 0; b < 8; ++b) acc[b] = (f32x4){0.f, 0.f, 0.f, 0.f};
#pragma unroll 4
        for (int kk = 0; kk < 64; ++kk) { const f32x4 w4 = *(const f32x4*)(wp + (size_t)kk * NMOD); const int kx = 64 * ks + kk + ks;
#pragma unroll
            for (int b = 0; b < 8; ++b) acc[b] += sc[b * SC_STRIDE + kx] * w4; }
#pragma unroll
        for (int b = 0; b < 8; ++b)
#pragma unroll
            for (int j = 0; j < 4; ++j) { acc[b][j] = xsum32(xsum16(acc[b][j])); }
        if (lane < 16) {
#pragma unroll
            for (int b = 0; b < 8; ++b) *(LAS f32x4*)(red + (wave * 8 + b) * 64 + 4 * cg) = acc[b]; }
        __syncthreads();
        { const int b = tid >> 6, col = tid & 63; float s = as_global(a.L[l].ada_b)[col0 + col];
#pragma unroll
          for (int w = 0; w < 8; ++w) s += red[(w * 8 + b) * 64 + col];
          mod[((size_t)l * BATCH + b) * NMOD + col0 + col] = s; }
        __syncthreads();
    }
}
__device__ __forceinline__ void ld8(const void* base, int is_f32, size_t idx, f32x4& a, f32x4& b) {
    if (is_f32) { const float* p = (const float*)base + idx; a = *(const f32x4*)p; b = *(const f32x4*)(p + 4); }
    else { const v4u w = *(const v4u*)((const bf16*)base + idx); a = (f32x4){__uint_as_float(w.x << 16), __uint_as_float(w.x & 0xFFFF0000u), __uint_as_float(w.y << 16), __uint_as_float(w.y & 0xFFFF0000u)};
        b = (f32x4){__uint_as_float(w.z << 16), __uint_as_float(w.z & 0xFFFF0000u), __uint_as_float(w.w << 16), __uint_as_float(w.w & 0xFFFF0000u)}; }
}
__device__ __forceinline__ void norm_mod_phase(const void* x, int xf32, const float* gain, const float* shift, const float* scale, bf16* h, int gw, int NGW, int lane) {
    for (int grp = gw; grp < M / 8; grp += NGW) {
        const int b = (grp * 8) >> 11;
        f32x4 A[8], B[8];
#pragma unroll
        for (int j = 0; j < 4; ++j)
#pragma unroll
            for (int e = 0; e < 2; ++e) { const int col = 8 * lane + 512 * j + 4 * e;
                const f32x4 g = *(const f32x4*)(gain + col), sc = *(const f32x4*)(scale + (size_t)b * NMOD + col); A[2 * j + e] = g * (sc + 1.0f); B[2 * j + e] = *(const f32x4*)(shift + (size_t)b * NMOD + col); }
        for (int rr = 0; rr < 8; ++rr) { const size_t row = (size_t)grp * 8 + rr;
            f32x4 v[8]; float ss = 0.f;
#pragma unroll
            for (int j = 0; j < 4; ++j) { ld8(x, xf32, row * D + 8 * lane + 512 * j, v[2 * j], v[2 * j + 1]);
#pragma unroll
                for (int e = 0; e < 2; ++e) { const f32x4 t = v[2 * j + e]; ss += (t[0] * t[0] + t[1] * t[1]) + (t[2] * t[2] + t[3] * t[3]); } }
            const float rstd = __builtin_amdgcn_rsqf(wave_sum(ss) * (1.0f / D) + EPS);
#pragma unroll
            for (int j = 0; j < 4; ++j) { const f32x4 y0 = v[2 * j] * rstd * A[2 * j] + B[2 * j], y1 = v[2 * j + 1] * rstd * A[2 * j + 1] + B[2 * j + 1];
                v4u o; o.x = cvtpk(y0[0], y0[1]); o.y = cvtpk(y0[2], y0[3]); o.z = cvtpk(y1[0], y1[1]); o.w = cvtpk(y1[2], y1[3]);
                *(v4u*)(h + row * D + 8 * lane + 512 * j) = o; }
        }
    }
}

__device__ __forceinline__ void norm_mod_phase_q(const void* x, int xf32, const float* gain, const float* shift, const float* scale, signed char* h, float* sA, unsigned* rmax0, int gw, int NGW, int lane) {
    for (int grp = gw; grp < M / 8; grp += NGW) {
        const int b = (grp * 8) >> 11;
        f32x4 A[8], B[8];
#pragma unroll
        for (int j = 0; j < 4; ++j)
#pragma unroll
            for (int e = 0; e < 2; ++e) { const int col = 8 * lane + 512 * j + 4 * e;
                const f32x4 g = *(const f32x4*)(gain + col), sc = *(const f32x4*)(scale + (size_t)b * NMOD + col); A[2 * j + e] = g * (sc + 1.0f); B[2 * j + e] = *(const f32x4*)(shift + (size_t)b * NMOD + col); }
        for (int rr = 0; rr < 8; ++rr) { const size_t row = (size_t)grp * 8 + rr;
            f32x4 v[8]; float ss = 0.f;
#pragma unroll
            for (int j = 0; j < 4; ++j) { ld8(x, xf32, row * D + 8 * lane + 512 * j, v[2 * j], v[2 * j + 1]);
#pragma unroll
                for (int e = 0; e < 2; ++e) { const f32x4 t = v[2 * j + e]; ss += (t[0] * t[0] + t[1] * t[1]) + (t[2] * t[2] + t[3] * t[3]); } }
            const float rstd = __builtin_amdgcn_rsqf(wave_sum(ss) * (1.0f / D) + EPS);
            float amax = 0.f;
#pragma unroll
            for (int j = 0; j < 8; ++j) { v[j] = v[j] * rstd * A[j] + B[j]; amax = fmaxf(fmaxf(amax, fmaxf(fabsf(v[j][0]), fabsf(v[j][1]))), fmaxf(fabsf(v[j][2]), fabsf(v[j][3]))); }
            amax = wave_max(amax);
            const float inv = amax > 0.f ? 127.0f / amax : 0.f;
#pragma unroll
            for (int j = 0; j < 4; ++j) { unsigned q[8];
#pragma unroll
                for (int e = 0; e < 4; ++e) { q[e] = (unsigned)(int)rintf(v[2 * j][e] * inv) & 0xFFu; q[4 + e] = (unsigned)(int)rintf(v[2 * j + 1][e] * inv) & 0xFFu; }
                v2u o; o.x = q[0] | (q[1] << 8) | (q[2] << 16) | (q[3] << 24); o.y = q[4] | (q[5] << 8) | (q[6] << 16) | (q[7] << 24);
                *(v2u*)(h + row * D + 8 * lane + 512 * j) = o; }
            if (lane == 0) { sA[row] = amax * (1.0f / 127.0f); if (rmax0) rmax0[row] = 0u; }
        }
    }
}

__device__ __forceinline__ void aq_load(const bf16* act, int row, int lane, v4u (&w)[11]) { const bf16* ar = act + (size_t)row * DFF + 8 * lane;
#pragma unroll
    for (int it = 0; it < 11; ++it) w[it] = *(const v4u*)(ar + 512 * it); }
__device__ __forceinline__ void aq_emit(const v4u (&w)[11], float mx, signed char* q, float* sA2, int row, int lane) {
    const float inv = mx > 0.f ? 127.0f / mx : 0.f; signed char* qr = q + (size_t)row * DFF + 8 * lane;
#pragma unroll
    for (int it = 0; it < 11; ++it) { unsigned o[8];
#pragma unroll
        for (int e = 0; e < 4; ++e) { const unsigned ww = w[it][e]; float lo = __uint_as_float(ww << 16) * inv, hi = __uint_as_float(ww & 0xFFFF0000u) * inv;
            lo = fminf(fmaxf(rintf(lo), -127.f), 127.f); hi = fminf(fmaxf(rintf(hi), -127.f), 127.f); o[2 * e] = (unsigned)(int)lo & 0xFFu; o[2 * e + 1] = (unsigned)(int)hi & 0xFFu; }
        v2u ov; ov.x = o[0] | (o[1] << 8) | (o[2] << 16) | (o[3] << 24); ov.y = o[4] | (o[5] << 8) | (o[6] << 16) | (o[7] << 24);
        *(v2u*)(qr + 512 * it) = ov; }
    if (lane == 0) sA2[row] = mx * (1.0f / 127.0f);
}
__device__ __forceinline__ void act_quant_phase(const bf16* act, const unsigned* rmax, signed char* q, float* sA2, int gw, int NGW, int lane) {
    int row = gw; if (row >= M) return;
    v4u wa[11], wb2[11]; float ma = __uint_as_float(rmax[row]); aq_load(act, row, lane, wa);
    for (;;) {
        const int r1 = row + NGW; const bool h1 = r1 < M; const int r1c = h1 ? r1 : row;
        const float mb = __uint_as_float(rmax[r1c]); aq_load(act, r1c, lane, wb2);
        aq_emit(wa, ma, q, sA2, row, lane);
        if (!h1) break;
        const int r2 = r1 + NGW; const bool h2 = r2 < M; const int r2c = h2 ? r2 : r1;
        ma = __uint_as_float(rmax[r2c]); aq_load(act, r2c, lane, wa);
        aq_emit(wb2, mb, q, sA2, r1, lane);
        if (!h2) break;
        row = r2;
    }
}
__device__ __forceinline__ void final_norm_phase(const bf16* x, float* out, const float* gain, int gw, int NGW, int lane) {
    for (int row = gw; row < M; row += NGW) {
        f32x4 v[8]; float ss = 0.f;
#pragma unroll
        for (int j = 0; j < 4; ++j) { ld8(x, 0, (size_t)row * D + 8 * lane + 512 * j, v[2 * j], v[2 * j + 1]);
#pragma unroll
            for (int e = 0; e < 2; ++e) { const f32x4 t = v[2 * j + e]; ss += (t[0] * t[0] + t[1] * t[1]) + (t[2] * t[2] + t[3] * t[3]); } }
        const float rstd = __builtin_amdgcn_rsqf(wave_sum(ss) * (1.0f / D) + EPS); float* orow = out + (size_t)row * D;
#pragma unroll
        for (int j = 0; j < 4; ++j)
#pragma unroll
            for (int e = 0; e < 2; ++e) { const int col = 8 * lane + 512 * j + 4 * e; const f32x4 g = *(const f32x4*)(gain + col); *(f32x4*)(orow + col) = v[2 * j + e] * rstd * g; }
    }
}
constexpr int VROW = 272;
constexpr int KV_LDS = 256 * VROW;
struct BAUnit { int b, h, qbase, qstride, kbase, kstride, first, dil; };
__device__ __forceinline__ BAUnit ba_decode(int pass, int u) {
    BAUnit U; const int bh = u >> 4, s = u & 15; U.b = bh >> 4; U.h = bh & 15;
    if (pass == 0) { U.qbase = 128 * s; U.qstride = 1; U.kbase = 128 * s - 128; U.kstride = 1; U.first = (s == 0); U.dil = 1; }
    else if (pass == 1) { const int rho = s >> 2, n = s & 3; U.qbase = 512 * n + rho; U.qstride = 4; U.kbase = 512 * n - 512 + rho; U.kstride = 4; U.first = (n == 0); U.dil = 4; }
    else { U.qbase = s; U.qstride = 16; U.kbase = s - 2048; U.kstride = 16; U.first = 1; U.dil = 16; }
    return U;
}
template <bool HALF = false> __device__ __forceinline__ void ba_load(const BAUnit& U, const bf16* K, const bf16* V, int tid, v4u (&kr)[8], v4u (&vr)[8]) {
    const int c = tid & 15, r0 = tid >> 4;
#pragma unroll
    for (int it = HALF ? 4 : 0; it < 8; ++it) { const int j = r0 + 32 * it; int p = U.kbase + U.kstride * j; p = p < 0 ? 0 : p;
        const size_t off = ((size_t)U.b * SEQ + p) * D + U.h * HD + 8 * c;
        kr[it] = *(const v4u*)(K + off); vr[it] = *(const v4u*)(V + off); }
}
template <bool HALF = false> __device__ __forceinline__ void ba_store(LAS unsigned char* lds, int tid, const v4u (&kr)[8], const v4u (&vr)[8]) {
    const int c = tid & 15, r0 = tid >> 4;
#pragma unroll
    for (int it = HALF ? 4 : 0; it < 8; ++it) { const int j = r0 + 32 * it; *(LAS v4u*)(lds + j * VROW + 16 * c) = kr[it]; *(LAS v4u*)(lds + KV_LDS + j * VROW + 16 * c) = vr[it]; }
}
__device__ __forceinline__ void ba_qload(const BAUnit& U, const bf16* Q, int w, int lane, bf16x8 (&qf)[4]) {
    const int i = lane & 15, g = lane >> 4, qi = 16 * w + i; const size_t qrow = (size_t)U.b * SEQ + U.qbase + U.qstride * qi;
#pragma unroll
    for (int kk = 0; kk < 4; ++kk) qf[kk] = *(const bf16x8*)(Q + qrow * D + U.h * HD + 32 * kk + 8 * g);
}
template <bool FUSED> __device__ __forceinline__ void ba_compute(const BAUnit& U, int pass, bf16x8 (&qf)[4], bf16* O, float* LSE, LAS unsigned char* lds, int w, int lane, unsigned* waitc, const v2u (&ppre)[8], float lpre, const BAUnit& Un, const bf16* Qn, unsigned char* O8 = nullptr) {
    const int i = lane & 15, g = lane >> 4, qi = 16 * w + i; const size_t qrow = (size_t)U.b * SEQ + U.qbase + U.qstride * qi;
    const float sl = __builtin_amdgcn_exp2f(-0.5f * (float)(U.h + 1)) * LOG2E * (float)U.dil;
    const int d0 = U.first ? (8 - w) : 0;
    f32x4 s[10];
#pragma unroll
    for (int d = 0; d < 9; ++d) { f32x4 acc = (f32x4){0.f, 0.f, 0.f, 0.f};
        if (d >= d0) { const LAS unsigned char* kp = lds + (16 * (w + d) + i) * VROW + 16 * g;
#pragma unroll
            for (int kk = 0; kk < 4; ++kk) { const bf16x8 kf = *(const LAS bf16x8*)(kp + 64 * kk); acc = __builtin_amdgcn_mfma_f32_16x16x32_bf16(kf, qf[kk], acc, 0, 0, 0); } }
        s[d] = acc; }
    if (Qn) ba_qload(Un, Qn, w, lane, qf);
    float cmax = -1e30f;
#pragma unroll
    for (int d = 0; d < 9; ++d)
#pragma unroll
        for (int r = 0; r < 4; ++r) { const int rel = i - (4 * g + r) + 16 * (8 - d);
            const bool ok = (d >= d0) && (rel >= 0) && (rel <= 128);
            const float v = ok ? (s[d][r] - sl * (float)rel) : -INFINITY; s[d][r] = v; cmax = fmaxf(cmax, v); }
    cmax = xmax32(xmax16(cmax));
    const float m = cmax; float l = 0.f;
#pragma unroll
    for (int d = 0; d < 9; ++d)
#pragma unroll
        for (int r = 0; r < 4; ++r) { const float pv = __builtin_amdgcn_exp2f(s[d][r] - m); s[d][r] = pv; l += pv; }
    l = xsum32(xsum16(l));
    s[9] = (f32x4){0.f, 0.f, 0.f, 0.f};
    f32x4 o[8];
#pragma unroll
    for (int c = 0; c < 8; ++c) o[c] = (f32x4){0.f, 0.f, 0.f, 0.f};
#pragma unroll
    for (int dp = 0; dp < 10; dp += 2) {
        if (dp + 1 >= d0) {
            bf16x8 pf; { const v4u t = (v4u){cvtpk(s[dp][0], s[dp][1]), cvtpk(s[dp][2], s[dp][3]), cvtpk(s[dp + 1][0], s[dp + 1][1]), cvtpk(s[dp + 1][2], s[dp + 1][3])}; pf = __builtin_bit_cast(bf16x8, t); }
            int t0 = w + dp, t1 = w + dp + 1; t0 = t0 > 15 ? 15 : t0; t1 = t1 > 15 ? 15 : t1;
            const LAS unsigned char* vb0 = lds + KV_LDS + (16 * t0 + 4 * g + (i >> 2)) * VROW + 8 * (i & 3);
            const LAS unsigned char* vb1 = lds + KV_LDS + (16 * t1 + 4 * g + (i >> 2)) * VROW + 8 * (i & 3);
#pragma unroll
            for (int c = 0; c < 8; ++c) { const s16x4 lo = tr_read(vb0 + 32 * c), hi = tr_read(vb1 + 32 * c); o[c] = __builtin_amdgcn_mfma_f32_16x16x32_bf16(cat8(lo, hi), pf, o[c], 0, 0, 0); }
        }
    }
    float inv = 1.0f / l; float lse = m + __builtin_amdgcn_logf(l);
    bf16* op = O + qrow * D + U.h * HD + 4 * g; float* lp = LSE + qrow * NH + U.h;
    if (FUSED && pass > 0) {
        if (threadIdx.x == 0) { unsigned sp = 0; while (__hip_atomic_load(waitc, RLX_AGENT) < 16u) { __builtin_amdgcn_s_sleep(2); if (++sp > (1u << 22)) break; }
            __builtin_amdgcn_fence(__ATOMIC_ACQUIRE, "agent"); asm volatile("s_waitcnt vmcnt(0)" ::: "memory"); }
        __syncthreads(); }
    if (pass > 0) { const float lprev = FUSED ? *lp : lpre; const float mx = fmaxf(lprev, lse); const float wa = __builtin_amdgcn_exp2f(lprev - mx), wb = __builtin_amdgcn_exp2f(lse - mx); const float wi = 1.0f / (wa + wb);
        const float fa = wa * wi, fb = wb * wi * inv;
#pragma unroll
        for (int c = 0; c < 8; ++c) { const v2u pw = FUSED ? *(const v2u*)(op + 16 * c) : ppre[c];
            const float p0 = __uint_as_float(pw.x << 16), p1 = __uint_as_float(pw.x & 0xFFFF0000u), p2 = __uint_as_float(pw.y << 16), p3 = __uint_as_float(pw.y & 0xFFFF0000u);
            o[c][0] = fa * p0 + fb * o[c][0]; o[c][1] = fa * p1 + fb * o[c][1]; o[c][2] = fa * p2 + fb * o[c][2]; o[c][3] = fa * p3 + fb * o[c][3]; }
        inv = 1.0f; lse = mx + __builtin_amdgcn_logf(wa + wb); }
#pragma unroll
    for (int c = 0; c < 8; ++c) { v2u w2; w2.x = cvtpk(o[c][0] * inv, o[c][1] * inv); w2.y = cvtpk(o[c][2] * inv, o[c][3] * inv);
        if (FUSED && pass < 2) __hip_atomic_store((unsigned long long*)(op + 16 * c), ((unsigned long long)w2.y << 32) | w2.x, RLX_AGENT);
        else if (pass == 2 && O8) { unsigned w8 = 0u; w8 = __builtin_amdgcn_cvt_pk_fp8_f32(o[c][0] * inv, o[c][1] * inv, w8, false); w8 = __builtin_amdgcn_cvt_pk_fp8_f32(o[c][2] * inv, o[c][3] * inv, w8, true);
            *(unsigned*)(O8 + qrow * D + U.h * HD + 4 * g + 16 * c) = w8; }
        else *(v2u*)(op + 16 * c) = w2; }
    if (pass < 2 && g == 0) { if (FUSED) __hip_atomic_store((unsigned*)lp, __float_as_uint(lse), RLX_AGENT); else *lp = lse; }
}
__device__ __forceinline__ void ba_pload(const BAUnit& U, const bf16* O, const float* LSE, int w, int lane, v2u (&pp)[8], float& lp) {
    const int i = lane & 15, g = lane >> 4, qi = 16 * w + i; const size_t qrow = (size_t)U.b * SEQ + U.qbase + U.qstride * qi;
    const bf16* op = O + qrow * D + U.h * HD + 4 * g;
#pragma unroll
    for (int c = 0; c < 8; ++c) pp[c] = *(const v2u*)(op + 16 * c);
    lp = LSE[qrow * NH + U.h];
}
template <int variant = 0, bool HALF = false  > __device__ __forceinline__ void dil_attn_pass(int pass, const bf16* Q, const bf16* K, const bf16* V, bf16* O, float* LSE, LAS unsigned char* lds, int vcu, int G, int tid, int wave, int lane, int u_lo = 0, int u_hi = BATCH * NH * 16, unsigned char* O8 = nullptr) {
    v4u kr[8], vr[8]; bf16x8 qf[4]; v2u pp[8]; float lp = 0.f;
#pragma unroll
    for (int c = 0; c < 8; ++c) pp[c] = (v2u){0u, 0u};
    int u = u_lo + vcu; const int NU = u_hi;
    if (u >= NU) return;
    BAUnit U = ba_decode(pass, u);
    ba_qload(U, Q, wave, lane, qf);
    ba_load<HALF>(U, K, V, tid, kr, vr);
    for (;;) {
        ba_store<HALF>(lds, tid, kr, vr);
        __syncthreads();
        const int un = u + G; const BAUnit Un = ba_decode(pass, un < NU ? un : u);
        if (pass > 0) ba_pload(U, O, LSE, wave, lane, pp, lp);
        asm volatile("" ::: "memory");
        ba_load<HALF>(Un, K, V, tid, kr, vr);
        ba_compute<false>(U, pass, qf, O, LSE, lds, wave, lane, nullptr, pp, lp, Un, Q, O8);
        __syncthreads();
        if (un >= NU) break;
        u = un; U = Un;
    }
}

__device__ __forceinline__ void dil_attn_fused(const bf16* Q, const bf16* K, const bf16* V, bf16* O, float* LSE, unsigned* cnt, LAS unsigned char* lds, int vcu, int G, int tid, int wave, int lane) {
    v4u kr[8], vr[8];
    const int team = vcu >> 4, sidx = vcu & 15, nteam = G >> 4, NBH = BATCH * NH;
    const int nit = ((NBH - team + nteam - 1) / nteam) * 3;
    if (nit <= 0) return;
    int it = 0; int bh = team, pass = 0;
    BAUnit U = ba_decode(pass, bh * 16 + sidx);
    ba_load(U, K, V, tid, kr, vr);
    for (;;) {
        ba_store(lds, tid, kr, vr);
        __syncthreads();
        bf16x8 qf[4]; ba_qload(U, Q, wave, lane, qf);
        asm volatile("" ::: "memory");
        const int itn = it + 1; int passn = pass + 1, bhn = bh; if (passn == 3) { passn = 0; bhn = bh + nteam; }
        const bool has = itn < nit;
        const BAUnit Un = ba_decode(has ? passn : pass, (has ? bhn : bh) * 16 + sidx); ba_load(Un, K, V, tid, kr, vr);
        { v2u ppd[8]; ba_compute<true>(U, pass, qf, O, LSE, lds, wave, lane, cnt + ((size_t)bh * 2 + (pass > 0 ? pass - 1 : 0)) * 16, ppd, 0.f, U, nullptr); }
        if (pass < 2) asm volatile("s_waitcnt vmcnt(0)" ::: "memory");
        __syncthreads();
        if (pass < 2 && tid == 0) __hip_atomic_fetch_add(cnt + ((size_t)bh * 2 + pass) * 16, 1u, RLX_AGENT);
        if (!has) break;
        it = itn; pass = passn; bh = bhn; U = Un;
    }
}

template <int KK  , int NT  , int TT  , bool OUT8 = false  >
__device__ __forceinline__ void head_gemm(const bf16* X, int ldx, int xcol0, const bf16* WT, bf16* Out, int ldo, int ocol0, int tok0, float scale, int lane) {
    const int i = lane & 15, g = lane >> 4;
    bf16x8 xf[TT][KK];
#pragma unroll
    for (int tt = 0; tt < TT; ++tt)
#pragma unroll
        for (int kk = 0; kk < KK; ++kk) xf[tt][kk] = *(const bf16x8*)(X + (size_t)(tok0 + 16 * tt + i) * ldx + xcol0 + 32 * kk + 8 * g);
    const bf16* wp = WT + (size_t)(8 * (i >> 2) + (i & 3)) * (32 * KK) + 8 * g;
    bf16x8 aA[2][KK], aB[2][KK];
#pragma unroll
    for (int h2 = 0; h2 < 2; ++h2)
#pragma unroll
        for (int kk = 0; kk < KK; ++kk) aA[h2][kk] = *(const bf16x8*)(wp + (size_t)(4 * h2) * (32 * KK) + 32 * kk);
#pragma unroll
    for (int tt = 0; tt < TT; ++tt)
#pragma unroll
        for (int kk = 0; kk < KK; ++kk) asm volatile("" : "+v"(xf[tt][kk]));
#define HG_PAIR(cur, nxt, p_) do { \
        _Pragma("unroll") for (int h2 = 0; h2 < 2; ++h2) _Pragma("unroll") for (int kk = 0; kk < KK; ++kk) asm volatile("" : "+v"(cur[h2][kk])); \
        if ((p_) + 1 < NT / 2) { _Pragma("unroll") for (int h2 = 0; h2 < 2; ++h2) _Pragma("unroll") for (int kk = 0; kk < KK; ++kk) nxt[h2][kk] = *(const bf16x8*)(wp + (size_t)(32 * ((p_) + 1) + 4 * h2) * (32 * KK) + 32 * kk); } \
        _Pragma("unroll") for (int tt = 0; tt < TT; ++tt) { f32x4 c0 = (f32x4){0.f, 0.f, 0.f, 0.f}, c1 = c0; \
            _Pragma("unroll") for (int kk = 0; kk < KK; ++kk) { c0 = __builtin_amdgcn_mfma_f32_16x16x32_bf16(cur[0][kk], xf[tt][kk], c0, 0, 0, 0); c1 = __builtin_amdgcn_mfma_f32_16x16x32_bf16(cur[1][kk], xf[tt][kk], c1, 0, 0, 0); } \
            const size_t oo = (size_t)(tok0 + 16 * tt + i) * ldo + ocol0 + 32 * (p_) + 8 * g; \
            if constexpr (OUT8) { unsigned w0 = 0u, w1 = 0u; w0 = __builtin_amdgcn_cvt_pk_fp8_f32(c0[0] * scale, c0[1] * scale, w0, false); w0 = __builtin_amdgcn_cvt_pk_fp8_f32(c0[2] * scale, c0[3] * scale, w0, true); \
                w1 = __builtin_amdgcn_cvt_pk_fp8_f32(c1[0] * scale, c1[1] * scale, w1, false); w1 = __builtin_amdgcn_cvt_pk_fp8_f32(c1[2] * scale, c1[3] * scale, w1, true); \
                *(v2u*)((unsigned char*)Out + oo) = (v2u){w0, w1}; } \
            else *(v4u*)(Out + oo) = (v4u){cvtpk(c0[0] * scale, c0[1] * scale), cvtpk(c0[2] * scale, c0[3] * scale), cvtpk(c1[0] * scale, c1[1] * scale), cvtpk(c1[2] * scale, c1[3] * scale)}; } } while (0)
    for (int p = 0; p < NT / 2; p += 2) { HG_PAIR(aA, aB, p); HG_PAIR(aB, aA, p + 1); }
#undef HG_PAIR
}
__device__ __forceinline__ void ckv_norm_phase(const float* raw, const float* gain, bf16* out, int gw, int NGW, int lane) {
    const f32x4 gv = *(const f32x4*)(gain + 4 * lane);
    for (int row = gw; row < M; row += NGW) { const f32x4 t = *(const f32x4*)(raw + (size_t)row * KVL + 4 * lane);
        const float ss = (t[0] * t[0] + t[1] * t[1]) + (t[2] * t[2] + t[3] * t[3]);
        const float rstd = __builtin_amdgcn_rsqf(wave_sum(ss) * (1.0f / KVL) + EPS); const f32x4 y = t * rstd * gv;
        v2u w2; w2.x = cvtpk(y[0], y[1]); w2.y = cvtpk(y[2], y[3]); *(v2u*)(out + (size_t)row * KVL + 4 * lane) = w2; }
}
constexpr int IX_KROW = 272, IX_KEYS = 256, IX_STAGE = IX_KEYS * IX_KROW, IX_SC_OFF = IX_STAGE;
__device__ __forceinline__ void ix_load(const bf16* KI, int b, int st, int tid, v4u (&kr)[8]) {
    const int c = tid & 15, r0 = tid >> 4;
#pragma unroll
    for (int it = 0; it < 8; ++it) kr[it] = *(const v4u*)(KI + ((size_t)b * SEQ + IX_KEYS * st + r0 + 32 * it) * 128 + 8 * c);
}
__device__ __forceinline__ void ix_store(LAS unsigned char* buf, int tid, const v4u (&kr)[8]) {
    const int c = tid & 15, r0 = tid >> 4;
#pragma unroll
    for (int it = 0; it < 8; ++it) *(LAS v4u*)(buf + (r0 + 32 * it) * IX_KROW + 16 * c) = kr[it];
}
__device__ __forceinline__ void ix_topk(const LAS u16* sc, u16* selr, int t, int lane) {
    if (t < TOPK) { for (int j = lane; j < TOPK; j += 64) selr[j] = (u16)(j <= t ? j : 0xFFFF); return; }
    const int ng = (t >> 9) + 1;
    unsigned key[32];
#pragma unroll
    for (int u = 0; u < 32; ++u) key[u] = 0u;
#pragma unroll
    for (int gq = 0; gq < 4; ++gq) if (gq < ng) {
#pragma unroll
        for (int u = 8 * gq; u < 8 * gq + 8; ++u) { const int idx = 64 * u + lane; const unsigned bits = sc[idx]; const unsigned k = (bits & 0x8000u) ? (~bits & 0xFFFFu) : (bits | 0x8000u); key[u] = (idx <= t) ? k : 0u; } }
    unsigned prefix = 0u;
    for (int bit = 15; bit >= 0; --bit) { const unsigned cand = prefix | (1u << bit); int cnt = 0;
#pragma unroll
        for (int gq = 0; gq < 4; ++gq) if (gq < ng) {
#pragma unroll
            for (int u = 8 * gq; u < 8 * gq + 8; ++u) cnt += __popcll(__ballot(key[u] >= cand)); }
        if (cnt >= TOPK) prefix = cand; }
    int cgt = 0;
#pragma unroll
    for (int gq = 0; gq < 4; ++gq) if (gq < ng) {
#pragma unroll
        for (int u = 8 * gq; u < 8 * gq + 8; ++u) cgt += __popcll(__ballot(key[u] > prefix)); }
    const int need_eq = TOPK - cgt; int base = 0, eqb = 0;
#pragma unroll
    for (int gq = 0; gq < 4; ++gq) if (gq < ng) {
#pragma unroll
        for (int u = 8 * gq; u < 8 * gq + 8; ++u) { const bool gt = key[u] > prefix, eq = key[u] == prefix; const unsigned long long meq = __ballot(eq);
            const bool take = gt || (eq && (int)(eqb + mbcnt64(meq)) < need_eq); const unsigned long long mt = __ballot(take);
            if (take) selr[base + mbcnt64(mt)] = (u16)(64 * u + lane);
            base += __popcll(mt); eqb += __popcll(meq); } }
}
__device__ __forceinline__ void dsa_index_unit(const bf16* QI, const bf16* KI, const float* WI, u16* SEL, LAS unsigned char* lds, int b, int qb, int tid, int w, int lane) {
    const int i = lane & 15, g = lane >> 4; const int t0 = 16 * qb + 2 * w;
    const size_t row0 = (size_t)b * SEQ + t0;
    LAS u16* sc0 = (LAS u16*)(lds + IX_SC_OFF + (2 * w) * 4096); LAS u16* sc1 = sc0 + 2048;
    bf16x8 a0[4], a1[4];
#pragma unroll
    for (int kk = 0; kk < 4; ++kk) { a0[kk] = *(const bf16x8*)(QI + row0 * D + i * 128 + 32 * kk + 8 * g); a1[kk] = *(const bf16x8*)(QI + (row0 + 1) * D + i * 128 + 32 * kk + 8 * g); }
    const f32x4 w0 = *(const f32x4*)(WI + row0 * 16 + 4 * g), w1 = *(const f32x4*)(WI + (row0 + 1) * 16 + 4 * g);
    const int nst = (16 * qb + 15) / IX_KEYS + 1;
    v4u kA[8], kB[8];
    ix_load(KI, b, 0, tid, kA); ix_load(KI, b, nst > 1 ? 1 : 0, tid, kB);
#define IX_STAGE_BODY(st_, kcur) do { \
        ix_store(lds, tid, kcur); \
        __syncthreads(); \
        { const int sn = (st_) + 2 < nst ? (st_) + 2 : nst - 1; ix_load(KI, b, sn, tid, kcur); } \
        int ntile = (t0 + 1 - IX_KEYS * (st_)) / 16 + 1; ntile = ntile > 16 ? 16 : ntile; \
        _Pragma("unroll 2") for (int tt = 0; tt < ntile; tt += 2) { const LAS unsigned char* kp = lds + (16 * tt + i) * IX_KROW + 16 * g; \
            f32x4 c0 = (f32x4){0.f, 0.f, 0.f, 0.f}, c1 = c0, e0 = c0, e1 = c0; \
            _Pragma("unroll") for (int kk = 0; kk < 4; ++kk) { const bf16x8 bfa = *(const LAS bf16x8*)(kp + 64 * kk), bfb = *(const LAS bf16x8*)(kp + 16 * IX_KROW + 64 * kk); \
                c0 = __builtin_amdgcn_mfma_f32_16x16x32_bf16(a0[kk], bfa, c0, 0, 0, 0); c1 = __builtin_amdgcn_mfma_f32_16x16x32_bf16(a1[kk], bfa, c1, 0, 0, 0); \
                e0 = __builtin_amdgcn_mfma_f32_16x16x32_bf16(a0[kk], bfb, e0, 0, 0, 0); e1 = __builtin_amdgcn_mfma_f32_16x16x32_bf16(a1[kk], bfb, e1, 0, 0, 0); } \
            float s0 = w0[0] * fmaxf(c0[0], 0.f) + w0[1] * fmaxf(c0[1], 0.f) + w0[2] * fmaxf(c0[2], 0.f) + w0[3] * fmaxf(c0[3], 0.f); \
            float s1 = w1[0] * fmaxf(c1[0], 0.f) + w1[1] * fmaxf(c1[1], 0.f) + w1[2] * fmaxf(c1[2], 0.f) + w1[3] * fmaxf(c1[3], 0.f); \
            float u0 = w0[0] * fmaxf(e0[0], 0.f) + w0[1] * fmaxf(e0[1], 0.f) + w0[2] * fmaxf(e0[2], 0.f) + w0[3] * fmaxf(e0[3], 0.f); \
            float u1 = w1[0] * fmaxf(e1[0], 0.f) + w1[1] * fmaxf(e1[1], 0.f) + w1[2] * fmaxf(e1[2], 0.f) + w1[3] * fmaxf(e1[3], 0.f); \
            s0 = xsum32(xsum16(s0)); s1 = xsum32(xsum16(s1)); u0 = xsum32(xsum16(u0)); u1 = xsum32(xsum16(u1)); \
            if (g == 0) { const int key = IX_KEYS * (st_) + 16 * tt + i; sc0[key] = __builtin_bit_cast(u16, (_Float16)s0); sc1[key] = __builtin_bit_cast(u16, (_Float16)s1); \
                          sc0[key + 16] = __builtin_bit_cast(u16, (_Float16)u0); sc1[key + 16] = __builtin_bit_cast(u16, (_Float16)u1); } } \
        __syncthreads();                                         \
    } while (0)
    for (int st = 0; st < nst; st += 2) { IX_STAGE_BODY(st, kA); if (st + 1 < nst) IX_STAGE_BODY(st + 1, kB); }
#undef IX_STAGE_BODY
    LDS_WAIT(); asm volatile("" ::: "memory");
#ifndef REPS4
#define REPS4 1
#endif
    for (int rk = 0; rk < REPS4; ++rk) {
    ix_topk(sc0, SEL + row0 * TOPK, t0, lane);
    ix_topk(sc1, SEL + (row0 + 1) * TOPK, t0 + 1, lane); }
    __syncthreads();
}
constexpr int CROW = 528;
constexpr int DSA_WAVE_LDS = 32 * CROW + 512;
__device__ __forceinline__ void dsa_attn_query(const bf16* QL, const bf16* CKV, const u16* SEL, bf16* OL, LAS unsigned char* wl, int b, int t, int lane) {
    const int i = lane & 15, g = lane >> 4; const size_t row = (size_t)b * SEQ + t;
    LAS u16* sl = (LAS u16*)(wl + 32 * CROW);
    *(LAS v2u*)(sl + 4 * lane) = *(const v2u*)(SEL + row * TOPK + 4 * lane);
    bf16x8 bq[8];
#pragma unroll
    for (int kk = 0; kk < 8; ++kk) bq[kk] = *(const bf16x8*)(QL + row * (NH * KVL) + i * KVL + 32 * kk + 8 * g);
    const float slope2 = __builtin_amdgcn_exp2f(-0.5f * (float)(i + 1)) * LOG2E;
    float m = -1e30f, l = 0.f; f32x4 o[16];
#pragma unroll
    for (int c = 0; c < 16; ++c) o[c] = (f32x4){0.f, 0.f, 0.f, 0.f};
    const int nvalid = (t + 1) < TOPK ? (t + 1) : TOPK, nch = (nvalid + 31) >> 5;
    const bf16* cb = CKV + (size_t)b * SEQ * KVL;
    LDS_WAIT(); asm volatile("" ::: "memory");
    v4u pre[16];
#pragma unroll
    for (int it = 0; it < 16; ++it) { const int r = 2 * it + (lane >> 5); unsigned key = sl[r]; key = (key == 0xFFFFu) ? 0u : key; pre[it] = *(const v4u*)(cb + (size_t)key * KVL + 8 * (lane & 31)); }
    for (int c = 0; c < nch; ++c) {
#pragma unroll
        for (int it = 0; it < 16; ++it) { const int r = 2 * it + (lane >> 5); *(LAS v4u*)(wl + r * CROW + 16 * (lane & 31)) = pre[it]; }
        if (c + 1 < nch) {
#pragma unroll
            for (int it = 0; it < 16; ++it) { const int r = 2 * it + (lane >> 5); unsigned key = sl[32 * (c + 1) + r]; key = (key == 0xFFFFu) ? 0u : key; pre[it] = *(const v4u*)(cb + (size_t)key * KVL + 8 * (lane & 31)); } }
        LDS_WAIT(); asm volatile("" ::: "memory");
        f32x4 s[2];
#pragma unroll
        for (int T = 0; T < 2; ++T) { const LAS unsigned char* ap = wl + (16 * T + i) * CROW + 16 * g; f32x4 acc = (f32x4){0.f, 0.f, 0.f, 0.f};
#pragma unroll
            for (int kk = 0; kk < 8; ++kk) { const bf16x8 af = *(const LAS bf16x8*)(ap + 64 * kk); acc = __builtin_amdgcn_mfma_f32_16x16x32_bf16(af, bq[kk], acc, 0, 0, 0); }
            s[T] = acc; }
        float cmax = -INFINITY;
#pragma unroll
        for (int T = 0; T < 2; ++T) { const v2u kw = *(const LAS v2u*)(sl + 32 * c + 16 * T + 4 * g);
#pragma unroll
            for (int r = 0; r < 4; ++r) { const unsigned key = ((r < 2 ? kw.x : kw.y) >> (16 * (r & 1))) & 0xFFFFu; const int dl = t - (int)key;
                const float v = (key != 0xFFFFu && dl >= 0) ? (s[T][r] - slope2 * (float)dl) : -INFINITY; s[T][r] = v; cmax = fmaxf(cmax, v); } }
        cmax = xmax32(xmax16(cmax));
        const float mn = fmaxf(m, cmax), alpha = __builtin_amdgcn_exp2f(m - mn); m = mn;
        float rs = 0.f;
#pragma unroll
        for (int T = 0; T < 2; ++T)
#pragma unroll
            for (int r = 0; r < 4; ++r) { const float pv = __builtin_amdgcn_exp2f(s[T][r] - mn); s[T][r] = pv; rs += pv; }
        rs = xsum32(xsum16(rs));
        l = l * alpha + rs;
        bf16x8 pf; { const unsigned a0 = cvtpk(s[0][0], s[0][1]), a1 = cvtpk(s[0][2], s[0][3]), a2 = cvtpk(s[1][0], s[1][1]), a3 = cvtpk(s[1][2], s[1][3]); const v4u tt = (v4u){a0, a1, a2, a3}; pf = __builtin_bit_cast(bf16x8, tt); }
        const LAS unsigned char* vb = wl + (4 * g + (i >> 2)) * CROW + 8 * (i & 3);
#pragma unroll
        for (int ct = 0; ct < 16; ++ct) { const s16x4 lo = tr_read(vb + 32 * ct), hi = tr_read(vb + 16 * CROW + 32 * ct);
            o[ct] = o[ct] * alpha; o[ct] = __builtin_amdgcn_mfma_f32_16x16x32_bf16(cat8(lo, hi), pf, o[ct], 0, 0, 0); }
        LDS_WAIT(); asm volatile("" ::: "memory");
    }
    const float inv = 1.0f / l;
    bf16* op = OL + row * (NH * KVL) + i * KVL + 4 * g;
#pragma unroll
    for (int ct = 0; ct < 16; ++ct) { v2u w2; w2.x = cvtpk(o[ct][0] * inv, o[ct][1] * inv); w2.y = cvtpk(o[ct][2] * inv, o[ct][3] * inv); *(v2u*)(op + 16 * ct) = w2; }
}
__device__ __forceinline__ void dsa_attn_query_p(const bf16* QL, const bf16* CKV, const u16* SEL, bf16* OL, LAS unsigned char* wl, int b, int t, int lane, bf16x8 (&bq)[8], size_t row_n, v2u& seln) {
    const int i = lane & 15, g = lane >> 4; const size_t row = (size_t)b * SEQ + t;
    LAS u16* sl = (LAS u16*)(wl + 32 * CROW);
    const float slope2 = __builtin_amdgcn_exp2f(-0.5f * (float)(i + 1)) * LOG2E;
    float m = -1e30f, l = 0.f; f32x4 o[16];
#pragma unroll
    for (int c = 0; c < 16; ++c) o[c] = (f32x4){0.f, 0.f, 0.f, 0.f};
    const int nvalid = (t + 1) < TOPK ? (t + 1) : TOPK, nch = (nvalid + 31) >> 5;
    const bf16* cb = CKV + (size_t)b * SEQ * KVL;
    LDS_WAIT(); asm volatile("" ::: "memory");
    v4u pre[16];
#pragma unroll
    for (int it = 0; it < 16; ++it) { const int r = 2 * it + (lane >> 5); unsigned key = sl[r]; key = (key == 0xFFFFu) ? 0u : key; pre[it] = *(const v4u*)(cb + (size_t)key * KVL + 8 * (lane & 31)); }
    seln = *(const v2u*)(SEL + row_n * TOPK + 4 * lane);
    bf16x8 bqn[8];
#pragma unroll
    for (int kk = 0; kk < 8; ++kk) bqn[kk] = *(const bf16x8*)(QL + row_n * (NH * KVL) + i * KVL + 32 * kk + 8 * g);
    for (int c = 0; c < nch; ++c) {
#pragma unroll
        for (int it = 0; it < 16; ++it) { const int r = 2 * it + (lane >> 5); *(LAS v4u*)(wl + r * CROW + 16 * (lane & 31)) = pre[it]; }
        if (c + 1 < nch) {
#pragma unroll
            for (int it = 0; it < 16; ++it) { const int r = 2 * it + (lane >> 5); unsigned key = sl[32 * (c + 1) + r]; key = (key == 0xFFFFu) ? 0u : key; pre[it] = *(const v4u*)(cb + (size_t)key * KVL + 8 * (lane & 31)); } }
        LDS_WAIT(); asm volatile("" ::: "memory");
        f32x4 s[2];
#pragma unroll
        for (int T = 0; T < 2; ++T) { const LAS unsigned char* ap = wl + (16 * T + i) * CROW + 16 * g; f32x4 acc = (f32x4){0.f, 0.f, 0.f, 0.f};
#pragma unroll
            for (int kk = 0; kk < 8; ++kk) { const bf16x8 af = *(const LAS bf16x8*)(ap + 64 * kk); acc = __builtin_amdgcn_mfma_f32_16x16x32_bf16(af, bq[kk], acc, 0, 0, 0); }
            s[T] = acc; }
        float cmax = -INFINITY;
#pragma unroll
        for (int T = 0; T < 2; ++T) { const v2u kw = *(const LAS v2u*)(sl + 32 * c + 16 * T + 4 * g);
#pragma unroll
            for (int r = 0; r < 4; ++r) { const unsigned key = ((r < 2 ? kw.x : kw.y) >> (16 * (r & 1))) & 0xFFFFu; const int dl = t - (int)key;
                const float v = (key != 0xFFFFu && dl >= 0) ? (s[T][r] - slope2 * (float)dl) : -INFINITY; s[T][r] = v; cmax = fmaxf(cmax, v); } }
        cmax = xmax32(xmax16(cmax));
        const float mn = fmaxf(m, cmax), alpha = __builtin_amdgcn_exp2f(m - mn); m = mn;
        float rs = 0.f;
#pragma unroll
        for (int T = 0; T < 2; ++T)
#pragma unroll
            for (int r = 0; r < 4; ++r) { const float pv = __builtin_amdgcn_exp2f(s[T][r] - mn); s[T][r] = pv; rs += pv; }
        rs = xsum32(xsum16(rs));
        l = l * alpha + rs;
        bf16x8 pf; { const unsigned a0 = cvtpk(s[0][0], s[0][1]), a1 = cvtpk(s[0][2], s[0][3]), a2 = cvtpk(s[1][0], s[1][1]), a3 = cvtpk(s[1][2], s[1][3]); const v4u tt = (v4u){a0, a1, a2, a3}; pf = __builtin_bit_cast(bf16x8, tt); }
        const LAS unsigned char* vb = wl + (4 * g + (i >> 2)) * CROW + 8 * (i & 3);
#pragma unroll
        for (int ct = 0; ct < 16; ++ct) { const s16x4 lo = tr_read(vb + 32 * ct), hi = tr_read(vb + 16 * CROW + 32 * ct);
            o[ct] = o[ct] * alpha; o[ct] = __builtin_amdgcn_mfma_f32_16x16x32_bf16(cat8(lo, hi), pf, o[ct], 0, 0, 0); }
        LDS_WAIT(); asm volatile("" ::: "memory");
    }
    const float inv = 1.0f / l;
    bf16* op = OL + row * (NH * KVL) + i * KVL + 4 * g;
#pragma unroll
    for (int ct = 0; ct < 16; ++ct) { v2u w2; w2.x = cvtpk(o[ct][0] * inv, o[ct][1] * inv); w2.y = cvtpk(o[ct][2] * inv, o[ct][3] * inv); *(v2u*)(op + 16 * ct) = w2; }
#pragma unroll
    for (int kk = 0; kk < 8; ++kk) bq[kk] = bqn[kk];
}
constexpr int PH_PER_LAYER = 10, PH_L0 = 2, PH_FINAL = PH_L0 + PH_PER_LAYER * DEPTH, PH_COUNT = PH_FINAL + 1;
__global__ void __launch_bounds__(NWAVES * 64, 2) mk_fwd(Args args) {
    extern __shared__ __attribute__((aligned(16))) unsigned char lds_raw[];
    LAS unsigned char* lds = (LAS unsigned char*)lds_raw;
    volatile LAS unsigned* MISC = (volatile LAS unsigned*)(lds + MISC_OFF);
    const int tid = threadIdx.x, lane = tid & 63, wave = __builtin_amdgcn_readfirstlane(tid >> 6);
    const int G = gridDim.x; const int bx = blockIdx.x; const int vcu = (G % 8 == 0) ? (bx % 8) * (G / 8) + bx / 8 : bx;
    const int gw = vcu * NWAVES + wave, NGW = G * NWAVES;
    unsigned char* ws = as_global(args.ws);
    gu32* ctl = (gu32*)(ws + WS_CTL);
    if (tid < 64) MISC[tid] = 0u;
    __syncthreads();
    const int lo = args.ph_lo, hi = args.ph_hi;
#ifdef DIAG_XCC
    if (tid == 0) ((unsigned*)(ws + WS_CTL + 700000))[bx] = xb_xcc_id() + 1u;
#endif
#ifdef PROBE_IDX
    if (bx == 0 && tid == 0) { unsigned long long* pt = (unsigned long long*)(ws + WS_CTL + 614400); pt[63] = wall_clock64(); }
#endif
    XcdBarrier bar; bar.bar = (unsigned*)(ctl + CW_BAR); bar.x = 0; bar.st = nullptr;
    if (hi - lo > 1) { bar = xcd_barrier_post((unsigned*)(ctl + CW_BAR), MISC + 8); if (tid == 0) xcd_barrier_census(bar); __syncthreads(); }
#define IN(k) (lo <= (k) && (k) < hi)
#ifdef REP_PHASE
#define REPN(k) (((k) == REP_PHASE) ? (1 + REP_N) : 1)
#else
#define REPN(k) 1
#endif
#ifndef REP_VARIANT
#define REP_VARIANT 0
#endif
#ifndef DIL_VARIANT
#define DIL_VARIANT 0
#endif
#ifndef REPS3
#define REPS3 1
#endif
#ifndef REPS1
#define REPS1 1
#endif
#ifndef REPS2
#define REPS2 1
#endif
#define REP_BEGIN(k) for (int rep_ = 0; rep_ < REPN(k); ++rep_) { if (rep_) GBAR();
#define REP_END }
#ifdef PROBE_IDX
#define PMARK(idx) do { if (bx == 0 && tid == 0) { unsigned long long* pt = (unsigned long long*)(ws + WS_CTL + 614400); const unsigned long long now_ = wall_clock64(); pt[(idx)] += now_ - pt[63]; pt[63] = now_; } } while (0)
#else
#define PMARK(idx) do {} while (0)
#endif
#define GBAR() do { XcdBarrier b_ = bar; GAS unsigned* bp_ = (GAS unsigned*)b_.bar; asm volatile("" : "+s"(bp_)); b_.bar = (unsigned*)bp_; xcd_barrier(b_, wave == 0 && ({ unsigned m_ = ~0u; asm volatile("" : "+s"(m_)); (int)__builtin_amdgcn_mbcnt_hi(m_, __builtin_amdgcn_mbcnt_lo(m_, 0u)); }) == 0); } while (0)
#define SEAM(k) do { if ((k) + 1 < hi) GBAR(); PMARK(((k) < PH_L0) ? (k) : (2 + (((k) - PH_L0) / PH_PER_LAYER & 1) * PH_PER_LAYER + ((k) - PH_L0) % PH_PER_LAYER)); } while (0)

#define LAUNDER_S(x) ({ int v_ = (x); asm volatile("" : "+s"(v_)); v_; })
#define Gv LAUNDER_S(G)
#define bxv LAUNDER_S(bx)
#define Kd LAUNDER_S(D)
#define Kf LAUNDER_S(DFF)
#define gwv LAUNDER_S(gw)
#define vcuv LAUNDER_S(vcu)
#define LANE_NOW ({ unsigned m_ = ~0u; asm volatile("" : "+s"(m_)); (int)__builtin_amdgcn_mbcnt_hi(m_, __builtin_amdgcn_mbcnt_lo(m_, 0u)); })
#define lanev LANE_NOW
#define tidv (LAUNDER_S(wave) * 64 + LANE_NOW)
    if (IN(0)) {
        if (!PRO_SINGLE) { REP_BEGIN(0) if (I8_QKV || I8_DSA || I8_GU) p0_colmax(args, gwv, NGW, lanev); REP_END SEAM(0); }
    }
    if (IN(1)) {
        REP_BEGIN(1)
        if (PRO_SINGLE) { p0_strips(args, lds, vcuv, Gv, tidv, wave, lanev); p0_bf16_items(args, lds, gwv, NGW, wave, lanev); }
        else p0_transposes(args, lds, gwv, NGW, wave, lanev);
        __syncthreads();
        for (int ra = 0; ra < REPS3; ++ra) { p0_adaln(args, lds, Gv, tidv, wave, lanev);
        __syncthreads(); }
        REP_END
        SEAM(1);
    }
    for (int l = 0; l < DEPTH; ++l) {
        const int pb = PH_L0 + PH_PER_LAYER * l;
        if (hi <= pb || lo >= pb + PH_PER_LAYER) continue;
        const LayerW& W = args.L[l];
#define wsv ({ GAS unsigned char* q_ = (GAS unsigned char*)ws; asm volatile("" : "+s"(q_)); (unsigned char*)q_; })
#define wb (wsv + WS_W + (size_t)l * W_LAYER)
#define Hb ((bf16*)(wsv + WS_H))
#define ATT ((bf16*)(wsv + WS_ATT))
#define r1 (wsv + WS_R1)
#define r2 (wsv + WS_R2)
#define modl ((const float*)(wsv + WS_MOD) + (size_t)l * BATCH * NMOD)
#define sAp ((float*)(wsv + WS_SA))
#define sBl ((const float*)(wsv + WS_SB) + l * CM_LAYER)
#define x16 ((bf16*)(wsv + WS_X16))
#define xin ((l == 0) ? (const void*)as_global(args.x) : (const void*)x16)
#define xin_f32 (l == 0)
#define xout x16
        const bool dsa = (l & 1) != 0;
        if (IN(pb + 0)) { REP_BEGIN(pb + 0)
            if (dsa ? I8_DSA : I8_QKV) norm_mod_phase_q(xin, xin_f32, as_global(W.norm_attn), modl + 0 * D, modl + 1 * D, (signed char*)Hb, sAp, nullptr, gwv, NGW, lanev);
            else norm_mod_phase(xin, xin_f32, as_global(W.norm_attn), modl + 0 * D, modl + 1 * D, Hb, gwv, NGW, lanev);
            REP_END SEAM(pb + 0); }
        if (IN(pb + 1)) { REP_BEGIN(pb + 1)
            if (!dsa) { pg8::Gemm g{Hb, (const bf16*)(wb + WO_IN), M, NIN_A, Kd}; pg8::StaticOrder S; S.init(M, NIN_A, Gv, bxv, WGM_QKV);
                pg8::EpiQKV<I8_QKV> E{(bf16*)r1, (size_t)M * D, QSCALE, sAp, sBl};
                pg8::gemm_phase<pg8::EpiQKV<I8_QKV>, pg8::StaticOrder, PG8_ALIGN, PG8_SP2>(lds, g, S, E, tidv); }
            else { pg8::Gemm g{Hb, (const bf16*)(wb + WO_IN), M, NIN_BP, Kd}; pg8::StaticOrder S; S.init(M, NIN_BP, Gv, bxv, WGM_DSA);
                pg8::EpiDsaProj<I8_DSA> E{(bf16*)(r1 + R1_Q), (float*)(r1 + R1_CKVR), (bf16*)(r1 + R1_QI), (bf16*)(r1 + R1_KI), (float*)(r1 + R1_WI), sAp, sBl};
                pg8::gemm_phase<pg8::EpiDsaProj<I8_DSA>, pg8::StaticOrder, PG8_ALIGN, PG8_SP2>(lds, g, S, E, tidv); }
            REP_END SEAM(pb + 1);
        }
        const bool dfused = DIL_FUSED && (Gv & 15) == 0;
#define DIL_ARGS (const bf16*)r1, (const bf16*)r1 + (size_t)M * D, (const bf16*)r1 + 2 * (size_t)M * D, ATT, (float*)r2
        if (!dsa) {
            if (dfused) { if (IN(pb + 2)) { dil_attn_fused(DIL_ARGS, (unsigned*)(wsv + WS_CTL + CTL_DILCNT) + (size_t)(l >> 1) * 128 * 2 * 16, lds, vcuv, Gv, tidv, wave, lanev); SEAM(pb + 4); } }
            else if (DIL_SPLIT > 1 && !MK_MULTI) {
                if (IN(pb + 2)) { for (int sp = 0; sp < DIL_SPLIT; ++sp) for (int ps = 0; ps < 3; ++ps) { if (sp + ps) GBAR();
                        dil_attn_pass(ps, DIL_ARGS, lds, vcuv, Gv, tidv, wave, lanev, sp * (BATCH * NH * 16 / DIL_SPLIT), (sp + 1) * (BATCH * NH * 16 / DIL_SPLIT)); }
                    SEAM(pb + 4); }
            } else {
                if (IN(pb + 2)) { REP_BEGIN(pb + 2) dil_attn_pass<DIL_VARIANT>(0, DIL_ARGS, lds, vcuv, Gv, tidv, wave, lanev); REP_END SEAM(pb + 2); }
                if (IN(pb + 3)) { dil_attn_pass(1, DIL_ARGS, lds, vcuv, Gv, tidv, wave, lanev); SEAM(pb + 3); }
                if (IN(pb + 4)) { dil_attn_pass<0, true>(2, DIL_ARGS, lds, vcuv, Gv, tidv, wave, lanev, 0, BATCH * NH * 16, OUT_MODE == 2 ? (unsigned char*)(r2 + R2_ATT8) : nullptr); SEAM(pb + 4); }
            }
        } else {
        if (IN(pb + 2)) { REP_BEGIN(pb + 2)
            for (int rs1 = 0; rs1 < REPS1; ++rs1) {
            ckv_norm_phase((const float*)(r1 + R1_CKVR), as_global(W.kv_norm), (bf16*)(r1 + R1_CKV), gwv, NGW, lanev);
            for (int wu = gwv; wu < (M / 64) * NH; wu += NGW) { const int h = wu & 15, tg = wu >> 4;
                head_gemm<4, 16, 4>((const bf16*)(r1 + R1_Q), D, h * HD, (const bf16*)(wb + WO_UK) + (size_t)h * KVL * HD, (bf16*)r2, NH * KVL, h * KVL, 64 * tg, QSCALE, lanev); }
            }
            for (int rs2 = 0; rs2 < REPS2; ++rs2)
            { const int vb = vcuv;
              for (int pi = vb; pi < BATCH * 64; pi += Gv) { const int b = pi >> 6, ql = pi & 63;
                  dsa_index_unit((const bf16*)(r1 + R1_QI), (const bf16*)(r1 + R1_KI), (const float*)(r1 + R1_WI), (u16*)(r1 + R1_SEL), lds, b, ql, tidv, wave, lanev);
                  dsa_index_unit((const bf16*)(r1 + R1_QI), (const bf16*)(r1 + R1_KI), (const float*)(r1 + R1_WI), (u16*)(r1 + R1_SEL), lds, b, 127 - ql, tidv, wave, lanev); } }
            REP_END SEAM(pb + 2);
        }
        if (IN(pb + 3)) { REP_BEGIN(pb + 3)
            LAS unsigned char* wl = lds + wave * DSA_WAVE_LDS;
            if (DSA_MERGE_POST) {
                for (int blk = vcuv; blk < M / 64; blk += Gv) { const int tokb = 64 * blk;
                    { const bf16* QLp = (const bf16*)r2; const u16* SELp = (const u16*)(r1 + R1_SEL); const int ln = lanev, q0 = tokb + 8 * wave; LAS u16* slp = (LAS u16*)(wl + 32 * CROW);
                      bf16x8 bq[8]; v2u seln = *(const v2u*)(SELp + (size_t)q0 * TOPK + 4 * ln);
#pragma unroll
                      for (int kk = 0; kk < 8; ++kk) bq[kk] = *(const bf16x8*)(QLp + (size_t)q0 * (NH * KVL) + (ln & 15) * KVL + 32 * kk + 8 * (ln >> 4));
                      for (int jj = 0; jj < 8; ++jj) { const int q = q0 + jj; const int qn = q0 + (jj < 7 ? jj + 1 : jj);
                          *(LAS v2u*)(slp + 4 * ln) = seln; LDS_WAIT(); asm volatile("" ::: "memory");
                          dsa_attn_query_p(QLp, (const bf16*)(r1 + R1_CKV), SELp, (bf16*)(r1 + R1_OLAT), wl, q >> 11, q & (SEQ - 1), ln, bq, (size_t)qn, seln); } }
                    asm volatile("s_waitcnt vmcnt(0)" ::: "memory"); __syncthreads();
                    __builtin_amdgcn_fence(__ATOMIC_ACQUIRE, "agent"); asm volatile("s_waitcnt vmcnt(0)" ::: "memory");
                    for (int wu = wave; wu < 2 * NH; wu += NWAVES) { const int h = wu & 15, tg = wu >> 4;
                        head_gemm<8, 8, 2, OUT_MODE == 2>((const bf16*)(r1 + R1_OLAT), NH * KVL, h * KVL, (const bf16*)(wb + WO_UV) + (size_t)h * HD * KVL, ATT  , D, h * HD, tokb + 32 * tg, 1.0f, lanev); }
                    __syncthreads(); }
            } else {
                for (int q = gwv; q < M; q += NGW) dsa_attn_query((const bf16*)r2, (const bf16*)(r1 + R1_CKV), (const u16*)(r1 + R1_SEL), (bf16*)(r1 + R1_OLAT), wl, q >> 11, q & (SEQ - 1), lanev); }
            REP_END SEAM(pb + 3);
        }
        if (!DSA_MERGE_POST && IN(pb + 4)) { REP_BEGIN(pb + 4)
            for (int wu = gwv; wu < (M / 32) * NH; wu += NGW) { const int h = wu & 15, tg = wu >> 4;
                head_gemm<8, 8, 2, OUT_MODE == 2>((const bf16*)(r1 + R1_OLAT), NH * KVL, h * KVL, (const bf16*)(wb + WO_UV) + (size_t)h * HD * KVL, ATT, D, h * HD, 32 * tg, 1.0f, lanev); }
            REP_END SEAM(pb + 4);
        }
        }
#undef DIL_ARGS
        if (IN(pb + 5)) { REP_BEGIN(pb + 5) pg8::Gemm g{(OUT_MODE == 2 && !dsa) ? (const bf16*)(r2 + R2_ATT8) : ATT, (const bf16*)(wb + WO_OUT), M, D, Kd}; pg8::StaticOrder S; S.init(M, D, Gv, bxv, WGM_OUT);
            pg8::EpiResid<OUT_MODE> E{xin, xin_f32, xout, modl + 2 * D, NMOD, nullptr, sBl + CM_OUT};
            pg8::gemm_phase<pg8::EpiResid<OUT_MODE>, pg8::StaticOrder, PG8_ALIGN, PG8_SP2>(lds, g, S, E, tidv); REP_END SEAM(pb + 5); }
        if (IN(pb + 6)) {
            if (I8_GU) norm_mod_phase_q(xout, 0, as_global(W.norm_ffn), modl + 3 * D, modl + 4 * D, (signed char*)Hb, sAp, I8_DN ? (unsigned*)(wsv + WS_RMAX) : nullptr, gwv, NGW, lanev);
            else norm_mod_phase(xout, 0, as_global(W.norm_ffn), modl + 3 * D, modl + 4 * D, Hb, gwv, NGW, lanev);
            SEAM(pb + 6); }
        if (IN(pb + 7)) { REP_BEGIN(pb + 7) pg8::Gemm g{Hb, (const bf16*)(wb + WO_GU), M, 2 * DFF, Kd}; pg8::StaticOrder S; S.init(M, 2 * DFF, Gv, bxv, WGM_GU);
            pg8::EpiSwiglu<I8_GU, DN_MODE == 2> E{(bf16*)r2, sAp, sBl + CM_GU, I8_DN ? (unsigned*)(wsv + WS_RMAX) : nullptr};
            pg8::gemm_phase<pg8::EpiSwiglu<I8_GU, DN_MODE == 2>, pg8::StaticOrder, PG8_ALIGN, PG8_SP2>(lds, g, S, E, tidv); REP_END SEAM(pb + 7); }
        if (I8_DN && IN(pb + 8)) { REP_BEGIN(pb + 8) act_quant_phase((const bf16*)r2, (const unsigned*)(wsv + WS_RMAX), (signed char*)r1, (float*)(wsv + WS_SA2), gwv, NGW, lanev); REP_END SEAM(pb + 8); }
        if (IN(pb + 9)) { pg8::Gemm g{(const bf16*)(I8_DN ? r1 : r2), (const bf16*)(wb + WO_DN), M, D, Kf}; pg8::StaticOrder S; S.init(M, D, Gv, bxv, WGM_DN);
            pg8::EpiResid<DN_MODE> E{xout, 0, xout, modl + 5 * D, NMOD, (const float*)(wsv + WS_SA2), sBl + CM_DN};
            pg8::gemm_phase<pg8::EpiResid<DN_MODE>, pg8::StaticOrder, PG8_ALIGN, PG8_SP2>(lds, g, S, E, tidv); SEAM(pb + 9); }
    }
#undef wsv
#undef wb
#undef Hb
#undef ATT
#undef r1
#undef r2
#undef modl
#undef sAp
#undef sBl
#undef x16
#undef xin
#undef xin_f32
#undef xout
    if (IN(PH_FINAL)) {
#ifdef DIAG_XCC
        { const unsigned* ids = (const unsigned*)(ws + WS_CTL + 700000); int bad = 0, distinct = 0;
          for (int b = 0; b < G; ++b) if (ids[b] != ids[b & 7]) bad++;
          for (int a = 0; a < 8; ++a) { int dup = 0; for (int c = 0; c < a; ++c) if (ids[a] == ids[c]) dup = 1; distinct += !dup; }
          const float cval = (bad ? 2.0f : 0.0f) + (distinct == 8 ? 0.0f : 1.0f); float* o = as_global(args.out);
          for (size_t e = (size_t)bx * 512 + tid; e < (size_t)M * D; e += (size_t)G * 512) o[e] = cval; }
#endif
#if defined(PROBE_IDX)
        { const unsigned long long* pt = (const unsigned long long*)(ws + WS_CTL + 614400); unsigned long long tt = 0; for (int q = PROBE_IDX; q <= PROBE_IDX_END; ++q) tt += pt[q];
          const float cval = (float)tt * 0.01f / (float)PROBE_DIV; float* o = as_global(args.out);
          for (size_t e = (size_t)bx * 512 + tid; e < (size_t)M * D; e += (size_t)G * 512) o[e] = cval; }
#elif !defined(DIAG_XCC)
        final_norm_phase((const bf16*)(ws + WS_X16), as_global(args.out), as_global(args.final_norm), gwv, NGW, lanev);
#endif
    }
#undef Gv
#undef bxv
#undef Kd
#undef Kf
#undef gwv
#undef vcuv
#undef lanev
#undef LANE_NOW
#undef tidv
#undef IN
#undef SEAM
}


#ifdef DIAG_PROBE
struct ProbeArgs { const unsigned* buf[4]; unsigned long long nwords[4]; int is_bf16[4]; int pad[4]; unsigned* cnt; float* out; };
__global__ void probe_kernel(ProbeArgs a) {
    for (int k = 0; k < 4; ++k) { if (!a.buf[k]) continue; unsigned bad = 0;
        for (unsigned long long i = (unsigned long long)blockIdx.x * blockDim.x + threadIdx.x; i < a.nwords[k]; i += (unsigned long long)gridDim.x * blockDim.x) { const unsigned w = a.buf[k][i];
            const int md = a.is_bf16[k];
            if (md == 1) { if ((w & 0x7F80u) == 0x7F80u || (w & 0x7F800000u) == 0x7F800000u) bad++; } else if (md == 0) { if ((w & 0x7F800000u) == 0x7F800000u) bad++; }
            else if (md == 4) { const unsigned lo = w & 0xFFFFu, hi = w >> 16; if ((lo > 2047u && lo != 0xFFFFu) || (hi > 2047u && hi != 0xFFFFu)) bad++; }
            else if (md == 2) { if ((w & 0x7F80u) >= 0x4680u || (w & 0x7F800000u) >= 0x46800000u) bad++; } else { if ((w & 0x7F800000u) >= 0x46000000u) bad++; } }
        if (bad) atomicAdd(a.cnt + k, bad); }
}
__global__ void probe_fill(ProbeArgs a) {
    float c = 0.f; for (int k = 0; k < 4; ++k) if (a.cnt[k]) c += 0.5f * (float)(1 << k);
    for (size_t i = (size_t)blockIdx.x * blockDim.x + threadIdx.x; i < (size_t)M * D; i += (size_t)gridDim.x * blockDim.x) a.out[i] = c;
}
#endif
extern "C" void kernel_launch(void* const* d_in, const int* in_sizes, int n_in, void* d_out, int out_size, void* d_ws, size_t ws_size, hipStream_t stream) {
    static int grid = 0;
    if (grid == 0) {
        if (n_in != 41 || in_sizes[0] != M * D || out_size != M * D || ws_size < WS_END) { fprintf(stderr, "kernel_launch: unexpected shapes (n_in %d, in0 %d, out %d, ws %zu)\n", n_in, n_in > 0 ? in_sizes[0] : -1, out_size, ws_size); grid = -1; return; }
        int dev = 0, cus = 0;
        if (hipGetDevice(&dev) != hipSuccess || hipDeviceGetAttribute(&cus, hipDeviceAttributeMultiprocessorCount, dev) != hipSuccess) { grid = -1; return; }
        if (hipFuncSetAttribute((const void*)mk_fwd, hipFuncAttributeMaxDynamicSharedMemorySize, LDS_BYTES) != hipSuccess) { fprintf(stderr, "kernel_launch: hipFuncSetAttribute failed\n"); grid = -1; return; }
        int per_cu = 0;
        if (hipOccupancyMaxActiveBlocksPerMultiprocessor(&per_cu, (const void*)mk_fwd, NWAVES * 64, LDS_BYTES) != hipSuccess || per_cu < 1) fprintf(stderr, "kernel_launch: occupancy query reports %d\n", per_cu);
        (void)hipGetLastError();
        grid = cus;
    }
    if (grid < 0) return;
    if (hipMemsetAsync((char*)d_ws + WS_CTL, 0, CTL_ZERO_BYTES, stream) != hipSuccess) return;
    Args a{};
    a.x = (const float*)d_in[0]; a.c = (const float*)d_in[1]; a.final_norm = (const float*)d_in[40];
    int k = 2;
    for (int l = 0; l < DEPTH; ++l) { LayerW& w = a.L[l];
        w.norm_attn = (const float*)d_in[k++]; w.ada_w = (const float*)d_in[k++]; w.ada_b = (const float*)d_in[k++]; w.w_in = (const float*)d_in[k++];
        if (l & 1) { w.kv_norm = (const float*)d_in[k++]; w.w_uk = (const float*)d_in[k++]; w.w_uv = (const float*)d_in[k++]; }
        else { w.kv_norm = nullptr; w.w_uk = nullptr; w.w_uv = nullptr; }
        w.w_out = (const float*)d_in[k++]; w.norm_ffn = (const float*)d_in[k++]; w.w_gu = (const float*)d_in[k++]; w.w_down = (const float*)d_in[k++]; }
    a.out = (float*)d_out; a.ws = (unsigned char*)d_ws;
#if MK_MULTI
    for (int p = 0; p < PH_COUNT; ++p) {

        a.ph_lo = p; a.ph_hi = p + 1;
#ifdef DIAG_PROBE
        if (p > DIAG_LAST) break;
#endif
        hipLaunchKernelGGL(mk_fwd, dim3(grid), dim3(NWAVES * 64), LDS_BYTES, stream, a);
    }
#ifdef DIAG_PROBE
    { ProbeArgs pa{}; unsigned char* ws = (unsigned char*)d_ws; DIAG_SETUP; pa.cnt = (unsigned*)(ws + WS_CTL) + 64; pa.out = (float*)d_out;
      hipLaunchKernelGGL(probe_kernel, dim3(1024), dim3(256), 0, stream, pa); hipLaunchKernelGGL(probe_fill, dim3(1024), dim3(256), 0, stream, pa); }
#endif
#else
    a.ph_lo = 0; a.ph_hi = PH_COUNT;
    hipLaunchKernelGGL(mk_fwd, dim3(grid), dim3(NWAVES * 64), LDS_BYTES, stream, a);
#endif
    const hipError_t le = hipPeekAtLastError();
    if (le != hipSuccess) fprintf(stderr, "kernel_launch: launch failed: %s\n", hipGetErrorName(le));
}
```

```cpp
#include <hip/hip_runtime.h>
#include <cstdio>
#include <cstdint>
#define MK_MULTI 0
namespace pg8 {
#define PG8_LAS __attribute__((address_space(3)))
typedef unsigned short bf16_t;
typedef short bf16x8 __attribute__((ext_vector_type(8)));
typedef float f32x4 __attribute__((ext_vector_type(4)));
typedef unsigned u32x4 __attribute__((ext_vector_type(4)));
constexpr int BM = 256, BK = 64, HALF = 128, HTB = HALF * BK * 2  , STAGE_BYTES = 8 * HTB, NXCD = 8, WGM = 8;

__host__ __device__ __forceinline__ int lds_byte(int r, int c) { const int st = (r >> 4) * 2 + (c >> 5), rr = r & 15, cc = c & 31, ob = rr * 64 + cc * 2; return st * 1024 + (ob ^ (((ob >> 9) & 1) << 5)); }
__host__ __device__ __forceinline__ void stage_rc(int b, int& R, int& C) { const int st = b / 1024, sb = b % 1024, swz = sb ^ (((sb >> 9) & 1) << 5); R = (st >> 1) * 16 + swz / 64; C = (st & 1) * 32 + (swz % 64) / 2; }
__host__ __device__ __forceinline__ int perm32(int rho) { const int n = rho >> 4, i = rho & 15; return 8 * (i >> 2) + 4 * n + (i & 3); }

struct Unit { int pm, pn; };
struct Gemm { const bf16_t* A; const bf16_t* Bt; int M, N, K; };

struct StaticOrder {
    int nM, nN, nwg, G, c, wgm;
    __host__ __device__ void init(int M, int N, int G_, int c_, int wgm_ = WGM) { nM = M / BM; nN = N / BM; nwg = nM * nN; G = G_; c = c_; wgm = wgm_; }
    __host__ __device__ bool next(int i, Unit& u) const {
        const long L = (long)i * G + c; if (L >= nwg) return false;
        int wgid = (int)L; { const int q = nwg / NXCD, r = nwg % NXCD, xcd = wgid % NXCD, off = wgid / NXCD; wgid = (xcd < r ? xcd * (q + 1) : r * (q + 1) + (xcd - r) * q) + off; }
        const int nig = wgm * nN, gid = wgid / nig, fm = gid * wgm, gsz = (nM - fm) < wgm ? (nM - fm) : wgm;
        u.pm = fm + ((wgid % nig) % gsz); u.pn = (wgid % nig) / gsz; return true;
    }
    __device__ __forceinline__ void a_ready(const Unit&) const {}
    __device__ __forceinline__ void done(const Unit&) const {}
};
typedef __bf16 bf16x2_cv __attribute__((ext_vector_type(2)));
typedef float f32x2_cv __attribute__((ext_vector_type(2)));
__device__ __forceinline__ unsigned cvt_pk_bf16(float lo, float hi) { const f32x2_cv v = {lo, hi}; const bf16x2_cv r = __builtin_convertvector(v, bf16x2_cv); return __builtin_bit_cast(unsigned, r); }
typedef float f32x2 __attribute__((ext_vector_type(2)));
__device__ __forceinline__ u32x4 pack8(const f32x4 v0, const f32x4 v1) { u32x4 w; w.x = cvt_pk_bf16(v0[0], v0[1]); w.y = cvt_pk_bf16(v0[2], v0[3]); w.z = cvt_pk_bf16(v1[0], v1[1]); w.w = cvt_pk_bf16(v1[2], v1[3]); return w; }

typedef int i32x4 __attribute__((ext_vector_type(4)));
template <bool I8_> struct AccT { typedef f32x4 type; };
template <> struct AccT<true> { typedef i32x4 type; };
template <bool I8_> __device__ __forceinline__ f32x4 deq(const typename AccT<I8_>::type a, float sa, const f32x4 sb) {
    if constexpr (I8_) { f32x4 r; r[0] = (float)a[0]; r[1] = (float)a[1]; r[2] = (float)a[2]; r[3] = (float)a[3]; return r * sa * sb; } else { (void)sa; (void)sb; return a; } }
template <bool I8_> __device__ __forceinline__ f32x4 deqg(const typename AccT<I8_>::type a, float sa, const f32x4 sb) { if constexpr (I8_) return deq<true>(a, sa, sb); else { (void)sa; return a * sb; } }
template <bool I8_> struct EpiQKV {
    static constexpr bool PERM = true, AFTER_DRAIN = false, I8 = I8_, FP8 = false; typedef typename AccT<I8_>::type acc_t;
    bf16_t* O; size_t split_stride; float qscale; const float* sA; const float* sB;
    __device__ __forceinline__ void operator()(const acc_t (&acc)[2][2][4][2], const Unit& u, int wr, int wc, int fr, int fq) const {
        const int row0 = u.pm * BM + wr * 64 + fr; const int t = u.pn >> 3; const int col0 = (u.pn & 7) * BM + wc * 32 + 8 * fq;
        bf16_t* base = O + (size_t)t * split_stride; const float sc = (t == 0) ? qscale : 1.f;
        f32x4 sb[2][2];
#pragma unroll
        for (int bj = 0; bj < 2; ++bj)
#pragma unroll
            for (int n = 0; n < 2; ++n) sb[bj][n] = I8_ ? *(const f32x4*)(sB + u.pn * BM + bj * HALF + wc * 32 + 8 * fq + 4 * n) : (f32x4){1.f, 1.f, 1.f, 1.f};
#pragma unroll
        for (int ai = 0; ai < 2; ++ai)
#pragma unroll
            for (int m = 0; m < 4; ++m) { const int r = row0 + ai * HALF + m * 16; bf16_t* rowp = base + (size_t)r * 2048 + col0; const float sa = (I8_ ? sA[r] : 1.f) * sc;
#pragma unroll
                for (int bj = 0; bj < 2; ++bj) { f32x4 v0 = deq<I8_>(acc[ai][bj][m][0], sa, sb[bj][0]), v1 = deq<I8_>(acc[ai][bj][m][1], sa, sb[bj][1]);
                    if (!I8_) { v0 = v0 * sc; v1 = v1 * sc; } *(u32x4*)(rowp + bj * HALF) = pack8(v0, v1); } }
    }
};
template <int MODE  > struct EpiResid {
    static constexpr bool PERM = false, AFTER_DRAIN = false, I8 = (MODE == 1), FP8 = (MODE == 2), I8_ = (MODE == 1); typedef typename AccT<(MODE == 1)>::type acc_t;
    const void* base; int base_f32; bf16_t* out; const float* gate; int gstride; const float* sA; const float* sB;
    __device__ __forceinline__ void operator()(const acc_t (&acc)[2][2][4][2], const Unit& u, int wr, int wc, int fr, int fq) const {
        typedef unsigned u32x2 __attribute__((ext_vector_type(2)));
        const int row0 = u.pm * BM + wr * 64 + fr, col0 = u.pn * BM + wc * 32 + 4 * fq;
        const float* gp = gate + (size_t)((u.pm * BM) >> 11) * gstride + col0;
        f32x4 gv[2][2];
#pragma unroll
        for (int bj = 0; bj < 2; ++bj)
#pragma unroll
            for (int n = 0; n < 2; ++n) { gv[bj][n] = *(const f32x4*)(gp + bj * HALF + n * 16); if (MODE != 0) gv[bj][n] = gv[bj][n] * *(const f32x4*)(sB + col0 + bj * HALF + n * 16); }
#pragma unroll
        for (int ai = 0; ai < 2; ++ai)
#pragma unroll
            for (int m = 0; m < 4; ++m) { const int r = row0 + ai * HALF + m * 16; const size_t off = (size_t)r * 2048 + col0; const float sa = I8_ ? sA[r] : 1.f;
                f32x4 bs[2][2];
                if (base_f32) {
#pragma unroll
                    for (int bj = 0; bj < 2; ++bj)
#pragma unroll
                        for (int n = 0; n < 2; ++n) bs[bj][n] = *(const f32x4*)((const float*)base + off + bj * HALF + n * 16);
                } else {
#pragma unroll
                    for (int bj = 0; bj < 2; ++bj)
#pragma unroll
                        for (int n = 0; n < 2; ++n) { const u32x2 w = *(const u32x2*)((const bf16_t*)base + off + bj * HALF + n * 16);
                            bs[bj][n] = (f32x4){__uint_as_float(w.x << 16), __uint_as_float(w.x & 0xFFFF0000u), __uint_as_float(w.y << 16), __uint_as_float(w.y & 0xFFFF0000u)}; }
                }
#pragma unroll
                for (int bj = 0; bj < 2; ++bj)
#pragma unroll
                    for (int n = 0; n < 2; ++n) { const f32x4 v = bs[bj][n] + deqg<I8_>(acc[ai][bj][m][n], sa, gv[bj][n]); *(u32x2*)(out + off + bj * HALF + n * 16) = (u32x2){cvt_pk_bf16(v[0], v[1]), cvt_pk_bf16(v[2], v[3])}; }
                asm volatile("" ::: "memory"); }
    }
};
template <bool I8_, bool OUT8  > struct EpiSwiglu {
    static constexpr bool PERM = true, AFTER_DRAIN = false, I8 = I8_, FP8 = false; typedef typename AccT<I8_>::type acc_t;
    bf16_t* O; const float* sA; const float* sB; unsigned* rmax;
    __device__ __forceinline__ static float silu(float x) { return x * __builtin_amdgcn_rcpf(1.0f + __builtin_amdgcn_exp2f(-1.44269504f * x)); }
    __device__ __forceinline__ void operator()(const acc_t (&acc)[2][2][4][2], const Unit& u, int wr, int wc, int fr, int fq) const {
        const int row0 = u.pm * BM + wr * 64 + fr; const int col0 = u.pn * HALF + wc * 32 + 8 * fq;
        f32x4 sb[2][2];
#pragma unroll
        for (int bj = 0; bj < 2; ++bj)
#pragma unroll
            for (int n = 0; n < 2; ++n) sb[bj][n] = I8_ ? *(const f32x4*)(sB + u.pn * BM + bj * HALF + wc * 32 + 8 * fq + 4 * n) : (f32x4){1.f, 1.f, 1.f, 1.f};
#pragma unroll
        for (int ai = 0; ai < 2; ++ai)
#pragma unroll
            for (int m = 0; m < 4; ++m) { const int r = row0 + ai * HALF + m * 16; bf16_t* rowp = O + (size_t)r * 5632 + col0; const float sa = I8_ ? sA[r] : 1.f;
                const f32x4 g0 = deq<I8_>(acc[ai][0][m][0], sa, sb[0][0]), g1 = deq<I8_>(acc[ai][0][m][1], sa, sb[0][1]), u0 = deq<I8_>(acc[ai][1][m][0], sa, sb[1][0]), u1 = deq<I8_>(acc[ai][1][m][1], sa, sb[1][1]);
                f32x4 v0, v1;
#pragma unroll
                for (int j = 0; j < 4; ++j) { v0[j] = silu(g0[j]) * u0[j]; v1[j] = silu(g1[j]) * u1[j]; }
                if constexpr (OUT8) { unsigned w0 = 0u, w1 = 0u; w0 = __builtin_amdgcn_cvt_pk_fp8_f32(v0[0], v0[1], w0, false); w0 = __builtin_amdgcn_cvt_pk_fp8_f32(v0[2], v0[3], w0, true);
                    w1 = __builtin_amdgcn_cvt_pk_fp8_f32(v1[0], v1[1], w1, false); w1 = __builtin_amdgcn_cvt_pk_fp8_f32(v1[2], v1[3], w1, true);
                    typedef unsigned u32x2 __attribute__((ext_vector_type(2))); *(u32x2*)((unsigned char*)O + (size_t)r * 5632 + col0) = (u32x2){w0, w1}; }
                else *(u32x4*)rowp = pack8(v0, v1);
                if (rmax) { float mx = fmaxf(fmaxf(fmaxf(fabsf(v0[0]), fabsf(v0[1])), fmaxf(fabsf(v0[2]), fabsf(v0[3]))), fmaxf(fmaxf(fabsf(v1[0]), fabsf(v1[1])), fmaxf(fabsf(v1[2]), fabsf(v1[3]))));
                    { unsigned uu = __float_as_uint(mx); auto r16 = __builtin_amdgcn_permlane16_swap(uu, uu, false, false); mx = fmaxf(__uint_as_float(r16[0]), __uint_as_float(r16[1])); uu = __float_as_uint(mx); auto r32 = __builtin_amdgcn_permlane32_swap(uu, uu, false, false); mx = fmaxf(__uint_as_float(r32[0]), __uint_as_float(r32[1])); }
                    if (fq == 0) atomicMax(rmax + r, __float_as_uint(mx)); } }
    }
};
template <bool I8_> struct EpiDsaProj {
    static constexpr bool PERM = true, AFTER_DRAIN = false, I8 = I8_, FP8 = false; typedef typename AccT<I8_>::type acc_t;
    bf16_t* Q; float* CKVR; bf16_t* QI; bf16_t* KI; float* WI; const float* sA; const float* sB;
    __device__ __forceinline__ void operator()(const acc_t (&acc)[2][2][4][2], const Unit& u, int wr, int wc, int fr, int fq) const {
        const int row0 = u.pm * BM + wr * 64 + fr; const int lc0 = wc * 32 + 8 * fq;
        f32x4 sb[2][2];
#pragma unroll
        for (int bj = 0; bj < 2; ++bj)
#pragma unroll
            for (int n = 0; n < 2; ++n) sb[bj][n] = I8_ ? *(const f32x4*)(sB + u.pn * BM + bj * HALF + lc0 + 4 * n) : (f32x4){1.f, 1.f, 1.f, 1.f};
#define DQ(ai, bj, m, n) deq<I8_>(acc[ai][bj][m][n], sa, sb[bj][n])
        if (u.pn < 8 || (u.pn >= 9 && u.pn < 17)) {
            bf16_t* base = (u.pn < 8) ? Q : QI; const int col0 = ((u.pn < 8) ? u.pn : (u.pn - 9)) * BM + lc0;
#pragma unroll
            for (int ai = 0; ai < 2; ++ai)
#pragma unroll
                for (int m = 0; m < 4; ++m) { const int r = row0 + ai * HALF + m * 16; const float sa = I8_ ? sA[r] : 1.f; bf16_t* rowp = base + (size_t)r * 2048 + col0;
#pragma unroll
                    for (int bj = 0; bj < 2; ++bj) *(u32x4*)(rowp + bj * HALF) = pack8(DQ(ai, bj, m, 0), DQ(ai, bj, m, 1)); }
        } else if (u.pn == 8) {
#pragma unroll
            for (int ai = 0; ai < 2; ++ai)
#pragma unroll
                for (int m = 0; m < 4; ++m) { const int r = row0 + ai * HALF + m * 16; const float sa = I8_ ? sA[r] : 1.f; float* rowp = CKVR + (size_t)r * 256 + lc0;
#pragma unroll
                    for (int bj = 0; bj < 2; ++bj) { *(f32x4*)(rowp + bj * HALF) = DQ(ai, bj, m, 0); *(f32x4*)(rowp + bj * HALF + 4) = DQ(ai, bj, m, 1); } }
        } else {
#pragma unroll
            for (int ai = 0; ai < 2; ++ai)
#pragma unroll
                for (int m = 0; m < 4; ++m) { const size_t r = (size_t)(row0 + ai * HALF + m * 16); const float sa = I8_ ? sA[r] : 1.f;
                    *(u32x4*)(KI + r * 128 + lc0) = pack8(DQ(ai, 0, m, 0), DQ(ai, 0, m, 1));
                    if (lc0 < 16) { *(f32x4*)(WI + r * 16 + lc0) = DQ(ai, 1, m, 0); *(f32x4*)(WI + r * 16 + lc0 + 4) = DQ(ai, 1, m, 1); } }
        }
#undef DQ
    }
};
template <class Epi, class Sched, bool ALIGN_EPI = false, bool SP2 = false>
__device__ __forceinline__ void gemm_phase(PG8_LAS unsigned char* lds, const Gemm g, const Sched& S, const Epi& E, int tid_in) {
    int tid_ = tid_in; asm volatile("" : "+v"(tid_));
    const int tid = tid_, wid = __builtin_amdgcn_readfirstlane(tid >> 6), lane = tid & 63, wr = wid >> 2, wc = wid & 3, fr = lane & 15, fq = lane >> 4;
    constexpr bool I8 = Epi::I8, F8 = Epi::FP8; typedef typename Epi::acc_t acc_t; typedef int i32x4_t __attribute__((ext_vector_type(4))); typedef int i32x8_t __attribute__((ext_vector_type(8)));
    const int K = g.K * ((I8 || F8) ? 1 : 2)  , nt = K / (BK * 2);
    unsigned voffA[2], voffB[2];
#pragma unroll
    for (int i = 0; i < 2; ++i) { int R, C; stage_rc(tid * 16 + i * 8192, R, C); const int Rb = Epi::PERM ? ((R & ~31) + perm32(R & 31)) : R;
        voffA[i] = (unsigned)(R * K + C * 2); voffB[i] = (unsigned)(Rb * K + C * 2); }
    const size_t kstep = (size_t)(BK * 2);
    const size_t hstep = (size_t)HALF * K;
    const size_t tstep = 2 * hstep;
    const unsigned ldsw = (unsigned)wid * 1024u;
    const int aoff = lds_byte(wr * 64 + fr, fq * 8), boff = lds_byte(wc * 32 + fr, fq * 8);
#define PG8_SA(b, h) (((b) * 2 + (h)) * HTB)
#define PG8_SB(b, h) ((4 + (b) * 2 + (h)) * HTB)
#define PG8_STAGE(bufoff, gbase, voff) do { _Pragma("unroll") for (int _i = 0; _i < 2; ++_i) \
        __builtin_amdgcn_global_load_lds((const unsigned*)((const char*)(gbase) + (voff)[_i]), (PG8_LAS unsigned*)(lds + (bufoff) + ldsw + _i * 8192), 16, 0, 0); } while (0)
#define PG8_LDA(dst, b, h) do { _Pragma("unroll") for (int m = 0; m < 4; ++m) _Pragma("unroll") for (int k = 0; k < 2; ++k) dst[m][k] = *(const PG8_LAS bf16x8*)(lds + PG8_SA(b, h) + aoff + m * 2048 + k * 1024); } while (0)
#define PG8_LDB(dst, b, h) do { _Pragma("unroll") for (int n = 0; n < 2; ++n) _Pragma("unroll") for (int k = 0; k < 2; ++k) dst[n][k] = *(const PG8_LAS bf16x8*)(lds + PG8_SB(b, h) + boff + n * 2048 + k * 1024); } while (0)
#define PG8_CAT8(x) ({ const i32x4_t lo_ = __builtin_bit_cast(i32x4_t, (x)[0]), hi_ = __builtin_bit_cast(i32x4_t, (x)[1]); (i32x8_t){lo_[0], lo_[1], lo_[2], lo_[3], hi_[0], hi_[1], hi_[2], hi_[3]}; })
#define PG8_MMA(ai, bj, At, Bt) do { __builtin_amdgcn_s_setprio(1); \
        if constexpr (F8) {   \
            _Pragma("unroll") for (int m = 0; m < 4; ++m) _Pragma("unroll") for (int n = 0; n < 2; ++n) \
                { const i32x8_t b8_ = PG8_CAT8(Bt[n]), a8_ = PG8_CAT8(At[m]); asm volatile("v_mfma_scale_f32_16x16x128_f8f6f4 %0, %1, %2, %0, %3, %3 op_sel_hi:[0,0,0]" : "+v"(acc[ai][bj][m][n]) : "v"(b8_), "v"(a8_), "v"(0x7F7F7F7F)); } \
        } else { _Pragma("unroll") for (int m = 0; m < 4; ++m) _Pragma("unroll") for (int n = 0; n < 2; ++n) _Pragma("unroll") for (int k = 0; k < 2; ++k) \
        { if constexpr (I8) acc[ai][bj][m][n] = __builtin_bit_cast(acc_t, __builtin_amdgcn_mfma_i32_16x16x64_i8(__builtin_bit_cast(i32x4_t, Bt[n][k]), __builtin_bit_cast(i32x4_t, At[m][k]), __builtin_bit_cast(i32x4_t, acc[ai][bj][m][n]), 0, 0, 0)); \
          else acc[ai][bj][m][n] = __builtin_bit_cast(acc_t, __builtin_amdgcn_mfma_f32_16x16x32_bf16(Bt[n][k], At[m][k], __builtin_bit_cast(f32x4, acc[ai][bj][m][n]), 0, 0, 0)); } } __builtin_amdgcn_s_setprio(0); } while (0)
#define PG8_WAIT_V(n) asm volatile("s_waitcnt vmcnt(" #n ")" ::: "memory")
#define PG8_WAIT_L(n) asm volatile("s_waitcnt lgkmcnt(" #n ")" ::: "memory")
#define PG8_BAR __builtin_amdgcn_s_barrier()
#define PG8_SCHED __builtin_amdgcn_sched_barrier(0)
    Unit cur, nxt; int ui = 0;
    if (!S.next(0, cur)) return;
    acc_t acc[2][2][4][2];
#pragma unroll
    for (int a = 0; a < 2; ++a)
#pragma unroll
        for (int b = 0; b < 2; ++b)
#pragma unroll
            for (int m = 0; m < 4; ++m)
#pragma unroll
                for (int n = 0; n < 2; ++n) acc[a][b][m][n] = acc_t{};
    bf16x8 At[4][2], B0[2][2], B1[2][2];
    const char* cA = (const char*)g.A + (size_t)cur.pm * tstep; const char* cB = (const char*)g.Bt + (size_t)cur.pn * tstep;
    S.a_ready(cur);
    if constexpr (SP2) {
        PG8_STAGE(PG8_SB(0, 0), cB, voffB); PG8_STAGE(PG8_SB(0, 1), cB + hstep, voffB); PG8_STAGE(PG8_SA(0, 0), cA, voffA); PG8_STAGE(PG8_SA(0, 1), cA + hstep, voffA);
        if (wr == 1) PG8_BAR;
        PG8_WAIT_V(2); PG8_BAR;
        PG8_STAGE(PG8_SB(1, 0), cB + kstep, voffB); PG8_STAGE(PG8_SA(1, 0), cA + kstep, voffA); PG8_STAGE(PG8_SB(1, 1), cB + hstep + kstep, voffB);
        PG8_WAIT_V(6); PG8_BAR;
    } else {
        PG8_STAGE(PG8_SB(0, 0), cB, voffB); PG8_STAGE(PG8_SA(0, 0), cA, voffA); PG8_STAGE(PG8_SB(0, 1), cB + hstep, voffB); PG8_STAGE(PG8_SA(0, 1), cA + hstep, voffA);
        if (wr == 1) PG8_BAR;
        PG8_WAIT_V(4); PG8_BAR;
        PG8_STAGE(PG8_SB(1, 0), cB + kstep, voffB); PG8_STAGE(PG8_SA(1, 0), cA + kstep, voffA); PG8_STAGE(PG8_SB(1, 1), cB + hstep + kstep, voffB);
        PG8_WAIT_V(6); PG8_BAR;
    }
    for (;;) {
        const bool has_next = S.next(ui + 1, nxt);
        const char* nA = has_next ? (const char*)g.A + (size_t)nxt.pm * tstep : cA; const char* nB = has_next ? (const char*)g.Bt + (size_t)nxt.pn * tstep : cB;
        for (int t = 0; t < nt; t += 2) {
            const bool last = (t == nt - 2);
            const char* a1 = cA + (size_t)(t + 1) * kstep;
            const char* a2 = last ? nA : cA + (size_t)(t + 2) * kstep; const char* b2 = last ? nB : cB + (size_t)(t + 2) * kstep;
            const char* a3 = a2 + kstep; const char* b3 = b2 + kstep;
            if (last && has_next) S.a_ready(nxt);
            if constexpr (SP2) {
            PG8_LDB(B0, 0, 0); PG8_LDB(B1, 0, 1); PG8_SCHED; PG8_LDA(At, 0, 0); PG8_STAGE(PG8_SA(1, 1), a1 + hstep, voffA);
            PG8_WAIT_V(8); PG8_WAIT_L(0); PG8_BAR; PG8_MMA(0, 0, At, B0); PG8_MMA(0, 1, At, B1); PG8_BAR; PG8_SCHED;
            PG8_LDA(At, 0, 1); PG8_STAGE(PG8_SB(0, 0), b2, voffB); PG8_STAGE(PG8_SB(0, 1), b2 + hstep, voffB); PG8_STAGE(PG8_SA(0, 0), a2, voffA);
            PG8_WAIT_V(8); PG8_WAIT_L(0); PG8_BAR; PG8_MMA(1, 0, At, B0); PG8_MMA(1, 1, At, B1); PG8_BAR; PG8_SCHED;
            PG8_LDB(B0, 1, 0); PG8_LDB(B1, 1, 1); PG8_SCHED; PG8_LDA(At, 1, 0); PG8_STAGE(PG8_SA(0, 1), a2 + hstep, voffA);
            PG8_WAIT_V(8); PG8_WAIT_L(0); PG8_BAR; PG8_MMA(0, 0, At, B0); PG8_MMA(0, 1, At, B1); PG8_BAR; PG8_SCHED;
            PG8_LDA(At, 1, 1); PG8_STAGE(PG8_SB(1, 0), b3, voffB); PG8_STAGE(PG8_SB(1, 1), b3 + hstep, voffB); PG8_STAGE(PG8_SA(1, 0), a3, voffA);
            PG8_WAIT_V(8); PG8_WAIT_L(0); PG8_BAR; PG8_MMA(1, 0, At, B0); PG8_MMA(1, 1, At, B1); PG8_BAR; PG8_SCHED;
            } else {
            PG8_LDB(B0, 0, 0); PG8_SCHED; PG8_LDA(At, 0, 0); PG8_STAGE(PG8_SA(1, 1), a1 + hstep, voffA);
            PG8_WAIT_L(8); PG8_BAR; PG8_WAIT_L(0); PG8_MMA(0, 0, At, B0); PG8_BAR; PG8_SCHED;
            PG8_LDB(B1, 0, 1); PG8_STAGE(PG8_SB(0, 0), b2, voffB);
            PG8_BAR; PG8_WAIT_L(0); PG8_MMA(0, 1, At, B1); PG8_BAR;
            PG8_LDA(At, 0, 1); PG8_STAGE(PG8_SA(0, 0), a2, voffA);
            PG8_BAR; PG8_WAIT_L(0); PG8_MMA(1, 0, At, B0); PG8_BAR; PG8_SCHED;
            PG8_STAGE(PG8_SB(0, 1), b2 + hstep, voffB);
            PG8_WAIT_V(6); PG8_BAR; PG8_MMA(1, 1, At, B1); PG8_BAR;
            PG8_LDB(B0, 1, 0); PG8_SCHED; PG8_LDA(At, 1, 0); PG8_STAGE(PG8_SA(0, 1), a2 + hstep, voffA);
            PG8_WAIT_L(8); PG8_BAR; PG8_WAIT_L(0); PG8_MMA(0, 0, At, B0); PG8_BAR; PG8_SCHED;
            PG8_LDB(B1, 1, 1); PG8_STAGE(PG8_SB(1, 0), b3, voffB);
            PG8_BAR; PG8_WAIT_L(0); PG8_MMA(0, 1, At, B1); PG8_BAR;
            PG8_LDA(At, 1, 1); PG8_STAGE(PG8_SA(1, 0), a3, voffA);
            PG8_BAR; PG8_WAIT_L(0); PG8_MMA(1, 0, At, B0); PG8_BAR; PG8_SCHED;
            PG8_STAGE(PG8_SB(1, 1), b3 + hstep, voffB);
            PG8_WAIT_V(6); PG8_BAR; PG8_MMA(1, 1, At, B1); PG8_BAR;
            }
        }
        if constexpr (ALIGN_EPI) { if (wr == 0) PG8_BAR; }
        if constexpr (!Epi::AFTER_DRAIN) { E(acc, cur, wr, wc, fr, fq);
#ifdef EPI_TWICE
            if constexpr (Epi::PERM) { asm volatile("" ::: "memory"); E(acc, cur, wr, wc, fr, fq); }
#endif
            S.done(cur); }
        if (!has_next) break;
#pragma unroll
        for (int a = 0; a < 2; ++a)
#pragma unroll
            for (int b = 0; b < 2; ++b)
#pragma unroll
                for (int m = 0; m < 4; ++m)
#pragma unroll
                    for (int n = 0; n < 2; ++n) acc[a][b][m][n] = acc_t{};
        cur = nxt; cA = nA; cB = nB; ++ui;
        if constexpr (ALIGN_EPI) { if (wr == 1) PG8_BAR; }
    }
    PG8_WAIT_V(0);
    if constexpr (!ALIGN_EPI) { if (wr == 0) PG8_BAR; }
    PG8_BAR;
    if constexpr (Epi::AFTER_DRAIN) { E.fused(acc, cur, wr, wc, fr, fq, lds, wid, lane); S.done(cur); }
#undef PG8_SA
#undef PG8_SB
#undef PG8_STAGE
#undef PG8_LDA
#undef PG8_LDB
#undef PG8_MMA
#undef PG8_CAT8
#undef PG8_WAIT_V
#undef PG8_WAIT_L
#undef PG8_BAR
#undef PG8_SCHED
}
}
#ifndef PG8_SP2
#define PG8_SP2 true
#endif
#ifndef PG8_ALIGN
#define PG8_ALIGN true
#endif
#ifndef USE_I8
#define USE_I8 true
#endif
#ifndef I8_QKV
#define I8_QKV USE_I8
#endif
#ifndef I8_DSA
#define I8_DSA true
#endif
#ifndef I8_GU
#define I8_GU USE_I8
#endif
#ifndef OUT_MODE
#define OUT_MODE 2
#endif
#ifndef DN_MODE
#define DN_MODE 2
#endif
#define I8_DN (DN_MODE == 1)
#ifndef WGM_QKV
#define WGM_QKV 2
#endif
#ifndef WGM_DSA
#define WGM_DSA 4
#endif
#ifndef WGM_OUT
#define WGM_OUT 4
#endif
#ifndef WGM_GU
#define WGM_GU 4
#endif
#ifndef WGM_DN
#define WGM_DN 4
#endif
#ifndef DSA_MERGE_POST
#define DSA_MERGE_POST 1
#endif
#ifndef PRO_SINGLE
#define PRO_SINGLE 1
#endif
#ifndef DIL_SPLIT
#define DIL_SPLIT 1
#endif
#ifndef DIL_FUSED
#define DIL_FUSED 0
#endif
#ifndef MK_MULTI
#define MK_MULTI 0
#endif

constexpr int NWAVES = 8;
constexpr int BATCH = 8, SEQ = 2048, D = 2048, M = BATCH * SEQ, NH = 16, HD = 128, DFF = 5632, KVL = 256, TOPK = 256, DEPTH = 4;
constexpr int NIN_A = 6144, NIN_B = 4496, NIN_BP = 4608, NMOD = 6 * D;
constexpr float EPS = 1e-6f;
constexpr float LOG2E = 1.4426950408889634f;
constexpr float QSCALE = 0.08838834764831845f * LOG2E;

constexpr size_t MiB = 1u << 20;
constexpr size_t WS_CTL = 0, CTL_ZERO_BYTES = 1 * MiB;
constexpr size_t WS_MOD = 1 * MiB;
constexpr size_t WS_W = 4 * MiB, W_LAYER = 100 * MiB;
constexpr size_t WO_IN = 0, WO_OUT = 24 * MiB, WO_GU = 32 * MiB, WO_DN = 76 * MiB, WO_UK = 98 * MiB, WO_UV = 99 * MiB;
constexpr size_t WS_H = 404 * MiB;
constexpr size_t WS_R1 = 468 * MiB;
constexpr size_t WS_ATT = 660 * MiB;
constexpr size_t WS_R2 = 724 * MiB;
constexpr size_t WS_X16 = 900 * MiB;
constexpr size_t WS_END = 964 * MiB;
constexpr size_t R2_ATT8 = 16 * MiB;
constexpr size_t R1_Q = 0, R1_QI = 64 * MiB, R1_OLAT = 0, R1_CKVR = 128 * MiB, R1_KI = 144 * MiB, R1_WI = 148 * MiB, R1_CKV = 149 * MiB, R1_SEL = 157 * MiB;
constexpr int CW_BAR = 4096;
constexpr size_t CTL_CMAX = 65536;
constexpr size_t CTL_DILCNT = 524288;
constexpr int CM_LAYER = 21504, CM_GU = 6144, CM_DN = 17408, CM_OUT = 19456;
constexpr size_t WS_SA = 2 * MiB + 512 * 1024;
constexpr size_t WS_RMAX = WS_SA + 65536;
constexpr size_t WS_SA2 = WS_SA + 131072;
constexpr size_t WS_SB = 3 * MiB;

constexpr int RING_BYTES = 143360;
constexpr int MISC_OFF = RING_BYTES;
constexpr int LDS_BYTES = RING_BYTES + 256;

#define GAS __attribute__((address_space(1)))
#define LAS __attribute__((address_space(3)))
typedef unsigned short bf16;
typedef unsigned short u16;
typedef unsigned v4u __attribute__((ext_vector_type(4)));
typedef unsigned v2u __attribute__((ext_vector_type(2)));
typedef float f32x4 __attribute__((ext_vector_type(4)));
typedef short bf16x8 __attribute__((ext_vector_type(8)));
typedef short s16x4 __attribute__((ext_vector_type(4)));
typedef short v4i16_t __attribute__((ext_vector_type(4)));
typedef GAS unsigned gu32;
template <class T> __device__ __forceinline__ T* as_global(T* p) { return (T*)(GAS T*)p; }
#define RLX_AGENT __ATOMIC_RELAXED, __HIP_MEMORY_SCOPE_AGENT
#define LDS_WAIT() asm volatile("s_waitcnt lgkmcnt(0)" ::: "memory")
#define VM_WAIT() asm volatile("s_waitcnt vmcnt(0)" ::: "memory")
__device__ __forceinline__ unsigned cvtpk(float lo, float hi) { return pg8::cvt_pk_bf16(lo, hi); }
#define DPPF(v, ctrl) __builtin_bit_cast(float, __builtin_amdgcn_update_dpp(0, __builtin_bit_cast(int, (v)), (ctrl), 0xF, 0xF, true))
__device__ __forceinline__ float xmax16(float v) { const unsigned u = __float_as_uint(v); auto r = __builtin_amdgcn_permlane16_swap(u, u, false, false); return fmaxf(__uint_as_float(r[0]), __uint_as_float(r[1])); }
__device__ __forceinline__ float xmax32(float v) { const unsigned u = __float_as_uint(v); auto r = __builtin_amdgcn_permlane32_swap(u, u, false, false); return fmaxf(__uint_as_float(r[0]), __uint_as_float(r[1])); }
__device__ __forceinline__ float xsum16(float v) { const unsigned u = __float_as_uint(v); auto r = __builtin_amdgcn_permlane16_swap(u, u, false, false); return __uint_as_float(r[0]) + __uint_as_float(r[1]); }
__device__ __forceinline__ float xsum32(float v) { const unsigned u = __float_as_uint(v); auto r = __builtin_amdgcn_permlane32_swap(u, u, false, false); return __uint_as_float(r[0]) + __uint_as_float(r[1]); }
__device__ __forceinline__ float wave_sum(float v) {
    v += DPPF(v, 0xB1); v += DPPF(v, 0x4E); v += DPPF(v, 0x141); v += DPPF(v, 0x140);
    return xsum32(xsum16(v));
}
__device__ __forceinline__ float wave_max(float v) {
    v = fmaxf(v, DPPF(v, 0xB1)); v = fmaxf(v, DPPF(v, 0x4E)); v = fmaxf(v, DPPF(v, 0x141)); v = fmaxf(v, DPPF(v, 0x140));
    return xmax32(xmax16(v));
}
__device__ __forceinline__ s16x4 tr_read(LAS const unsigned char* p) { return __builtin_bit_cast(s16x4, __builtin_amdgcn_ds_read_tr16_b64_v4i16((LAS v4i16_t*)p)); }
__device__ __forceinline__ bf16x8 cat8(s16x4 a, s16x4 b) { bf16x8 r; r[0] = a[0]; r[1] = a[1]; r[2] = a[2]; r[3] = a[3]; r[4] = b[0]; r[5] = b[1]; r[6] = b[2]; r[7] = b[3]; return r; }
__device__ __forceinline__ unsigned mbcnt64(unsigned long long m) { return __builtin_amdgcn_mbcnt_hi((unsigned)(m >> 32), __builtin_amdgcn_mbcnt_lo((unsigned)m, 0u)); }

#define XB_TMO      128
#define XB_XCNT(j)  (256  + 64 * (j))
#define XB_XSUB(j)  (1280 + 64 * (j))
#define XB_XGEN(j)  (2304 + 64 * (j))
#define XB_TOP      3328
#define XB_TOPGEN   3392
#define XCD_BAR_WORDS 3456
#define XB_SPIN_CAP (1u << 18)

__device__ __forceinline__ unsigned xb_ld(unsigned* p)              { return __hip_atomic_load(p, __ATOMIC_RELAXED, __HIP_MEMORY_SCOPE_AGENT); }
__device__ __forceinline__ unsigned xb_add(unsigned* p, unsigned v) { return __hip_atomic_fetch_add(p, v, __ATOMIC_RELAXED, __HIP_MEMORY_SCOPE_AGENT); }
__device__ __forceinline__ unsigned xb_xcc_id() { return (unsigned)__builtin_amdgcn_s_getreg((3 << 11) | 20) & 0xFu; }
#define XB_SPIN(cond, bar) do { unsigned _sp = 0; while (cond) { __builtin_amdgcn_s_sleep(1); \
    if ((++_sp & 255u) == 0u) { if (xb_ld(&(bar)[XB_TMO])) break; if (_sp > XB_SPIN_CAP) { atomicAdd(&(bar)[XB_TMO], 1u); break; } } } } while (0)

struct XcdBarrier {
    unsigned* bar; unsigned x;
    volatile LAS unsigned* st;
};

__device__ __forceinline__ XcdBarrier xcd_barrier_post(unsigned* bar, volatile LAS unsigned* st) {
    XcdBarrier b; b.bar = bar; b.x = xb_xcc_id(); b.st = st;
    if (threadIdx.x == 0) (void)xb_add(&bar[XB_XCNT(b.x)], 1u);
    return b;
}
__device__ __forceinline__ void xcd_barrier_complete(unsigned* bar, unsigned x, unsigned& nloc, unsigned& nx) {
    const unsigned G = gridDim.x * gridDim.y * gridDim.z;
    unsigned sum, cnt, mine, sp = 0u;
    for (;;) {
        sum = 0u; cnt = 0u; mine = 0u;
#pragma unroll
        for (unsigned j = 0; j < 16; ++j) { const unsigned c = xb_ld(&bar[XB_XCNT(j)]); sum += c; cnt += (c > 0u) ? 1u : 0u; mine = (j == x) ? c : mine; }
        if (sum == G) break;
        __builtin_amdgcn_s_sleep(1);
        if ((++sp & 255u) == 0u) { if (xb_ld(&bar[XB_TMO])) break; if (sp > XB_SPIN_CAP) { atomicAdd(&bar[XB_TMO], 1u); break; } }
    }
    nloc = mine > 0u ? mine : 1u; nx = cnt > 0u ? cnt : 1u;
}

__device__ __forceinline__ void xcd_barrier_census(const XcdBarrier& b) { unsigned nloc, nx; xcd_barrier_complete(b.bar, b.x, nloc, nx); b.st[0] = nloc; b.st[1] = nx; }
__device__ __forceinline__ void xcd_barrier(const XcdBarrier& b, const bool thread0  ) {
    asm volatile("s_waitcnt vmcnt(0)" ::: "memory");
    __syncthreads();
    if (thread0) {
        unsigned* bar = b.bar;
        __builtin_amdgcn_s_waitcnt(0);
        unsigned nloc = b.st[0], nx = b.st[1];
        const unsigned old = xb_add(&bar[XB_XSUB(b.x)], 1u);
        const unsigned gen = old / nloc;
        if (old + 1u == (gen + 1u) * nloc) {
            __builtin_amdgcn_fence(__ATOMIC_RELEASE, "agent");
            asm volatile("s_waitcnt vmcnt(0)" ::: "memory");
            const unsigned og = xb_add(&bar[XB_TOP], 1u);
            const unsigned tg = og / nx;
            if (og + 1u == (tg + 1u) * nx) xb_add(&bar[XB_TOPGEN], 1u);
            else XB_SPIN(xb_ld(&bar[XB_TOPGEN]) == tg, bar);
            __builtin_amdgcn_fence(__ATOMIC_ACQUIRE, "agent");
            xb_add(&bar[XB_XGEN(b.x)], 1u);
            asm volatile("s_waitcnt vmcnt(0)" ::: "memory");
        } else {
            XB_SPIN(xb_ld(&bar[XB_XGEN(b.x)]) == gen, bar);
            __builtin_amdgcn_fence(__ATOMIC_ACQUIRE, "agent");
            asm volatile("s_waitcnt vmcnt(0)" ::: "memory");
        }
    }
    __syncthreads();
}
struct LayerW { const float *norm_attn, *ada_w, *ada_b, *w_in, *kv_norm, *w_uk, *w_uv, *w_out, *norm_ffn, *w_gu, *w_down; };
struct Args { const float* x; const float* c; const float* final_norm; LayerW L[DEPTH]; float* out; unsigned char* ws; int ph_lo, ph_hi; };

__device__ __forceinline__ void colmax_item(const float* W, int N, unsigned* cmax, int item, int lane) {
    const int nnb = (N + 255) / 256, kb = item / nnb, nb = item % nnb, col = 256 * nb + 4 * lane;
    if (col < N) { const float* p = W + (size_t)(64 * kb) * N + col; f32x4 m = (f32x4){0.f, 0.f, 0.f, 0.f};
#pragma unroll 8
        for (int kk = 0; kk < 64; ++kk) { const f32x4 v = *(const f32x4*)(p + (size_t)kk * N); m[0] = fmaxf(m[0], fabsf(v[0])); m[1] = fmaxf(m[1], fabsf(v[1])); m[2] = fmaxf(m[2], fabsf(v[2])); m[3] = fmaxf(m[3], fabsf(v[3])); }
#pragma unroll
        for (int j = 0; j < 4; ++j) atomicMax(cmax + col + j, __float_as_uint(m[j])); }
}
constexpr int CI_INA = (D / 64) * (NIN_A / 256), CI_INB = I8_DSA ? (D / 64) * ((NIN_B + 255) / 256) : 0, CI_GU = (D / 64) * (2 * DFF / 256), CI_DN = (DFF / 64) * (D / 256), CI_OUT = OUT_MODE ? (D / 64) * (D / 256) : 0;
constexpr int CI_DIL = CI_INA + CI_GU + CI_DN + CI_OUT, CI_DSA = CI_INB + CI_GU + CI_DN + CI_OUT, CI_ALL = 2 * CI_DIL + 2 * CI_DSA;
__device__ __forceinline__ void p0_colmax(const Args& a, int gw, int NGW, int lane) {
    unsigned* cm = (unsigned*)(as_global(a.ws) + WS_CTL + CTL_CMAX);
    for (int it = gw; it < CI_ALL; it += NGW) {
        int r = it; int l;
        if (r < CI_DIL) l = 0; else { r -= CI_DIL; if (r < CI_DSA) l = 1; else { r -= CI_DSA; if (r < CI_DIL) l = 2; else { r -= CI_DIL; l = 3; } } }
        const LayerW& w = a.L[l]; unsigned* cml = cm + l * CM_LAYER; const int nin = (l & 1) ? NIN_B : NIN_A, ci_in = (l & 1) ? CI_INB : CI_INA;
        if (r < ci_in) colmax_item(as_global(w.w_in), nin, cml, r, lane); else if (r < ci_in + CI_GU) colmax_item(as_global(w.w_gu), 2 * DFF, cml + CM_GU, r - ci_in, lane); else if (r < ci_in + CI_GU + CI_DN) colmax_item(as_global(w.w_down), D, cml + CM_DN, r - ci_in - CI_GU, lane); else colmax_item(as_global(w.w_out), D, cml + CM_OUT, r - ci_in - CI_GU - CI_DN, lane);
    }
}
constexpr int TSCR = 64 * 65 * 4;
struct TrItem { const float* W; int ldw, srccol0, nvalid, k0, K, destrow0, mode; void* WT; const unsigned* cmax; float* sB; LAS const float* cml; };
__device__ __forceinline__ void tr_load(const TrItem& T, int lane, f32x4 (&v)[16]) {
    const int c4 = lane & 15, r4 = lane >> 4; const bool ok = 4 * c4 < T.nvalid; const float* p = T.W + (size_t)(T.k0 + r4) * T.ldw + T.srccol0 + 4 * c4;
#pragma unroll
    for (int it = 0; it < 16; ++it) { v[it] = (f32x4){0.f, 0.f, 0.f, 0.f}; if (ok) v[it] = *(const f32x4*)(p + (size_t)(4 * it) * T.ldw); }
}
__device__ __forceinline__ void tr_fill(LAS float* scr, int lane, const f32x4 (&v)[16]) {
    const int c4 = lane & 15, r4 = lane >> 4;
#pragma unroll
    for (int it = 0; it < 16; ++it) { LAS float* d = scr + (4 * it + r4) * 65 + 4 * c4; d[0] = v[it][0]; d[1] = v[it][1]; d[2] = v[it][2]; d[3] = v[it][3]; }
}
__device__ __forceinline__ void tr_emit(const TrItem& T, LAS float* scr, int lane) {
    const int q = lane & 3, rr = lane >> 2;
#pragma unroll
    for (int j = 0; j < 4; ++j) { const int n = rr + 16 * j; const LAS float* sp = scr + (16 * q) * 65 + n; float v[16];
#pragma unroll
        for (int e = 0; e < 16; ++e) v[e] = sp[e * 65];
        if (T.mode == 2) { const float cmx = (n < T.nvalid) ? (T.cml ? T.cml[n] : __uint_as_float(T.cmax[T.srccol0 + n])) : 0.f; const float inv = cmx > 0.f ? 256.0f / cmx : 0.f; unsigned w[4];
#pragma unroll
            for (int e = 0; e < 4; ++e) { unsigned ww = 0u; ww = __builtin_amdgcn_cvt_pk_fp8_f32(v[4 * e] * inv, v[4 * e + 1] * inv, ww, false); ww = __builtin_amdgcn_cvt_pk_fp8_f32(v[4 * e + 2] * inv, v[4 * e + 3] * inv, ww, true); w[e] = ww; }
            *(v4u*)((signed char*)T.WT + (size_t)(T.destrow0 + n) * T.K + T.k0 + 16 * q) = (v4u){w[0], w[1], w[2], w[3]}; }
        else if (T.mode) { const float cmx = (n < T.nvalid) ? (T.cml ? T.cml[n] : __uint_as_float(T.cmax[T.srccol0 + n])) : 0.f; const float inv = cmx > 0.f ? 127.0f / cmx : 0.f; unsigned b[16];
#pragma unroll
            for (int e = 0; e < 16; ++e) b[e] = (unsigned)(int)rintf(v[e] * inv) & 0xFFu;
            v4u o; o.x = b[0] | (b[1] << 8) | (b[2] << 16) | (b[3] << 24); o.y = b[4] | (b[5] << 8) | (b[6] << 16) | (b[7] << 24); o.z = b[8] | (b[9] << 8) | (b[10] << 16) | (b[11] << 24); o.w = b[12] | (b[13] << 8) | (b[14] << 16) | (b[15] << 24);
            *(v4u*)((signed char*)T.WT + (size_t)(T.destrow0 + n) * T.K + T.k0 + 16 * q) = o; }
        else { v4u o0, o1; o0.x = cvtpk(v[0], v[1]); o0.y = cvtpk(v[2], v[3]); o0.z = cvtpk(v[4], v[5]); o0.w = cvtpk(v[6], v[7]); o1.x = cvtpk(v[8], v[9]); o1.y = cvtpk(v[10], v[11]); o1.z = cvtpk(v[12], v[13]); o1.w = cvtpk(v[14], v[15]);
            bf16* dp = (bf16*)T.WT + (size_t)(T.destrow0 + n) * T.K + T.k0 + 16 * q; *(v4u*)dp = o0; *(v4u*)(dp + 8) = o1; } }
    if (T.mode && T.k0 == 0 && !T.cml) T.sB[T.destrow0 + lane] = (lane < T.nvalid) ? __uint_as_float(T.cmax[T.srccol0 + lane]) * (T.mode == 2 ? (1.0f / 256.0f) : (1.0f / 127.0f)) : 0.f;
}
__device__ __forceinline__ void tr_set(TrItem& T, const float* W, int K, int N, int Ndest, void* WT, int mode, const unsigned* cmax, float* sB, int item) {
    const int nnb = Ndest / 64, kb = item / nnb, nb = item % nnb, n0 = 64 * nb; int nv = N - n0; nv = nv < 0 ? 0 : (nv > 64 ? 64 : nv);
    T.W = W; T.ldw = N; T.srccol0 = n0; T.nvalid = nv; T.k0 = 64 * kb; T.K = K; T.destrow0 = n0; T.mode = mode; T.WT = WT; T.cmax = cmax; T.sB = sB; T.cml = nullptr;
}
constexpr int IT_INA = (D / 64) * (NIN_A / 64), IT_INB = (D / 64) * (NIN_BP / 64), IT_OUT = (D / 64) * (D / 64), IT_GU = (D / 64) * (2 * DFF / 64), IT_DN = (DFF / 64) * (D / 64), IT_UK = 16 * 8, IT_UV = 16 * 8;
constexpr int IT_DIL = IT_INA + IT_OUT + IT_GU + IT_DN, IT_DSA = IT_INB + IT_OUT + IT_GU + IT_DN + IT_UK + IT_UV;
constexpr int IT_ALL = 2 * IT_DIL + 2 * IT_DSA;
__device__ __forceinline__ void tr_decode(const Args& a, int it, TrItem& T) {
    int r = it; int l;
    if (r < IT_DIL) l = 0; else { r -= IT_DIL; if (r < IT_DSA) l = 1; else { r -= IT_DSA; if (r < IT_DIL) l = 2; else { r -= IT_DIL; l = 3; } } }
    const LayerW& w = a.L[l]; unsigned char* wb = as_global(a.ws) + WS_W + (size_t)l * W_LAYER;
    const unsigned* cml = (const unsigned*)(as_global(a.ws) + WS_CTL + CTL_CMAX) + l * CM_LAYER; float* sbl = (float*)(as_global(a.ws) + WS_SB) + l * CM_LAYER;
    if (!(l & 1)) { if (r < IT_INA) { tr_set(T, as_global(w.w_in), D, NIN_A, NIN_A, wb + WO_IN, I8_QKV, cml, sbl, r); return; } r -= IT_INA; }
    else { if (r < IT_INB) { tr_set(T, as_global(w.w_in), D, NIN_B, NIN_BP, wb + WO_IN, I8_DSA, cml, sbl, r); return; } r -= IT_INB; }
    if (r < IT_OUT) { tr_set(T, as_global(w.w_out), D, D, D, wb + WO_OUT, OUT_MODE, cml + CM_OUT, sbl + CM_OUT, r); return; } r -= IT_OUT;
    if (r < IT_GU) {
        const int nnb = (2 * DFF) / 64, kb = r / nnb, nb = r % nnb, n0 = 64 * nb, pn = n0 >> 8, lc = n0 & 255;
        T.W = as_global(w.w_gu); T.ldw = 2 * DFF; T.srccol0 = ((lc < 128) ? 0 : DFF) + 128 * pn + (lc & 127); T.nvalid = 64; T.k0 = 64 * kb; T.K = D; T.destrow0 = n0; T.mode = I8_GU; T.WT = wb + WO_GU; T.cmax = cml + CM_GU; T.sB = sbl + CM_GU; T.cml = nullptr; return; }
    r -= IT_GU;
    if (r < IT_DN) { tr_set(T, as_global(w.w_down), DFF, D, D, wb + WO_DN, DN_MODE, cml + CM_DN, sbl + CM_DN, r); return; } r -= IT_DN;
    if (r < IT_UK) { const int h = r >> 3; tr_set(T, as_global(w.w_uk) + (size_t)h * HD * KVL, HD, KVL, KVL, (bf16*)(wb + WO_UK) + (size_t)h * KVL * HD, 0, cml, sbl, r & 7); return; } r -= IT_UK;
    { const int h = r >> 3; tr_set(T, as_global(w.w_uv) + (size_t)h * KVL * HD, KVL, HD, HD, (bf16*)(wb + WO_UV) + (size_t)h * HD * KVL, 0, cml, sbl, r & 7); }
}
__device__ __forceinline__ void p0_transposes(const Args& a, LAS unsigned char* lds, int gw, int NGW, int wave, int lane) {
    LAS float* scr = (LAS float*)(lds + wave * TSCR);
    int it = gw; if (it >= IT_ALL) return;
    TrItem T, Tn; f32x4 v[16];
    tr_decode(a, it, T); tr_load(T, lane, v);
    for (;;) {
        tr_fill(scr, lane, v);
        LDS_WAIT(); asm volatile("" ::: "memory");
        const int itn = it + NGW; const bool has = itn < IT_ALL;
        tr_decode(a, has ? itn : it, Tn); tr_load(Tn, lane, v);
        tr_emit(T, scr, lane);
        LDS_WAIT(); asm volatile("" ::: "memory");
        if (!has) break;
        it = itn; T = Tn;
    }
}
constexpr int ST_INA = NIN_A / 64, ST_INB = NIN_BP / 64, ST_OUT = D / 64, ST_GU = 2 * DFF / 64, ST_DN = D / 64;
constexpr int ST_DIL = (I8_QKV ? ST_INA : 0) + (OUT_MODE ? ST_OUT : 0) + (I8_GU ? ST_GU : 0) + (DN_MODE ? ST_DN : 0), ST_DSA = (I8_DSA ? ST_INB : 0) + (OUT_MODE ? ST_OUT : 0) + (I8_GU ? ST_GU : 0) + (DN_MODE ? ST_DN : 0);
constexpr int ST_ALL = 2 * ST_DIL + 2 * ST_DSA;
__device__ __forceinline__ void strip_decode(const Args& a, int sidx, TrItem& T) {
    int r = sidx; int l;
    if (DN_MODE && r < 4 * ST_DN) { l = r / ST_DN; r = r % ST_DN; const LayerW& w = a.L[l]; unsigned char* wb = as_global(a.ws) + WS_W + (size_t)l * W_LAYER; float* sbl = (float*)(as_global(a.ws) + WS_SB) + l * CM_LAYER;
        T.W = as_global(w.w_down); T.ldw = D; T.srccol0 = 64 * r; T.nvalid = 64; T.K = DFF; T.destrow0 = 64 * r; T.mode = DN_MODE; T.WT = wb + WO_DN; T.cmax = nullptr; T.sB = sbl + CM_DN; return; }
    if (DN_MODE) r -= 4 * ST_DN;
    const int per_dil = ST_DIL - (DN_MODE ? ST_DN : 0), per_dsa = ST_DSA - (DN_MODE ? ST_DN : 0);
    if (r < per_dil) l = 0; else { r -= per_dil; if (r < per_dsa) l = 1; else { r -= per_dsa; if (r < per_dil) l = 2; else { r -= per_dil; l = 3; } } }
    const LayerW& w = a.L[l]; unsigned char* wb = as_global(a.ws) + WS_W + (size_t)l * W_LAYER; float* sbl = (float*)(as_global(a.ws) + WS_SB) + l * CM_LAYER;
    const bool dsa = l & 1; const int st_in = dsa ? (I8_DSA ? ST_INB : 0) : (I8_QKV ? ST_INA : 0);
    T.cmax = nullptr; T.K = D;
    if (r < st_in) { const int N = dsa ? NIN_B : NIN_A; int nv = N - 64 * r; nv = nv < 0 ? 0 : (nv > 64 ? 64 : nv);
        T.W = as_global(w.w_in); T.ldw = N; T.srccol0 = 64 * r; T.nvalid = nv; T.destrow0 = 64 * r; T.mode = 1; T.WT = wb + WO_IN; T.sB = sbl; return; }
    r -= st_in;
    if (OUT_MODE && r < ST_OUT) { T.W = as_global(w.w_out); T.ldw = D; T.srccol0 = 64 * r; T.nvalid = 64; T.destrow0 = 64 * r; T.mode = OUT_MODE; T.WT = wb + WO_OUT; T.sB = sbl + CM_OUT; return; }
    if (OUT_MODE) r -= ST_OUT;
    { const int n0 = 64 * r, pn = n0 >> 8, lc = n0 & 255;
      T.W = as_global(w.w_gu); T.ldw = 2 * DFF; T.srccol0 = ((lc < 128) ? 0 : DFF) + 128 * pn + (lc & 127); T.nvalid = 64; T.destrow0 = n0; T.mode = 1; T.WT = wb + WO_GU; T.sB = sbl + CM_GU; }
}
__device__ __forceinline__ void p0_strips(const Args& a, LAS unsigned char* lds, int vcu, int G, int tid, int wave, int lane) {
    LAS float* scr = (LAS float*)(lds + wave * TSCR); LAS float* wm = (LAS float*)(lds + 8 * TSCR); LAS float* cmx = wm + 8 * 64;
    constexpr int ST_LONG = DN_MODE ? 4 * ST_DN : 0, ST_SHORT = ST_ALL - ST_LONG;
    const bool bal = (G == 256) && (ST_LONG == 128) && (ST_SHORT >= 1152);
    for (int i = 0;; ++i) {
        int sidx;
        if (bal) { if (vcu < 128) { if (i == 0) sidx = vcu; else if (i <= 3) sidx = ST_LONG + 3 * vcu + (i - 1); else break; }
                   else { const int c = vcu - 128; if (i < 6) sidx = ST_LONG + 384 + 6 * c + i; else if (i == 6 && 1152 + c < ST_SHORT) sidx = ST_LONG + 1152 + c; else break; } }
        else { sidx = vcu + i * G; if (sidx >= ST_ALL) break; }
        TrItem T; strip_decode(a, sidx, T); T.cml = cmx;
        const int nkb = T.K / 64; f32x4 v[16];
        f32x4 mx = (f32x4){0.f, 0.f, 0.f, 0.f};
        { int kb = wave; T.k0 = 64 * kb; if (kb < nkb) tr_load(T, lane, v);
          while (kb < nkb) { f32x4 m2 = (f32x4){0.f, 0.f, 0.f, 0.f};
#pragma unroll
              for (int it = 0; it < 16; ++it) { m2[0] = fmaxf(m2[0], fabsf(v[it][0])); m2[1] = fmaxf(m2[1], fabsf(v[it][1])); m2[2] = fmaxf(m2[2], fabsf(v[it][2])); m2[3] = fmaxf(m2[3], fabsf(v[it][3])); }
              const int kn = kb + 8; T.k0 = 64 * (kn < nkb ? kn : kb); tr_load(T, lane, v);
              mx[0] = fmaxf(mx[0], m2[0]); mx[1] = fmaxf(mx[1], m2[1]); mx[2] = fmaxf(mx[2], m2[2]); mx[3] = fmaxf(mx[3], m2[3]); kb = kn; } }
#pragma unroll
        for (int j = 0; j < 4; ++j) mx[j] = xmax32(xmax16(mx[j]));
        if (lane < 16) *(LAS f32x4*)(wm + wave * 64 + 4 * lane) = mx;
        __syncthreads();
        if (tid < 64) { float m = wm[tid];
#pragma unroll
            for (int w8 = 1; w8 < 8; ++w8) m = fmaxf(m, wm[w8 * 64 + tid]);
            cmx[tid] = m; T.sB[T.destrow0 + tid] = (tid < T.nvalid) ? m * (T.mode == 2 ? (1.0f / 256.0f) : (1.0f / 127.0f)) : 0.f; }
        __syncthreads();
        { int kb = wave; if (kb < nkb) { T.k0 = 64 * kb; tr_load(T, lane, v);
            for (;;) { tr_fill(scr, lane, v); LDS_WAIT(); asm volatile("" ::: "memory");
                const int kn = kb + 8; TrItem Tn = T; Tn.k0 = 64 * (kn < nkb ? kn : kb); tr_load(Tn, lane, v);
                tr_emit(T, scr, lane); LDS_WAIT(); asm volatile("" ::: "memory");
                if (kn >= nkb) break; kb = kn; T.k0 = 64 * kb; } } }
        __syncthreads();
    }
}
__device__ __forceinline__ void p0_bf16_items(const Args& a, LAS unsigned char* lds, int gw, int NGW, int wave, int lane) {
    LAS float* scr = (LAS float*)(lds + wave * TSCR); f32x4 v[16];
    for (int it = gw; it < IT_ALL; it += NGW) { TrItem T; tr_decode(a, it, T); if (T.mode != 0) continue;
        tr_load(T, lane, v); tr_fill(scr, lane, v); LDS_WAIT(); asm volatile("" ::: "memory"); tr_emit(T, scr, lane); LDS_WAIT(); asm volatile("" ::: "memory"); }
}
constexpr int SC_STRIDE = 2112;
__device__ __forceinline__ void p0_adaln(const Args& a, LAS unsigned char* lds, int G, int tid, int wave, int lane) {
    LAS float* sc = (LAS float*)lds;
    LAS float* red = (LAS float*)(lds + 8 * SC_STRIDE * 4);
    float* mod = (float*)(as_global(a.ws) + WS_MOD); const float* cin = as_global(a.c);
    for (int i = tid; i < BATCH * D; i += NWAVES * 64) { const int b = i >> 11, k = i & 2047; const float v = cin[i]; sc[b * SC_STRIDE + k + (k >> 6)] = v / (1.0f + __expf(-v)); }
    __syncthreads();
    const int cg = tid & 15, ks = tid >> 4;
    for (int u = blockIdx.x; u < DEPTH * (NMOD / 64); u += G) {
        const int l = u / (NMOD / 64), col0 = 64 * (u % (NMOD / 64));
        const float* wp = as_global(a.L[l].ada_w) + (size_t)(64 * ks) * NMOD + col0 + 4 * cg;
        f32x4 acc[8];
#pragma unroll
        for (int b = 0; b < 8; ++b) acc[b] = (f32x4){0.f, 0.f, 0.f, 0.f};
#pragma unroll 4
        for (int kk = 0; kk < 64; ++kk) { const f32x4 w4 = *(const f32x4*)(wp + (size_t)kk * NMOD); const int kx = 64 * ks + kk + ks;
#pragma unroll
            for (int b = 0; b < 8; ++b) acc[b] += sc[b * SC_STRIDE + kx] * w4; }
#pragma unroll
        for (int b = 0; b < 8; ++b)
#pragma unroll
            for (int j = 0; j < 4; ++j) { acc[b][j] = xsum32(xsum16(acc[b][j])); }
        if (lane < 16) {
#pragma unroll
            for (int b = 0; b < 8; ++b) *(LAS f32x4*)(red + (wave * 8 + b) * 64 + 4 * cg) = acc[b]; }
        __syncthreads();
        { const int b = tid >> 6, col = tid & 63; float s = as_global(a.L[l].ada_b)[col0 + col];
#pragma unroll
          for (int w = 0; w < 8; ++w) s += red[(w * 8 + b) * 64 + col];
          mod[((size_t)l * BATCH + b) * NMOD + col0 + col] = s; }
        __syncthreads();
    }
}
__device__ __forceinline__ void ld8(const void* base, int is_f32, size_t idx, f32x4& a, f32x4& b) {
    if (is_f32) { const float* p = (const float*)base + idx; a = *(const f32x4*)p; b = *(const f32x4*)(p + 4); }
    else { const v4u w = *(const v4u*)((const bf16*)base + idx); a = (f32x4){__uint_as_float(w.x << 16), __uint_as_float(w.x & 0xFFFF0000u), __uint_as_float(w.y << 16), __uint_as_float(w.y & 0xFFFF0000u)};
        b = (f32x4){__uint_as_float(w.z << 16), __uint_as_float(w.z & 0xFFFF0000u), __uint_as_float(w.w << 16), __uint_as_float(w.w & 0xFFFF0000u)}; }
}
__device__ __forceinline__ void norm_mod_phase(const void* x, int xf32, const float* gain, const float* shift, const float* scale, bf16* h, int gw, int NGW, int lane) {
    for (int grp = gw; grp < M / 8; grp += NGW) {
        const int b = (grp * 8) >> 11;
        f32x4 A[8], B[8];
#pragma unroll
        for (int j = 0; j < 4; ++j)
#pragma unroll
            for (int e = 0; e < 2; ++e) { const int col = 8 * lane + 512 * j + 4 * e;
                const f32x4 g = *(const f32x4*)(gain + col), sc = *(const f32x4*)(scale + (size_t)b * NMOD + col); A[2 * j + e] = g * (sc + 1.0f); B[2 * j + e] = *(const f32x4*)(shift + (size_t)b * NMOD + col); }
        for (int rr = 0; rr < 8; ++rr) { const size_t row = (size_t)grp * 8 + rr;
            f32x4 v[8]; float ss = 0.f;
#pragma unroll
            for (int j = 0; j < 4; ++j) { ld8(x, xf32, row * D + 8 * lane + 512 * j, v[2 * j], v[2 * j + 1]);
#pragma unroll
                for (int e = 0; e < 2; ++e) { const f32x4 t = v[2 * j + e]; ss += (t[0] * t[0] + t[1] * t[1]) + (t[2] * t[2] + t[3] * t[3]); } }
            const float rstd = __builtin_amdgcn_rsqf(wave_sum(ss) * (1.0f / D) + EPS);
#pragma unroll
            for (int j = 0; j < 4; ++j) { const f32x4 y0 = v[2 * j] * rstd * A[2 * j] + B[2 * j], y1 = v[2 * j + 1] * rstd * A[2 * j + 1] + B[2 * j + 1];
                v4u o; o.x = cvtpk(y0[0], y0[1]); o.y = cvtpk(y0[2], y0[3]); o.z = cvtpk(y1[0], y1[1]); o.w = cvtpk(y1[2], y1[3]);
                *(v4u*)(h + row * D + 8 * lane + 512 * j) = o; }
        }
    }
}

__device__ __forceinline__ void norm_mod_phase_q(const void* x, int xf32, const float* gain, const float* shift, const float* scale, signed char* h, float* sA, unsigned* rmax0, int gw, int NGW, int lane) {
    for (int grp = gw; grp < M / 8; grp += NGW) {
        const int b = (grp * 8) >> 11;
        f32x4 A[8], B[8];
#pragma unroll
        for (int j = 0; j < 4; ++j)
#pragma unroll
            for (int e = 0; e < 2; ++e) { const int col = 8 * lane + 512 * j + 4 * e;
                const f32x4 g = *(const f32x4*)(gain + col), sc = *(const f32x4*)(scale + (size_t)b * NMOD + col); A[2 * j + e] = g * (sc + 1.0f); B[2 * j + e] = *(const f32x4*)(shift + (size_t)b * NMOD + col); }
        for (int rr = 0; rr < 8; ++rr) { const size_t row = (size_t)grp * 8 + rr;
            f32x4 v[8]; float ss = 0.f;
#pragma unroll
            for (int j = 0; j < 4; ++j) { ld8(x, xf32, row * D + 8 * lane + 512 * j, v[2 * j], v[2 * j + 1]);
#pragma unroll
                for (int e = 0; e < 2; ++e) { const f32x4 t = v[2 * j + e]; ss += (t[0] * t[0] + t[1] * t[1]) + (t[2] * t[2] + t[3] * t[3]); } }
            const float rstd = __builtin_amdgcn_rsqf(wave_sum(ss) * (1.0f / D) + EPS);
            float amax = 0.f;
#pragma unroll
            for (int j = 0; j < 8; ++j) { v[j] = v[j] * rstd * A[j] + B[j]; amax = fmaxf(fmaxf(amax, fmaxf(fabsf(v[j][0]), fabsf(v[j][1]))), fmaxf(fabsf(v[j][2]), fabsf(v[j][3]))); }
            amax = wave_max(amax);
            const float inv = amax > 0.f ? 127.0f / amax : 0.f;
#pragma unroll
            for (int j = 0; j < 4; ++j) { unsigned q[8];
#pragma unroll
                for (int e = 0; e < 4; ++e) { q[e] = (unsigned)(int)rintf(v[2 * j][e] * inv) & 0xFFu; q[4 + e] = (unsigned)(int)rintf(v[2 * j + 1][e] * inv) & 0xFFu; }
                v2u o; o.x = q[0] | (q[1] << 8) | (q[2] << 16) | (q[3] << 24); o.y = q[4] | (q[5] << 8) | (q[6] << 16) | (q[7] << 24);
                *(v2u*)(h + row * D + 8 * lane + 512 * j) = o; }
            if (lane == 0) { sA[row] = amax * (1.0f / 127.0f); if (rmax0) rmax0[row] = 0u; }
        }
    }
}

__device__ __forceinline__ void aq_load(const bf16* act, int row, int lane, v4u (&w)[11]) { const bf16* ar = act + (size_t)row * DFF + 8 * lane;
#pragma unroll
    for (int it = 0; it < 11; ++it) w[it] = *(const v4u*)(ar + 512 * it); }
__device__ __forceinline__ void aq_emit(const v4u (&w)[11], float mx, signed char* q, float* sA2, int row, int lane) {
    const float inv = mx > 0.f ? 127.0f / mx : 0.f; signed char* qr = q + (size_t)row * DFF + 8 * lane;
#pragma unroll
    for (int it = 0; it < 11; ++it) { unsigned o[8];
#pragma unroll
        for (int e = 0; e < 4; ++e) { const unsigned ww = w[it][e]; float lo = __uint_as_float(ww << 16) * inv, hi = __uint_as_float(ww & 0xFFFF0000u) * inv;
            lo = fminf(fmaxf(rintf(lo), -127.f), 127.f); hi = fminf(fmaxf(rintf(hi), -127.f), 127.f); o[2 * e] = (unsigned)(int)lo & 0xFFu; o[2 * e + 1] = (unsigned)(int)hi & 0xFFu; }
        v2u ov; ov.x = o[0] | (o[1] << 8) | (o[2] << 16) | (o[3] << 24); ov.y = o[4] | (o[5] << 8) | (o[6] << 16) | (o[7] << 24);
        *(v2u*)(qr + 512 * it) = ov; }
    if (lane == 0) sA2[row] = mx * (1.0f / 127.0f);
}
__device__ __forceinline__ void act_quant_phase(const bf16* act, const unsigned* rmax, signed char* q, float* sA2, int gw, int NGW, int lane) {
    int row = gw; if (row >= M) return;
    v4u wa[11], wb2[11]; float ma = __uint_as_float(rmax[row]); aq_load(act, row, lane, wa);
    for (;;) {
        const int r1 = row + NGW; const bool h1 = r1 < M; const int r1c = h1 ? r1 : row;
        const float mb = __uint_as_float(rmax[r1c]); aq_load(act, r1c, lane, wb2);
        aq_emit(wa, ma, q, sA2, row, lane);
        if (!h1) break;
        const int r2 = r1 + NGW; const bool h2 = r2 < M; const int r2c = h2 ? r2 : r1;
        ma = __uint_as_float(rmax[r2c]); aq_load(act, r2c, lane, wa);
        aq_emit(wb2, mb, q, sA2, r1, lane);
        if (!h2) break;
        row = r2;
    }
}
__device__ __forceinline__ void final_norm_phase(const bf16* x, float* out, const float* gain, int gw, int NGW, int lane) {
    for (int row = gw; row < M; row += NGW) {
        f32x4 v[8]; float ss = 0.f;
#pragma unroll
        for (int j = 0; j < 4; ++j) { ld8(x, 0, (size_t)row * D + 8 * lane + 512 * j, v[2 * j], v[2 * j + 1]);
#pragma unroll
            for (int e = 0; e < 2; ++e) { const f32x4 t = v[2 * j + e]; ss += (t[0] * t[0] + t[1] * t[1]) + (t[2] * t[2] + t[3] * t[3]); } }
        const float rstd = __builtin_amdgcn_rsqf(wave_sum(ss) * (1.0f / D) + EPS); float* orow = out + (size_t)row * D;
#pragma unroll
        for (int j = 0; j < 4; ++j)
#pragma unroll
            for (int e = 0; e < 2; ++e) { const int col = 8 * lane + 512 * j + 4 * e; const f32x4 g = *(const f32x4*)(gain + col); *(f32x4*)(orow + col) = v[2 * j + e] * rstd * g; }
    }
}
constexpr int VROW = 272;
constexpr int KV_LDS = 256 * VROW;
struct BAUnit { int b, h, qbase, qstride, kbase, kstride, first, dil; };
__device__ __forceinline__ BAUnit ba_decode(int pass, int u) {
    BAUnit U; const int bh = u >> 4, s = u & 15; U.b = bh >> 4; U.h = bh & 15;
    if (pass == 0) { U.qbase = 128 * s; U.qstride = 1; U.kbase = 128 * s - 128; U.kstride = 1; U.first = (s == 0); U.dil = 1; }
    else if (pass == 1) { const int rho = s >> 2, n = s & 3; U.qbase = 512 * n + rho; U.qstride = 4; U.kbase = 512 * n - 512 + rho; U.kstride = 4; U.first = (n == 0); U.dil = 4; }
    else { U.qbase = s; U.qstride = 16; U.kbase = s - 2048; U.kstride = 16; U.first = 1; U.dil = 16; }
    return U;
}
template <bool HALF = false> __device__ __forceinline__ void ba_load(const BAUnit& U, const bf16* K, const bf16* V, int tid, v4u (&kr)[8], v4u (&vr)[8]) {
    const int c = tid & 15, r0 = tid >> 4;
#pragma unroll
    for (int it = HALF ? 4 : 0; it < 8; ++it) { const int j = r0 + 32 * it; int p = U.kbase + U.kstride * j; p = p < 0 ? 0 : p;
        const size_t off = ((size_t)U.b * SEQ + p) * D + U.h * HD + 8 * c;
        kr[it] = *(const v4u*)(K + off); vr[it] = *(const v4u*)(V + off); }
}
template <bool HALF = false> __device__ __forceinline__ void ba_store(LAS unsigned char* lds, int tid, const v4u (&kr)[8], const v4u (&vr)[8]) {
    const int c = tid & 15, r0 = tid >> 4;
#pragma unroll
    for (int it = HALF ? 4 : 0; it < 8; ++it) { const int j = r0 + 32 * it; *(LAS v4u*)(lds + j * VROW + 16 * c) = kr[it]; *(LAS v4u*)(lds + KV_LDS + j * VROW + 16 * c) = vr[it]; }
}
__device__ __forceinline__ void ba_qload(const BAUnit& U, const bf16* Q, int w, int lane, bf16x8 (&qf)[4]) {
    const int i = lane & 15, g = lane >> 4, qi = 16 * w + i; const size_t qrow = (size_t)U.b * SEQ + U.qbase + U.qstride * qi;
#pragma unroll
    for (int kk = 0; kk < 4; ++kk) qf[kk] = *(const bf16x8*)(Q + qrow * D + U.h * HD + 32 * kk + 8 * g);
}
template <bool FUSED> __device__ __forceinline__ void ba_compute(const BAUnit& U, int pass, bf16x8 (&qf)[4], bf16* O, float* LSE, LAS unsigned char* lds, int w, int lane, unsigned* waitc, const v2u (&ppre)[8], float lpre, const BAUnit& Un, const bf16* Qn, unsigned char* O8 = nullptr) {
    const int i = lane & 15, g = lane >> 4, qi = 16 * w + i; const size_t qrow = (size_t)U.b * SEQ + U.qbase + U.qstride * qi;
    const float sl = __builtin_amdgcn_exp2f(-0.5f * (float)(U.h + 1)) * LOG2E * (float)U.dil;
    const int d0 = U.first ? (8 - w) : 0;
    f32x4 s[10];
#pragma unroll
    for (int d = 0; d < 9; ++d) { f32x4 acc = (f32x4){0.f, 0.f, 0.f, 0.f};
        if (d >= d0) { const LAS unsigned char* kp = lds + (16 * (w + d) + i) * VROW + 16 * g;
#pragma unroll
            for (int kk = 0; kk < 4; ++kk) { const bf16x8 kf = *(const LAS bf16x8*)(kp + 64 * kk); acc = __builtin_amdgcn_mfma_f32_16x16x32_bf16(kf, qf[kk], acc, 0, 0, 0); } }
        s[d] = acc; }
    if (Qn) ba_qload(Un, Qn, w, lane, qf);
    float cmax = -1e30f;
#pragma unroll
    for (int d = 0; d < 9; ++d)
#pragma unroll
        for (int r = 0; r < 4; ++r) { const int rel = i - (4 * g + r) + 16 * (8 - d);
            const bool ok = (d >= d0) && (rel >= 0) && (rel <= 128);
            const float v = ok ? (s[d][r] - sl * (float)rel) : -INFINITY; s[d][r] = v; cmax = fmaxf(cmax, v); }
    cmax = xmax32(xmax16(cmax));
    const float m = cmax; float l = 0.f;
#pragma unroll
    for (int d = 0; d < 9; ++d)
#pragma unroll
        for (int r = 0; r < 4; ++r) { const float pv = __builtin_amdgcn_exp2f(s[d][r] - m); s[d][r] = pv; l += pv; }
    l = xsum32(xsum16(l));
    s[9] = (f32x4){0.f, 0.f, 0.f, 0.f};
    f32x4 o[8];
#pragma unroll
    for (int c = 0; c < 8; ++c) o[c] = (f32x4){0.f, 0.f, 0.f, 0.f};
#pragma unroll
    for (int dp = 0; dp < 10; dp += 2) {
        if (dp + 1 >= d0) {
            bf16x8 pf; { const v4u t = (v4u){cvtpk(s[dp][0], s[dp][1]), cvtpk(s[dp][2], s[dp][3]), cvtpk(s[dp + 1][0], s[dp + 1][1]), cvtpk(s[dp + 1][2], s[dp + 1][3])}; pf = __builtin_bit_cast(bf16x8, t); }
            int t0 = w + dp, t1 = w + dp + 1; t0 = t0 > 15 ? 15 : t0; t1 = t1 > 15 ? 15 : t1;
            const LAS unsigned char* vb0 = lds + KV_LDS + (16 * t0 + 4 * g + (i >> 2)) * VROW + 8 * (i & 3);
            const LAS unsigned char* vb1 = lds + KV_LDS + (16 * t1 + 4 * g + (i >> 2)) * VROW + 8 * (i & 3);
#pragma unroll
            for (int c = 0; c < 8; ++c) { const s16x4 lo = tr_read(vb0 + 32 * c), hi = tr_read(vb1 + 32 * c); o[c] = __builtin_amdgcn_mfma_f32_16x16x32_bf16(cat8(lo, hi), pf, o[c], 0, 0, 0); }
        }
    }
    float inv = 1.0f / l; float lse = m + __builtin_amdgcn_logf(l);
    bf16* op = O + qrow * D + U.h * HD + 4 * g; float* lp = LSE + qrow * NH + U.h;
    if (FUSED && pass > 0) {
        if (threadIdx.x == 0) { unsigned sp = 0; while (__hip_atomic_load(waitc, RLX_AGENT) < 16u) { __builtin_amdgcn_s_sleep(2); if (++sp > (1u << 22)) break; }
            __builtin_amdgcn_fence(__ATOMIC_ACQUIRE, "agent"); asm volatile("s_waitcnt vmcnt(0)" ::: "memory"); }
        __syncthreads(); }
    if (pass > 0) { const float lprev = FUSED ? *lp : lpre; const float mx = fmaxf(lprev, lse); const float wa = __builtin_amdgcn_exp2f(lprev - mx), wb = __builtin_amdgcn_exp2f(lse - mx); const float wi = 1.0f / (wa + wb);
        const float fa = wa * wi, fb = wb * wi * inv;
#pragma unroll
        for (int c = 0; c < 8; ++c) { const v2u pw = FUSED ? *(const v2u*)(op + 16 * c) : ppre[c];
            const float p0 = __uint_as_float(pw.x << 16), p1 = __uint_as_float(pw.x & 0xFFFF0000u), p2 = __uint_as_float(pw.y << 16), p3 = __uint_as_float(pw.y & 0xFFFF0000u);
            o[c][0] = fa * p0 + fb * o[c][0]; o[c][1] = fa * p1 + fb * o[c][1]; o[c][2] = fa * p2 + fb * o[c][2]; o[c][3] = fa * p3 + fb * o[c][3]; }
        inv = 1.0f; lse = mx + __builtin_amdgcn_logf(wa + wb); }
#pragma unroll
    for (int c = 0; c < 8; ++c) { v2u w2; w2.x = cvtpk(o[c][0] * inv, o[c][1] * inv); w2.y = cvtpk(o[c][2] * inv, o[c][3] * inv);
        if (FUSED && pass < 2) __hip_atomic_store((unsigned long long*)(op + 16 * c), ((unsigned long long)w2.y << 32) | w2.x, RLX_AGENT);
        else if (pass == 2 && O8) { unsigned w8 = 0u; w8 = __builtin_amdgcn_cvt_pk_fp8_f32(o[c][0] * inv, o[c][1] * inv, w8, false); w8 = __builtin_amdgcn_cvt_pk_fp8_f32(o[c][2] * inv, o[c][3] * inv, w8, true);
            *(unsigned*)(O8 + qrow * D + U.h * HD + 4 * g + 16 * c) = w8; }
        else *(v2u*)(op + 16 * c) = w2; }
    if (pass < 2 && g == 0) { if (FUSED) __hip_atomic_store((unsigned*)lp, __float_as_uint(lse), RLX_AGENT); else *lp = lse; }
}
__device__ __forceinline__ void ba_pload(const BAUnit& U, const bf16* O, const float* LSE, int w, int lane, v2u (&pp)[8], float& lp) {
    const int i = lane & 15, g = lane >> 4, qi = 16 * w + i; const size_t qrow = (size_t)U.b * SEQ + U.qbase + U.qstride * qi;
    const bf16* op = O + qrow * D + U.h * HD + 4 * g;
#pragma unroll
    for (int c = 0; c < 8; ++c) pp[c] = *(const v2u*)(op + 16 * c);
    lp = LSE[qrow * NH + U.h];
}
template <int variant = 0, bool HALF = false  > __device__ __forceinline__ void dil_attn_pass(int pass, const bf16* Q, const bf16* K, const bf16* V, bf16* O, float* LSE, LAS unsigned char* lds, int vcu, int G, int tid, int wave, int lane, int u_lo = 0, int u_hi = BATCH * NH * 16, unsigned char* O8 = nullptr) {
    v4u kr[8], vr[8]; bf16x8 qf[4]; v2u pp[8]; float lp = 0.f;
#pragma unroll
    for (int c = 0; c < 8; ++c) pp[c] = (v2u){0u, 0u};
    int u = u_lo + vcu; const int NU = u_hi;
    if (u >= NU) return;
    BAUnit U = ba_decode(pass, u);
    ba_qload(U, Q, wave, lane, qf);
    ba_load<HALF>(U, K, V, tid, kr, vr);
    for (;;) {
        ba_store<HALF>(lds, tid, kr, vr);
        __syncthreads();
        const int un = u + G; const BAUnit Un = ba_decode(pass, un < NU ? un : u);
        if (pass > 0) ba_pload(U, O, LSE, wave, lane, pp, lp);
        asm volatile("" ::: "memory");
        ba_load<HALF>(Un, K, V, tid, kr, vr);
        ba_compute<false>(U, pass, qf, O, LSE, lds, wave, lane, nullptr, pp, lp, Un, Q, O8);
        __syncthreads();
        if (un >= NU) break;
        u = un; U = Un;
    }
}

__device__ __forceinline__ void dil_attn_fused(const bf16* Q, const bf16* K, const bf16* V, bf16* O, float* LSE, unsigned* cnt, LAS unsigned char* lds, int vcu, int G, int tid, int wave, int lane) {
    v4u kr[8], vr[8];
    const int team = vcu >> 4, sidx = vcu & 15, nteam = G >> 4, NBH = BATCH * NH;
    const int nit = ((NBH - team + nteam - 1) / nteam) * 3;
    if (nit <= 0) return;
    int it = 0; int bh = team, pass = 0;
    BAUnit U = ba_decode(pass, bh * 16 + sidx);
    ba_load(U, K, V, tid, kr, vr);
    for (;;) {
        ba_store(lds, tid, kr, vr);
        __syncthreads();
        bf16x8 qf[4]; ba_qload(U, Q, wave, lane, qf);
        asm volatile("" ::: "memory");
        const int itn = it + 1; int passn = pass + 1, bhn = bh; if (passn == 3) { passn = 0; bhn = bh + nteam; }
        const bool has = itn < nit;
        const BAUnit Un = ba_decode(has ? passn : pass, (has ? bhn : bh) * 16 + sidx); ba_load(Un, K, V, tid, kr, vr);
        { v2u ppd[8]; ba_compute<true>(U, pass, qf, O, LSE, lds, wave, lane, cnt + ((size_t)bh * 2 + (pass > 0 ? pass - 1 : 0)) * 16, ppd, 0.f, U, nullptr); }
        if (pass < 2) asm volatile("s_waitcnt vmcnt(0)" ::: "memory");
        __syncthreads();
        if (pass < 2 && tid == 0) __hip_atomic_fetch_add(cnt + ((size_t)bh * 2 + pass) * 16, 1u, RLX_AGENT);
        if (!has) break;
        it = itn; pass = passn; bh = bhn; U = Un;
    }
}

template <int KK  , int NT  , int TT  , bool OUT8 = false  >
__device__ __forceinline__ void head_gemm(const bf16* X, int ldx, int xcol0, const bf16* WT, bf16* Out, int ldo, int ocol0, int tok0, float scale, int lane) {
    const int i = lane & 15, g = lane >> 4;
    bf16x8 xf[TT][KK];
#pragma unroll
    for (int tt = 0; tt < TT; ++tt)
#pragma unroll
        for (int kk = 0; kk < KK; ++kk) xf[tt][kk] = *(const bf16x8*)(X + (size_t)(tok0 + 16 * tt + i) * ldx + xcol0 + 32 * kk + 8 * g);
    const bf16* wp = WT + (size_t)(8 * (i >> 2) + (i & 3)) * (32 * KK) + 8 * g;
    bf16x8 aA[2][KK], aB[2][KK];
#pragma unroll
    for (int h2 = 0; h2 < 2; ++h2)
#pragma unroll
        for (int kk = 0; kk < KK; ++kk) aA[h2][kk] = *(const bf16x8*)(wp + (size_t)(4 * h2) * (32 * KK) + 32 * kk);
#pragma unroll
    for (int tt = 0; tt < TT; ++tt)
#pragma unroll
        for (int kk = 0; kk < KK; ++kk) asm volatile("" : "+v"(xf[tt][kk]));
#define HG_PAIR(cur, nxt, p_) do { \
        _Pragma("unroll") for (int h2 = 0; h2 < 2; ++h2) _Pragma("unroll") for (int kk = 0; kk < KK; ++kk) asm volatile("" : "+v"(cur[h2][kk])); \
        if ((p_) + 1 < NT / 2) { _Pragma("unroll") for (int h2 = 0; h2 < 2; ++h2) _Pragma("unroll") for (int kk = 0; kk < KK; ++kk) nxt[h2][kk] = *(const bf16x8*)(wp + (size_t)(32 * ((p_) + 1) + 4 * h2) * (32 * KK) + 32 * kk); } \
        _Pragma("unroll") for (int tt = 0; tt < TT; ++tt) { f32x4 c0 = (f32x4){0.f, 0.f, 0.f, 0.f}, c1 = c0; \
            _Pragma("unroll") for (int kk = 0; kk < KK; ++kk) { c0 = __builtin_amdgcn_mfma_f32_16x16x32_bf16(cur[0][kk], xf[tt][kk], c0, 0, 0, 0); c1 = __builtin_amdgcn_mfma_f32_16x16x32_bf16(cur[1][kk], xf[tt][kk], c1, 0, 0, 0); } \
            const size_t oo = (size_t)(tok0 + 16 * tt + i) * ldo + ocol0 + 32 * (p_) + 8 * g; \
            if constexpr (OUT8) { unsigned w0 = 0u, w1 = 0u; w0 = __builtin_amdgcn_cvt_pk_fp8_f32(c0[0] * scale, c0[1] * scale, w0, false); w0 = __builtin_amdgcn_cvt_pk_fp8_f32(c0[2] * scale, c0[3] * scale, w0, true); \
                w1 = __builtin_amdgcn_cvt_pk_fp8_f32(c1[0] * scale, c1[1] * scale, w1, false); w1 = __builtin_amdgcn_cvt_pk_fp8_f32(c1[2] * scale, c1[3] * scale, w1, true); \
                *(v2u*)((unsigned char*)Out + oo) = (v2u){w0, w1}; } \
            else *(v4u*)(Out + oo) = (v4u){cvtpk(c0[0] * scale, c0[1] * scale), cvtpk(c0[2] * scale, c0[3] * scale), cvtpk(c1[0] * scale, c1[1] * scale), cvtpk(c1[2] * scale, c1[3] * scale)}; } } while (0)
    for (int p = 0; p < NT / 2; p += 2) { HG_PAIR(aA, aB, p); HG_PAIR(aB, aA, p + 1); }
#undef HG_PAIR
}
__device__ __forceinline__ void ckv_norm_phase(const float* raw, const float* gain, bf16* out, int gw, int NGW, int lane) {
    const f32x4 gv = *(const f32x4*)(gain + 4 * lane);
    for (int row = gw; row < M; row += NGW) { const f32x4 t = *(const f32x4*)(raw + (size_t)row * KVL + 4 * lane);
        const float ss = (t[0] * t[0] + t[1] * t[1]) + (t[2] * t[2] + t[3] * t[3]);
        const float rstd = __builtin_amdgcn_rsqf(wave_sum(ss) * (1.0f / KVL) + EPS); const f32x4 y = t * rstd * gv;
        v2u w2; w2.x = cvtpk(y[0], y[1]); w2.y = cvtpk(y[2], y[3]); *(v2u*)(out + (size_t)row * KVL + 4 * lane) = w2; }
}
constexpr int IX_KROW = 272, IX_KEYS = 256, IX_STAGE = IX_KEYS * IX_KROW, IX_SC_OFF = IX_STAGE;
__device__ __forceinline__ void ix_load(const bf16* KI, int b, int st, int tid, v4u (&kr)[8]) {
    const int c = tid & 15, r0 = tid >> 4;
#pragma unroll
    for (int it = 0; it < 8; ++it) kr[it] = *(const v4u*)(KI + ((size_t)b * SEQ + IX_KEYS * st + r0 + 32 * it) * 128 + 8 * c);
}
__device__ __forceinline__ void ix_store(LAS unsigned char* buf, int tid, const v4u (&kr)[8]) {
    const int c = tid & 15, r0 = tid >> 4;
#pragma unroll
    for (int it = 0; it < 8; ++it) *(LAS v4u*)(buf + (r0 + 32 * it) * IX_KROW + 16 * c) = kr[it];
}
__device__ __forceinline__ void ix_topk(const LAS u16* sc, u16* selr, int t, int lane) {
    if (t < TOPK) { for (int j = lane; j < TOPK; j += 64) selr[j] = (u16)(j <= t ? j : 0xFFFF); return; }
    const int ng = (t >> 9) + 1;
    unsigned key[32];
#pragma unroll
    for (int u = 0; u < 32; ++u) key[u] = 0u;
#pragma unroll
    for (int gq = 0; gq < 4; ++gq) if (gq < ng) {
#pragma unroll
        for (int u = 8 * gq; u < 8 * gq + 8; ++u) { const int idx = 64 * u + lane; const unsigned bits = sc[idx]; const unsigned k = (bits & 0x8000u) ? (~bits & 0xFFFFu) : (bits | 0x8000u); key[u] = (idx <= t) ? k : 0u; } }
    unsigned prefix = 0u;
    for (int bit = 15; bit >= 0; --bit) { const unsigned cand = prefix | (1u << bit); int cnt = 0;
#pragma unroll
        for (int gq = 0; gq < 4; ++gq) if (gq < ng) {
#pragma unroll
            for (int u = 8 * gq; u < 8 * gq + 8; ++u) cnt += __popcll(__ballot(key[u] >= cand)); }
        if (cnt >= TOPK) prefix = cand; }
    int cgt = 0;
#pragma unroll
    for (int gq = 0; gq < 4; ++gq) if (gq < ng) {
#pragma unroll
        for (int u = 8 * gq; u < 8 * gq + 8; ++u) cgt += __popcll(__ballot(key[u] > prefix)); }
    const int need_eq = TOPK - cgt; int base = 0, eqb = 0;
#pragma unroll
    for (int gq = 0; gq < 4; ++gq) if (gq < ng) {
#pragma unroll
        for (int u = 8 * gq; u < 8 * gq + 8; ++u) { const bool gt = key[u] > prefix, eq = key[u] == prefix; const unsigned long long meq = __ballot(eq);
            const bool take = gt || (eq && (int)(eqb + mbcnt64(meq)) < need_eq); const unsigned long long mt = __ballot(take);
            if (take) selr[base + mbcnt64(mt)] = (u16)(64 * u + lane);
            base += __popcll(mt); eqb += __popcll(meq); } }
}
__device__ __forceinline__ void dsa_index_unit(const bf16* QI, const bf16* KI, const float* WI, u16* SEL, LAS unsigned char* lds, int b, int qb, int tid, int w, int lane) {
    const int i = lane & 15, g = lane >> 4; const int t0 = 16 * qb + 2 * w;
    const size_t row0 = (size_t)b * SEQ + t0;
    LAS u16* sc0 = (LAS u16*)(lds + IX_SC_OFF + (2 * w) * 4096); LAS u16* sc1 = sc0 + 2048;
    bf16x8 a0[4], a1[4];
#pragma unroll
    for (int kk = 0; kk < 4; ++kk) { a0[kk] = *(const bf16x8*)(QI + row0 * D + i * 128 + 32 * kk + 8 * g); a1[kk] = *(const bf16x8*)(QI + (row0 + 1) * D + i * 128 + 32 * kk + 8 * g); }
    const f32x4 w0 = *(const f32x4*)(WI + row0 * 16 + 4 * g), w1 = *(const f32x4*)(WI + (row0 + 1) * 16 + 4 * g);
    const int nst = (16 * qb + 15) / IX_KEYS + 1;
    v4u kA[8], kB[8];
    ix_load(KI, b, 0, tid, kA); ix_load(KI, b, nst > 1 ? 1 : 0, tid, kB);
#define IX_STAGE_BODY(st_, kcur) do { \
        ix_store(lds, tid, kcur); \
        __syncthreads(); \
        { const int sn = (st_) + 2 < nst ? (st_) + 2 : nst - 1; ix_load(KI, b, sn, tid, kcur); } \
        int ntile = (t0 + 1 - IX_KEYS * (st_)) / 16 + 1; ntile = ntile > 16 ? 16 : ntile; \
        _Pragma("unroll 2") for (int tt = 0; tt < ntile; tt += 2) { const LAS unsigned char* kp = lds + (16 * tt + i) * IX_KROW + 16 * g; \
            f32x4 c0 = (f32x4){0.f, 0.f, 0.f, 0.f}, c1 = c0, e0 = c0, e1 = c0; \
            _Pragma("unroll") for (int kk = 0; kk < 4; ++kk) { const bf16x8 bfa = *(const LAS bf16x8*)(kp + 64 * kk), bfb = *(const LAS bf16x8*)(kp + 16 * IX_KROW + 64 * kk); \
                c0 = __builtin_amdgcn_mfma_f32_16x16x32_bf16(a0[kk], bfa, c0, 0, 0, 0); c1 = __builtin_amdgcn_mfma_f32_16x16x32_bf16(a1[kk], bfa, c1, 0, 0, 0); \
                e0 = __builtin_amdgcn_mfma_f32_16x16x32_bf16(a0[kk], bfb, e0, 0, 0, 0); e1 = __builtin_amdgcn_mfma_f32_16x16x32_bf16(a1[kk], bfb, e1, 0, 0, 0); } \
            float s0 = w0[0] * fmaxf(c0[0], 0.f) + w0[1] * fmaxf(c0[1], 0.f) + w0[2] * fmaxf(c0[2], 0.f) + w0[3] * fmaxf(c0[3], 0.f); \
            float s1 = w1[0] * fmaxf(c1[0], 0.f) + w1[1] * fmaxf(c1[1], 0.f) + w1[2] * fmaxf(c1[2], 0.f) + w1[3] * fmaxf(c1[3], 0.f); \
            float u0 = w0[0] * fmaxf(e0[0], 0.f) + w0[1] * fmaxf(e0[1], 0.f) + w0[2] * fmaxf(e0[2], 0.f) + w0[3] * fmaxf(e0[3], 0.f); \
            float u1 = w1[0] * fmaxf(e1[0], 0.f) + w1[1] * fmaxf(e1[1], 0.f) + w1[2] * fmaxf(e1[2], 0.f) + w1[3] * fmaxf(e1[3], 0.f); \
            s0 = xsum32(xsum16(s0)); s1 = xsum32(xsum16(s1)); u0 = xsum32(xsum16(u0)); u1 = xsum32(xsum16(u1)); \
            if (g == 0) { const int key = IX_KEYS * (st_) + 16 * tt + i; sc0[key] = __builtin_bit_cast(u16, (_Float16)s0); sc1[key] = __builtin_bit_cast(u16, (_Float16)s1); \
                          sc0[key + 16] = __builtin_bit_cast(u16, (_Float16)u0); sc1[key + 16] = __builtin_bit_cast(u16, (_Float16)u1); } } \
        __syncthreads();                                         \
    } while (0)
    for (int st = 0; st < nst; st += 2) { IX_STAGE_BODY(st, kA); if (st + 1 < nst) IX_STAGE_BODY(st + 1, kB); }
#undef IX_STAGE_BODY
    LDS_WAIT(); asm volatile("" ::: "memory");
#ifndef REPS4
#define REPS4 1
#endif
    for (int rk = 0; rk < REPS4; ++rk) {
    ix_topk(sc0, SEL + row0 * TOPK, t0, lane);
    ix_topk(sc1, SEL + (row0 + 1) * TOPK, t0 + 1, lane); }
    __syncthreads();
}
constexpr int CROW = 528;
constexpr int DSA_WAVE_LDS = 32 * CROW + 512;
__device__ __forceinline__ void dsa_attn_query(const bf16* QL, const bf16* CKV, const u16* SEL, bf16* OL, LAS unsigned char* wl, int b, int t, int lane) {
    const int i = lane & 15, g = lane >> 4; const size_t row = (size_t)b * SEQ + t;
    LAS u16* sl = (LAS u16*)(wl + 32 * CROW);
    *(LAS v2u*)(sl + 4 * lane) = *(const v2u*)(SEL + row * TOPK + 4 * lane);
    bf16x8 bq[8];
#pragma unroll
    for (int kk = 0; kk < 8; ++kk) bq[kk] = *(const bf16x8*)(QL + row * (NH * KVL) + i * KVL + 32 * kk + 8 * g);
    const float slope2 = __builtin_amdgcn_exp2f(-0.5f * (float)(i + 1)) * LOG2E;
    float m = -1e30f, l = 0.f; f32x4 o[16];
#pragma unroll
    for (int c = 0; c < 16; ++c) o[c] = (f32x4){0.f, 0.f, 0.f, 0.f};
    const int nvalid = (t + 1) < TOPK ? (t + 1) : TOPK, nch = (nvalid + 31) >> 5;
    const bf16* cb = CKV + (size_t)b * SEQ * KVL;
    LDS_WAIT(); asm volatile("" ::: "memory");
    v4u pre[16];
#pragma unroll
    for (int it = 0; it < 16; ++it) { const int r = 2 * it + (lane >> 5); unsigned key = sl[r]; key = (key == 0xFFFFu) ? 0u : key; pre[it] = *(const v4u*)(cb + (size_t)key * KVL + 8 * (lane & 31)); }
    for (int c = 0; c < nch; ++c) {
#pragma unroll
        for (int it = 0; it < 16; ++it) { const int r = 2 * it + (lane >> 5); *(LAS v4u*)(wl + r * CROW + 16 * (lane & 31)) = pre[it]; }
        if (c + 1 < nch) {
#pragma unroll
            for (int it = 0; it < 16; ++it) { const int r = 2 * it + (lane >> 5); unsigned key = sl[32 * (c + 1) + r]; key = (key == 0xFFFFu) ? 0u : key; pre[it] = *(const v4u*)(cb + (size_t)key * KVL + 8 * (lane & 31)); } }
        LDS_WAIT(); asm volatile("" ::: "memory");
        f32x4 s[2];
#pragma unroll
        for (int T = 0; T < 2; ++T) { const LAS unsigned char* ap = wl + (16 * T + i) * CROW + 16 * g; f32x4 acc = (f32x4){0.f, 0.f, 0.f, 0.f};
#pragma unroll
            for (int kk = 0; kk < 8; ++kk) { const bf16x8 af = *(const LAS bf16x8*)(ap + 64 * kk); acc = __builtin_amdgcn_mfma_f32_16x16x32_bf16(af, bq[kk], acc, 0, 0, 0); }
            s[T] = acc; }
        float cmax = -INFINITY;
#pragma unroll
        for (int T = 0; T < 2; ++T) { const v2u kw = *(const LAS v2u*)(sl + 32 * c + 16 * T + 4 * g);
#pragma unroll
            for (int r = 0; r < 4; ++r) { const unsigned key = ((r < 2 ? kw.x : kw.y) >> (16 * (r & 1))) & 0xFFFFu; const int dl = t - (int)key;
                const float v = (key != 0xFFFFu && dl >= 0) ? (s[T][r] - slope2 * (float)dl) : -INFINITY; s[T][r] = v; cmax = fmaxf(cmax, v); } }
        cmax = xmax32(xmax16(cmax));
        const float mn = fmaxf(m, cmax), alpha = __builtin_amdgcn_exp2f(m - mn); m = mn;
        float rs = 0.f;
#pragma unroll
        for (int T = 0; T < 2; ++T)
#pragma unroll
            for (int r = 0; r < 4; ++r) { const float pv = __builtin_amdgcn_exp2f(s[T][r] - mn); s[T][r] = pv; rs += pv; }
        rs = xsum32(xsum16(rs));
        l = l * alpha + rs;
        bf16x8 pf; { const unsigned a0 = cvtpk(s[0][0], s[0][1]), a1 = cvtpk(s[0][2], s[0][3]), a2 = cvtpk(s[1][0], s[1][1]), a3 = cvtpk(s[1][2], s[1][3]); const v4u tt = (v4u){a0, a1, a2, a3}; pf = __builtin_bit_cast(bf16x8, tt); }
        const LAS unsigned char* vb = wl + (4 * g + (i >> 2)) * CROW + 8 * (i & 3);
#pragma unroll
        for (int ct = 0; ct < 16; ++ct) { const s16x4 lo = tr_read(vb + 32 * ct), hi = tr_read(vb + 16 * CROW + 32 * ct);
            o[ct] = o[ct] * alpha; o[ct] = __builtin_amdgcn_mfma_f32_16x16x32_bf16(cat8(lo, hi), pf, o[ct], 0, 0, 0); }
        LDS_WAIT(); asm volatile("" ::: "memory");
    }
    const float inv = 1.0f / l;
    bf16* op = OL + row * (NH * KVL) + i * KVL + 4 * g;
#pragma unroll
    for (int ct = 0; ct < 16; ++ct) { v2u w2; w2.x = cvtpk(o[ct][0] * inv, o[ct][1] * inv); w2.y = cvtpk(o[ct][2] * inv, o[ct][3] * inv); *(v2u*)(op + 16 * ct) = w2; }
}
__device__ __forceinline__ void dsa_attn_query_p(const bf16* QL, const bf16* CKV, const u16* SEL, bf16* OL, LAS unsigned char* wl, int b, int t, int lane, bf16x8 (&bq)[8], size_t row_n, v2u& seln) {
    const int i = lane & 15, g = lane >> 4; const size_t row = (size_t)b * SEQ + t;
    LAS u16* sl = (LAS u16*)(wl + 32 * CROW);
    const float slope2 = __builtin_amdgcn_exp2f(-0.5f * (float)(i + 1)) * LOG2E;
    float m = -1e30f, l = 0.f; f32x4 o[16];
#pragma unroll
    for (int c = 0; c < 16; ++c) o[c] = (f32x4){0.f, 0.f, 0.f, 0.f};
    const int nvalid = (t + 1) < TOPK ? (t + 1) : TOPK, nch = (nvalid + 31) >> 5;
    const bf16* cb = CKV + (size_t)b * SEQ * KVL;
    LDS_WAIT(); asm volatile("" ::: "memory");
    v4u pre[16];
#pragma unroll
    for (int it = 0; it < 16; ++it) { const int r = 2 * it + (lane >> 5); unsigned key = sl[r]; key = (key == 0xFFFFu) ? 0u : key; pre[it] = *(const v4u*)(cb + (size_t)key * KVL + 8 * (lane & 31)); }
    seln = *(const v2u*)(SEL + row_n * TOPK + 4 * lane);
    bf16x8 bqn[8];
#pragma unroll
    for (int kk = 0; kk < 8; ++kk) bqn[kk] = *(const bf16x8*)(QL + row_n * (NH * KVL) + i * KVL + 32 * kk + 8 * g);
    for (int c = 0; c < nch; ++c) {
#pragma unroll
        for (int it = 0; it < 16; ++it) { const int r = 2 * it + (lane >> 5); *(LAS v4u*)(wl + r * CROW + 16 * (lane & 31)) = pre[it]; }
        if (c + 1 < nch) {
#pragma unroll
            for (int it = 0; it < 16; ++it) { const int r = 2 * it + (lane >> 5); unsigned key = sl[32 * (c + 1) + r]; key = (key == 0xFFFFu) ? 0u : key; pre[it] = *(const v4u*)(cb + (size_t)key * KVL + 8 * (lane & 31)); } }
        LDS_WAIT(); asm volatile("" ::: "memory");
        f32x4 s[2];
#pragma unroll
        for (int T = 0; T < 2; ++T) { const LAS unsigned char* ap = wl + (16 * T + i) * CROW + 16 * g; f32x4 acc = (f32x4){0.f, 0.f, 0.f, 0.f};
#pragma unroll
            for (int kk = 0; kk < 8; ++kk) { const bf16x8 af = *(const LAS bf16x8*)(ap + 64 * kk); acc = __builtin_amdgcn_mfma_f32_16x16x32_bf16(af, bq[kk], acc, 0, 0, 0); }
            s[T] = acc; }
        float cmax = -INFINITY;
#pragma unroll
        for (int T = 0; T < 2; ++T) { const v2u kw = *(const LAS v2u*)(sl + 32 * c + 16 * T + 4 * g);
#pragma unroll
            for (int r = 0; r < 4; ++r) { const unsigned key = ((r < 2 ? kw.x : kw.y) >> (16 * (r & 1))) & 0xFFFFu; const int dl = t - (int)key;
                const float v = (key != 0xFFFFu && dl >= 0) ? (s[T][r] - slope2 * (float)dl) : -INFINITY; s[T][r] = v; cmax = fmaxf(cmax, v); } }
        cmax = xmax32(xmax16(cmax));
        const float mn = fmaxf(m, cmax), alpha = __builtin_amdgcn_exp2f(m - mn); m = mn;
        float rs = 0.f;
#pragma unroll
        for (int T = 0; T < 2; ++T)
#pragma unroll
            for (int r = 0; r < 4; ++r) { const float pv = __builtin_amdgcn_exp2f(s[T][r] - mn); s[T][r] = pv; rs += pv; }
        rs = xsum32(xsum16(rs));
        l = l * alpha + rs;
        bf16x8 pf; { const unsigned a0 = cvtpk(s[0][0], s[0][1]), a1 = cvtpk(s[0][2], s[0][3]), a2 = cvtpk(s[1][0], s[1][1]), a3 = cvtpk(s[1][2], s[1][3]); const v4u tt = (v4u){a0, a1, a2, a3}; pf = __builtin_bit_cast(bf16x8, tt); }
        const LAS unsigned char* vb = wl + (4 * g + (i >> 2)) * CROW + 8 * (i & 3);
#pragma unroll
        for (int ct = 0; ct < 16; ++ct) { const s16x4 lo = tr_read(vb + 32 * ct), hi = tr_read(vb + 16 * CROW + 32 * ct);
            o[ct] = o[ct] * alpha; o[ct] = __builtin_amdgcn_mfma_f32_16x16x32_bf16(cat8(lo, hi), pf, o[ct], 0, 0, 0); }
        LDS_WAIT(); asm volatile("" ::: "memory");
    }
    const float inv = 1.0f / l;
    bf16* op = OL + row * (NH * KVL) + i * KVL + 4 * g;
#pragma unroll
    for (int ct = 0; ct < 16; ++ct) { v2u w2; w2.x = cvtpk(o[ct][0] * inv, o[ct][1] * inv); w2.y = cvtpk(o[ct][2] * inv, o[ct][3] * inv); *(v2u*)(op + 16 * ct) = w2; }
#pragma unroll
    for (int kk = 0; kk < 8; ++kk) bq[kk] = bqn[kk];
}
constexpr int PH_PER_LAYER = 10, PH_L0 = 2, PH_FINAL = PH_L0 + PH_PER_LAYER * DEPTH, PH_COUNT = PH_FINAL + 1;
__global__ void __launch_bounds__(NWAVES * 64, 2) mk_fwd(Args args) {
    extern __shared__ __attribute__((aligned(16))) unsigned char lds_raw[];
    LAS unsigned char* lds = (LAS unsigned char*)lds_raw;
    volatile LAS unsigned* MISC = (volatile LAS unsigned*)(lds + MISC_OFF);
    const int tid = threadIdx.x, lane = tid & 63, wave = __builtin_amdgcn_readfirstlane(tid >> 6);
    const int G = gridDim.x; const int bx = blockIdx.x; const int vcu = (G % 8 == 0) ? (bx % 8) * (G / 8) + bx / 8 : bx;
    const int gw = vcu * NWAVES + wave, NGW = G * NWAVES;
    unsigned char* ws = as_global(args.ws);
    gu32* ctl = (gu32*)(ws + WS_CTL);
    if (tid < 64) MISC[tid] = 0u;
    __syncthreads();
    const int lo = args.ph_lo, hi = args.ph_hi;
#ifdef DIAG_XCC
    if (tid == 0) ((unsigned*)(ws + WS_CTL + 700000))[bx] = xb_xcc_id() + 1u;
#endif
#ifdef PROBE_IDX
    if (bx == 0 && tid == 0) { unsigned long long* pt = (unsigned long long*)(ws + WS_CTL + 614400); pt[63] = wall_clock64(); }
#endif
    XcdBarrier bar; bar.bar = (unsigned*)(ctl + CW_BAR); bar.x = 0; bar.st = nullptr;
    if (hi - lo > 1) { bar = xcd_barrier_post((unsigned*)(ctl + CW_BAR), MISC + 8); if (tid == 0) xcd_barrier_census(bar); __syncthreads(); }
#define IN(k) (lo <= (k) && (k) < hi)
#ifdef REP_PHASE
#define REPN(k) (((k) == REP_PHASE) ? (1 + REP_N) : 1)
#else
#define REPN(k) 1
#endif
#ifndef REP_VARIANT
#define REP_VARIANT 0
#endif
#ifndef DIL_VARIANT
#define DIL_VARIANT 0
#endif
#ifndef REPS3
#define REPS3 1
#endif
#ifndef REPS1
#define REPS1 1
#endif
#ifndef REPS2
#define REPS2 1
#endif
#define REP_BEGIN(k) for (int rep_ = 0; rep_ < REPN(k); ++rep_) { if (rep_) GBAR();
#define REP_END }
#ifdef PROBE_IDX
#define PMARK(idx) do { if (bx == 0 && tid == 0) { unsigned long long* pt = (unsigned long long*)(ws + WS_CTL + 614400); const unsigned long long now_ = wall_clock64(); pt[(idx)] += now_ - pt[63]; pt[63] = now_; } } while (0)
#else
#define PMARK(idx) do {} while (0)
#endif
#define GBAR() do { XcdBarrier b_ = bar; GAS unsigned* bp_ = (GAS unsigned*)b_.bar; asm volatile("" : "+s"(bp_)); b_.bar = (unsigned*)bp_; xcd_barrier(b_, wave == 0 && ({ unsigned m_ = ~0u; asm volatile("" : "+s"(m_)); (int)__builtin_amdgcn_mbcnt_hi(m_, __builtin_amdgcn_mbcnt_lo(m_, 0u)); }) == 0); } while (0)
#define SEAM(k) do { if ((k) + 1 < hi) GBAR(); PMARK(((k) < PH_L0) ? (k) : (2 + (((k) - PH_L0) / PH_PER_LAYER & 1) * PH_PER_LAYER + ((k) - PH_L0) % PH_PER_LAYER)); } while (0)

#define LAUNDER_S(x) ({ int v_ = (x); asm volatile("" : "+s"(v_)); v_; })
#define Gv LAUNDER_S(G)
#define bxv LAUNDER_S(bx)
#define Kd LAUNDER_S(D)
#define Kf LAUNDER_S(DFF)
#define gwv LAUNDER_S(gw)
#define vcuv LAUNDER_S(vcu)
#define LANE_NOW ({ unsigned m_ = ~0u; asm volatile("" : "+s"(m_)); (int)__builtin_amdgcn_mbcnt_hi(m_, __builtin_amdgcn_mbcnt_lo(m_, 0u)); })
#define lanev LANE_NOW
#define tidv (LAUNDER_S(wave) * 64 + LANE_NOW)
    if (IN(0)) {
        if (!PRO_SINGLE) { REP_BEGIN(0) if (I8_QKV || I8_DSA || I8_GU) p0_colmax(args, gwv, NGW, lanev); REP_END SEAM(0); }
    }
    if (IN(1)) {
        REP_BEGIN(1)
        if (PRO_SINGLE) { p0_strips(args, lds, vcuv, Gv, tidv, wave, lanev); p0_bf16_items(args, lds, gwv, NGW, wave, lanev); }
        else p0_transposes(args, lds, gwv, NGW, wave, lanev);
        __syncthreads();
        for (int ra = 0; ra < REPS3; ++ra) { p0_adaln(args, lds, Gv, tidv, wave, lanev);
        __syncthreads(); }
        REP_END
        SEAM(1);
    }
    for (int l = 0; l < DEPTH; ++l) {
        const int pb = PH_L0 + PH_PER_LAYER * l;
        if (hi <= pb || lo >= pb + PH_PER_LAYER) continue;
        const LayerW& W = args.L[l];
#define wsv ({ GAS unsigned char* q_ = (GAS unsigned char*)ws; asm volatile("" : "+s"(q_)); (unsigned char*)q_; })
#define wb (wsv + WS_W + (size_t)l * W_LAYER)
#define Hb ((bf16*)(wsv + WS_H))
#define ATT ((bf16*)(wsv + WS_ATT))
#define r1 (wsv + WS_R1)
#define r2 (wsv + WS_R2)
#define modl ((const float*)(wsv + WS_MOD) + (size_t)l * BATCH * NMOD)
#define sAp ((float*)(wsv + WS_SA))
#define sBl ((const float*)(wsv + WS_SB) + l * CM_LAYER)
#define x16 ((bf16*)(wsv + WS_X16))
#define xin ((l == 0) ? (const void*)as_global(args.x) : (const void*)x16)
#define xin_f32 (l == 0)
#define xout x16
        const bool dsa = (l & 1) != 0;
        if (IN(pb + 0)) { REP_BEGIN(pb + 0)
            if (dsa ? I8_DSA : I8_QKV) norm_mod_phase_q(xin, xin_f32, as_global(W.norm_attn), modl + 0 * D, modl + 1 * D, (signed char*)Hb, sAp, nullptr, gwv, NGW, lanev);
            else norm_mod_phase(xin, xin_f32, as_global(W.norm_attn), modl + 0 * D, modl + 1 * D, Hb, gwv, NGW, lanev);
            REP_END SEAM(pb + 0); }
        if (IN(pb + 1)) { REP_BEGIN(pb + 1)
            if (!dsa) { pg8::Gemm g{Hb, (const bf16*)(wb + WO_IN), M, NIN_A, Kd}; pg8::StaticOrder S; S.init(M, NIN_A, Gv, bxv, WGM_QKV);
                pg8::EpiQKV<I8_QKV> E{(bf16*)r1, (size_t)M * D, QSCALE, sAp, sBl};
                pg8::gemm_phase<pg8::EpiQKV<I8_QKV>, pg8::StaticOrder, PG8_ALIGN, PG8_SP2>(lds, g, S, E, tidv); }
            else { pg8::Gemm g{Hb, (const bf16*)(wb + WO_IN), M, NIN_BP, Kd}; pg8::StaticOrder S; S.init(M, NIN_BP, Gv, bxv, WGM_DSA);
                pg8::EpiDsaProj<I8_DSA> E{(bf16*)(r1 + R1_Q), (float*)(r1 + R1_CKVR), (bf16*)(r1 + R1_QI), (bf16*)(r1 + R1_KI), (float*)(r1 + R1_WI), sAp, sBl};
                pg8::gemm_phase<pg8::EpiDsaProj<I8_DSA>, pg8::StaticOrder, PG8_ALIGN, PG8_SP2>(lds, g, S, E, tidv); }
            REP_END SEAM(pb + 1);
        }
        const bool dfused = DIL_FUSED && (Gv & 15) == 0;
#define DIL_ARGS (const bf16*)r1, (const bf16*)r1 + (size_t)M * D, (const bf16*)r1 + 2 * (size_t)M * D, ATT, (float*)r2
        if (!dsa) {
            if (dfused) { if (IN(pb + 2)) { dil_attn_fused(DIL_ARGS, (unsigned*)(wsv + WS_CTL + CTL_DILCNT) + (size_t)(l >> 1) * 128 * 2 * 16, lds, vcuv, Gv, tidv, wave, lanev); SEAM(pb + 4); } }
            else if (DIL_SPLIT > 1 && !MK_MULTI) {
                if (IN(pb + 2)) { for (int sp = 0; sp < DIL_SPLIT; ++sp) for (int ps = 0; ps < 3; ++ps) { if (sp + ps) GBAR();
                        dil_attn_pass(ps, DIL_ARGS, lds, vcuv, Gv, tidv, wave, lanev, sp * (BATCH * NH * 16 / DIL_SPLIT), (sp + 1) * (BATCH * NH * 16 / DIL_SPLIT)); }
                    SEAM(pb + 4); }
            } else {
                if (IN(pb + 2)) { REP_BEGIN(pb + 2) dil_attn_pass<DIL_VARIANT>(0, DIL_ARGS, lds, vcuv, Gv, tidv, wave, lanev); REP_END SEAM(pb + 2); }
                if (IN(pb + 3)) { dil_attn_pass(1, DIL_ARGS, lds, vcuv, Gv, tidv, wave, lanev); SEAM(pb + 3); }
                if (IN(pb + 4)) { dil_attn_pass<0, true>(2, DIL_ARGS, lds, vcuv, Gv, tidv, wave, lanev, 0, BATCH * NH * 16, OUT_MODE == 2 ? (unsigned char*)(r2 + R2_ATT8) : nullptr); SEAM(pb + 4); }
            }
        } else {
        if (IN(pb + 2)) { REP_BEGIN(pb + 2)
            for (int rs1 = 0; rs1 < REPS1; ++rs1) {
            ckv_norm_phase((const float*)(r1 + R1_CKVR), as_global(W.kv_norm), (bf16*)(r1 + R1_CKV), gwv, NGW, lanev);
            for (int wu = gwv; wu < (M / 64) * NH; wu += NGW) { const int h = wu & 15, tg = wu >> 4;
                head_gemm<4, 16, 4>((const bf16*)(r1 + R1_Q), D, h * HD, (const bf16*)(wb + WO_UK) + (size_t)h * KVL * HD, (bf16*)r2, NH * KVL, h * KVL, 64 * tg, QSCALE, lanev); }
            }
            for (int rs2 = 0; rs2 < REPS2; ++rs2)
            { const int vb = vcuv;
              for (int pi = vb; pi < BATCH * 64; pi += Gv) { const int b = pi >> 6, ql = pi & 63;
                  dsa_index_unit((const bf16*)(r1 + R1_QI), (const bf16*)(r1 + R1_KI), (const float*)(r1 + R1_WI), (u16*)(r1 + R1_SEL), lds, b, ql, tidv, wave, lanev);
                  dsa_index_unit((const bf16*)(r1 + R1_QI), (const bf16*)(r1 + R1_KI), (const float*)(r1 + R1_WI), (u16*)(r1 + R1_SEL), lds, b, 127 - ql, tidv, wave, lanev); } }
            REP_END SEAM(pb + 2);
        }
        if (IN(pb + 3)) { REP_BEGIN(pb + 3)
            LAS unsigned char* wl = lds + wave * DSA_WAVE_LDS;
            if (DSA_MERGE_POST) {
                for (int blk = vcuv; blk < M / 64; blk += Gv) { const int tokb = 64 * blk;
                    { const bf16* QLp = (const bf16*)r2; const u16* SELp = (const u16*)(r1 + R1_SEL); const int ln = lanev, q0 = tokb + 8 * wave; LAS u16* slp = (LAS u16*)(wl + 32 * CROW);
                      bf16x8 bq[8]; v2u seln = *(const v2u*)(SELp + (size_t)q0 * TOPK + 4 * ln);
#pragma unroll
                      for (int kk = 0; kk < 8; ++kk) bq[kk] = *(const bf16x8*)(QLp + (size_t)q0 * (NH * KVL) + (ln & 15) * KVL + 32 * kk + 8 * (ln >> 4));
                      for (int jj = 0; jj < 8; ++jj) { const int q = q0 + jj; const int qn = q0 + (jj < 7 ? jj + 1 : jj);
                          *(LAS v2u*)(slp + 4 * ln) = seln; LDS_WAIT(); asm volatile("" ::: "memory");
                          dsa_attn_query_p(QLp, (const bf16*)(r1 + R1_CKV), SELp, (bf16*)(r1 + R1_OLAT), wl, q >> 11, q & (SEQ - 1), ln, bq, (size_t)qn, seln); } }
                    asm volatile("s_waitcnt vmcnt(0)" ::: "memory"); __syncthreads();
                    __builtin_amdgcn_fence(__ATOMIC_ACQUIRE, "agent"); asm volatile("s_waitcnt vmcnt(0)" ::: "memory");
                    for (int wu = wave; wu < 2 * NH; wu += NWAVES) { const int h = wu & 15, tg = wu >> 4;
                        head_gemm<8, 8, 2, OUT_MODE == 2>((const bf16*)(r1 + R1_OLAT), NH * KVL, h * KVL, (const bf16*)(wb + WO_UV) + (size_t)h * HD * KVL, ATT  , D, h * HD, tokb + 32 * tg, 1.0f, lanev); }
                    __syncthreads(); }
            } else {
                for (int q = gwv; q < M; q += NGW) dsa_attn_query((const bf16*)r2, (const bf16*)(r1 + R1_CKV), (const u16*)(r1 + R1_SEL), (bf16*)(r1 + R1_OLAT), wl, q >> 11, q & (SEQ - 1), lanev); }
            REP_END SEAM(pb + 3);
        }
        if (!DSA_MERGE_POST && IN(pb + 4)) { REP_BEGIN(pb + 4)
            for (int wu = gwv; wu < (M / 32) * NH; wu += NGW) { const int h = wu & 15, tg = wu >> 4;
                head_gemm<8, 8, 2, OUT_MODE == 2>((const bf16*)(r1 + R1_OLAT), NH * KVL, h * KVL, (const bf16*)(wb + WO_UV) + (size_t)h * HD * KVL, ATT, D, h * HD, 32 * tg, 1.0f, lanev); }
            REP_END SEAM(pb + 4);
        }
        }
#undef DIL_ARGS
        if (IN(pb + 5)) { REP_BEGIN(pb + 5) pg8::Gemm g{(OUT_MODE == 2 && !dsa) ? (const bf16*)(r2 + R2_ATT8) : ATT, (const bf16*)(wb + WO_OUT), M, D, Kd}; pg8::StaticOrder S; S.init(M, D, Gv, bxv, WGM_OUT);
            pg8::EpiResid<OUT_MODE> E{xin, xin_f32, xout, modl + 2 * D, NMOD, nullptr, sBl + CM_OUT};
            pg8::gemm_phase<pg8::EpiResid<OUT_MODE>, pg8::StaticOrder, PG8_ALIGN, PG8_SP2>(lds, g, S, E, tidv); REP_END SEAM(pb + 5); }
        if (IN(pb + 6)) {
            if (I8_GU) norm_mod_phase_q(xout, 0, as_global(W.norm_ffn), modl + 3 * D, modl + 4 * D, (signed char*)Hb, sAp, I8_DN ? (unsigned*)(wsv + WS_RMAX) : nullptr, gwv, NGW, lanev);
            else norm_mod_phase(xout, 0, as_global(W.norm_ffn), modl + 3 * D, modl + 4 * D, Hb, gwv, NGW, lanev);
            SEAM(pb + 6); }
        if (IN(pb + 7)) { REP_BEGIN(pb + 7) pg8::Gemm g{Hb, (const bf16*)(wb + WO_GU), M, 2 * DFF, Kd}; pg8::StaticOrder S; S.init(M, 2 * DFF, Gv, bxv, WGM_GU);
            pg8::EpiSwiglu<I8_GU, DN_MODE == 2> E{(bf16*)r2, sAp, sBl + CM_GU, I8_DN ? (unsigned*)(wsv + WS_RMAX) : nullptr};
            pg8::gemm_phase<pg8::EpiSwiglu<I8_GU, DN_MODE == 2>, pg8::StaticOrder, PG8_ALIGN, PG8_SP2>(lds, g, S, E, tidv); REP_END SEAM(pb + 7); }
        if (I8_DN && IN(pb + 8)) { REP_BEGIN(pb + 8) act_quant_phase((const bf16*)r2, (const unsigned*)(wsv + WS_RMAX), (signed char*)r1, (float*)(wsv + WS_SA2), gwv, NGW, lanev); REP_END SEAM(pb + 8); }
        if (IN(pb + 9)) { pg8::Gemm g{(const bf16*)(I8_DN ? r1 : r2), (const bf16*)(wb + WO_DN), M, D, Kf}; pg8::StaticOrder S; S.init(M, D, Gv, bxv, WGM_DN);
            pg8::EpiResid<DN_MODE> E{xout, 0, xout, modl + 5 * D, NMOD, (const float*)(wsv + WS_SA2), sBl + CM_DN};
            pg8::gemm_phase<pg8::EpiResid<DN_MODE>, pg8::StaticOrder, PG8_ALIGN, PG8_SP2>(lds, g, S, E, tidv); SEAM(pb + 9); }
    }
#undef wsv
#undef wb
#undef Hb
#undef ATT
#undef r1
#undef r2
#undef modl
#undef sAp
#undef sBl
#undef x16
#undef xin
#undef xin_f32
#undef xout
    if (IN(PH_FINAL)) {
#ifdef DIAG_XCC
        { const unsigned* ids = (const unsigned*)(ws + WS_CTL + 700000); int bad = 0, distinct = 0;
          for (int b = 0; b < G; ++b) if (ids[b] != ids[b & 7]) bad++;
          for (int a = 0; a < 8; ++a) { int dup = 0; for (int c = 0; c < a; ++c) if (ids[a] == ids[c]) dup = 1; distinct += !dup; }
          const float cval = (bad ? 2.0f : 0.0f) + (distinct == 8 ? 0.0f : 1.0f); float* o = as_global(args.out);
          for (size_t e = (size_t)bx * 512 + tid; e < (size_t)M * D; e += (size_t)G * 512) o[e] = cval; }
#endif
#if defined(PROBE_IDX)
        { const unsigned long long* pt = (const unsigned long long*)(ws + WS_CTL + 614400); unsigned long long tt = 0; for (int q = PROBE_IDX; q <= PROBE_IDX_END; ++q) tt += pt[q];
          const float cval = (float)tt * 0.01f / (float)PROBE_DIV; float* o = as_global(args.out);
          for (size_t e = (size_t)bx * 512 + tid; e < (size_t)M * D; e += (size_t)G * 512) o[e] = cval; }
#elif !defined(DIAG_XCC)
        final_norm_phase((const bf16*)(ws + WS_X16), as_global(args.out), as_global(args.final_norm), gwv, NGW, lanev);
#endif
    }
#undef Gv
#undef bxv
#undef Kd
#undef Kf
#undef gwv
#undef vcuv
#undef lanev
#undef LANE_NOW
#undef tidv
#undef IN
#undef SEAM
}


#ifdef DIAG_PROBE
struct ProbeArgs { const unsigned* buf[4]; unsigned long long nwords[4]; int is_bf16[4]; int pad[4]; unsigned* cnt; float* out; };
__global__ void probe_kernel(ProbeArgs a) {
    for (int k = 0; k < 4; ++k) { if (!a.buf[k]) continue; unsigned bad = 0;
        for (unsigned long long i = (unsigned long long)blockIdx.x * blockDim.x + threadIdx.x; i < a.nwords[k]; i += (unsigned long long)gridDim.x * blockDim.x) { const unsigned w = a.buf[k][i];
            const int md = a.is_bf16[k];
            if (md == 1) { if ((w & 0x7F80u) == 0x7F80u || (w & 0x7F800000u) == 0x7F800000u) bad++; } else if (md == 0) { if ((w & 0x7F800000u) == 0x7F800000u) bad++; }
            else if (md == 4) { const unsigned lo = w & 0xFFFFu, hi = w >> 16; if ((lo > 2047u && lo != 0xFFFFu) || (hi > 2047u && hi != 0xFFFFu)) bad++; }
            else if (md == 2) { if ((w & 0x7F80u) >= 0x4680u || (w & 0x7F800000u) >= 0x46800000u) bad++; } else { if ((w & 0x7F800000u) >= 0x46000000u) bad++; } }
        if (bad) atomicAdd(a.cnt + k, bad); }
}
__global__ void probe_fill(ProbeArgs a) {
    float c = 0.f; for (int k = 0; k < 4; ++k) if (a.cnt[k]) c += 0.5f * (float)(1 << k);
    for (size_t i = (size_t)blockIdx.x * blockDim.x + threadIdx.x; i < (size_t)M * D; i += (size_t)gridDim.x * blockDim.x) a.out[i] = c;
}
#endif
extern "C" void kernel_launch(void* const* d_in, const int* in_sizes, int n_in, void* d_out, int out_size, void* d_ws, size_t ws_size, hipStream_t stream) {
    static int grid = 0;
    if (grid == 0) {
        if (n_in != 41 || in_sizes[0] != M * D || out_size != M * D || ws_size < WS_END) { fprintf(stderr, "kernel_launch: unexpected shapes (n_in %d, in0 %d, out %d, ws %zu)\n", n_in, n_in > 0 ? in_sizes[0] : -1, out_size, ws_size); grid = -1; return; }
        int dev = 0, cus = 0;
        if (hipGetDevice(&dev) != hipSuccess || hipDeviceGetAttribute(&cus, hipDeviceAttributeMultiprocessorCount, dev) != hipSuccess) { grid = -1; return; }
        if (hipFuncSetAttribute((const void*)mk_fwd, hipFuncAttributeMaxDynamicSharedMemorySize, LDS_BYTES) != hipSuccess) { fprintf(stderr, "kernel_launch: hipFuncSetAttribute failed\n"); grid = -1; return; }
        int per_cu = 0;
        if (hipOccupancyMaxActiveBlocksPerMultiprocessor(&per_cu, (const void*)mk_fwd, NWAVES * 64, LDS_BYTES) != hipSuccess || per_cu < 1) fprintf(stderr, "kernel_launch: occupancy query reports %d\n", per_cu);
        (void)hipGetLastError();
        grid = cus;
    }
    if (grid < 0) return;
    if (hipMemsetAsync((char*)d_ws + WS_CTL, 0, CTL_ZERO_BYTES, stream) != hipSuccess) return;
    Args a{};
    a.x = (const float*)d_in[0]; a.c = (const float*)d_in[1]; a.final_norm = (const float*)d_in[40];
    int k = 2;
    for (int l = 0; l < DEPTH; ++l) { LayerW& w = a.L[l];
        w.norm_attn = (const float*)d_in[k++]; w.ada_w = (const float*)d_in[k++]; w.ada_b = (const float*)d_in[k++]; w.w_in = (const float*)d_in[k++];
        if (l & 1) { w.kv_norm = (const float*)d_in[k++]; w.w_uk = (const float*)d_in[k++]; w.w_uv = (const float*)d_in[k++]; }
        else { w.kv_norm = nullptr; w.w_uk = nullptr; w.w_uv = nullptr; }
        w.w_out = (const float*)d_in[k++]; w.norm_ffn = (const float*)d_in[k++]; w.w_gu = (const float*)d_in[k++]; w.w_down = (const float*)d_in[k++]; }
    a.out = (float*)d_out; a.ws = (unsigned char*)d_ws;
#if MK_MULTI
    for (int p = 0; p < PH_COUNT; ++p) {

        a.ph_lo = p; a.ph_hi = p + 1;
#ifdef DIAG_PROBE
        if (p > DIAG_LAST) break;
#endif
        hipLaunchKernelGGL(mk_fwd, dim3(grid), dim3(NWAVES * 64), LDS_BYTES, stream, a);
    }
#ifdef DIAG_PROBE
    { ProbeArgs pa{}; unsigned char* ws = (unsigned char*)d_ws; DIAG_SETUP; pa.cnt = (unsigned*)(ws + WS_CTL) + 64; pa.out = (float*)d_out;
      hipLaunchKernelGGL(probe_kernel, dim3(1024), dim3(256), 0, stream, pa); hipLaunchKernelGGL(probe_fill, dim3(1024), dim3(256), 0, stream, pa); }
#endif
#else
    a.ph_lo = 0; a.ph_hi = PH_COUNT;
    hipLaunchKernelGGL(mk_fwd, dim3(grid), dim3(NWAVES * 64), LDS_BYTES, stream, a);
#endif
    const hipError_t le = hipPeekAtLastError();
    if (le != hipSuccess) fprintf(stderr, "kernel_launch: launch failed: %s\n", hipGetErrorName(le));
}
```

```cpp
#include <hip/hip_runtime.h>
#include <cstdio>
#include <cstdint>
#define MK_MULTI 0
namespace pg8 {
#define PG8_LAS __attribute__((address_space(3)))
typedef unsigned short bf16_t;
typedef short bf16x8 __attribute__((ext_vector_type(8)));
typedef float f32x4 __attribute__((ext_vector_type(4)));
typedef unsigned u32x4 __attribute__((ext_vector_type(4)));
constexpr int BM = 256, BK = 64, HALF = 128, HTB = HALF * BK * 2  , STAGE_BYTES = 8 * HTB, NXCD = 8, WGM = 8;

__host__ __device__ __forceinline__ int lds_byte(int r, int c) { const int st = (r >> 4) * 2 + (c >> 5), rr = r & 15, cc = c & 31, ob = rr * 64 + cc * 2; return st * 1024 + (ob ^ (((ob >> 9) & 1) << 5)); }
__host__ __device__ __forceinline__ void stage_rc(int b, int& R, int& C) { const int st = b / 1024, sb = b % 1024, swz = sb ^ (((sb >> 9) & 1) << 5); R = (st >> 1) * 16 + swz / 64; C = (st & 1) * 32 + (swz % 64) / 2; }
__host__ __device__ __forceinline__ int perm32(int rho) { const int n = rho >> 4, i = rho & 15; return 8 * (i >> 2) + 4 * n + (i & 3); }

struct Unit { int pm, pn; };
struct Gemm { const bf16_t* A; const bf16_t* Bt; int M, N, K; };

struct StaticOrder {
    int nM, nN, nwg, G, c, wgm;
    __host__ __device__ void init(int M, int N, int G_, int c_, int wgm_ = WGM) { nM = M / BM; nN = N / BM; nwg = nM * nN; G = G_; c = c_; wgm = wgm_; }
    __host__ __device__ bool next(int i, Unit& u) const {
        const long L = (long)i * G + c; if (L >= nwg) return false;
        int wgid = (int)L; { const int q = nwg / NXCD, r = nwg % NXCD, xcd = wgid % NXCD, off = wgid / NXCD; wgid = (xcd < r ? xcd * (q + 1) : r * (q + 1) + (xcd - r) * q) + off; }
        const int nig = wgm * nN, gid = wgid / nig, fm = gid * wgm, gsz = (nM - fm) < wgm ? (nM - fm) : wgm;
        u.pm = fm + ((wgid % nig) % gsz); u.pn = (wgid % nig) / gsz; return true;
    }
    __device__ __forceinline__ void a_ready(const Unit&) const {}
    __device__ __forceinline__ void done(const Unit&) const {}
};
typedef __bf16 bf16x2_cv __attribute__((ext_vector_type(2)));
typedef float f32x2_cv __attribute__((ext_vector_type(2)));
__device__ __forceinline__ unsigned cvt_pk_bf16(float lo, float hi) { const f32x2_cv v = {lo, hi}; const bf16x2_cv r = __builtin_convertvector(v, bf16x2_cv); return __builtin_bit_cast(unsigned, r); }
typedef float f32x2 __attribute__((ext_vector_type(2)));
__device__ __forceinline__ u32x4 pack8(const f32x4 v0, const f32x4 v1) { u32x4 w; w.x = cvt_pk_bf16(v0[0], v0[1]); w.y = cvt_pk_bf16(v0[2], v0[3]); w.z = cvt_pk_bf16(v1[0], v1[1]); w.w = cvt_pk_bf16(v1[2], v1[3]); return w; }

typedef int i32x4 __attribute__((ext_vector_type(4)));
template <bool I8_> struct AccT { typedef f32x4 type; };
template <> struct AccT<true> { typedef i32x4 type; };
template <bool I8_> __device__ __forceinline__ f32x4 deq(const typename AccT<I8_>::type a, float sa, const f32x4 sb) {
    if constexpr (I8_) { f32x4 r; r[0] = (float)a[0]; r[1] = (float)a[1]; r[2] = (float)a[2]; r[3] = (float)a[3]; return r * sa * sb; } else { (void)sa; (void)sb; return a; } }
template <bool I8_> __device__ __forceinline__ f32x4 deqg(const typename AccT<I8_>::type a, float sa, const f32x4 sb) { if constexpr (I8_) return deq<true>(a, sa, sb); else { (void)sa; return a * sb; } }
template <bool I8_> struct EpiQKV {
    static constexpr bool PERM = true, AFTER_DRAIN = false, I8 = I8_, FP8 = false; typedef typename AccT<I8_>::type acc_t;
    bf16_t* O; size_t split_stride; float qscale; const float* sA; const float* sB;
    __device__ __forceinline__ void operator()(const acc_t (&acc)[2][2][4][2], const Unit& u, int wr, int wc, int fr, int fq) const {
        const int row0 = u.pm * BM + wr * 64 + fr; const int t = u.pn >> 3; const int col0 = (u.pn & 7) * BM + wc * 32 + 8 * fq;
        bf16_t* base = O + (size_t)t * split_stride; const float sc = (t == 0) ? qscale : 1.f;
        f32x4 sb[2][2];
#pragma unroll
        for (int bj = 0; bj < 2; ++bj)
#pragma unroll
            for (int n = 0; n < 2; ++n) sb[bj][n] = I8_ ? *(const f32x4*)(sB + u.pn * BM + bj * HALF + wc * 32 + 8 * fq + 4 * n) : (f32x4){1.f, 1.f, 1.f, 1.f};
#pragma unroll
        for (int ai = 0; ai < 2; ++ai)
#pragma unroll
            for (int m = 0; m < 4; ++m) { const int r = row0 + ai * HALF + m * 16; bf16_t* rowp = base + (size_t)r * 2048 + col0; const float sa = (I8_ ? sA[r] : 1.f) * sc;
#pragma unroll
                for (int bj = 0; bj < 2; ++bj) { f32x4 v0 = deq<I8_>(acc[ai][bj][m][0], sa, sb[bj][0]), v1 = deq<I8_>(acc[ai][bj][m][1], sa, sb[bj][1]);
                    if (!I8_) { v0 = v0 * sc; v1 = v1 * sc; } *(u32x4*)(rowp + bj * HALF) = pack8(v0, v1); } }
    }
};
template <int MODE  > struct EpiResid {
    static constexpr bool PERM = false, AFTER_DRAIN = false, I8 = (MODE == 1), FP8 = (MODE == 2), I8_ = (MODE == 1); typedef typename AccT<(MODE == 1)>::type acc_t;
    const void* base; int base_f32; bf16_t* out; const float* gate; int gstride; const float* sA; const float* sB;
    __device__ __forceinline__ void operator()(const acc_t (&acc)[2][2][4][2], const Unit& u, int wr, int wc, int fr, int fq) const {
        typedef unsigned u32x2 __attribute__((ext_vector_type(2)));
        const int row0 = u.pm * BM + wr * 64 + fr, col0 = u.pn * BM + wc * 32 + 4 * fq;
        const float* gp = gate + (size_t)((u.pm * BM) >> 11) * gstride + col0;
        f32x4 gv[2][2];
#pragma unroll
        for (int bj = 0; bj < 2; ++bj)
#pragma unroll
            for (int n = 0; n < 2; ++n) { gv[bj][n] = *(const f32x4*)(gp + bj * HALF + n * 16); if (MODE != 0) gv[bj][n] = gv[bj][n] * *(const f32x4*)(sB + col0 + bj * HALF + n * 16); }
#pragma unroll
        for (int ai = 0; ai < 2; ++ai)
#pragma unroll
            for (int m = 0; m < 4; ++m) { const int r = row0 + ai * HALF + m * 16; const size_t off = (size_t)r * 2048 + col0; const float sa = I8_ ? sA[r] : 1.f;
                f32x4 bs[2][2];
                if (base_f32) {
#pragma unroll
                    for (int bj = 0; bj < 2; ++bj)
#pragma unroll
                        for (int n = 0; n < 2; ++n) bs[bj][n] = *(const f32x4*)((const float*)base + off + bj * HALF + n * 16);
                } else {
#pragma unroll
                    for (int bj = 0; bj < 2; ++bj)
#pragma unroll
                        for (int n = 0; n < 2; ++n) { const u32x2 w = *(const u32x2*)((const bf16_t*)base + off + bj * HALF + n * 16);
                            bs[bj][n] = (f32x4){__uint_as_float(w.x << 16), __uint_as_float(w.x & 0xFFFF0000u), __uint_as_float(w.y << 16), __uint_as_float(w.y & 0xFFFF0000u)}; }
                }
#pragma unroll
                for (int bj = 0; bj < 2; ++bj)
#pragma unroll
                    for (int n = 0; n < 2; ++n) { const f32x4 v = bs[bj][n] + deqg<I8_>(acc[ai][bj][m][n], sa, gv[bj][n]); *(u32x2*)(out + off + bj * HALF + n * 16) = (u32x2){cvt_pk_bf16(v[0], v[1]), cvt_pk_bf16(v[2], v[3])}; }
                asm volatile("" ::: "memory"); }
    }
};
template <bool I8_, bool OUT8  > struct EpiSwiglu {
    static constexpr bool PERM = true, AFTER_DRAIN = false, I8 = I8_, FP8 = false; typedef typename AccT<I8_>::type acc_t;
    bf16_t* O; const float* sA; const float* sB; unsigned* rmax;
    __device__ __forceinline__ static float silu(float x) { return x * __builtin_amdgcn_rcpf(1.0f + __builtin_amdgcn_exp2f(-1.44269504f * x)); }
    __device__ __forceinline__ void operator()(const acc_t (&acc)[2][2][4][2], const Unit& u, int wr, int wc, int fr, int fq) const {
        const int row0 = u.pm * BM + wr * 64 + fr; const int col0 = u.pn * HALF + wc * 32 + 8 * fq;
        f32x4 sb[2][2];
#pragma unroll
        for (int bj = 0; bj < 2; ++bj)
#pragma unroll
            for (int n = 0; n < 2; ++n) sb[bj][n] = I8_ ? *(const f32x4*)(sB + u.pn * BM + bj * HALF + wc * 32 + 8 * fq + 4 * n) : (f32x4){1.f, 1.f, 1.f, 1.f};
#pragma unroll
        for (int ai = 0; ai < 2; ++ai)
#pragma unroll
            for (int m = 0; m < 4; ++m) { const int r = row0 + ai * HALF + m * 16; bf16_t* rowp = O + (size_t)r * 5632 + col0; const float sa = I8_ ? sA[r] : 1.f;
                const f32x4 g0 = deq<I8_>(acc[ai][0][m][0], sa, sb[0][0]), g1 = deq<I8_>(acc[ai][0][m][1], sa, sb[0][1]), u0 = deq<I8_>(acc[ai][1][m][0], sa, sb[1][0]), u1 = deq<I8_>(acc[ai][1][m][1], sa, sb[1][1]);
                f32x4 v0, v1;
#pragma unroll
                for (int j = 0; j < 4; ++j) { v0[j] = silu(g0[j]) * u0[j]; v1[j] = silu(g1[j]) * u1[j]; }
                if constexpr (OUT8) { unsigned w0 = 0u, w1 = 0u; w0 = __builtin_amdgcn_cvt_pk_fp8_f32(v0[0], v0[1], w0, false); w0 = __builtin_amdgcn_cvt_pk_fp8_f32(v0[2], v0[3], w0, true);
                    w1 = __builtin_amdgcn_cvt_pk_fp8_f32(v1[0], v1[1], w1, false); w1 = __builtin_amdgcn_cvt_pk_fp8_f32(v1[2], v1[3], w1, true);
                    typedef unsigned u32x2 __attribute__((ext_vector_type(2))); *(u32x2*)((unsigned char*)O + (size_t)r * 5632 + col0) = (u32x2){w0, w1}; }
                else *(u32x4*)rowp = pack8(v0, v1);
                if (rmax) { float mx = fmaxf(fmaxf(fmaxf(fabsf(v0[0]), fabsf(v0[1])), fmaxf(fabsf(v0[2]), fabsf(v0[3]))), fmaxf(fmaxf(fabsf(v1[0]), fabsf(v1[1])), fmaxf(fabsf(v1[2]), fabsf(v1[3]))));
                    { unsigned uu = __float_as_uint(mx); auto r16 = __builtin_amdgcn_permlane16_swap(uu, uu, false, false); mx = fmaxf(__uint_as_float(r16[0]), __uint_as_float(r16[1])); uu = __float_as_uint(mx); auto r32 = __builtin_amdgcn_permlane32_swap(uu, uu, false, false); mx = fmaxf(__uint_as_float(r32[0]), __uint_as_float(r32[1])); }
                    if (fq == 0) atomicMax(rmax + r, __float_as_uint(mx)); } }
    }
};
template <bool I8_> struct EpiDsaProj {
    static constexpr bool PERM = true, AFTER_DRAIN = false, I8 = I8_, FP8 = false; typedef typename AccT<I8_>::type acc_t;
    bf16_t* Q; float* CKVR; bf16_t* QI; bf16_t* KI; float* WI; const float* sA; const float* sB;
    __device__ __forceinline__ void operator()(const acc_t (&acc)[2][2][4][2], const Unit& u, int wr, int wc, int fr, int fq) const {
        const int row0 = u.pm * BM + wr * 64 + fr; const int lc0 = wc * 32 + 8 * fq;
        f32x4 sb[2][2];
#pragma unroll
        for (int bj = 0; bj < 2; ++bj)
#pragma unroll
            for (int n = 0; n < 2; ++n) sb[bj][n] = I8_ ? *(const f32x4*)(sB + u.pn * BM + bj * HALF + lc0 + 4 * n) : (f32x4){1.f, 1.f, 1.f, 1.f};
#define DQ(ai, bj, m, n) deq<I8_>(acc[ai][bj][m][n], sa, sb[bj][n])
        if (u.pn < 8 || (u.pn >= 9 && u.pn < 17)) {
            bf16_t* base = (u.pn < 8) ? Q : QI; const int col0 = ((u.pn < 8) ? u.pn : (u.pn - 9)) * BM + lc0;
#pragma unroll
            for (int ai = 0; ai < 2; ++ai)
#pragma unroll
                for (int m = 0; m < 4; ++m) { const int r = row0 + ai * HALF + m * 16; const float sa = I8_ ? sA[r] : 1.f; bf16_t* rowp = base + (size_t)r * 2048 + col0;
#pragma unroll
                    for (int bj = 0; bj < 2; ++bj) *(u32x4*)(rowp + bj * HALF) = pack8(DQ(ai, bj, m, 0), DQ(ai, bj, m, 1)); }
        } else if (u.pn == 8) {
#pragma unroll
            for (int ai = 0; ai < 2; ++ai)
#pragma unroll
                for (int m = 0; m < 4; ++m) { const int r = row0 + ai * HALF + m * 16; const float sa = I8_ ? sA[r] : 1.f; float* rowp = CKVR + (size_t)r * 256 + lc0;
#pragma unroll
                    for (int bj = 0; bj < 2; ++bj) { *(f32x4*)(rowp + bj * HALF) = DQ(ai, bj, m, 0); *(f32x4*)(rowp + bj * HALF + 4) = DQ(ai, bj, m, 1); } }
        } else {
#pragma unroll
            for (int ai = 0; ai < 2; ++ai)
#pragma unroll
                for (int m = 0; m < 4; ++m) { const size_t r = (size_t)(row0 + ai * HALF + m * 16); const float sa = I8_ ? sA[r] : 1.f;
                    *(u32x4*)(KI + r * 128 + lc0) = pack8(DQ(ai, 0, m, 0), DQ(ai, 0, m, 1));
                    if (lc0 < 16) { *(f32x4*)(WI + r * 16 + lc0) = DQ(ai, 1, m, 0); *(f32x4*)(WI + r * 16 + lc0 + 4) = DQ(ai, 1, m, 1); } }
        }
#undef DQ
    }
};
template <class Epi, class Sched, bool ALIGN_EPI = false, bool SP2 = false>
__device__ __forceinline__ void gemm_phase(PG8_LAS unsigned char* lds, const Gemm g, const Sched& S, const Epi& E, int tid_in) {
    int tid_ = tid_in; asm volatile("" : "+v"(tid_));
    const int tid = tid_, wid = __builtin_amdgcn_readfirstlane(tid >> 6), lane = tid & 63, wr = wid >> 2, wc = wid & 3, fr = lane & 15, fq = lane >> 4;
    constexpr bool I8 = Epi::I8, F8 = Epi::FP8; typedef typename Epi::acc_t acc_t; typedef int i32x4_t __attribute__((ext_vector_type(4))); typedef int i32x8_t __attribute__((ext_vector_type(8)));
    const int K = g.K * ((I8 || F8) ? 1 : 2)  , nt = K / (BK * 2);
    unsigned voffA[2], voffB[2];
#pragma unroll
    for (int i = 0; i < 2; ++i) { int R, C; stage_rc(tid * 16 + i * 8192, R, C); const int Rb = Epi::PERM ? ((R & ~31) + perm32(R & 31)) : R;
        voffA[i] = (unsigned)(R * K + C * 2); voffB[i] = (unsigned)(Rb * K + C * 2); }
    const size_t kstep = (size_t)(BK * 2);
    const size_t hstep = (size_t)HALF * K;
    const size_t tstep = 2 * hstep;
    const unsigned ldsw = (unsigned)wid * 1024u;
    const int aoff = lds_byte(wr * 64 + fr, fq * 8), boff = lds_byte(wc * 32 + fr, fq * 8);
#define PG8_SA(b, h) (((b) * 2 + (h)) * HTB)
#define PG8_SB(b, h) ((4 + (b) * 2 + (h)) * HTB)
#define PG8_STAGE(bufoff, gbase, voff) do { _Pragma("unroll") for (int _i = 0; _i < 2; ++_i) \
        __builtin_amdgcn_global_load_lds((const unsigned*)((const char*)(gbase) + (voff)[_i]), (PG8_LAS unsigned*)(lds + (bufoff) + ldsw + _i * 8192), 16, 0, 0); } while (0)
#define PG8_LDA(dst, b, h) do { _Pragma("unroll") for (int m = 0; m < 4; ++m) _Pragma("unroll") for (int k = 0; k < 2; ++k) dst[m][k] = *(const PG8_LAS bf16x8*)(lds + PG8_SA(b, h) + aoff + m * 2048 + k * 1024); } while (0)
#define PG8_LDB(dst, b, h) do { _Pragma("unroll") for (int n = 0; n < 2; ++n) _Pragma("unroll") for (int k = 0; k < 2; ++k) dst[n][k] = *(const PG8_LAS bf16x8*)(lds + PG8_SB(b, h) + boff + n * 2048 + k * 1024); } while (0)
#define PG8_CAT8(x) ({ const i32x4_t lo_ = __builtin_bit_cast(i32x4_t, (x)[0]), hi_ = __builtin_bit_cast(i32x4_t, (x)[1]); (i32x8_t){lo_[0], lo_[1], lo_[2], lo_[3], hi_[0], hi_[1], hi_[2], hi_[3]}; })
#define PG8_MMA(ai, bj, At, Bt) do { __builtin_amdgcn_s_setprio(1); \
        if constexpr (F8) {   \
            _Pragma("unroll") for (int m = 0; m < 4; ++m) _Pragma("unroll") for (int n = 0; n < 2; ++n) \
                { const i32x8_t b8_ = PG8_CAT8(Bt[n]), a8_ = PG8_CAT8(At[m]); asm volatile("v_mfma_scale_f32_16x16x128_f8f6f4 %0, %1, %2, %0, %3, %3 op_sel_hi:[0,0,0]" : "+v"(acc[ai][bj][m][n]) : "v"(b8_), "v"(a8_), "v"(0x7F7F7F7F)); } \
        } else { _Pragma("unroll") for (int m = 0; m < 4; ++m) _Pragma("unroll") for (int n = 0; n < 2; ++n) _Pragma("unroll") for (int k = 0; k < 2; ++k) \
        { if constexpr (I8) acc[ai][bj][m][n] = __builtin_bit_cast(acc_t, __builtin_amdgcn_mfma_i32_16x16x64_i8(__builtin_bit_cast(i32x4_t, Bt[n][k]), __builtin_bit_cast(i32x4_t, At[m][k]), __builtin_bit_cast(i32x4_t, acc[ai][bj][m][n]), 0, 0, 0)); \
          else acc[ai][bj][m][n] = __builtin_bit_cast(acc_t, __builtin_amdgcn_mfma_f32_16x16x32_bf16(Bt[n][k], At[m][k], __builtin_bit_cast(f32x4, acc[ai][bj][m][n]), 0, 0, 0)); } } __builtin_amdgcn_s_setprio(0); } while (0)
#define PG8_WAIT_V(n) asm volatile("s_waitcnt vmcnt(" #n ")" ::: "memory")
#define PG8_WAIT_L(n) asm volatile("s_waitcnt lgkmcnt(" #n ")" ::: "memory")
#define PG8_BAR __builtin_amdgcn_s_barrier()
#define PG8_SCHED __builtin_amdgcn_sched_barrier(0)
    Unit cur, nxt; int ui = 0;
    if (!S.next(0, cur)) return;
    acc_t acc[2][2][4][2];
#pragma unroll
    for (int a = 0; a < 2; ++a)
#pragma unroll
        for (int b = 0; b < 2; ++b)
#pragma unroll
            for (int m = 0; m < 4; ++m)
#pragma unroll
                for (int n = 0; n < 2; ++n) acc[a][b][m][n] = acc_t{};
    bf16x8 At[4][2], B0[2][2], B1[2][2];
    const char* cA = (const char*)g.A + (size_t)cur.pm * tstep; const char* cB = (const char*)g.Bt + (size_t)cur.pn * tstep;
    S.a_ready(cur);
    if constexpr (SP2) {
        PG8_STAGE(PG8_SB(0, 0), cB, voffB); PG8_STAGE(PG8_SB(0, 1), cB + hstep, voffB); PG8_STAGE(PG8_SA(0, 0), cA, voffA); PG8_STAGE(PG8_SA(0, 1), cA + hstep, voffA);
        if (wr == 1) PG8_BAR;
        PG8_WAIT_V(2); PG8_BAR;
        PG8_STAGE(PG8_SB(1, 0), cB + kstep, voffB); PG8_STAGE(PG8_SA(1, 0), cA + kstep, voffA); PG8_STAGE(PG8_SB(1, 1), cB + hstep + kstep, voffB);
        PG8_WAIT_V(6); PG8_BAR;
    } else {
        PG8_STAGE(PG8_SB(0, 0), cB, voffB); PG8_STAGE(PG8_SA(0, 0), cA, voffA); PG8_STAGE(PG8_SB(0, 1), cB + hstep, voffB); PG8_STAGE(PG8_SA(0, 1), cA + hstep, voffA);
        if (wr == 1) PG8_BAR;
        PG8_WAIT_V(4); PG8_BAR;
        PG8_STAGE(PG8_SB(1, 0), cB + kstep, voffB); PG8_STAGE(PG8_SA(1, 0), cA + kstep, voffA); PG8_STAGE(PG8_SB(1, 1), cB + hstep + kstep, voffB);
        PG8_WAIT_V(6); PG8_BAR;
    }
    for (;;) {
        const bool has_next = S.next(ui + 1, nxt);
        const char* nA = has_next ? (const char*)g.A + (size_t)nxt.pm * tstep : cA; const char* nB = has_next ? (const char*)g.Bt + (size_t)nxt.pn * tstep : cB;
        for (int t = 0; t < nt; t += 2) {
            const bool last = (t == nt - 2);
            const char* a1 = cA + (size_t)(t + 1) * kstep;
            const char* a2 = last ? nA : cA + (size_t)(t + 2) * kstep; const char* b2 = last ? nB : cB + (size_t)(t + 2) * kstep;
            const char* a3 = a2 + kstep; const char* b3 = b2 + kstep;
            if (last && has_next) S.a_ready(nxt);
            if constexpr (SP2) {
            PG8_LDB(B0, 0, 0); PG8_LDB(B1, 0, 1); PG8_SCHED; PG8_LDA(At, 0, 0); PG8_STAGE(PG8_SA(1, 1), a1 + hstep, voffA);
            PG8_WAIT_V(8); PG8_WAIT_L(0); PG8_BAR; PG8_MMA(0, 0, At, B0); PG8_MMA(0, 1, At, B1); PG8_BAR; PG8_SCHED;
            PG8_LDA(At, 0, 1); PG8_STAGE(PG8_SB(0, 0), b2, voffB); PG8_STAGE(PG8_SB(0, 1), b2 + hstep, voffB); PG8_STAGE(PG8_SA(0, 0), a2, voffA);
            PG8_WAIT_V(8); PG8_WAIT_L(0); PG8_BAR; PG8_MMA(1, 0, At, B0); PG8_MMA(1, 1, At, B1); PG8_BAR; PG8_SCHED;
            PG8_LDB(B0, 1, 0); PG8_LDB(B1, 1, 1); PG8_SCHED; PG8_LDA(At, 1, 0); PG8_STAGE(PG8_SA(0, 1), a2 + hstep, voffA);
            PG8_WAIT_V(8); PG8_WAIT_L(0); PG8_BAR; PG8_MMA(0, 0, At, B0); PG8_MMA(0, 1, At, B1); PG8_BAR; PG8_SCHED;
            PG8_LDA(At, 1, 1); PG8_STAGE(PG8_SB(1, 0), b3, voffB); PG8_STAGE(PG8_SB(1, 1), b3 + hstep, voffB); PG8_STAGE(PG8_SA(1, 0), a3, voffA);
            PG8_WAIT_V(8); PG8_WAIT_L(0); PG8_BAR; PG8_MMA(1, 0, At, B0); PG8_MMA(1, 1, At, B1); PG8_BAR; PG8_SCHED;
            } else {
            PG8_LDB(B0, 0, 0); PG8_SCHED; PG8_LDA(At, 0, 0); PG8_STAGE(PG8_SA(1, 1), a1 + hstep, voffA);
            PG8_WAIT_L(8); PG8_BAR; PG8_WAIT_L(0); PG8_MMA(0, 0, At, B0); PG8_BAR; PG8_SCHED;
            PG8_LDB(B1, 0, 1); PG8_STAGE(PG8_SB(0, 0), b2, voffB);
            PG8_BAR; PG8_WAIT_L(0); PG8_MMA(0, 1, At, B1); PG8_BAR;
            PG8_LDA(At, 0, 1); PG8_STAGE(PG8_SA(0, 0), a2, voffA);
            PG8_BAR; PG8_WAIT_L(0); PG8_MMA(1, 0, At, B0); PG8_BAR; PG8_SCHED;
            PG8_STAGE(PG8_SB(0, 1), b2 + hstep, voffB);
            PG8_WAIT_V(6); PG8_BAR; PG8_MMA(1, 1, At, B1); PG8_BAR;
            PG8_LDB(B0, 1, 0); PG8_SCHED; PG8_LDA(At, 1, 0); PG8_STAGE(PG8_SA(0, 1), a2 + hstep, voffA);
            PG8_WAIT_L(8); PG8_BAR; PG8_WAIT_L(0); PG8_MMA(0, 0, At, B0); PG8_BAR; PG8_SCHED;
            PG8_LDB(B1, 1, 1); PG8_STAGE(PG8_SB(1, 0), b3, voffB);
            PG8_BAR; PG8_WAIT_L(0); PG8_MMA(0, 1, At, B1); PG8_BAR;
            PG8_LDA(At, 1, 1); PG8_STAGE(PG8_SA(1, 0), a3, voffA);
            PG8_BAR; PG8_WAIT_L(0); PG8_MMA(1, 0, At, B0); PG8_BAR; PG8_SCHED;
            PG8_STAGE(PG8_SB(1, 1), b3 + hstep, voffB);
            PG8_WAIT_V(6); PG8_BAR; PG8_MMA(1, 1, At, B1); PG8_BAR;
            }
        }
        if constexpr (ALIGN_EPI) { if (wr == 0) PG8_BAR; }
        if constexpr (!Epi::AFTER_DRAIN) { E(acc, cur, wr, wc, fr, fq);
#ifdef EPI_TWICE
            if constexpr (Epi::PERM) { asm volatile("" ::: "memory"); E(acc, cur, wr, wc, fr, fq); }
#endif
            S.done(cur); }
        if (!has_next) break;
#pragma unroll
        for (int a = 0; a < 2; ++a)
#pragma unroll
            for (int b = 0; b < 2; ++b)
#pragma unroll
                for (int m = 0; m < 4; ++m)
#pragma unroll
                    for (int n = 0; n < 2; ++n) acc[a][b][m][n] = acc_t{};
        cur = nxt; cA = nA; cB = nB; ++ui;
        if constexpr (ALIGN_EPI) { if (wr == 1) PG8_BAR; }
    }
    PG8_WAIT_V(0);
    if constexpr (!ALIGN_EPI) { if (wr == 0) PG8_BAR; }
    PG8_BAR;
    if constexpr (Epi::AFTER_DRAIN) { E.fused(acc, cur, wr, wc, fr, fq, lds, wid, lane); S.done(cur); }
#undef PG8_SA
#undef PG8_SB
#undef PG8_STAGE
#undef PG8_LDA
#undef PG8_LDB
#undef PG8_MMA
#undef PG8_CAT8
#undef PG8_WAIT_V
#undef PG8_WAIT_L
#undef PG8_BAR
#undef PG8_SCHED
}
}
#ifndef PG8_SP2
#define PG8_SP2 true
#endif
#ifndef PG8_ALIGN
#define PG8_ALIGN true
#endif
#ifndef USE_I8
#define USE_I8 true
#endif
#ifndef I8_QKV
#define I8_QKV USE_I8
#endif
#ifndef I8_DSA
#define I8_DSA true
#endif
#ifndef I8_GU
#define I8_GU USE_I8
#endif
#ifndef OUT_MODE
#define OUT_MODE 2
#endif
#ifndef DN_MODE
#define DN_MODE 2
#endif
#define I8_DN (DN_MODE == 1)
#ifndef WGM_QKV
#define WGM_QKV 2
#endif
#ifndef WGM_DSA
#define WGM_DSA 4
#endif
#ifndef WGM_OUT
#define WGM_OUT 4
#endif
#ifndef WGM_GU
#define WGM_GU 4
#endif
#ifndef WGM_DN
#define WGM_DN 4
#endif
#ifndef DSA_MERGE_POST
#define DSA_MERGE_POST 1
#endif
#ifndef PRO_SINGLE
#define PRO_SINGLE 1
#endif
#ifndef DIL_SPLIT
#define DIL_SPLIT 1
#endif
#ifndef DIL_FUSED
#define DIL_FUSED 0
#endif
#ifndef MK_MULTI
#define MK_MULTI 0
#endif

constexpr int NWAVES = 8;
constexpr int BATCH = 8, SEQ = 2048, D = 2048, M = BATCH * SEQ, NH = 16, HD = 128, DFF = 5632, KVL = 256, TOPK = 256, DEPTH = 4;
constexpr int NIN_A = 6144, NIN_B = 4496, NIN_BP = 4608, NMOD = 6 * D;
constexpr float EPS = 1e-6f;
constexpr float LOG2E = 1.4426950408889634f;
constexpr float QSCALE = 0.08838834764831845f * LOG2E;

constexpr size_t MiB = 1u << 20;
constexpr size_t WS_CTL = 0, CTL_ZERO_BYTES = 1 * MiB;
constexpr size_t WS_MOD = 1 * MiB;
constexpr size_t WS_W = 4 * MiB, W_LAYER = 100 * MiB;
constexpr size_t WO_IN = 0, WO_OUT = 24 * MiB, WO_GU = 32 * MiB, WO_DN = 76 * MiB, WO_UK = 98 * MiB, WO_UV = 99 * MiB;
constexpr size_t WS_H = 404 * MiB;
constexpr size_t WS_R1 = 468 * MiB;
constexpr size_t WS_ATT = 660 * MiB;
constexpr size_t WS_R2 = 724 * MiB;
constexpr size_t WS_X16 = 900 * MiB;
constexpr size_t WS_END = 964 * MiB;
constexpr size_t R2_ATT8 = 16 * MiB;
constexpr size_t R1_Q = 0, R1_QI = 64 * MiB, R1_OLAT = 0, R1_CKVR = 128 * MiB, R1_KI = 144 * MiB, R1_WI = 148 * MiB, R1_CKV = 149 * MiB, R1_SEL = 157 * MiB;
constexpr int CW_BAR = 4096;
constexpr size_t CTL_CMAX = 65536;
constexpr size_t CTL_DILCNT = 524288;
constexpr int CM_LAYER = 21504, CM_GU = 6144, CM_DN = 17408, CM_OUT = 19456;
constexpr size_t WS_SA = 2 * MiB + 512 * 1024;
constexpr size_t WS_RMAX = WS_SA + 65536;
constexpr size_t WS_SA2 = WS_SA + 131072;
constexpr size_t WS_SB = 3 * MiB;

constexpr int RING_BYTES = 143360;
constexpr int MISC_OFF = RING_BYTES;
constexpr int LDS_BYTES = RING_BYTES + 256;

#define GAS __attribute__((address_space(1)))
#define LAS __attribute__((address_space(3)))
typedef unsigned short bf16;
typedef unsigned short u16;
typedef unsigned v4u __attribute__((ext_vector_type(4)));
typedef unsigned v2u __attribute__((ext_vector_type(2)));
typedef float f32x4 __attribute__((ext_vector_type(4)));
typedef short bf16x8 __attribute__((ext_vector_type(8)));
typedef short s16x4 __attribute__((ext_vector_type(4)));
typedef short v4i16_t __attribute__((ext_vector_type(4)));
typedef GAS unsigned gu32;
template <class T> __device__ __forceinline__ T* as_global(T* p) { return (T*)(GAS T*)p; }
#define RLX_AGENT __ATOMIC_RELAXED, __HIP_MEMORY_SCOPE_AGENT
#define LDS_WAIT() asm volatile("s_waitcnt lgkmcnt(0)" ::: "memory")
#define VM_WAIT() asm volatile("s_waitcnt vmcnt(0)" ::: "memory")
__device__ __forceinline__ unsigned cvtpk(float lo, float hi) { return pg8::cvt_pk_bf16(lo, hi); }
#define DPPF(v, ctrl) __builtin_bit_cast(float, __builtin_amdgcn_update_dpp(0, __builtin_bit_cast(int, (v)), (ctrl), 0xF, 0xF, true))
__device__ __forceinline__ float xmax16(float v) { const unsigned u = __float_as_uint(v); auto r = __builtin_amdgcn_permlane16_swap(u, u, false, false); return fmaxf(__uint_as_float(r[0]), __uint_as_float(r[1])); }
__device__ __forceinline__ float xmax32(float v) { const unsigned u = __float_as_uint(v); auto r = __builtin_amdgcn_permlane32_swap(u, u, false, false); return fmaxf(__uint_as_float(r[0]), __uint_as_float(r[1])); }
__device__ __forceinline__ float xsum16(float v) { const unsigned u = __float_as_uint(v); auto r = __builtin_amdgcn_permlane16_swap(u, u, false, false); return __uint_as_float(r[0]) + __uint_as_float(r[1]); }
__device__ __forceinline__ float xsum32(float v) { const unsigned u = __float_as_uint(v); auto r = __builtin_amdgcn_permlane32_swap(u, u, false, false); return __uint_as_float(r[0]) + __uint_as_float(r[1]); }
__device__ __forceinline__ float wave_sum(float v) {
    v += DPPF(v, 0xB1); v += DPPF(v, 0x4E); v += DPPF(v, 0x141); v += DPPF(v, 0x140);
    return xsum32(xsum16(v));
}
__device__ __forceinline__ float wave_max(float v) {
    v = fmaxf(v, DPPF(v, 0xB1)); v = fmaxf(v, DPPF(v, 0x4E)); v = fmaxf(v, DPPF(v, 0x141)); v = fmaxf(v, DPPF(v, 0x140));
    return xmax32(xmax16(v));
}
__device__ __forceinline__ s16x4 tr_read(LAS const unsigned char* p) { return __builtin_bit_cast(s16x4, __builtin_amdgcn_ds_read_tr16_b64_v4i16((LAS v4i16_t*)p)); }
__device__ __forceinline__ bf16x8 cat8(s16x4 a, s16x4 b) { bf16x8 r; r[0] = a[0]; r[1] = a[1]; r[2] = a[2]; r[3] = a[3]; r[4] = b[0]; r[5] = b[1]; r[6] = b[2]; r[7] = b[3]; return r; }
__device__ __forceinline__ unsigned mbcnt64(unsigned long long m) { return __builtin_amdgcn_mbcnt_hi((unsigned)(m >> 32), __builtin_amdgcn_mbcnt_lo((unsigned)m, 0u)); }

#define XB_TMO      128
#define XB_XCNT(j)  (256  + 64 * (j))
#define XB_XSUB(j)  (1280 + 64 * (j))
#define XB_XGEN(j)  (2304 + 64 * (j))
#define XB_TOP      3328
#define XB_TOPGEN   3392
#define XCD_BAR_WORDS 3456
#define XB_SPIN_CAP (1u << 18)

__device__ __forceinline__ unsigned xb_ld(unsigned* p)              { return __hip_atomic_load(p, __ATOMIC_RELAXED, __HIP_MEMORY_SCOPE_AGENT); }
__device__ __forceinline__ unsigned xb_add(unsigned* p, unsigned v) { return __hip_atomic_fetch_add(p, v, __ATOMIC_RELAXED, __HIP_MEMORY_SCOPE_AGENT); }
__device__ __forceinline__ unsigned xb_xcc_id() { return (unsigned)__builtin_amdgcn_s_getreg((3 << 11) | 20) & 0xFu; }
#define XB_SPIN(cond, bar) do { unsigned _sp = 0; while (cond) { __builtin_amdgcn_s_sleep(1); \
    if ((++_sp & 255u) == 0u) { if (xb_ld(&(bar)[XB_TMO])) break; if (_sp > XB_SPIN_CAP) { atomicAdd(&(bar)[XB_TMO], 1u); break; } } } } while (0)

struct XcdBarrier {
    unsigned* bar; unsigned x;
    volatile LAS unsigned* st;
};

__device__ __forceinline__ XcdBarrier xcd_barrier_post(unsigned* bar, volatile LAS unsigned* st) {
    XcdBarrier b; b.bar = bar; b.x = xb_xcc_id(); b.st = st;
    if (threadIdx.x == 0) (void)xb_add(&bar[XB_XCNT(b.x)], 1u);
    return b;
}
__device__ __forceinline__ void xcd_barrier_complete(unsigned* bar, unsigned x, unsigned& nloc, unsigned& nx) {
    const unsigned G = gridDim.x * gridDim.y * gridDim.z;
    unsigned sum, cnt, mine, sp = 0u;
    for (;;) {
        sum = 0u; cnt = 0u; mine = 0u;
#pragma unroll
        for (unsigned j = 0; j < 16; ++j) { const unsigned c = xb_ld(&bar[XB_XCNT(j)]); sum += c; cnt += (c > 0u) ? 1u : 0u; mine = (j == x) ? c : mine; }
        if (sum == G) break;
        __builtin_amdgcn_s_sleep(1);
        if ((++sp & 255u) == 0u) { if (xb_ld(&bar[XB_TMO])) break; if (sp > XB_SPIN_CAP) { atomicAdd(&bar[XB_TMO], 1u); break; } }
    }
    nloc = mine > 0u ? mine : 1u; nx = cnt > 0u ? cnt : 1u;
}

__device__ __forceinline__ void xcd_barrier_census(const XcdBarrier& b) { unsigned nloc, nx; xcd_barrier_complete(b.bar, b.x, nloc, nx); b.st[0] = nloc; b.st[1] = nx; }
__device__ __forceinline__ void xcd_barrier(const XcdBarrier& b, const bool thread0  ) {
    asm volatile("s_waitcnt vmcnt(0)" ::: "memory");
    __syncthreads();
    if (thread0) {
        unsigned* bar = b.bar;
        __builtin_amdgcn_s_waitcnt(0);
        unsigned nloc = b.st[0], nx = b.st[1];
        const unsigned old = xb_add(&bar[XB_XSUB(b.x)], 1u);
        const unsigned gen = old / nloc;
        if (old + 1u == (gen + 1u) * nloc) {
            __builtin_amdgcn_fence(__ATOMIC_RELEASE, "agent");
            asm volatile("s_waitcnt vmcnt(0)" ::: "memory");
            const unsigned og = xb_add(&bar[XB_TOP], 1u);
            const unsigned tg = og / nx;
            if (og + 1u == (tg + 1u) * nx) xb_add(&bar[XB_TOPGEN], 1u);
            else XB_SPIN(xb_ld(&bar[XB_TOPGEN]) == tg, bar);
            __builtin_amdgcn_fence(__ATOMIC_ACQUIRE, "agent");
            xb_add(&bar[XB_XGEN(b.x)], 1u);
            asm volatile("s_waitcnt vmcnt(0)" ::: "memory");
        } else {
            XB_SPIN(xb_ld(&bar[XB_XGEN(b.x)]) == gen, bar);
            __builtin_amdgcn_fence(__ATOMIC_ACQUIRE, "agent");
            asm volatile("s_waitcnt vmcnt(0)" ::: "memory");
        }
    }
    __syncthreads();
}
struct LayerW { const float *norm_attn, *ada_w, *ada_b, *w_in, *kv_norm, *w_uk, *w_uv, *w_out, *norm_ffn, *w_gu, *w_down; };
struct Args { const float* x; const float* c; const float* final_norm; LayerW L[DEPTH]; float* out; unsigned char* ws; int ph_lo, ph_hi; };

__device__ __forceinline__ void colmax_item(const float* W, int N, unsigned* cmax, int item, int lane) {
    const int nnb = (N + 255) / 256, kb = item / nnb, nb = item % nnb, col = 256 * nb + 4 * lane;
    if (col < N) { const float* p = W + (size_t)(64 * kb) * N + col; f32x4 m = (f32x4){0.f, 0.f, 0.f, 0.f};
#pragma unroll 8
        for (int kk = 0; kk < 64; ++kk) { const f32x4 v = *(const f32x4*)(p + (size_t)kk * N); m[0] = fmaxf(m[0], fabsf(v[0])); m[1] = fmaxf(m[1], fabsf(v[1])); m[2] = fmaxf(m[2], fabsf(v[2])); m[3] = fmaxf(m[3], fabsf(v[3])); }
#pragma unroll
        for (int j = 0; j < 4; ++j) atomicMax(cmax + col + j, __float_as_uint(m[j])); }
}
constexpr int CI_INA = (D / 64) * (NIN_A / 256), CI_INB = I8_DSA ? (D / 64) * ((NIN_B + 255) / 256) : 0, CI_GU = (D / 64) * (2 * DFF / 256), CI_DN = (DFF / 64) * (D / 256), CI_OUT = OUT_MODE ? (D / 64) * (D / 256) : 0;
constexpr int CI_DIL = CI_INA + CI_GU + CI_DN + CI_OUT, CI_DSA = CI_INB + CI_GU + CI_DN + CI_OUT, CI_ALL = 2 * CI_DIL + 2 * CI_DSA;
__device__ __forceinline__ void p0_colmax(const Args& a, int gw, int NGW, int lane) {
    unsigned* cm = (unsigned*)(as_global(a.ws) + WS_CTL + CTL_CMAX);
    for (int it = gw; it < CI_ALL; it += NGW) {
        int r = it; int l;
        if (r < CI_DIL) l = 0; else { r -= CI_DIL; if (r < CI_DSA) l = 1; else { r -= CI_DSA; if (r < CI_DIL) l = 2; else { r -= CI_DIL; l = 3; } } }
        const LayerW& w = a.L[l]; unsigned* cml = cm + l * CM_LAYER; const int nin = (l & 1) ? NIN_B : NIN_A, ci_in = (l & 1) ? CI_INB : CI_INA;
        if (r < ci_in) colmax_item(as_global(w.w_in), nin, cml, r, lane); else if (r < ci_in + CI_GU) colmax_item(as_global(w.w_gu), 2 * DFF, cml + CM_GU, r - ci_in, lane); else if (r < ci_in + CI_GU + CI_DN) colmax_item(as_global(w.w_down), D, cml + CM_DN, r - ci_in - CI_GU, lane); else colmax_item(as_global(w.w_out), D, cml + CM_OUT, r - ci_in - CI_GU - CI_DN, lane);
    }
}
constexpr int TSCR = 64 * 65 * 4;
struct TrItem { const float* W; int ldw, srccol0, nvalid, k0, K, destrow0, mode; void* WT; const unsigned* cmax; float* sB; LAS const float* cml; };
__device__ __forceinline__ void tr_load(const TrItem& T, int lane, f32x4 (&v)[16]) {
    const int c4 = lane & 15, r4 = lane >> 4; const bool ok = 4 * c4 < T.nvalid; const float* p = T.W + (size_t)(T.k0 + r4) * T.ldw + T.srccol0 + 4 * c4;
#pragma unroll
    for (int it = 0; it < 16; ++it) { v[it] = (f32x4){0.f, 0.f, 0.f, 0.f}; if (ok) v[it] = *(const f32x4*)(p + (size_t)(4 * it) * T.ldw); }
}
__device__ __forceinline__ void tr_fill(LAS float* scr, int lane, const f32x4 (&v)[16]) {
    const int c4 = lane & 15, r4 = lane >> 4;
#pragma unroll
    for (int it = 0; it < 16; ++it) { LAS float* d = scr + (4 * it + r4) * 65 + 4 * c4; d[0] = v[it][0]; d[1] = v[it][1]; d[2] = v[it][2]; d[3] = v[it][3]; }
}
__device__ __forceinline__ void tr_emit(const TrItem& T, LAS float* scr, int lane) {
    const int q = lane & 3, rr = lane >> 2;
#pragma unroll
    for (int j = 0; j < 4; ++j) { const int n = rr + 16 * j; const LAS float* sp = scr + (16 * q) * 65 + n; float v[16];
#pragma unroll
        for (int e = 0; e < 16; ++e) v[e] = sp[e * 65];
        if (T.mode == 2) { const float cmx = (n < T.nvalid) ? (T.cml ? T.cml[n] : __uint_as_float(T.cmax[T.srccol0 + n])) : 0.f; const float inv = cmx > 0.f ? 256.0f / cmx : 0.f; unsigned w[4];
#pragma unroll
            for (int e = 0; e < 4; ++e) { unsigned ww = 0u; ww = __builtin_amdgcn_cvt_pk_fp8_f32(v[4 * e] * inv, v[4 * e + 1] * inv, ww, false); ww = __builtin_amdgcn_cvt_pk_fp8_f32(v[4 * e + 2] * inv, v[4 * e + 3] * inv, ww, true); w[e] = ww; }
            *(v4u*)((signed char*)T.WT + (size_t)(T.destrow0 + n) * T.K + T.k0 + 16 * q) = (v4u){w[0], w[1], w[2], w[3]}; }
        else if (T.mode) { const float cmx = (n < T.nvalid) ? (T.cml ? T.cml[n] : __uint_as_float(T.cmax[T.srccol0 + n])) : 0.f; const float inv = cmx > 0.f ? 127.0f / cmx : 0.f; unsigned b[16];
#pragma unroll
            for (int e = 0; e < 16; ++e) b[e] = (unsigned)(int)rintf(v[e] * inv) & 0xFFu;
            v4u o; o.x = b[0] | (b[1] << 8) | (b[2] << 16) | (b[3] << 24); o.y = b[4] | (b[5] << 8) | (b[6] << 16) | (b[7] << 24); o.z = b[8] | (b[9] << 8) | (b[10] << 16) | (b[11] << 24); o.w = b[12] | (b[13] << 8) | (b[14] << 16) | (b[15] << 24);
            *(v4u*)((signed char*)T.WT + (size_t)(T.destrow0 + n) * T.K + T.k0 + 16 * q) = o; }
        else { v4u o0, o1; o0.x = cvtpk(v[0], v[1]); o0.y = cvtpk(v[2], v[3]); o0.z = cvtpk(v[4], v[5]); o0.w = cvtpk(v[6], v[7]); o1.x = cvtpk(v[8], v[9]); o1.y = cvtpk(v[10], v[11]); o1.z = cvtpk(v[12], v[13]); o1.w = cvtpk(v[14], v[15]);
            bf16* dp = (bf16*)T.WT + (size_t)(T.destrow0 + n) * T.K + T.k0 + 16 * q; *(v4u*)dp = o0; *(v4u*)(dp + 8) = o1; } }
    if (T.mode && T.k0 == 0 && !T.cml) T.sB[T.destrow0 + lane] = (lane < T.nvalid) ? __uint_as_float(T.cmax[T.srccol0 + lane]) * (T.mode == 2 ? (1.0f / 256.0f) : (1.0f / 127.0f)) : 0.f;
}
__device__ __forceinline__ void tr_set(TrItem& T, const float* W, int K, int N, int Ndest, void* WT, int mode, const unsigned* cmax, float* sB, int item) {
    const int nnb = Ndest / 64, kb = item / nnb, nb = item % nnb, n0 = 64 * nb; int nv = N - n0; nv = nv < 0 ? 0 : (nv > 64 ? 64 : nv);
    T.W = W; T.ldw = N; T.srccol0 = n0; T.nvalid = nv; T.k0 = 64 * kb; T.K = K; T.destrow0 = n0; T.mode = mode; T.WT = WT; T.cmax = cmax; T.sB = sB; T.cml = nullptr;
}
constexpr int IT_INA = (D / 64) * (NIN_A / 64), IT_INB = (D / 64) * (NIN_BP / 64), IT_OUT = (D / 64) * (D / 64), IT_GU = (D / 64) * (2 * DFF / 64), IT_DN = (DFF / 64) * (D / 64), IT_UK = 16 * 8, IT_UV = 16 * 8;
constexpr int IT_DIL = IT_INA + IT_OUT + IT_GU + IT_DN, IT_DSA = IT_INB + IT_OUT + IT_GU + IT_DN + IT_UK + IT_UV;
constexpr int IT_ALL = 2 * IT_DIL + 2 * IT_DSA;
__device__ __forceinline__ void tr_decode(const Args& a, int it, TrItem& T) {
    int r = it; int l;
    if (r < IT_DIL) l = 0; else { r -= IT_DIL; if (r < IT_DSA) l = 1; else { r -= IT_DSA; if (r < IT_DIL) l = 2; else { r -= IT_DIL; l = 3; } } }
    const LayerW& w = a.L[l]; unsigned char* wb = as_global(a.ws) + WS_W + (size_t)l * W_LAYER;
    const unsigned* cml = (const unsigned*)(as_global(a.ws) + WS_CTL + CTL_CMAX) + l * CM_LAYER; float* sbl = (float*)(as_global(a.ws) + WS_SB) + l * CM_LAYER;
    if (!(l & 1)) { if (r < IT_INA) { tr_set(T, as_global(w.w_in), D, NIN_A, NIN_A, wb + WO_IN, I8_QKV, cml, sbl, r); return; } r -= IT_INA; }
    else { if (r < IT_INB) { tr_set(T, as_global(w.w_in), D, NIN_B, NIN_BP, wb + WO_IN, I8_DSA, cml, sbl, r); return; } r -= IT_INB; }
    if (r < IT_OUT) { tr_set(T, as_global(w.w_out), D, D, D, wb + WO_OUT, OUT_MODE, cml + CM_OUT, sbl + CM_OUT, r); return; } r -= IT_OUT;
    if (r < IT_GU) {
        const int nnb = (2 * DFF) / 64, kb = r / nnb, nb = r % nnb, n0 = 64 * nb, pn = n0 >> 8, lc = n0 & 255;
        T.W = as_global(w.w_gu); T.ldw = 2 * DFF; T.srccol0 = ((lc < 128) ? 0 : DFF) + 128 * pn + (lc & 127); T.nvalid = 64; T.k0 = 64 * kb; T.K = D; T.destrow0 = n0; T.mode = I8_GU; T.WT = wb + WO_GU; T.cmax = cml + CM_GU; T.sB = sbl + CM_GU; T.cml = nullptr; return; }
    r -= IT_GU;
    if (r < IT_DN) { tr_set(T, as_global(w.w_down), DFF, D, D, wb + WO_DN, DN_MODE, cml + CM_DN, sbl + CM_DN, r); return; } r -= IT_DN;
    if (r < IT_UK) { const int h = r >> 3; tr_set(T, as_global(w.w_uk) + (size_t)h * HD * KVL, HD, KVL, KVL, (bf16*)(wb + WO_UK) + (size_t)h * KVL * HD, 0, cml, sbl, r & 7); return; } r -= IT_UK;
    { const int h = r >> 3; tr_set(T, as_global(w.w_uv) + (size_t)h * KVL * HD, KVL, HD, HD, (bf16*)(wb + WO_UV) + (size_t)h * HD * KVL, 0, cml, sbl, r & 7); }
}
__device__ __forceinline__ void p0_transposes(const Args& a, LAS unsigned char* lds, int gw, int NGW, int wave, int lane) {
    LAS float* scr = (LAS float*)(lds + wave * TSCR);
    int it = gw; if (it >= IT_ALL) return;
    TrItem T, Tn; f32x4 v[16];
    tr_decode(a, it, T); tr_load(T, lane, v);
    for (;;) {
        tr_fill(scr, lane, v);
        LDS_WAIT(); asm volatile("" ::: "memory");
        const int itn = it + NGW; const bool has = itn < IT_ALL;
        tr_decode(a, has ? itn : it, Tn); tr_load(Tn, lane, v);
        tr_emit(T, scr, lane);
        LDS_WAIT(); asm volatile("" ::: "memory");
        if (!has) break;
        it = itn; T = Tn;
    }
}
constexpr int ST_INA = NIN_A / 64, ST_INB = NIN_BP / 64, ST_OUT = D / 64, ST_GU = 2 * DFF / 64, ST_DN = D / 64;
constexpr int ST_DIL = (I8_QKV ? ST_INA : 0) + (OUT_MODE ? ST_OUT : 0) + (I8_GU ? ST_GU : 0) + (DN_MODE ? ST_DN : 0), ST_DSA = (I8_DSA ? ST_INB : 0) + (OUT_MODE ? ST_OUT : 0) + (I8_GU ? ST_GU : 0) + (DN_MODE ? ST_DN : 0);
constexpr int ST_ALL = 2 * ST_DIL + 2 * ST_DSA;
__device__ __forceinline__ void strip_decode(const Args& a, int sidx, TrItem& T) {
    int r = sidx; int l;
    if (DN_MODE && r < 4 * ST_DN) { l = r / ST_DN; r = r % ST_DN; const LayerW& w = a.L[l]; unsigned char* wb = as_global(a.ws) + WS_W + (size_t)l * W_LAYER; float* sbl = (float*)(as_global(a.ws) + WS_SB) + l * CM_LAYER;
        T.W = as_global(w.w_down); T.ldw = D; T.srccol0 = 64 * r; T.nvalid = 64; T.K = DFF; T.destrow0 = 64 * r; T.mode = DN_MODE; T.WT = wb + WO_DN; T.cmax = nullptr; T.sB = sbl + CM_DN; return; }
    if (DN_MODE) r -= 4 * ST_DN;
    const int per_dil = ST_DIL - (DN_MODE ? ST_DN : 0), per_dsa = ST_DSA - (DN_MODE ? ST_DN : 0);
    if (r < per_dil) l = 0; else { r -= per_dil; if (r < per_dsa) l = 1; else { r -= per_dsa; if (r < per_dil) l = 2; else { r -= per_dil; l = 3; } } }
    const LayerW& w = a.L[l]; unsigned char* wb = as_global(a.ws) + WS_W + (size_t)l * W_LAYER; float* sbl = (float*)(as_global(a.ws) + WS_SB) + l * CM_LAYER;
    const bool dsa = l & 1; const int st_in = dsa ? (I8_DSA ? ST_INB : 0) : (I8_QKV ? ST_INA : 0);
    T.cmax = nullptr; T.K = D;
    if (r < st_in) { const int N = dsa ? NIN_B : NIN_A; int nv = N - 64 * r; nv = nv < 0 ? 0 : (nv > 64 ? 64 : nv);
        T.W = as_global(w.w_in); T.ldw = N; T.srccol0 = 64 * r; T.nvalid = nv; T.destrow0 = 64 * r; T.mode = 1; T.WT = wb + WO_IN; T.sB = sbl; return; }
    r -= st_in;
    if (OUT_MODE && r < ST_OUT) { T.W = as_global(w.w_out); T.ldw = D; T.srccol0 = 64 * r; T.nvalid = 64; T.destrow0 = 64 * r; T.mode = OUT_MODE; T.WT = wb + WO_OUT; T.sB = sbl + CM_OUT; return; }
    if (OUT_MODE) r -= ST_OUT;
    { const int n0 = 64 * r, pn = n0 >> 8, lc = n0 & 255;
      T.W = as_global(w.w_gu); T.ldw = 2 * DFF; T.srccol0 = ((lc < 128) ? 0 : DFF) + 128 * pn + (lc & 127); T.nvalid = 64; T.destrow0 = n0; T.mode = 1; T.WT = wb + WO_GU; T.sB = sbl + CM_GU; }
}
__device__ __forceinline__ void p0_strips(const Args& a, LAS unsigned char* lds, int vcu, int G, int tid, int wave, int lane) {
    LAS float* scr = (LAS float*)(lds + wave * TSCR); LAS float* wm = (LAS float*)(lds + 8 * TSCR); LAS float* cmx = wm + 8 * 64;
    constexpr int ST_LONG = DN_MODE ? 4 * ST_DN : 0, ST_SHORT = ST_ALL - ST_LONG;
    const bool bal = (G == 256) && (ST_LONG == 128) && (ST_SHORT >= 1152);
    for (int i = 0;; ++i) {
        int sidx;
        if (bal) { if (vcu < 128) { if (i == 0) sidx = vcu; else if (i <= 3) sidx = ST_LONG + 3 * vcu + (i - 1); else break; }
                   else { const int c = vcu - 128; if (i < 6) sidx = ST_LONG + 384 + 6 * c + i; else if (i == 6 && 1152 + c < ST_SHORT) sidx = ST_LONG + 1152 + c; else break; } }
        else { sidx = vcu + i * G; if (sidx >= ST_ALL) break; }
        TrItem T; strip_decode(a, sidx, T); T.cml = cmx;
        const int nkb = T.K / 64; f32x4 v[16];
        f32x4 mx = (f32x4){0.f, 0.f, 0.f, 0.f};
        { int kb = wave; T.k0 = 64 * kb; if (kb < nkb) tr_load(T, lane, v);
          while (kb < nkb) { f32x4 m2 = (f32x4){0.f, 0.f, 0.f, 0.f};
#pragma unroll
              for (int it = 0; it < 16; ++it) { m2[0] = fmaxf(m2[0], fabsf(v[it][0])); m2[1] = fmaxf(m2[1], fabsf(v[it][1])); m2[2] = fmaxf(m2[2], fabsf(v[it][2])); m2[3] = fmaxf(m2[3], fabsf(v[it][3])); }
              const int kn = kb + 8; T.k0 = 64 * (kn < nkb ? kn : kb); tr_load(T, lane, v);
              mx[0] = fmaxf(mx[0], m2[0]); mx[1] = fmaxf(mx[1], m2[1]); mx[2] = fmaxf(mx[2], m2[2]); mx[3] = fmaxf(mx[3], m2[3]); kb = kn; } }
#pragma unroll
        for (int j = 0; j < 4; ++j) mx[j] = xmax32(xmax16(mx[j]));
        if (lane < 16) *(LAS f32x4*)(wm + wave * 64 + 4 * lane) = mx;
        __syncthreads();
        if (tid < 64) { float m = wm[tid];
#pragma unroll
            for (int w8 = 1; w8 < 8; ++w8) m = fmaxf(m, wm[w8 * 64 + tid]);
            cmx[tid] = m; T.sB[T.destrow0 + tid] = (tid < T.nvalid) ? m * (T.mode == 2 ? (1.0f / 256.0f) : (1.0f / 127.0f)) : 0.f; }
        __syncthreads();
        { int kb = wave; if (kb < nkb) { T.k0 = 64 * kb; tr_load(T, lane, v);
            for (;;) { tr_fill(scr, lane, v); LDS_WAIT(); asm volatile("" ::: "memory");
                const int kn = kb + 8; TrItem Tn = T; Tn.k0 = 64 * (kn < nkb ? kn : kb); tr_load(Tn, lane, v);
                tr_emit(T, scr, lane); LDS_WAIT(); asm volatile("" ::: "memory");
                if (kn >= nkb) break; kb = kn; T.k0 = 64 * kb; } } }
        __syncthreads();
    }
}
__device__ __forceinline__ void p0_bf16_items(const Args& a, LAS unsigned char* lds, int gw, int NGW, int wave, int lane) {
    LAS float* scr = (LAS float*)(lds + wave * TSCR); f32x4 v[16];
    for (int it = gw; it < IT_ALL; it += NGW) { TrItem T; tr_decode(a, it, T); if (T.mode != 0) continue;
        tr_load(T, lane, v); tr_fill(scr, lane, v); LDS_WAIT(); asm volatile("" ::: "memory"); tr_emit(T, scr, lane); LDS_WAIT(); asm volatile("" ::: "memory"); }
}
constexpr int SC_STRIDE = 2112;
__device__ __forceinline__ void p0_adaln(const Args& a, LAS unsigned char* lds, int G, int tid, int wave, int lane) {
    LAS float* sc = (LAS float*)lds;
    LAS float* red = (LAS float*)(lds + 8 * SC_STRIDE * 4);
    float* mod = (float*)(as_global(a.ws) + WS_MOD); const float* cin = as_global(a.c);
    for (int i = tid; i < BATCH * D; i += NWAVES * 64) { const int b = i >> 11, k = i & 2047; const float v = cin[i]; sc[b * SC_STRIDE + k + (k >> 6)] = v / (1.0f + __expf(-v)); }
    __syncthreads();
    const int cg = tid & 15, ks = tid >> 4;
    for (int u = blockIdx.x; u < DEPTH * (NMOD / 64); u += G) {
        const int l = u / (NMOD / 64), col0 = 64 * (u % (NMOD / 64));
        const float* wp = as_global(a.L[l].ada_w) + (size_t)(64 * ks) * NMOD + col0 + 4 * cg;
        f32x4 acc[8];
#pragma unroll
        for (int b = 0; b < 8; ++b) acc[b] = (f32x4){0.f, 0.f, 0.f, 0.f};
#pragma unroll 4
        for (int kk = 0; kk < 64; ++kk) { const f32x4 w4 = *(const f32x4*)(wp + (size_t)kk * NMOD); const int kx = 64 * ks + kk + ks;
#pragma unroll
            for (int b = 0; b < 8; ++b) acc[b] += sc[b * SC_STRIDE + kx] * w4; }
#pragma unroll
        for (int b = 0; b < 8; ++b)
#pragma unroll
            for (int j = 0; j < 4; ++j) { acc[b][j] = xsum32(xsum16(acc[b][j])); }
        if (lane < 16) {
#pragma unroll
            for (int b = 0; b < 8; ++b) *(LAS f32x4*)(red + (wave * 8 + b) * 64 + 4 * cg) = acc[b]; }
        __syncthreads();
        { const int b = tid >> 6, col = tid & 63; float s = as_global(a.L[l].ada_b)[col0 + col];
#pragma unroll
          for (int w = 0; w < 8; ++w) s += red[(w * 8 + b) * 64 + col];
          mod[((size_t)l * BATCH + b) * NMOD + col0 + col] = s; }
        __syncthreads();
    }
}
__device__ __forceinline__ void ld8(const void* base, int is_f32, size_t idx, f32x4& a, f32x4& b) {
    if (is_f32) { const float* p = (const float*)base + idx; a = *(const f32x4*)p; b = *(const f32x4*)(p + 4); }
    else { const v4u w = *(const v4u*)((const bf16*)base + idx); a = (f32x4){__uint_as_float(w.x << 16), __uint_as_float(w.x & 0xFFFF0000u), __uint_as_float(w.y << 16), __uint_as_float(w.y & 0xFFFF0000u)};
        b = (f32x4){__uint_as_float(w.z << 16), __uint_as_float(w.z & 0xFFFF0000u), __uint_as_float(w.w << 16), __uint_as_float(w.w & 0xFFFF0000u)}; }
}
__device__ __forceinline__ void norm_mod_phase(const void* x, int xf32, const float* gain, const float* shift, const float* scale, bf16* h, int gw, int NGW, int lane) {
    for (int grp = gw; grp < M / 8; grp += NGW) {
        const int b = (grp * 8) >> 11;
        f32x4 A[8], B[8];
#pragma unroll
        for (int j = 0; j < 4; ++j)
#pragma unroll
            for (int e = 0; e < 2; ++e) { const int col = 8 * lane + 512 * j + 4 * e;
                const f32x4 g = *(const f32x4*)(gain + col), sc = *(const f32x4*)(scale + (size_t)b * NMOD + col); A[2 * j + e] = g * (sc + 1.0f); B[2 * j + e] = *(const f32x4*)(shift + (size_t)b * NMOD + col); }
        for (int rr = 0; rr < 8; ++rr) { const size_t row = (size_t)grp * 8 + rr;
            f32x4 v[8]; float ss = 0.f;
#pragma unroll
            for (int j = 0; j < 4; ++j) { ld8(x, xf32, row * D + 8 * lane + 512 * j, v[2 * j], v[2 * j + 1]);
#pragma unroll
                for (int e = 0; e < 2; ++e) { const f32x4 t = v[2 * j + e]; ss += (t[0] * t[0] + t[1] * t[1]) + (t[2] * t[2] + t[3] * t[3]); } }
            const float rstd = __builtin_amdgcn_rsqf(wave_sum(ss) * (1.0f / D) + EPS);
#pragma unroll
            for (int j = 0; j < 4; ++j) { const f32x4 y0 = v[2 * j] * rstd * A[2 * j] + B[2 * j], y1 = v[2 * j + 1] * rstd * A[2 * j + 1] + B[2 * j + 1];
                v4u o; o.x = cvtpk(y0[0], y0[1]); o.y = cvtpk(y0[2], y0[3]); o.z = cvtpk(y1[0], y1[1]); o.w = cvtpk(y1[2], y1[3]);
                *(v4u*)(h + row * D + 8 * lane + 512 * j) = o; }
        }
    }
}

__device__ __forceinline__ void norm_mod_phase_q(const void* x, int xf32, const float* gain, const float* shift, const float* scale, signed char* h, float* sA, unsigned* rmax0, int gw, int NGW, int lane) {
    for (int grp = gw; grp < M / 8; grp += NGW) {
        const int b = (grp * 8) >> 11;
        f32x4 A[8], B[8];
#pragma unroll
        for (int j = 0; j < 4; ++j)
#pragma unroll
            for (int e = 0; e < 2; ++e) { const int col = 8 * lane + 512 * j + 4 * e;
                const f32x4 g = *(const f32x4*)(gain + col), sc = *(const f32x4*)(scale + (size_t)b * NMOD + col); A[2 * j + e] = g * (sc + 1.0f); B[2 * j + e] = *(const f32x4*)(shift + (size_t)b * NMOD + col); }
        v4u pk[4][4];
#pragma unroll
        for (int rr = 0; rr < 8; ++rr) { const size_t row = (size_t)grp * 8 + rr;
            if (!xf32 && (rr & 3) == 0) {
#pragma unroll
                for (int r4 = 0; r4 < 4; ++r4)
#pragma unroll
                    for (int j = 0; j < 4; ++j) pk[r4][j] = *(const v4u*)((const bf16*)x + (row + r4) * D + 8 * lane + 512 * j); }
            f32x4 v[8]; float ss = 0.f;
#pragma unroll
            for (int j = 0; j < 4; ++j) { if (xf32) ld8(x, 1, row * D + 8 * lane + 512 * j, v[2 * j], v[2 * j + 1]);
                else { const v4u w = pk[rr & 3][j]; v[2 * j] = (f32x4){__uint_as_float(w.x << 16), __uint_as_float(w.x & 0xFFFF0000u), __uint_as_float(w.y << 16), __uint_as_float(w.y & 0xFFFF0000u)};
                    v[2 * j + 1] = (f32x4){__uint_as_float(w.z << 16), __uint_as_float(w.z & 0xFFFF0000u), __uint_as_float(w.w << 16), __uint_as_float(w.w & 0xFFFF0000u)}; }
#pragma unroll
                for (int e = 0; e < 2; ++e) { const f32x4 t = v[2 * j + e]; ss += (t[0] * t[0] + t[1] * t[1]) + (t[2] * t[2] + t[3] * t[3]); } }
            const float rstd = __builtin_amdgcn_rsqf(wave_sum(ss) * (1.0f / D) + EPS);
            float amax = 0.f;
#pragma unroll
            for (int j = 0; j < 8; ++j) { v[j] = v[j] * rstd * A[j] + B[j]; amax = fmaxf(fmaxf(amax, fmaxf(fabsf(v[j][0]), fabsf(v[j][1]))), fmaxf(fabsf(v[j][2]), fabsf(v[j][3]))); }
            amax = wave_max(amax);
            const float inv = amax > 0.f ? 127.0f / amax : 0.f;
#pragma unroll
            for (int j = 0; j < 4; ++j) { unsigned q[8];
#pragma unroll
                for (int e = 0; e < 4; ++e) { q[e] = (unsigned)(int)rintf(v[2 * j][e] * inv) & 0xFFu; q[4 + e] = (unsigned)(int)rintf(v[2 * j + 1][e] * inv) & 0xFFu; }
                v2u o; o.x = q[0] | (q[1] << 8) | (q[2] << 16) | (q[3] << 24); o.y = q[4] | (q[5] << 8) | (q[6] << 16) | (q[7] << 24);
                *(v2u*)(h + row * D + 8 * lane + 512 * j) = o; }
            if (lane == 0) { sA[row] = amax * (1.0f / 127.0f); if (rmax0) rmax0[row] = 0u; }
        }
    }
}

__device__ __forceinline__ void aq_load(const bf16* act, int row, int lane, v4u (&w)[11]) { const bf16* ar = act + (size_t)row * DFF + 8 * lane;
#pragma unroll
    for (int it = 0; it < 11; ++it) w[it] = *(const v4u*)(ar + 512 * it); }
__device__ __forceinline__ void aq_emit(const v4u (&w)[11], float mx, signed char* q, float* sA2, int row, int lane) {
    const float inv = mx > 0.f ? 127.0f / mx : 0.f; signed char* qr = q + (size_t)row * DFF + 8 * lane;
#pragma unroll
    for (int it = 0; it < 11; ++it) { unsigned o[8];
#pragma unroll
        for (int e = 0; e < 4; ++e) { const unsigned ww = w[it][e]; float lo = __uint_as_float(ww << 16) * inv, hi = __uint_as_float(ww & 0xFFFF0000u) * inv;
            lo = fminf(fmaxf(rintf(lo), -127.f), 127.f); hi = fminf(fmaxf(rintf(hi), -127.f), 127.f); o[2 * e] = (unsigned)(int)lo & 0xFFu; o[2 * e + 1] = (unsigned)(int)hi & 0xFFu; }
        v2u ov; ov.x = o[0] | (o[1] << 8) | (o[2] << 16) | (o[3] << 24); ov.y = o[4] | (o[5] << 8) | (o[6] << 16) | (o[7] << 24);
        *(v2u*)(qr + 512 * it) = ov; }
    if (lane == 0) sA2[row] = mx * (1.0f / 127.0f);
}
__device__ __forceinline__ void act_quant_phase(const bf16* act, const unsigned* rmax, signed char* q, float* sA2, int gw, int NGW, int lane) {
    int row = gw; if (row >= M) return;
    v4u wa[11], wb2[11]; float ma = __uint_as_float(rmax[row]); aq_load(act, row, lane, wa);
    for (;;) {
        const int r1 = row + NGW; const bool h1 = r1 < M; const int r1c = h1 ? r1 : row;
        const float mb = __uint_as_float(rmax[r1c]); aq_load(act, r1c, lane, wb2);
        aq_emit(wa, ma, q, sA2, row, lane);
        if (!h1) break;
        const int r2 = r1 + NGW; const bool h2 = r2 < M; const int r2c = h2 ? r2 : r1;
        ma = __uint_as_float(rmax[r2c]); aq_load(act, r2c, lane, wa);
        aq_emit(wb2, mb, q, sA2, r1, lane);
        if (!h2) break;
        row = r2;
    }
}
__device__ __forceinline__ void final_norm_phase(const bf16* x, float* out, const float* gain, int gw, int NGW, int lane) {
    f32x4 gv[8];
#pragma unroll
    for (int j = 0; j < 4; ++j)
#pragma unroll
        for (int e = 0; e < 2; ++e) gv[2 * j + e] = *(const f32x4*)(gain + 8 * lane + 512 * j + 4 * e);
    for (int grp = gw; grp < M / 4; grp += NGW) {
        v4u pk[4][4];
#pragma unroll
        for (int r4 = 0; r4 < 4; ++r4)
#pragma unroll
            for (int j = 0; j < 4; ++j) pk[r4][j] = *(const v4u*)(x + ((size_t)grp * 4 + r4) * D + 8 * lane + 512 * j);
#pragma unroll
        for (int r4 = 0; r4 < 4; ++r4) { const size_t row = (size_t)grp * 4 + r4;
            f32x4 v[8]; float ss = 0.f;
#pragma unroll
            for (int j = 0; j < 4; ++j) { const v4u w = pk[r4][j]; v[2 * j] = (f32x4){__uint_as_float(w.x << 16), __uint_as_float(w.x & 0xFFFF0000u), __uint_as_float(w.y << 16), __uint_as_float(w.y & 0xFFFF0000u)};
                v[2 * j + 1] = (f32x4){__uint_as_float(w.z << 16), __uint_as_float(w.z & 0xFFFF0000u), __uint_as_float(w.w << 16), __uint_as_float(w.w & 0xFFFF0000u)};
#pragma unroll
                for (int e = 0; e < 2; ++e) { const f32x4 t = v[2 * j + e]; ss += (t[0] * t[0] + t[1] * t[1]) + (t[2] * t[2] + t[3] * t[3]); } }
            const float rstd = __builtin_amdgcn_rsqf(wave_sum(ss) * (1.0f / D) + EPS); float* orow = out + row * D;
#pragma unroll
            for (int j = 0; j < 4; ++j)
#pragma unroll
                for (int e = 0; e < 2; ++e) *(f32x4*)(orow + 8 * lane + 512 * j + 4 * e) = v[2 * j + e] * rstd * gv[2 * j + e]; }
    }
}
constexpr int VROW = 272, VROW2 = 288;
constexpr int KV_LDS = 256 * VROW;
struct BAUnit { int b, h, qbase, qstride, kbase, kstride, first, dil; };
__device__ __forceinline__ BAUnit ba_decode(int pass, int u) {
    BAUnit U; const int bh = u >> 4, s = u & 15; U.b = bh >> 4; U.h = bh & 15;
    if (pass == 0) { U.qbase = 128 * s; U.qstride = 1; U.kbase = 128 * s - 128; U.kstride = 1; U.first = (s == 0); U.dil = 1; }
    else if (pass == 1) { const int rho = s >> 2, n = s & 3; U.qbase = 512 * n + rho; U.qstride = 4; U.kbase = 512 * n - 512 + rho; U.kstride = 4; U.first = (n == 0); U.dil = 4; }
    else { U.qbase = s; U.qstride = 16; U.kbase = s - 2048; U.kstride = 16; U.first = 1; U.dil = 16; }
    return U;
}
template <bool HALF = false> __device__ __forceinline__ void ba_load(const BAUnit& U, const bf16* K, const bf16* V, int tid, v4u (&kr)[8], v4u (&vr)[8]) {
    const int c = tid & 15, r0 = tid >> 4;
#pragma unroll
    for (int it = HALF ? 4 : 0; it < 8; ++it) { const int j = r0 + 32 * it; int p = U.kbase + U.kstride * j; p = p < 0 ? 0 : p;
        const size_t off = ((size_t)U.b * SEQ + p) * D + U.h * HD + 8 * c;
        kr[it] = *(const v4u*)(K + off); vr[it] = *(const v4u*)(V + off); }
}
template <bool HALF = false> __device__ __forceinline__ void ba_store(LAS unsigned char* lds, int tid, const v4u (&kr)[8], const v4u (&vr)[8]) {
    const int c = tid & 15, r0 = tid >> 4;
#pragma unroll
    for (int it = HALF ? 4 : 0; it < 8; ++it) { const int j = r0 + 32 * it; *(LAS v4u*)(lds + j * VROW + 16 * c) = kr[it]; *(LAS v4u*)(lds + KV_LDS + j * VROW2 + 16 * c) = vr[it]; }
}
__device__ __forceinline__ void ba_qload(const BAUnit& U, const bf16* Q, int w, int lane, bf16x8 (&qf)[4]) {
    const int i = lane & 15, g = lane >> 4, qi = 16 * w + i; const size_t qrow = (size_t)U.b * SEQ + U.qbase + U.qstride * qi;
#pragma unroll
    for (int kk = 0; kk < 4; ++kk) qf[kk] = *(const bf16x8*)(Q + qrow * D + U.h * HD + 32 * kk + 8 * g);
}
template <bool FUSED> __device__ __forceinline__ void ba_compute(const BAUnit& U, int pass, bf16x8 (&qf)[4], bf16* O, float* LSE, LAS unsigned char* lds, int w, int lane, unsigned* waitc, const v2u (&ppre)[8], float lpre, const BAUnit& Un, const bf16* Qn, unsigned char* O8 = nullptr) {
    const int i = lane & 15, g = lane >> 4, qi = 16 * w + i; const size_t qrow = (size_t)U.b * SEQ + U.qbase + U.qstride * qi;
    const float sl = __builtin_amdgcn_exp2f(-0.5f * (float)(U.h + 1)) * LOG2E * (float)U.dil;
    const int d0 = U.first ? (8 - w) : 0;
    f32x4 s[10];
#pragma unroll
    for (int d = 0; d < 9; ++d) { f32x4 acc = (f32x4){0.f, 0.f, 0.f, 0.f};
        if (d >= d0) { const LAS unsigned char* kp = lds + (16 * (w + d) + i) * VROW + 16 * g;
#pragma unroll
            for (int kk = 0; kk < 4; ++kk) { const bf16x8 kf = *(const LAS bf16x8*)(kp + 64 * kk); acc = __builtin_amdgcn_mfma_f32_16x16x32_bf16(kf, qf[kk], acc, 0, 0, 0); } }
        s[d] = acc; }
    if (Qn) ba_qload(Un, Qn, w, lane, qf);
    float cmax = -1e30f;
#pragma unroll
    for (int d = 0; d < 9; ++d)
#pragma unroll
        for (int r = 0; r < 4; ++r) { const int rel = i - (4 * g + r) + 16 * (8 - d);
            const bool ok = (d >= d0) && (rel >= 0) && (rel <= 128);
            const float v = ok ? (s[d][r] - sl * (float)rel) : -INFINITY; s[d][r] = v; cmax = fmaxf(cmax, v); }
    cmax = xmax32(xmax16(cmax));
    const float m = cmax; float l = 0.f;
#pragma unroll
    for (int d = 0; d < 9; ++d)
#pragma unroll
        for (int r = 0; r < 4; ++r) { const float pv = __builtin_amdgcn_exp2f(s[d][r] - m); s[d][r] = pv; l += pv; }
    l = xsum32(xsum16(l));
    s[9] = (f32x4){0.f, 0.f, 0.f, 0.f};
    f32x4 o[8];
#pragma unroll
    for (int c = 0; c < 8; ++c) o[c] = (f32x4){0.f, 0.f, 0.f, 0.f};
#pragma unroll
    for (int dp = 0; dp < 10; dp += 2) {
        if (dp + 1 >= d0) {
            bf16x8 pf; { const v4u t = (v4u){cvtpk(s[dp][0], s[dp][1]), cvtpk(s[dp][2], s[dp][3]), cvtpk(s[dp + 1][0], s[dp + 1][1]), cvtpk(s[dp + 1][2], s[dp + 1][3])}; pf = __builtin_bit_cast(bf16x8, t); }
            int t0 = w + dp, t1 = w + dp + 1; t0 = t0 > 15 ? 15 : t0; t1 = t1 > 15 ? 15 : t1;
            const LAS unsigned char* vb0 = lds + KV_LDS + (16 * t0 + 4 * g + (i >> 2)) * VROW2 + 8 * (i & 3);
            const LAS unsigned char* vb1 = lds + KV_LDS + (16 * t1 + 4 * g + (i >> 2)) * VROW2 + 8 * (i & 3);
#pragma unroll
            for (int c = 0; c < 8; ++c) { const s16x4 lo = tr_read(vb0 + 32 * c), hi = tr_read(vb1 + 32 * c); o[c] = __builtin_amdgcn_mfma_f32_16x16x32_bf16(cat8(lo, hi), pf, o[c], 0, 0, 0); }
        }
    }
    float inv = 1.0f / l; float lse = m + __builtin_amdgcn_logf(l);
    bf16* op = O + qrow * D + U.h * HD + 4 * g; float* lp = LSE + qrow * NH + U.h;
    if (FUSED && pass > 0) {
        if (threadIdx.x == 0) { unsigned sp = 0; while (__hip_atomic_load(waitc, RLX_AGENT) < 16u) { __builtin_amdgcn_s_sleep(2); if (++sp > (1u << 22)) break; }
            __builtin_amdgcn_fence(__ATOMIC_ACQUIRE, "agent"); asm volatile("s_waitcnt vmcnt(0)" ::: "memory"); }
        __syncthreads(); }
    if (pass > 0) { const float lprev = FUSED ? *lp : lpre; const float mx = fmaxf(lprev, lse); const float wa = __builtin_amdgcn_exp2f(lprev - mx), wb = __builtin_amdgcn_exp2f(lse - mx); const float wi = 1.0f / (wa + wb);
        const float fa = wa * wi, fb = wb * wi * inv;
#pragma unroll
        for (int c = 0; c < 8; ++c) { const v2u pw = FUSED ? *(const v2u*)(op + 16 * c) : ppre[c];
            const float p0 = __uint_as_float(pw.x << 16), p1 = __uint_as_float(pw.x & 0xFFFF0000u), p2 = __uint_as_float(pw.y << 16), p3 = __uint_as_float(pw.y & 0xFFFF0000u);
            o[c][0] = fa * p0 + fb * o[c][0]; o[c][1] = fa * p1 + fb * o[c][1]; o[c][2] = fa * p2 + fb * o[c][2]; o[c][3] = fa * p3 + fb * o[c][3]; }
        inv = 1.0f; lse = mx + __builtin_amdgcn_logf(wa + wb); }
#pragma unroll
    for (int c = 0; c < 8; ++c) { v2u w2; w2.x = cvtpk(o[c][0] * inv, o[c][1] * inv); w2.y = cvtpk(o[c][2] * inv, o[c][3] * inv);
        if (FUSED && pass < 2) __hip_atomic_store((unsigned long long*)(op + 16 * c), ((unsigned long long)w2.y << 32) | w2.x, RLX_AGENT);
        else if (pass == 2 && O8) { unsigned w8 = 0u; w8 = __builtin_amdgcn_cvt_pk_fp8_f32(o[c][0] * inv, o[c][1] * inv, w8, false); w8 = __builtin_amdgcn_cvt_pk_fp8_f32(o[c][2] * inv, o[c][3] * inv, w8, true);
            *(unsigned*)(O8 + qrow * D + U.h * HD + 4 * g + 16 * c) = w8; }
        else *(v2u*)(op + 16 * c) = w2; }
    if (pass < 2 && g == 0) { if (FUSED) __hip_atomic_store((unsigned*)lp, __float_as_uint(lse), RLX_AGENT); else *lp = lse; }
}
__device__ __forceinline__ void ba_pload(const BAUnit& U, const bf16* O, const float* LSE, int w, int lane, v2u (&pp)[8], float& lp) {
    const int i = lane & 15, g = lane >> 4, qi = 16 * w + i; const size_t qrow = (size_t)U.b * SEQ + U.qbase + U.qstride * qi;
    const bf16* op = O + qrow * D + U.h * HD + 4 * g;
#pragma unroll
    for (int c = 0; c < 8; ++c) pp[c] = *(const v2u*)(op + 16 * c);
    lp = LSE[qrow * NH + U.h];
}
template <int variant = 0, bool HALF = false  > __device__ __forceinline__ void dil_attn_pass(int pass, const bf16* Q, const bf16* K, const bf16* V, bf16* O, float* LSE, LAS unsigned char* lds, int vcu, int G, int tid, int wave, int lane, int u_lo = 0, int u_hi = BATCH * NH * 16, unsigned char* O8 = nullptr) {
    v4u kr[8], vr[8]; bf16x8 qf[4]; v2u pp[8]; float lp = 0.f;
#pragma unroll
    for (int c = 0; c < 8; ++c) pp[c] = (v2u){0u, 0u};
    int u = u_lo + vcu; const int NU = u_hi;
    if (u >= NU) return;
    BAUnit U = ba_decode(pass, u);
    ba_qload(U, Q, wave, lane, qf);
    ba_load<HALF>(U, K, V, tid, kr, vr);
    for (;;) {
        ba_store<HALF>(lds, tid, kr, vr);
        __syncthreads();
        const int un = u + G; const BAUnit Un = ba_decode(pass, un < NU ? un : u);
        if (pass > 0) ba_pload(U, O, LSE, wave, lane, pp, lp);
        asm volatile("" ::: "memory");
        ba_load<HALF>(Un, K, V, tid, kr, vr);
        ba_compute<false>(U, pass, qf, O, LSE, lds, wave, lane, nullptr, pp, lp, Un, Q, O8);
        __syncthreads();
        if (un >= NU) break;
        u = un; U = Un;
    }
}

__device__ __forceinline__ void dil_attn_fused(const bf16* Q, const bf16* K, const bf16* V, bf16* O, float* LSE, unsigned* cnt, LAS unsigned char* lds, int vcu, int G, int tid, int wave, int lane) {
    v4u kr[8], vr[8];
    const int team = vcu >> 4, sidx = vcu & 15, nteam = G >> 4, NBH = BATCH * NH;
    const int nit = ((NBH - team + nteam - 1) / nteam) * 3;
    if (nit <= 0) return;
    int it = 0; int bh = team, pass = 0;
    BAUnit U = ba_decode(pass, bh * 16 + sidx);
    ba_load(U, K, V, tid, kr, vr);
    for (;;) {
        ba_store(lds, tid, kr, vr);
        __syncthreads();
        bf16x8 qf[4]; ba_qload(U, Q, wave, lane, qf);
        asm volatile("" ::: "memory");
        const int itn = it + 1; int passn = pass + 1, bhn = bh; if (passn == 3) { passn = 0; bhn = bh + nteam; }
        const bool has = itn < nit;
        const BAUnit Un = ba_decode(has ? passn : pass, (has ? bhn : bh) * 16 + sidx); ba_load(Un, K, V, tid, kr, vr);
        { v2u ppd[8]; ba_compute<true>(U, pass, qf, O, LSE, lds, wave, lane, cnt + ((size_t)bh * 2 + (pass > 0 ? pass - 1 : 0)) * 16, ppd, 0.f, U, nullptr); }
        if (pass < 2) asm volatile("s_waitcnt vmcnt(0)" ::: "memory");
        __syncthreads();
        if (pass < 2 && tid == 0) __hip_atomic_fetch_add(cnt + ((size_t)bh * 2 + pass) * 16, 1u, RLX_AGENT);
        if (!has) break;
        it = itn; pass = passn; bh = bhn; U = Un;
    }
}

template <int KK  , int NT  , int TT  , bool OUT8 = false  >
__device__ __forceinline__ void head_gemm(const bf16* X, int ldx, int xcol0, const bf16* WT, bf16* Out, int ldo, int ocol0, int tok0, float scale, int lane) {
    const int i = lane & 15, g = lane >> 4;
    bf16x8 xf[TT][KK];
#pragma unroll
    for (int tt = 0; tt < TT; ++tt)
#pragma unroll
        for (int kk = 0; kk < KK; ++kk) xf[tt][kk] = *(const bf16x8*)(X + (size_t)(tok0 + 16 * tt + i) * ldx + xcol0 + 32 * kk + 8 * g);
    const bf16* wp = WT + (size_t)(8 * (i >> 2) + (i & 3)) * (32 * KK) + 8 * g;
    bf16x8 aA[2][KK], aB[2][KK];
#pragma unroll
    for (int h2 = 0; h2 < 2; ++h2)
#pragma unroll
        for (int kk = 0; kk < KK; ++kk) aA[h2][kk] = *(const bf16x8*)(wp + (size_t)(4 * h2) * (32 * KK) + 32 * kk);
#pragma unroll
    for (int tt = 0; tt < TT; ++tt)
#pragma unroll
        for (int kk = 0; kk < KK; ++kk) asm volatile("" : "+v"(xf[tt][kk]));
#define HG_PAIR(cur, nxt, p_) do { \
        _Pragma("unroll") for (int h2 = 0; h2 < 2; ++h2) _Pragma("unroll") for (int kk = 0; kk < KK; ++kk) asm volatile("" : "+v"(cur[h2][kk])); \
        if ((p_) + 1 < NT / 2) { _Pragma("unroll") for (int h2 = 0; h2 < 2; ++h2) _Pragma("unroll") for (int kk = 0; kk < KK; ++kk) nxt[h2][kk] = *(const bf16x8*)(wp + (size_t)(32 * ((p_) + 1) + 4 * h2) * (32 * KK) + 32 * kk); } \
        _Pragma("unroll") for (int tt = 0; tt < TT; ++tt) { f32x4 c0 = (f32x4){0.f, 0.f, 0.f, 0.f}, c1 = c0; \
            _Pragma("unroll") for (int kk = 0; kk < KK; ++kk) { c0 = __builtin_amdgcn_mfma_f32_16x16x32_bf16(cur[0][kk], xf[tt][kk], c0, 0, 0, 0); c1 = __builtin_amdgcn_mfma_f32_16x16x32_bf16(cur[1][kk], xf[tt][kk], c1, 0, 0, 0); } \
            const size_t oo = (size_t)(tok0 + 16 * tt + i) * ldo + ocol0 + 32 * (p_) + 8 * g; \
            if constexpr (OUT8) { unsigned w0 = 0u, w1 = 0u; w0 = __builtin_amdgcn_cvt_pk_fp8_f32(c0[0] * scale, c0[1] * scale, w0, false); w0 = __builtin_amdgcn_cvt_pk_fp8_f32(c0[2] * scale, c0[3] * scale, w0, true); \
                w1 = __builtin_amdgcn_cvt_pk_fp8_f32(c1[0] * scale, c1[1] * scale, w1, false); w1 = __builtin_amdgcn_cvt_pk_fp8_f32(c1[2] * scale, c1[3] * scale, w1, true); \
                *(v2u*)((unsigned char*)Out + oo) = (v2u){w0, w1}; } \
            else *(v4u*)(Out + oo) = (v4u){cvtpk(c0[0] * scale, c0[1] * scale), cvtpk(c0[2] * scale, c0[3] * scale), cvtpk(c1[0] * scale, c1[1] * scale), cvtpk(c1[2] * scale, c1[3] * scale)}; } } while (0)
    for (int p = 0; p < NT / 2; p += 2) { HG_PAIR(aA, aB, p); HG_PAIR(aB, aA, p + 1); }
#undef HG_PAIR
}
__device__ __forceinline__ void ckv_norm_phase(const float* raw, const float* gain, bf16* out, int gw, int NGW, int lane) {
    const f32x4 gv = *(const f32x4*)(gain + 4 * lane);
    for (int row = gw; row < M; row += NGW) { const f32x4 t = *(const f32x4*)(raw + (size_t)row * KVL + 4 * lane);
        const float ss = (t[0] * t[0] + t[1] * t[1]) + (t[2] * t[2] + t[3] * t[3]);
        const float rstd = __builtin_amdgcn_rsqf(wave_sum(ss) * (1.0f / KVL) + EPS); const f32x4 y = t * rstd * gv;
        v2u w2; w2.x = cvtpk(y[0], y[1]); w2.y = cvtpk(y[2], y[3]); *(v2u*)(out + (size_t)row * KVL + 4 * lane) = w2; }
}
constexpr int IX_KROW = 272, IX_KEYS = 256, IX_STAGE = IX_KEYS * IX_KROW, IX_SC_OFF = IX_STAGE;
__device__ __forceinline__ void ix_load(const bf16* KI, int b, int st, int tid, v4u (&kr)[8]) {
    const int c = tid & 15, r0 = tid >> 4;
#pragma unroll
    for (int it = 0; it < 8; ++it) kr[it] = *(const v4u*)(KI + ((size_t)b * SEQ + IX_KEYS * st + r0 + 32 * it) * 128 + 8 * c);
}
__device__ __forceinline__ void ix_store(LAS unsigned char* buf, int tid, const v4u (&kr)[8]) {
    const int c = tid & 15, r0 = tid >> 4;
#pragma unroll
    for (int it = 0; it < 8; ++it) *(LAS v4u*)(buf + (r0 + 32 * it) * IX_KROW + 16 * c) = kr[it];
}
__device__ __forceinline__ void ix_topk(const LAS u16* sc, u16* selr, int t, int lane) {
    if (t < TOPK) { for (int j = lane; j < TOPK; j += 64) selr[j] = (u16)(j <= t ? j : 0xFFFF); return; }
    const int ng = (t >> 9) + 1;
    unsigned key[32];
#pragma unroll
    for (int u = 0; u < 32; ++u) key[u] = 0u;
#pragma unroll
    for (int gq = 0; gq < 4; ++gq) if (gq < ng) {
#pragma unroll
        for (int u = 8 * gq; u < 8 * gq + 8; ++u) { const int idx = 64 * u + lane; const unsigned bits = sc[idx]; const unsigned k = (bits & 0x8000u) ? (~bits & 0xFFFFu) : (bits | 0x8000u); key[u] = (idx <= t) ? k : 0u; } }
    unsigned prefix = 0u;
    for (int bit = 15; bit >= 0; --bit) { const unsigned cand = prefix | (1u << bit); int cnt = 0;
#pragma unroll
        for (int gq = 0; gq < 4; ++gq) if (gq < ng) {
#pragma unroll
            for (int u = 8 * gq; u < 8 * gq + 8; ++u) cnt += __popcll(__ballot(key[u] >= cand)); }
        if (cnt >= TOPK) prefix = cand; }
    int cgt = 0;
#pragma unroll
    for (int gq = 0; gq < 4; ++gq) if (gq < ng) {
#pragma unroll
        for (int u = 8 * gq; u < 8 * gq + 8; ++u) cgt += __popcll(__ballot(key[u] > prefix)); }
    const int need_eq = TOPK - cgt; int base = 0, eqb = 0;
#pragma unroll
    for (int gq = 0; gq < 4; ++gq) if (gq < ng) {
#pragma unroll
        for (int u = 8 * gq; u < 8 * gq + 8; ++u) { const bool gt = key[u] > prefix, eq = key[u] == prefix; const unsigned long long meq = __ballot(eq);
            const bool take = gt || (eq && (int)(eqb + mbcnt64(meq)) < need_eq); const unsigned long long mt = __ballot(take);
            if (take) selr[base + mbcnt64(mt)] = (u16)(64 * u + lane);
            base += __popcll(mt); eqb += __popcll(meq); } }
}
__device__ __forceinline__ void dsa_index_unit(const bf16* QI, const bf16* KI, const float* WI, u16* SEL, LAS unsigned char* lds, int b, int qb, int tid, int w, int lane) {
    const int i = lane & 15, g = lane >> 4; const int t0 = 16 * qb + 2 * w;
    const size_t row0 = (size_t)b * SEQ + t0;
    LAS u16* sc0 = (LAS u16*)(lds + IX_SC_OFF + (2 * w) * 4096); LAS u16* sc1 = sc0 + 2048;
    bf16x8 a0[4], a1[4];
#pragma unroll
    for (int kk = 0; kk < 4; ++kk) { a0[kk] = *(const bf16x8*)(QI + row0 * D + i * 128 + 32 * kk + 8 * g); a1[kk] = *(const bf16x8*)(QI + (row0 + 1) * D + i * 128 + 32 * kk + 8 * g); }
    const f32x4 w0 = *(const f32x4*)(WI + row0 * 16 + 4 * g), w1 = *(const f32x4*)(WI + (row0 + 1) * 16 + 4 * g);
    const int nst = (16 * qb + 15) / IX_KEYS + 1;
    v4u kA[8], kB[8];
    ix_load(KI, b, 0, tid, kA); ix_load(KI, b, nst > 1 ? 1 : 0, tid, kB);
#define IX_STAGE_BODY(st_, kcur) do { \
        ix_store(lds, tid, kcur); \
        __syncthreads(); \
        { const int sn = (st_) + 2 < nst ? (st_) + 2 : nst - 1; ix_load(KI, b, sn, tid, kcur); } \
        int ntile = (t0 + 1 - IX_KEYS * (st_)) / 16 + 1; ntile = ntile > 16 ? 16 : ntile; \
        _Pragma("unroll 2") for (int tt = 0; tt < ntile; tt += 2) { const LAS unsigned char* kp = lds + (16 * tt + i) * IX_KROW + 16 * g; \
            f32x4 c0 = (f32x4){0.f, 0.f, 0.f, 0.f}, c1 = c0, e0 = c0, e1 = c0; \
            _Pragma("unroll") for (int kk = 0; kk < 4; ++kk) { const bf16x8 bfa = *(const LAS bf16x8*)(kp + 64 * kk), bfb = *(const LAS bf16x8*)(kp + 16 * IX_KROW + 64 * kk); \
                c0 = __builtin_amdgcn_mfma_f32_16x16x32_bf16(a0[kk], bfa, c0, 0, 0, 0); c1 = __builtin_amdgcn_mfma_f32_16x16x32_bf16(a1[kk], bfa, c1, 0, 0, 0); \
                e0 = __builtin_amdgcn_mfma_f32_16x16x32_bf16(a0[kk], bfb, e0, 0, 0, 0); e1 = __builtin_amdgcn_mfma_f32_16x16x32_bf16(a1[kk], bfb, e1, 0, 0, 0); } \
            float s0 = w0[0] * fmaxf(c0[0], 0.f) + w0[1] * fmaxf(c0[1], 0.f) + w0[2] * fmaxf(c0[2], 0.f) + w0[3] * fmaxf(c0[3], 0.f); \
            float s1 = w1[0] * fmaxf(c1[0], 0.f) + w1[1] * fmaxf(c1[1], 0.f) + w1[2] * fmaxf(c1[2], 0.f) + w1[3] * fmaxf(c1[3], 0.f); \
            float u0 = w0[0] * fmaxf(e0[0], 0.f) + w0[1] * fmaxf(e0[1], 0.f) + w0[2] * fmaxf(e0[2], 0.f) + w0[3] * fmaxf(e0[3], 0.f); \
            float u1 = w1[0] * fmaxf(e1[0], 0.f) + w1[1] * fmaxf(e1[1], 0.f) + w1[2] * fmaxf(e1[2], 0.f) + w1[3] * fmaxf(e1[3], 0.f); \
            s0 = xsum32(xsum16(s0)); s1 = xsum32(xsum16(s1)); u0 = xsum32(xsum16(u0)); u1 = xsum32(xsum16(u1)); \
            if (g == 0) { const int key = IX_KEYS * (st_) + 16 * tt + i; sc0[key] = __builtin_bit_cast(u16, (_Float16)s0); sc1[key] = __builtin_bit_cast(u16, (_Float16)s1); \
                          sc0[key + 16] = __builtin_bit_cast(u16, (_Float16)u0); sc1[key + 16] = __builtin_bit_cast(u16, (_Float16)u1); } } \
        __syncthreads();                                         \
    } while (0)
    for (int st = 0; st < nst; st += 2) { IX_STAGE_BODY(st, kA); if (st + 1 < nst) IX_STAGE_BODY(st + 1, kB); }
#undef IX_STAGE_BODY
    LDS_WAIT(); asm volatile("" ::: "memory");
#ifndef REPS4
#define REPS4 1
#endif
    for (int rk = 0; rk < REPS4; ++rk) {
    ix_topk(sc0, SEL + row0 * TOPK, t0, lane);
    ix_topk(sc1, SEL + (row0 + 1) * TOPK, t0 + 1, lane); }
    __syncthreads();
}
constexpr int CROW = 544;
constexpr int DSA_WAVE_LDS = 32 * CROW + 512;
__device__ __forceinline__ void dsa_attn_query(const bf16* QL, const bf16* CKV, const u16* SEL, bf16* OL, LAS unsigned char* wl, int b, int t, int lane) {
    const int i = lane & 15, g = lane >> 4; const size_t row = (size_t)b * SEQ + t;
    LAS u16* sl = (LAS u16*)(wl + 32 * CROW);
    *(LAS v2u*)(sl + 4 * lane) = *(const v2u*)(SEL + row * TOPK + 4 * lane);
    bf16x8 bq[8];
#pragma unroll
    for (int kk = 0; kk < 8; ++kk) bq[kk] = *(const bf16x8*)(QL + row * (NH * KVL) + i * KVL + 32 * kk + 8 * g);
    const float slope2 = __builtin_amdgcn_exp2f(-0.5f * (float)(i + 1)) * LOG2E;
    float m = -1e30f, l = 0.f; f32x4 o[16];
#pragma unroll
    for (int c = 0; c < 16; ++c) o[c] = (f32x4){0.f, 0.f, 0.f, 0.f};
    const int nvalid = (t + 1) < TOPK ? (t + 1) : TOPK, nch = (nvalid + 31) >> 5;
    const bf16* cb = CKV + (size_t)b * SEQ * KVL;
    LDS_WAIT(); asm volatile("" ::: "memory");
    v4u pre[16];
#pragma unroll
    for (int it = 0; it < 16; ++it) { const int r = 2 * it + (lane >> 5); unsigned key = sl[r]; key = (key == 0xFFFFu) ? 0u : key; pre[it] = *(const v4u*)(cb + (size_t)key * KVL + 8 * (lane & 31)); }
    for (int c = 0; c < nch; ++c) {
#pragma unroll
        for (int it = 0; it < 16; ++it) { const int r = 2 * it + (lane >> 5); *(LAS v4u*)(wl + r * CROW + 16 * (lane & 31)) = pre[it]; }
        if (c + 1 < nch) {
#pragma unroll
            for (int it = 0; it < 16; ++it) { const int r = 2 * it + (lane >> 5); unsigned key = sl[32 * (c + 1) + r]; key = (key == 0xFFFFu) ? 0u : key; pre[it] = *(const v4u*)(cb + (size_t)key * KVL + 8 * (lane & 31)); } }
        LDS_WAIT(); asm volatile("" ::: "memory");
        f32x4 s[2];
#pragma unroll
        for (int T = 0; T < 2; ++T) { const LAS unsigned char* ap = wl + (16 * T + i) * CROW + 16 * g; f32x4 acc = (f32x4){0.f, 0.f, 0.f, 0.f};
#pragma unroll
            for (int kk = 0; kk < 8; ++kk) { const bf16x8 af = *(const LAS bf16x8*)(ap + 64 * kk); acc = __builtin_amdgcn_mfma_f32_16x16x32_bf16(af, bq[kk], acc, 0, 0, 0); }
            s[T] = acc; }
        float cmax = -INFINITY;
#pragma unroll
        for (int T = 0; T < 2; ++T) { const v2u kw = *(const LAS v2u*)(sl + 32 * c + 16 * T + 4 * g);
#pragma unroll
            for (int r = 0; r < 4; ++r) { const unsigned key = ((r < 2 ? kw.x : kw.y) >> (16 * (r & 1))) & 0xFFFFu; const int dl = t - (int)key;
                const float v = (key != 0xFFFFu && dl >= 0) ? (s[T][r] - slope2 * (float)dl) : -INFINITY; s[T][r] = v; cmax = fmaxf(cmax, v); } }
        cmax = xmax32(xmax16(cmax));
        const float mn = fmaxf(m, cmax), alpha = __builtin_amdgcn_exp2f(m - mn); m = mn;
        float rs = 0.f;
#pragma unroll
        for (int T = 0; T < 2; ++T)
#pragma unroll
            for (int r = 0; r < 4; ++r) { const float pv = __builtin_amdgcn_exp2f(s[T][r] - mn); s[T][r] = pv; rs += pv; }
        rs = xsum32(xsum16(rs));
        l = l * alpha + rs;
        bf16x8 pf; { const unsigned a0 = cvtpk(s[0][0], s[0][1]), a1 = cvtpk(s[0][2], s[0][3]), a2 = cvtpk(s[1][0], s[1][1]), a3 = cvtpk(s[1][2], s[1][3]); const v4u tt = (v4u){a0, a1, a2, a3}; pf = __builtin_bit_cast(bf16x8, tt); }
        const LAS unsigned char* vb = wl + (4 * g + (i >> 2)) * CROW + 8 * (i & 3);
#pragma unroll
        for (int ct = 0; ct < 16; ++ct) { const s16x4 lo = tr_read(vb + 32 * ct), hi = tr_read(vb + 16 * CROW + 32 * ct);
            o[ct] = o[ct] * alpha; o[ct] = __builtin_amdgcn_mfma_f32_16x16x32_bf16(cat8(lo, hi), pf, o[ct], 0, 0, 0); }
        LDS_WAIT(); asm volatile("" ::: "memory");
    }
    const float inv = 1.0f / l;
    bf16* op = OL + row * (NH * KVL) + i * KVL + 4 * g;
#pragma unroll
    for (int ct = 0; ct < 16; ++ct) { v2u w2; w2.x = cvtpk(o[ct][0] * inv, o[ct][1] * inv); w2.y = cvtpk(o[ct][2] * inv, o[ct][3] * inv); *(v2u*)(op + 16 * ct) = w2; }
}
__device__ __forceinline__ void dsa_attn_query_p(const bf16* QL, const bf16* CKV, const u16* SEL, bf16* OL, LAS unsigned char* wl, int b, int t, int lane, bf16x8 (&bq)[8], size_t row_n, v2u& seln) {
    const int i = lane & 15, g = lane >> 4; const size_t row = (size_t)b * SEQ + t;
    LAS u16* sl = (LAS u16*)(wl + 32 * CROW);
    const float slope2 = __builtin_amdgcn_exp2f(-0.5f * (float)(i + 1)) * LOG2E;
    float m = -1e30f, l = 0.f; f32x4 o[16];
#pragma unroll
    for (int c = 0; c < 16; ++c) o[c] = (f32x4){0.f, 0.f, 0.f, 0.f};
    const int nvalid = (t + 1) < TOPK ? (t + 1) : TOPK, nch = (nvalid + 31) >> 5;
    const bf16* cb = CKV + (size_t)b * SEQ * KVL;
    LDS_WAIT(); asm volatile("" ::: "memory");
    v4u pre[16];
#pragma unroll
    for (int it = 0; it < 16; ++it) { const int r = 2 * it + (lane >> 5); unsigned key = sl[r]; key = (key == 0xFFFFu) ? 0u : key; pre[it] = *(const v4u*)(cb + (size_t)key * KVL + 8 * (lane & 31)); }
    seln = *(const v2u*)(SEL + row_n * TOPK + 4 * lane);
    bf16x8 bqn[8];
#pragma unroll
    for (int kk = 0; kk < 8; ++kk) bqn[kk] = *(const bf16x8*)(QL + row_n * (NH * KVL) + i * KVL + 32 * kk + 8 * g);
    for (int c = 0; c < nch; ++c) {
#pragma unroll
        for (int it = 0; it < 16; ++it) { const int r = 2 * it + (lane >> 5); *(LAS v4u*)(wl + r * CROW + 16 * (lane & 31)) = pre[it]; }
        if (c + 1 < nch) {
#pragma unroll
            for (int it = 0; it < 16; ++it) { const int r = 2 * it + (lane >> 5); unsigned key = sl[32 * (c + 1) + r]; key = (key == 0xFFFFu) ? 0u : key; pre[it] = *(const v4u*)(cb + (size_t)key * KVL + 8 * (lane & 31)); } }
        LDS_WAIT(); asm volatile("" ::: "memory");
        f32x4 s[2];
#pragma unroll
        for (int T = 0; T < 2; ++T) { const LAS unsigned char* ap = wl + (16 * T + i) * CROW + 16 * g; f32x4 acc = (f32x4){0.f, 0.f, 0.f, 0.f};
#pragma unroll
            for (int kk = 0; kk < 8; ++kk) { const bf16x8 af = *(const LAS bf16x8*)(ap + 64 * kk); acc = __builtin_amdgcn_mfma_f32_16x16x32_bf16(af, bq[kk], acc, 0, 0, 0); }
            s[T] = acc; }
        float cmax = -INFINITY;
#pragma unroll
        for (int T = 0; T < 2; ++T) { const v2u kw = *(const LAS v2u*)(sl + 32 * c + 16 * T + 4 * g);
#pragma unroll
            for (int r = 0; r < 4; ++r) { const unsigned key = ((r < 2 ? kw.x : kw.y) >> (16 * (r & 1))) & 0xFFFFu; const int dl = t - (int)key;
                const float v = (key != 0xFFFFu && dl >= 0) ? (s[T][r] - slope2 * (float)dl) : -INFINITY; s[T][r] = v; cmax = fmaxf(cmax, v); } }
        cmax = xmax32(xmax16(cmax));
        const float mn = fmaxf(m, cmax), alpha = __builtin_amdgcn_exp2f(m - mn); m = mn;
        float rs = 0.f;
#pragma unroll
        for (int T = 0; T < 2; ++T)
#pragma unroll
            for (int r = 0; r < 4; ++r) { const float pv = __builtin_amdgcn_exp2f(s[T][r] - mn); s[T][r] = pv; rs += pv; }
        rs = xsum32(xsum16(rs));
        l = l * alpha + rs;
        bf16x8 pf; { const unsigned a0 = cvtpk(s[0][0], s[0][1]), a1 = cvtpk(s[0][2], s[0][3]), a2 = cvtpk(s[1][0], s[1][1]), a3 = cvtpk(s[1][2], s[1][3]); const v4u tt = (v4u){a0, a1, a2, a3}; pf = __builtin_bit_cast(bf16x8, tt); }
        const LAS unsigned char* vb = wl + (4 * g + (i >> 2)) * CROW + 8 * (i & 3);
#pragma unroll
        for (int ct = 0; ct < 16; ++ct) { const s16x4 lo = tr_read(vb + 32 * ct), hi = tr_read(vb + 16 * CROW + 32 * ct);
            o[ct] = o[ct] * alpha; o[ct] = __builtin_amdgcn_mfma_f32_16x16x32_bf16(cat8(lo, hi), pf, o[ct], 0, 0, 0); }
        LDS_WAIT(); asm volatile("" ::: "memory");
    }
    const float inv = 1.0f / l;
    bf16* op = OL + row * (NH * KVL) + i * KVL + 4 * g;
#pragma unroll
    for (int ct = 0; ct < 16; ++ct) { v2u w2; w2.x = cvtpk(o[ct][0] * inv, o[ct][1] * inv); w2.y = cvtpk(o[ct][2] * inv, o[ct][3] * inv); *(v2u*)(op + 16 * ct) = w2; }
#pragma unroll
    for (int kk = 0; kk < 8; ++kk) bq[kk] = bqn[kk];
}
constexpr int PH_PER_LAYER = 10, PH_L0 = 2, PH_FINAL = PH_L0 + PH_PER_LAYER * DEPTH, PH_COUNT = PH_FINAL + 1;
__global__ void __launch_bounds__(NWAVES * 64, 2) mk_fwd(Args args) {
    extern __shared__ __attribute__((aligned(16))) unsigned char lds_raw[];
    LAS unsigned char* lds = (LAS unsigned char*)lds_raw;
    volatile LAS unsigned* MISC = (volatile LAS unsigned*)(lds + MISC_OFF);
    const int tid = threadIdx.x, lane = tid & 63, wave = __builtin_amdgcn_readfirstlane(tid >> 6);
    const int G = gridDim.x; const int bx = blockIdx.x; const int vcu = (G % 8 == 0) ? (bx % 8) * (G / 8) + bx / 8 : bx;
    const int gw = vcu * NWAVES + wave, NGW = G * NWAVES;
    unsigned char* ws = as_global(args.ws);
    gu32* ctl = (gu32*)(ws + WS_CTL);
    if (tid < 64) MISC[tid] = 0u;
    __syncthreads();
    const int lo = args.ph_lo, hi = args.ph_hi;
#ifdef DIAG_XCC
    if (tid == 0) ((unsigned*)(ws + WS_CTL + 700000))[bx] = xb_xcc_id() + 1u;
#endif
#ifdef PROBE_IDX
    if (bx == 0 && tid == 0) { unsigned long long* pt = (unsigned long long*)(ws + WS_CTL + 614400); pt[63] = wall_clock64(); }
#endif
    XcdBarrier bar; bar.bar = (unsigned*)(ctl + CW_BAR); bar.x = 0; bar.st = nullptr;
    if (hi - lo > 1) { bar = xcd_barrier_post((unsigned*)(ctl + CW_BAR), MISC + 8); if (tid == 0) xcd_barrier_census(bar); __syncthreads(); }
#define IN(k) (lo <= (k) && (k) < hi)
#ifdef REP_PHASE
#define REPN(k) (((k) == REP_PHASE) ? (1 + REP_N) : 1)
#else
#define REPN(k) 1
#endif
#ifndef REP_VARIANT
#define REP_VARIANT 0
#endif
#ifndef DIL_VARIANT
#define DIL_VARIANT 0
#endif
#ifndef REPS3
#define REPS3 1
#endif
#ifndef REPS1
#define REPS1 1
#endif
#ifndef REPS2
#define REPS2 1
#endif
#define REP_BEGIN(k) for (int rep_ = 0; rep_ < REPN(k); ++rep_) { if (rep_) GBAR();
#define REP_END }
#ifdef PROBE_IDX
#define PMARK(idx) do { if (bx == 0 && tid == 0) { unsigned long long* pt = (unsigned long long*)(ws + WS_CTL + 614400); const unsigned long long now_ = wall_clock64(); pt[(idx)] += now_ - pt[63]; pt[63] = now_; } } while (0)
#else
#define PMARK(idx) do {} while (0)
#endif
#define GBAR() do { XcdBarrier b_ = bar; GAS unsigned* bp_ = (GAS unsigned*)b_.bar; asm volatile("" : "+s"(bp_)); b_.bar = (unsigned*)bp_; xcd_barrier(b_, wave == 0 && ({ unsigned m_ = ~0u; asm volatile("" : "+s"(m_)); (int)__builtin_amdgcn_mbcnt_hi(m_, __builtin_amdgcn_mbcnt_lo(m_, 0u)); }) == 0); } while (0)
#define SEAM(k) do { if ((k) + 1 < hi) GBAR(); PMARK(((k) < PH_L0) ? (k) : (2 + (((k) - PH_L0) / PH_PER_LAYER & 1) * PH_PER_LAYER + ((k) - PH_L0) % PH_PER_LAYER)); } while (0)

#define LAUNDER_S(x) ({ int v_ = (x); asm volatile("" : "+s"(v_)); v_; })
#define Gv LAUNDER_S(G)
#define bxv LAUNDER_S(bx)
#define Kd LAUNDER_S(D)
#define Kf LAUNDER_S(DFF)
#define gwv LAUNDER_S(gw)
#define vcuv LAUNDER_S(vcu)
#define LANE_NOW ({ unsigned m_ = ~0u; asm volatile("" : "+s"(m_)); (int)__builtin_amdgcn_mbcnt_hi(m_, __builtin_amdgcn_mbcnt_lo(m_, 0u)); })
#define lanev LANE_NOW
#define tidv (LAUNDER_S(wave) * 64 + LANE_NOW)
    if (IN(0)) {
        if (!PRO_SINGLE) { REP_BEGIN(0) if (I8_QKV || I8_DSA || I8_GU) p0_colmax(args, gwv, NGW, lanev); REP_END SEAM(0); }
    }
    if (IN(1)) {
        REP_BEGIN(1)
        if (PRO_SINGLE) { p0_strips(args, lds, vcuv, Gv, tidv, wave, lanev); p0_bf16_items(args, lds, gwv, NGW, wave, lanev); }
        else p0_transposes(args, lds, gwv, NGW, wave, lanev);
        __syncthreads();
        for (int ra = 0; ra < REPS3; ++ra) { p0_adaln(args, lds, Gv, tidv, wave, lanev);
        __syncthreads(); }
        REP_END
        SEAM(1);
    }
    for (int l = 0; l < DEPTH; ++l) {
        const int pb = PH_L0 + PH_PER_LAYER * l;
        if (hi <= pb || lo >= pb + PH_PER_LAYER) continue;
        const LayerW& W = args.L[l];
#define wsv ({ GAS unsigned char* q_ = (GAS unsigned char*)ws; asm volatile("" : "+s"(q_)); (unsigned char*)q_; })
#define wb (wsv + WS_W + (size_t)l * W_LAYER)
#define Hb ((bf16*)(wsv + WS_H))
#define ATT ((bf16*)(wsv + WS_ATT))
#define r1 (wsv + WS_R1)
#define r2 (wsv + WS_R2)
#define modl ((const float*)(wsv + WS_MOD) + (size_t)l * BATCH * NMOD)
#define sAp ((float*)(wsv + WS_SA))
#define sBl ((const float*)(wsv + WS_SB) + l * CM_LAYER)
#define x16 ((bf16*)(wsv + WS_X16))
#define xin ((l == 0) ? (const void*)as_global(args.x) : (const void*)x16)
#define xin_f32 (l == 0)
#define xout x16
        const bool dsa = (l & 1) != 0;
        if (IN(pb + 0)) { REP_BEGIN(pb + 0)
            if (dsa ? I8_DSA : I8_QKV) norm_mod_phase_q(xin, xin_f32, as_global(W.norm_attn), modl + 0 * D, modl + 1 * D, (signed char*)Hb, sAp, nullptr, gwv, NGW, lanev);
            else norm_mod_phase(xin, xin_f32, as_global(W.norm_attn), modl + 0 * D, modl + 1 * D, Hb, gwv, NGW, lanev);
            REP_END SEAM(pb + 0); }
        if (IN(pb + 1)) { REP_BEGIN(pb + 1)
            if (!dsa) { pg8::Gemm g{Hb, (const bf16*)(wb + WO_IN), M, NIN_A, Kd}; pg8::StaticOrder S; S.init(M, NIN_A, Gv, bxv, WGM_QKV);
                pg8::EpiQKV<I8_QKV> E{(bf16*)r1, (size_t)M * D, QSCALE, sAp, sBl};
                pg8::gemm_phase<pg8::EpiQKV<I8_QKV>, pg8::StaticOrder, PG8_ALIGN, PG8_SP2>(lds, g, S, E, tidv); }
            else { pg8::Gemm g{Hb, (const bf16*)(wb + WO_IN), M, NIN_BP, Kd}; pg8::StaticOrder S; S.init(M, NIN_BP, Gv, bxv, WGM_DSA);
                pg8::EpiDsaProj<I8_DSA> E{(bf16*)(r1 + R1_Q), (float*)(r1 + R1_CKVR), (bf16*)(r1 + R1_QI), (bf16*)(r1 + R1_KI), (float*)(r1 + R1_WI), sAp, sBl};
                pg8::gemm_phase<pg8::EpiDsaProj<I8_DSA>, pg8::StaticOrder, PG8_ALIGN, PG8_SP2>(lds, g, S, E, tidv); }
            REP_END SEAM(pb + 1);
        }
        const bool dfused = DIL_FUSED && (Gv & 15) == 0;
#define DIL_ARGS (const bf16*)r1, (const bf16*)r1 + (size_t)M * D, (const bf16*)r1 + 2 * (size_t)M * D, ATT, (float*)r2
        if (!dsa) {
            if (dfused) { if (IN(pb + 2)) { dil_attn_fused(DIL_ARGS, (unsigned*)(wsv + WS_CTL + CTL_DILCNT) + (size_t)(l >> 1) * 128 * 2 * 16, lds, vcuv, Gv, tidv, wave, lanev); SEAM(pb + 4); } }
            else if (DIL_SPLIT > 1 && !MK_MULTI) {
                if (IN(pb + 2)) { for (int sp = 0; sp < DIL_SPLIT; ++sp) for (int ps = 0; ps < 3; ++ps) { if (sp + ps) GBAR();
                        dil_attn_pass(ps, DIL_ARGS, lds, vcuv, Gv, tidv, wave, lanev, sp * (BATCH * NH * 16 / DIL_SPLIT), (sp + 1) * (BATCH * NH * 16 / DIL_SPLIT)); }
                    SEAM(pb + 4); }
            } else {
                if (IN(pb + 2)) { REP_BEGIN(pb + 2) dil_attn_pass<DIL_VARIANT>(0, DIL_ARGS, lds, vcuv, Gv, tidv, wave, lanev); REP_END SEAM(pb + 2); }
                if (IN(pb + 3)) { dil_attn_pass(1, DIL_ARGS, lds, vcuv, Gv, tidv, wave, lanev); SEAM(pb + 3); }
                if (IN(pb + 4)) { dil_attn_pass<0, true>(2, DIL_ARGS, lds, vcuv, Gv, tidv, wave, lanev, 0, BATCH * NH * 16, OUT_MODE == 2 ? (unsigned char*)(r2 + R2_ATT8) : nullptr); SEAM(pb + 4); }
            }
        } else {
        if (IN(pb + 2)) { REP_BEGIN(pb + 2)
            for (int rs1 = 0; rs1 < REPS1; ++rs1) {
            ckv_norm_phase((const float*)(r1 + R1_CKVR), as_global(W.kv_norm), (bf16*)(r1 + R1_CKV), gwv, NGW, lanev);
            for (int wu = gwv; wu < (M / 64) * NH; wu += NGW) { const int h = wu & 15, tg = wu >> 4;
                head_gemm<4, 16, 4>((const bf16*)(r1 + R1_Q), D, h * HD, (const bf16*)(wb + WO_UK) + (size_t)h * KVL * HD, (bf16*)r2, NH * KVL, h * KVL, 64 * tg, QSCALE, lanev); }
            }
            for (int rs2 = 0; rs2 < REPS2; ++rs2)
            { const int vb = vcuv;
              for (int pi = vb; pi < BATCH * 64; pi += Gv) { const int b = pi >> 6, ql = pi & 63;
                  dsa_index_unit((const bf16*)(r1 + R1_QI), (const bf16*)(r1 + R1_KI), (const float*)(r1 + R1_WI), (u16*)(r1 + R1_SEL), lds, b, ql, tidv, wave, lanev);
                  dsa_index_unit((const bf16*)(r1 + R1_QI), (const bf16*)(r1 + R1_KI), (const float*)(r1 + R1_WI), (u16*)(r1 + R1_SEL), lds, b, 127 - ql, tidv, wave, lanev); } }
            REP_END SEAM(pb + 2);
        }
        if (IN(pb + 3)) { REP_BEGIN(pb + 3)
            LAS unsigned char* wl = lds + wave * DSA_WAVE_LDS;
            if (DSA_MERGE_POST) {
                for (int blk = vcuv; blk < M / 64; blk += Gv) { const int tokb = 64 * blk;
                    { const bf16* QLp = (const bf16*)r2; const u16* SELp = (const u16*)(r1 + R1_SEL); const int ln = lanev, q0 = tokb + 8 * wave; LAS u16* slp = (LAS u16*)(wl + 32 * CROW);
                      bf16x8 bq[8]; v2u seln = *(const v2u*)(SELp + (size_t)q0 * TOPK + 4 * ln);
#pragma unroll
                      for (int kk = 0; kk < 8; ++kk) bq[kk] = *(const bf16x8*)(QLp + (size_t)q0 * (NH * KVL) + (ln & 15) * KVL + 32 * kk + 8 * (ln >> 4));
                      for (int jj = 0; jj < 8; ++jj) { const int q = q0 + jj; const int qn = q0 + (jj < 7 ? jj + 1 : jj);
                          *(LAS v2u*)(slp + 4 * ln) = seln; LDS_WAIT(); asm volatile("" ::: "memory");
                          dsa_attn_query_p(QLp, (const bf16*)(r1 + R1_CKV), SELp, (bf16*)(r1 + R1_OLAT), wl, q >> 11, q & (SEQ - 1), ln, bq, (size_t)qn, seln); } }
                    asm volatile("s_waitcnt vmcnt(0)" ::: "memory"); __syncthreads();
                    __builtin_amdgcn_fence(__ATOMIC_ACQUIRE, "agent"); asm volatile("s_waitcnt vmcnt(0)" ::: "memory");
                    for (int wu = wave; wu < 2 * NH; wu += NWAVES) { const int h = wu & 15, tg = wu >> 4;
                        head_gemm<8, 8, 2, OUT_MODE == 2>((const bf16*)(r1 + R1_OLAT), NH * KVL, h * KVL, (const bf16*)(wb + WO_UV) + (size_t)h * HD * KVL, ATT  , D, h * HD, tokb + 32 * tg, 1.0f, lanev); }
                    __syncthreads(); }
            } else {
                for (int q = gwv; q < M; q += NGW) dsa_attn_query((const bf16*)r2, (const bf16*)(r1 + R1_CKV), (const u16*)(r1 + R1_SEL), (bf16*)(r1 + R1_OLAT), wl, q >> 11, q & (SEQ - 1), lanev); }
            REP_END SEAM(pb + 3);
        }
        if (!DSA_MERGE_POST && IN(pb + 4)) { REP_BEGIN(pb + 4)
            for (int wu = gwv; wu < (M / 32) * NH; wu += NGW) { const int h = wu & 15, tg = wu >> 4;
                head_gemm<8, 8, 2, OUT_MODE == 2>((const bf16*)(r1 + R1_OLAT), NH * KVL, h * KVL, (const bf16*)(wb + WO_UV) + (size_t)h * HD * KVL, ATT, D, h * HD, 32 * tg, 1.0f, lanev); }
            REP_END SEAM(pb + 4);
        }
        }
#undef DIL_ARGS
        if (IN(pb + 5)) { REP_BEGIN(pb + 5) pg8::Gemm g{(OUT_MODE == 2 && !dsa) ? (const bf16*)(r2 + R2_ATT8) : ATT, (const bf16*)(wb + WO_OUT), M, D, Kd}; pg8::StaticOrder S; S.init(M, D, Gv, bxv, WGM_OUT);
            pg8::EpiResid<OUT_MODE> E{xin, xin_f32, xout, modl + 2 * D, NMOD, nullptr, sBl + CM_OUT};
            pg8::gemm_phase<pg8::EpiResid<OUT_MODE>, pg8::StaticOrder, PG8_ALIGN, PG8_SP2>(lds, g, S, E, tidv); REP_END SEAM(pb + 5); }
        if (IN(pb + 6)) {
            if (I8_GU) norm_mod_phase_q(xout, 0, as_global(W.norm_ffn), modl + 3 * D, modl + 4 * D, (signed char*)Hb, sAp, I8_DN ? (unsigned*)(wsv + WS_RMAX) : nullptr, gwv, NGW, lanev);
            else norm_mod_phase(xout, 0, as_global(W.norm_ffn), modl + 3 * D, modl + 4 * D, Hb, gwv, NGW, lanev);
            SEAM(pb + 6); }
        if (IN(pb + 7)) { REP_BEGIN(pb + 7) pg8::Gemm g{Hb, (const bf16*)(wb + WO_GU), M, 2 * DFF, Kd}; pg8::StaticOrder S; S.init(M, 2 * DFF, Gv, bxv, WGM_GU);
            pg8::EpiSwiglu<I8_GU, DN_MODE == 2> E{(bf16*)r2, sAp, sBl + CM_GU, I8_DN ? (unsigned*)(wsv + WS_RMAX) : nullptr};
            pg8::gemm_phase<pg8::EpiSwiglu<I8_GU, DN_MODE == 2>, pg8::StaticOrder, PG8_ALIGN, PG8_SP2>(lds, g, S, E, tidv); REP_END SEAM(pb + 7); }
        if (I8_DN && IN(pb + 8)) { REP_BEGIN(pb + 8) act_quant_phase((const bf16*)r2, (const unsigned*)(wsv + WS_RMAX), (signed char*)r1, (float*)(wsv + WS_SA2), gwv, NGW, lanev); REP_END SEAM(pb + 8); }
        if (IN(pb + 9)) { pg8::Gemm g{(const bf16*)(I8_DN ? r1 : r2), (const bf16*)(wb + WO_DN), M, D, Kf}; pg8::StaticOrder S; S.init(M, D, Gv, bxv, WGM_DN);
            pg8::EpiResid<DN_MODE> E{xout, 0, xout, modl + 5 * D, NMOD, (const float*)(wsv + WS_SA2), sBl + CM_DN};
            pg8::gemm_phase<pg8::EpiResid<DN_MODE>, pg8::StaticOrder, PG8_ALIGN, PG8_SP2>(lds, g, S, E, tidv); SEAM(pb + 9); }
    }
#undef wsv
#undef wb
#undef Hb
#undef ATT
#undef r1
#undef r2
#undef modl
#undef sAp
#undef sBl
#undef x16
#undef xin
#undef xin_f32
#undef xout
    if (IN(PH_FINAL)) {
#ifdef DIAG_XCC
        { const unsigned* ids = (const unsigned*)(ws + WS_CTL + 700000); int bad = 0, distinct = 0;
          for (int b = 0; b < G; ++b) if (ids[b] != ids[b & 7]) bad++;
          for (int a = 0; a < 8; ++a) { int dup = 0; for (int c = 0; c < a; ++c) if (ids[a] == ids[c]) dup = 1; distinct += !dup; }
          const float cval = (bad ? 2.0f : 0.0f) + (distinct == 8 ? 0.0f : 1.0f); float* o = as_global(args.out);
          for (size_t e = (size_t)bx * 512 + tid; e < (size_t)M * D; e += (size_t)G * 512) o[e] = cval; }
#endif
#if defined(PROBE_IDX)
        { const unsigned long long* pt = (const unsigned long long*)(ws + WS_CTL + 614400); unsigned long long tt = 0; for (int q = PROBE_IDX; q <= PROBE_IDX_END; ++q) tt += pt[q];
          const float cval = (float)tt * 0.01f / (float)PROBE_DIV; float* o = as_global(args.out);
          for (size_t e = (size_t)bx * 512 + tid; e < (size_t)M * D; e += (size_t)G * 512) o[e] = cval; }
#elif !defined(DIAG_XCC)
        final_norm_phase((const bf16*)(ws + WS_X16), as_global(args.out), as_global(args.final_norm), gwv, NGW, lanev);
#endif
    }
#undef Gv
#undef bxv
#undef Kd
#undef Kf
#undef gwv
#undef vcuv
#undef lanev
#undef LANE_NOW
#undef tidv
#undef IN
#undef SEAM
}


#ifdef DIAG_PROBE
struct ProbeArgs { const unsigned* buf[4]; unsigned long long nwords[4]; int is_bf16[4]; int pad[4]; unsigned* cnt; float* out; };
__global__ void probe_kernel(ProbeArgs a) {
    for (int k = 0; k < 4; ++k) { if (!a.buf[k]) continue; unsigned bad = 0;
        for (unsigned long long i = (unsigned long long)blockIdx.x * blockDim.x + threadIdx.x; i < a.nwords[k]; i += (unsigned long long)gridDim.x * blockDim.x) { const unsigned w = a.buf[k][i];
            const int md = a.is_bf16[k];
            if (md == 1) { if ((w & 0x7F80u) == 0x7F80u || (w & 0x7F800000u) == 0x7F800000u) bad++; } else if (md == 0) { if ((w & 0x7F800000u) == 0x7F800000u) bad++; }
            else if (md == 4) { const unsigned lo = w & 0xFFFFu, hi = w >> 16; if ((lo > 2047u && lo != 0xFFFFu) || (hi > 2047u && hi != 0xFFFFu)) bad++; }
            else if (md == 2) { if ((w & 0x7F80u) >= 0x4680u || (w & 0x7F800000u) >= 0x46800000u) bad++; } else { if ((w & 0x7F800000u) >= 0x46000000u) bad++; } }
        if (bad) atomicAdd(a.cnt + k, bad); }
}
__global__ void probe_fill(ProbeArgs a) {
    float c = 0.f; for (int k = 0; k < 4; ++k) if (a.cnt[k]) c += 0.5f * (float)(1 << k);
    for (size_t i = (size_t)blockIdx.x * blockDim.x + threadIdx.x; i < (size_t)M * D; i += (size_t)gridDim.x * blockDim.x) a.out[i] = c;
}
#endif
extern "C" void kernel_launch(void* const* d_in, const int* in_sizes, int n_in, void* d_out, int out_size, void* d_ws, size_t ws_size, hipStream_t stream) {
    static int grid = 0;
    if (grid == 0) {
        if (n_in != 41 || in_sizes[0] != M * D || out_size != M * D || ws_size < WS_END) { fprintf(stderr, "kernel_launch: unexpected shapes (n_in %d, in0 %d, out %d, ws %zu)\n", n_in, n_in > 0 ? in_sizes[0] : -1, out_size, ws_size); grid = -1; return; }
        int dev = 0, cus = 0;
        if (hipGetDevice(&dev) != hipSuccess || hipDeviceGetAttribute(&cus, hipDeviceAttributeMultiprocessorCount, dev) != hipSuccess) { grid = -1; return; }
        if (hipFuncSetAttribute((const void*)mk_fwd, hipFuncAttributeMaxDynamicSharedMemorySize, LDS_BYTES) != hipSuccess) { fprintf(stderr, "kernel_launch: hipFuncSetAttribute failed\n"); grid = -1; return; }
        int per_cu = 0;
        if (hipOccupancyMaxActiveBlocksPerMultiprocessor(&per_cu, (const void*)mk_fwd, NWAVES * 64, LDS_BYTES) != hipSuccess || per_cu < 1) fprintf(stderr, "kernel_launch: occupancy query reports %d\n", per_cu);
        (void)hipGetLastError();
        grid = cus;
    }
    if (grid < 0) return;
    if (hipMemsetAsync((char*)d_ws + WS_CTL, 0, CTL_ZERO_BYTES, stream) != hipSuccess) return;
    Args a{};
    a.x = (const float*)d_in[0]; a.c = (const float*)d_in[1]; a.final_norm = (const float*)d_in[40];
    int k = 2;
    for (int l = 0; l < DEPTH; ++l) { LayerW& w = a.L[l];
        w.norm_attn = (const float*)d_in[k++]; w.ada_w = (const float*)d_in[k++]; w.ada_b = (const float*)d_in[k++]; w.w_in = (const float*)d_in[k++];
        if (l & 1) { w.kv_norm = (const float*)d_in[k++]; w.w_uk = (const float*)d_in[k++]; w.w_uv = (const float*)d_in[k++]; }
        else { w.kv_norm = nullptr; w.w_uk = nullptr; w.w_uv = nullptr; }
        w.w_out = (const float*)d_in[k++]; w.norm_ffn = (const float*)d_in[k++]; w.w_gu = (const float*)d_in[k++]; w.w_down = (const float*)d_in[k++]; }
    a.out = (float*)d_out; a.ws = (unsigned char*)d_ws;
#if MK_MULTI
    for (int p = 0; p < PH_COUNT; ++p) {

        a.ph_lo = p; a.ph_hi = p + 1;
#ifdef DIAG_PROBE
        if (p > DIAG_LAST) break;
#endif
        hipLaunchKernelGGL(mk_fwd, dim3(grid), dim3(NWAVES * 64), LDS_BYTES, stream, a);
    }
#ifdef DIAG_PROBE
    { ProbeArgs pa{}; unsigned char* ws = (unsigned char*)d_ws; DIAG_SETUP; pa.cnt = (unsigned*)(ws + WS_CTL) + 64; pa.out = (float*)d_out;
      hipLaunchKernelGGL(probe_kernel, dim3(1024), dim3(256), 0, stream, pa); hipLaunchKernelGGL(probe_fill, dim3(1024), dim3(256), 0, stream, pa); }
#endif
#else
    a.ph_lo = 0; a.ph_hi = PH_COUNT;
    hipLaunchKernelGGL(mk_fwd, dim3(grid), dim3(NWAVES * 64), LDS_BYTES, stream, a);
#endif
    const hipError_t le = hipPeekAtLastError();
    if (le != hipSuccess) fprintf(stderr, "kernel_launch: launch failed: %s\n", hipGetErrorName(le));
}
```

```cpp
#include <hip/hip_runtime.h>
#include <cstdio>
#include <cstdint>
#define MK_MULTI 0
namespace pg8 {
#define PG8_LAS __attribute__((address_space(3)))
typedef unsigned short bf16_t;
typedef short bf16x8 __attribute__((ext_vector_type(8)));
typedef float f32x4 __attribute__((ext_vector_type(4)));
typedef unsigned u32x4 __attribute__((ext_vector_type(4)));
constexpr int BM = 256, BK = 64, HALF = 128, HTB = HALF * BK * 2  , STAGE_BYTES = 8 * HTB, NXCD = 8, WGM = 8;

__host__ __device__ __forceinline__ int lds_byte(int r, int c) { const int st = (r >> 4) * 2 + (c >> 5), rr = r & 15, cc = c & 31, ob = rr * 64 + cc * 2; return st * 1024 + (ob ^ (((ob >> 9) & 1) << 5)); }
__host__ __device__ __forceinline__ void stage_rc(int b, int& R, int& C) { const int st = b / 1024, sb = b % 1024, swz = sb ^ (((sb >> 9) & 1) << 5); R = (st >> 1) * 16 + swz / 64; C = (st & 1) * 32 + (swz % 64) / 2; }
__host__ __device__ __forceinline__ int perm32(int rho) { const int n = rho >> 4, i = rho & 15; return 8 * (i >> 2) + 4 * n + (i & 3); }

struct Unit { int pm, pn; };
struct Gemm { const bf16_t* A; const bf16_t* Bt; int M, N, K; };

struct StaticOrder {
    int nM, nN, nwg, G, c, wgm;
    __host__ __device__ void init(int M, int N, int G_, int c_, int wgm_ = WGM) { nM = M / BM; nN = N / BM; nwg = nM * nN; G = G_; c = c_; wgm = wgm_; }
    __host__ __device__ bool next(int i, Unit& u) const {
        const long L = (long)i * G + c; if (L >= nwg) return false;
        int wgid = (int)L; { const int q = nwg / NXCD, r = nwg % NXCD, xcd = wgid % NXCD, off = wgid / NXCD; wgid = (xcd < r ? xcd * (q + 1) : r * (q + 1) + (xcd - r) * q) + off; }
        const int nig = wgm * nN, gid = wgid / nig, fm = gid * wgm, gsz = (nM - fm) < wgm ? (nM - fm) : wgm;
        u.pm = fm + ((wgid % nig) % gsz); u.pn = (wgid % nig) / gsz; return true;
    }
    __device__ __forceinline__ void a_ready(const Unit&) const {}
    __device__ __forceinline__ void done(const Unit&) const {}
};
typedef __bf16 bf16x2_cv __attribute__((ext_vector_type(2)));
typedef float f32x2_cv __attribute__((ext_vector_type(2)));
__device__ __forceinline__ unsigned cvt_pk_bf16(float lo, float hi) { const f32x2_cv v = {lo, hi}; const bf16x2_cv r = __builtin_convertvector(v, bf16x2_cv); return __builtin_bit_cast(unsigned, r); }
typedef float f32x2 __attribute__((ext_vector_type(2)));
__device__ __forceinline__ u32x4 pack8(const f32x4 v0, const f32x4 v1) { u32x4 w; w.x = cvt_pk_bf16(v0[0], v0[1]); w.y = cvt_pk_bf16(v0[2], v0[3]); w.z = cvt_pk_bf16(v1[0], v1[1]); w.w = cvt_pk_bf16(v1[2], v1[3]); return w; }

typedef int i32x4 __attribute__((ext_vector_type(4)));
template <bool I8_> struct AccT { typedef f32x4 type; };
template <> struct AccT<true> { typedef i32x4 type; };
template <bool I8_> __device__ __forceinline__ f32x4 deq(const typename AccT<I8_>::type a, float sa, const f32x4 sb) {
    if constexpr (I8_) { f32x4 r; r[0] = (float)a[0]; r[1] = (float)a[1]; r[2] = (float)a[2]; r[3] = (float)a[3]; return r * sa * sb; } else { (void)sa; (void)sb; return a; } }
template <bool I8_> __device__ __forceinline__ f32x4 deqg(const typename AccT<I8_>::type a, float sa, const f32x4 sb) { if constexpr (I8_) return deq<true>(a, sa, sb); else { (void)sa; return a * sb; } }
template <bool I8_> struct EpiQKV {
    static constexpr bool PERM = true, AFTER_DRAIN = false, I8 = I8_, FP8 = false; typedef typename AccT<I8_>::type acc_t;
    bf16_t* O; size_t split_stride; float qscale; const float* sA; const float* sB;
    __device__ __forceinline__ void operator()(const acc_t (&acc)[2][2][4][2], const Unit& u, int wr, int wc, int fr, int fq) const {
        const int row0 = u.pm * BM + wr * 64 + fr; const int t = u.pn >> 3; const int col0 = (u.pn & 7) * BM + wc * 32 + 8 * fq;
        bf16_t* base = O + (size_t)t * split_stride; const float sc = (t == 0) ? qscale : 1.f;
        f32x4 sb[2][2];
#pragma unroll
        for (int bj = 0; bj < 2; ++bj)
#pragma unroll
            for (int n = 0; n < 2; ++n) sb[bj][n] = I8_ ? *(const f32x4*)(sB + u.pn * BM + bj * HALF + wc * 32 + 8 * fq + 4 * n) : (f32x4){1.f, 1.f, 1.f, 1.f};
#pragma unroll
        for (int ai = 0; ai < 2; ++ai)
#pragma unroll
            for (int m = 0; m < 4; ++m) { const int r = row0 + ai * HALF + m * 16; bf16_t* rowp = base + (size_t)r * 2048 + col0; const float sa = (I8_ ? sA[r] : 1.f) * sc;
#pragma unroll
                for (int bj = 0; bj < 2; ++bj) { f32x4 v0 = deq<I8_>(acc[ai][bj][m][0], sa, sb[bj][0]), v1 = deq<I8_>(acc[ai][bj][m][1], sa, sb[bj][1]);
                    if (!I8_) { v0 = v0 * sc; v1 = v1 * sc; } *(u32x4*)(rowp + bj * HALF) = pack8(v0, v1); } }
    }
};
template <int MODE  > struct EpiResid {
    static constexpr bool PERM = false, AFTER_DRAIN = false, I8 = (MODE == 1), FP8 = (MODE == 2), I8_ = (MODE == 1); typedef typename AccT<(MODE == 1)>::type acc_t;
    const void* base; int base_f32; bf16_t* out; const float* gate; int gstride; const float* sA; const float* sB;
    __device__ __forceinline__ void operator()(const acc_t (&acc)[2][2][4][2], const Unit& u, int wr, int wc, int fr, int fq) const {
        typedef unsigned u32x2 __attribute__((ext_vector_type(2)));
        const int row0 = u.pm * BM + wr * 64 + fr, col0 = u.pn * BM + wc * 32 + 4 * fq;
        const float* gp = gate + (size_t)((u.pm * BM) >> 11) * gstride + col0;
        f32x4 gv[2][2];
#pragma unroll
        for (int bj = 0; bj < 2; ++bj)
#pragma unroll
            for (int n = 0; n < 2; ++n) { gv[bj][n] = *(const f32x4*)(gp + bj * HALF + n * 16); if (MODE != 0) gv[bj][n] = gv[bj][n] * *(const f32x4*)(sB + col0 + bj * HALF + n * 16); }
#pragma unroll
        for (int ai = 0; ai < 2; ++ai)
#pragma unroll
            for (int m = 0; m < 4; ++m) { const int r = row0 + ai * HALF + m * 16; const size_t off = (size_t)r * 2048 + col0; const float sa = I8_ ? sA[r] : 1.f;
                f32x4 bs[2][2];
                if (base_f32) {
#pragma unroll
                    for (int bj = 0; bj < 2; ++bj)
#pragma unroll
                        for (int n = 0; n < 2; ++n) bs[bj][n] = *(const f32x4*)((const float*)base + off + bj * HALF + n * 16);
                } else {
#pragma unroll
                    for (int bj = 0; bj < 2; ++bj)
#pragma unroll
                        for (int n = 0; n < 2; ++n) { const u32x2 w = *(const u32x2*)((const bf16_t*)base + off + bj * HALF + n * 16);
                            bs[bj][n] = (f32x4){__uint_as_float(w.x << 16), __uint_as_float(w.x & 0xFFFF0000u), __uint_as_float(w.y << 16), __uint_as_float(w.y & 0xFFFF0000u)}; }
                }
#pragma unroll
                for (int bj = 0; bj < 2; ++bj)
#pragma unroll
                    for (int n = 0; n < 2; ++n) { const f32x4 v = bs[bj][n] + deqg<I8_>(acc[ai][bj][m][n], sa, gv[bj][n]); *(u32x2*)(out + off + bj * HALF + n * 16) = (u32x2){cvt_pk_bf16(v[0], v[1]), cvt_pk_bf16(v[2], v[3])}; }
                asm volatile("" ::: "memory"); }
    }
};
template <bool I8_, bool OUT8  > struct EpiSwiglu {
    static constexpr bool PERM = true, AFTER_DRAIN = false, I8 = I8_, FP8 = false; typedef typename AccT<I8_>::type acc_t;
    bf16_t* O; const float* sA; const float* sB; unsigned* rmax;
    __device__ __forceinline__ static float silu(float x) { return x * __builtin_amdgcn_rcpf(1.0f + __builtin_amdgcn_exp2f(-1.44269504f * x)); }
    __device__ __forceinline__ void operator()(const acc_t (&acc)[2][2][4][2], const Unit& u, int wr, int wc, int fr, int fq) const {
        const int row0 = u.pm * BM + wr * 64 + fr; const int col0 = u.pn * HALF + wc * 32 + 8 * fq;
        f32x4 sb[2][2];
#pragma unroll
        for (int bj = 0; bj < 2; ++bj)
#pragma unroll
            for (int n = 0; n < 2; ++n) sb[bj][n] = I8_ ? *(const f32x4*)(sB + u.pn * BM + bj * HALF + wc * 32 + 8 * fq + 4 * n) : (f32x4){1.f, 1.f, 1.f, 1.f};
#pragma unroll
        for (int ai = 0; ai < 2; ++ai)
#pragma unroll
            for (int m = 0; m < 4; ++m) { const int r = row0 + ai * HALF + m * 16; bf16_t* rowp = O + (size_t)r * 5632 + col0; const float sa = I8_ ? sA[r] : 1.f;
                const f32x4 g0 = deq<I8_>(acc[ai][0][m][0], sa, sb[0][0]), g1 = deq<I8_>(acc[ai][0][m][1], sa, sb[0][1]), u0 = deq<I8_>(acc[ai][1][m][0], sa, sb[1][0]), u1 = deq<I8_>(acc[ai][1][m][1], sa, sb[1][1]);
                f32x4 v0, v1;
#pragma unroll
                for (int j = 0; j < 4; ++j) { v0[j] = silu(g0[j]) * u0[j]; v1[j] = silu(g1[j]) * u1[j]; }
                if constexpr (OUT8) { unsigned w0 = 0u, w1 = 0u; w0 = __builtin_amdgcn_cvt_pk_fp8_f32(v0[0], v0[1], w0, false); w0 = __builtin_amdgcn_cvt_pk_fp8_f32(v0[2], v0[3], w0, true);
                    w1 = __builtin_amdgcn_cvt_pk_fp8_f32(v1[0], v1[1], w1, false); w1 = __builtin_amdgcn_cvt_pk_fp8_f32(v1[2], v1[3], w1, true);
                    typedef unsigned u32x2 __attribute__((ext_vector_type(2))); *(u32x2*)((unsigned char*)O + (size_t)r * 5632 + col0) = (u32x2){w0, w1}; }
                else *(u32x4*)rowp = pack8(v0, v1);
                if (rmax) { float mx = fmaxf(fmaxf(fmaxf(fabsf(v0[0]), fabsf(v0[1])), fmaxf(fabsf(v0[2]), fabsf(v0[3]))), fmaxf(fmaxf(fabsf(v1[0]), fabsf(v1[1])), fmaxf(fabsf(v1[2]), fabsf(v1[3]))));
                    { unsigned uu = __float_as_uint(mx); auto r16 = __builtin_amdgcn_permlane16_swap(uu, uu, false, false); mx = fmaxf(__uint_as_float(r16[0]), __uint_as_float(r16[1])); uu = __float_as_uint(mx); auto r32 = __builtin_amdgcn_permlane32_swap(uu, uu, false, false); mx = fmaxf(__uint_as_float(r32[0]), __uint_as_float(r32[1])); }
                    if (fq == 0) atomicMax(rmax + r, __float_as_uint(mx)); } }
    }
};
template <bool I8_> struct EpiDsaProj {
    static constexpr bool PERM = true, AFTER_DRAIN = false, I8 = I8_, FP8 = false; typedef typename AccT<I8_>::type acc_t;
    bf16_t* Q; float* CKVR; bf16_t* QI; bf16_t* KI; float* WI; const float* sA; const float* sB;
    __device__ __forceinline__ void operator()(const acc_t (&acc)[2][2][4][2], const Unit& u, int wr, int wc, int fr, int fq) const {
        const int row0 = u.pm * BM + wr * 64 + fr; const int lc0 = wc * 32 + 8 * fq;
        f32x4 sb[2][2];
#pragma unroll
        for (int bj = 0; bj < 2; ++bj)
#pragma unroll
            for (int n = 0; n < 2; ++n) sb[bj][n] = I8_ ? *(const f32x4*)(sB + u.pn * BM + bj * HALF + lc0 + 4 * n) : (f32x4){1.f, 1.f, 1.f, 1.f};
#define DQ(ai, bj, m, n) deq<I8_>(acc[ai][bj][m][n], sa, sb[bj][n])
        if (u.pn < 8 || (u.pn >= 9 && u.pn < 17)) {
            bf16_t* base = (u.pn < 8) ? Q : QI; const int col0 = ((u.pn < 8) ? u.pn : (u.pn - 9)) * BM + lc0;
#pragma unroll
            for (int ai = 0; ai < 2; ++ai)
#pragma unroll
                for (int m = 0; m < 4; ++m) { const int r = row0 + ai * HALF + m * 16; const float sa = I8_ ? sA[r] : 1.f; bf16_t* rowp = base + (size_t)r * 2048 + col0;
#pragma unroll
                    for (int bj = 0; bj < 2; ++bj) *(u32x4*)(rowp + bj * HALF) = pack8(DQ(ai, bj, m, 0), DQ(ai, bj, m, 1)); }
        } else if (u.pn == 8) {
#pragma unroll
            for (int ai = 0; ai < 2; ++ai)
#pragma unroll
                for (int m = 0; m < 4; ++m) { const int r = row0 + ai * HALF + m * 16; const float sa = I8_ ? sA[r] : 1.f; float* rowp = CKVR + (size_t)r * 256 + lc0;
#pragma unroll
                    for (int bj = 0; bj < 2; ++bj) { *(f32x4*)(rowp + bj * HALF) = DQ(ai, bj, m, 0); *(f32x4*)(rowp + bj * HALF + 4) = DQ(ai, bj, m, 1); } }
        } else {
#pragma unroll
            for (int ai = 0; ai < 2; ++ai)
#pragma unroll
                for (int m = 0; m < 4; ++m) { const size_t r = (size_t)(row0 + ai * HALF + m * 16); const float sa = I8_ ? sA[r] : 1.f;
                    *(u32x4*)(KI + r * 128 + lc0) = pack8(DQ(ai, 0, m, 0), DQ(ai, 0, m, 1));
                    if (lc0 < 16) { *(f32x4*)(WI + r * 16 + lc0) = DQ(ai, 1, m, 0); *(f32x4*)(WI + r * 16 + lc0 + 4) = DQ(ai, 1, m, 1); } }
        }
#undef DQ
    }
};
template <class Epi, class Sched, bool ALIGN_EPI = false, bool SP2 = false>
__device__ __forceinline__ void gemm_phase(PG8_LAS unsigned char* lds, const Gemm g, const Sched& S, const Epi& E, int tid_in) {
    int tid_ = tid_in; asm volatile("" : "+v"(tid_));
    const int tid = tid_, wid = __builtin_amdgcn_readfirstlane(tid >> 6), lane = tid & 63, wr = wid >> 2, wc = wid & 3, fr = lane & 15, fq = lane >> 4;
    constexpr bool I8 = Epi::I8, F8 = Epi::FP8; typedef typename Epi::acc_t acc_t; typedef int i32x4_t __attribute__((ext_vector_type(4))); typedef int i32x8_t __attribute__((ext_vector_type(8)));
    const int K = g.K * ((I8 || F8) ? 1 : 2)  , nt = K / (BK * 2);
    unsigned voffA[2], voffB[2];
#pragma unroll
    for (int i = 0; i < 2; ++i) { int R, C; stage_rc(tid * 16 + i * 8192, R, C); const int Rb = Epi::PERM ? ((R & ~31) + perm32(R & 31)) : R;
        voffA[i] = (unsigned)(R * K + C * 2); voffB[i] = (unsigned)(Rb * K + C * 2); }
    const size_t kstep = (size_t)(BK * 2);
    const size_t hstep = (size_t)HALF * K;
    const size_t tstep = 2 * hstep;
    const unsigned ldsw = (unsigned)wid * 1024u;
    const int aoff = lds_byte(wr * 64 + fr, fq * 8), boff = lds_byte(wc * 32 + fr, fq * 8);
#define PG8_SA(b, h) (((b) * 2 + (h)) * HTB)
#define PG8_SB(b, h) ((4 + (b) * 2 + (h)) * HTB)
#define PG8_STAGE(bufoff, gbase, voff) do { _Pragma("unroll") for (int _i = 0; _i < 2; ++_i) \
        __builtin_amdgcn_global_load_lds((const unsigned*)((const char*)(gbase) + (voff)[_i]), (PG8_LAS unsigned*)(lds + (bufoff) + ldsw + _i * 8192), 16, 0, 0); } while (0)
#define PG8_LDA(dst, b, h) do { _Pragma("unroll") for (int m = 0; m < 4; ++m) _Pragma("unroll") for (int k = 0; k < 2; ++k) dst[m][k] = *(const PG8_LAS bf16x8*)(lds + PG8_SA(b, h) + aoff + m * 2048 + k * 1024); } while (0)
#define PG8_LDB(dst, b, h) do { _Pragma("unroll") for (int n = 0; n < 2; ++n) _Pragma("unroll") for (int k = 0; k < 2; ++k) dst[n][k] = *(const PG8_LAS bf16x8*)(lds + PG8_SB(b, h) + boff + n * 2048 + k * 1024); } while (0)
#define PG8_CAT8(x) ({ const i32x4_t lo_ = __builtin_bit_cast(i32x4_t, (x)[0]), hi_ = __builtin_bit_cast(i32x4_t, (x)[1]); (i32x8_t){lo_[0], lo_[1], lo_[2], lo_[3], hi_[0], hi_[1], hi_[2], hi_[3]}; })
#define PG8_MMA(ai, bj, At, Bt) do { __builtin_amdgcn_s_setprio(1); \
        if constexpr (F8) {   \
            _Pragma("unroll") for (int m = 0; m < 4; ++m) _Pragma("unroll") for (int n = 0; n < 2; ++n) \
                { const i32x8_t b8_ = PG8_CAT8(Bt[n]), a8_ = PG8_CAT8(At[m]); asm volatile("v_mfma_scale_f32_16x16x128_f8f6f4 %0, %1, %2, %0, %3, %3 op_sel_hi:[0,0,0]" : "+v"(acc[ai][bj][m][n]) : "v"(b8_), "v"(a8_), "v"(0x7F7F7F7F)); } \
        } else { _Pragma("unroll") for (int m = 0; m < 4; ++m) _Pragma("unroll") for (int n = 0; n < 2; ++n) _Pragma("unroll") for (int k = 0; k < 2; ++k) \
        { if constexpr (I8) acc[ai][bj][m][n] = __builtin_bit_cast(acc_t, __builtin_amdgcn_mfma_i32_16x16x64_i8(__builtin_bit_cast(i32x4_t, Bt[n][k]), __builtin_bit_cast(i32x4_t, At[m][k]), __builtin_bit_cast(i32x4_t, acc[ai][bj][m][n]), 0, 0, 0)); \
          else acc[ai][bj][m][n] = __builtin_bit_cast(acc_t, __builtin_amdgcn_mfma_f32_16x16x32_bf16(Bt[n][k], At[m][k], __builtin_bit_cast(f32x4, acc[ai][bj][m][n]), 0, 0, 0)); } } __builtin_amdgcn_s_setprio(0); } while (0)
#define PG8_WAIT_V(n) asm volatile("s_waitcnt vmcnt(" #n ")" ::: "memory")
#define PG8_WAIT_L(n) asm volatile("s_waitcnt lgkmcnt(" #n ")" ::: "memory")
#define PG8_BAR __builtin_amdgcn_s_barrier()
#define PG8_SCHED __builtin_amdgcn_sched_barrier(0)
    Unit cur, nxt; int ui = 0;
    if (!S.next(0, cur)) return;
    acc_t acc[2][2][4][2];
#pragma unroll
    for (int a = 0; a < 2; ++a)
#pragma unroll
        for (int b = 0; b < 2; ++b)
#pragma unroll
            for (int m = 0; m < 4; ++m)
#pragma unroll
                for (int n = 0; n < 2; ++n) acc[a][b][m][n] = acc_t{};
    bf16x8 At[4][2], B0[2][2], B1[2][2];
    const char* cA = (const char*)g.A + (size_t)cur.pm * tstep; const char* cB = (const char*)g.Bt + (size_t)cur.pn * tstep;
    S.a_ready(cur);
    if constexpr (SP2) {
        PG8_STAGE(PG8_SB(0, 0), cB, voffB); PG8_STAGE(PG8_SB(0, 1), cB + hstep, voffB); PG8_STAGE(PG8_SA(0, 0), cA, voffA); PG8_STAGE(PG8_SA(0, 1), cA + hstep, voffA);
        if (wr == 1) PG8_BAR;
        PG8_WAIT_V(2); PG8_BAR;
        PG8_STAGE(PG8_SB(1, 0), cB + kstep, voffB); PG8_STAGE(PG8_SA(1, 0), cA + kstep, voffA); PG8_STAGE(PG8_SB(1, 1), cB + hstep + kstep, voffB);
        PG8_WAIT_V(6); PG8_BAR;
    } else {
        PG8_STAGE(PG8_SB(0, 0), cB, voffB); PG8_STAGE(PG8_SA(0, 0), cA, voffA); PG8_STAGE(PG8_SB(0, 1), cB + hstep, voffB); PG8_STAGE(PG8_SA(0, 1), cA + hstep, voffA);
        if (wr == 1) PG8_BAR;
        PG8_WAIT_V(4); PG8_BAR;
        PG8_STAGE(PG8_SB(1, 0), cB + kstep, voffB); PG8_STAGE(PG8_SA(1, 0), cA + kstep, voffA); PG8_STAGE(PG8_SB(1, 1), cB + hstep + kstep, voffB);
        PG8_WAIT_V(6); PG8_BAR;
    }
    for (;;) {
        const bool has_next = S.next(ui + 1, nxt);
        const char* nA = has_next ? (const char*)g.A + (size_t)nxt.pm * tstep : cA; const char* nB = has_next ? (const char*)g.Bt + (size_t)nxt.pn * tstep : cB;
        for (int t = 0; t < nt; t += 2) {
            const bool last = (t == nt - 2);
            const char* a1 = cA + (size_t)(t + 1) * kstep;
            const char* a2 = last ? nA : cA + (size_t)(t + 2) * kstep; const char* b2 = last ? nB : cB + (size_t)(t + 2) * kstep;
            const char* a3 = a2 + kstep; const char* b3 = b2 + kstep;
            if (last && has_next) S.a_ready(nxt);
            if constexpr (SP2) {
            PG8_LDB(B0, 0, 0); PG8_LDB(B1, 0, 1); PG8_SCHED; PG8_LDA(At, 0, 0); PG8_STAGE(PG8_SA(1, 1), a1 + hstep, voffA);
            PG8_WAIT_V(8); PG8_WAIT_L(0); PG8_BAR; PG8_MMA(0, 0, At, B0); PG8_MMA(0, 1, At, B1); PG8_BAR; PG8_SCHED;
            PG8_LDA(At, 0, 1); PG8_STAGE(PG8_SB(0, 0), b2, voffB); PG8_STAGE(PG8_SB(0, 1), b2 + hstep, voffB); PG8_STAGE(PG8_SA(0, 0), a2, voffA);
            PG8_WAIT_V(8); PG8_WAIT_L(0); PG8_BAR; PG8_MMA(1, 0, At, B0); PG8_MMA(1, 1, At, B1); PG8_BAR; PG8_SCHED;
            PG8_LDB(B0, 1, 0); PG8_LDB(B1, 1, 1); PG8_SCHED; PG8_LDA(At, 1, 0); PG8_STAGE(PG8_SA(0, 1), a2 + hstep, voffA);
            PG8_WAIT_V(8); PG8_WAIT_L(0); PG8_BAR; PG8_MMA(0, 0, At, B0); PG8_MMA(0, 1, At, B1); PG8_BAR; PG8_SCHED;
            PG8_LDA(At, 1, 1); PG8_STAGE(PG8_SB(1, 0), b3, voffB); PG8_STAGE(PG8_SB(1, 1), b3 + hstep, voffB); PG8_STAGE(PG8_SA(1, 0), a3, voffA);
            PG8_WAIT_V(8); PG8_WAIT_L(0); PG8_BAR; PG8_MMA(1, 0, At, B0); PG8_MMA(1, 1, At, B1); PG8_BAR; PG8_SCHED;
            } else {
            PG8_LDB(B0, 0, 0); PG8_SCHED; PG8_LDA(At, 0, 0); PG8_STAGE(PG8_SA(1, 1), a1 + hstep, voffA);
            PG8_WAIT_L(8); PG8_BAR; PG8_WAIT_L(0); PG8_MMA(0, 0, At, B0); PG8_BAR; PG8_SCHED;
            PG8_LDB(B1, 0, 1); PG8_STAGE(PG8_SB(0, 0), b2, voffB);
            PG8_BAR; PG8_WAIT_L(0); PG8_MMA(0, 1, At, B1); PG8_BAR;
            PG8_LDA(At, 0, 1); PG8_STAGE(PG8_SA(0, 0), a2, voffA);
            PG8_BAR; PG8_WAIT_L(0); PG8_MMA(1, 0, At, B0); PG8_BAR; PG8_SCHED;
            PG8_STAGE(PG8_SB(0, 1), b2 + hstep, voffB);
            PG8_WAIT_V(6); PG8_BAR; PG8_MMA(1, 1, At, B1); PG8_BAR;
            PG8_LDB(B0, 1, 0); PG8_SCHED; PG8_LDA(At, 1, 0); PG8_STAGE(PG8_SA(0, 1), a2 + hstep, voffA);
            PG8_WAIT_L(8); PG8_BAR; PG8_WAIT_L(0); PG8_MMA(0, 0, At, B0); PG8_BAR; PG8_SCHED;
            PG8_LDB(B1, 1, 1); PG8_STAGE(PG8_SB(1, 0), b3, voffB);
            PG8_BAR; PG8_WAIT_L(0); PG8_MMA(0, 1, At, B1); PG8_BAR;
            PG8_LDA(At, 1, 1); PG8_STAGE(PG8_SA(1, 0), a3, voffA);
            PG8_BAR; PG8_WAIT_L(0); PG8_MMA(1, 0, At, B0); PG8_BAR; PG8_SCHED;
            PG8_STAGE(PG8_SB(1, 1), b3 + hstep, voffB);
            PG8_WAIT_V(6); PG8_BAR; PG8_MMA(1, 1, At, B1); PG8_BAR;
            }
        }
        if constexpr (ALIGN_EPI) { if (wr == 0) PG8_BAR; }
        if constexpr (!Epi::AFTER_DRAIN) { E(acc, cur, wr, wc, fr, fq);
#ifdef EPI_TWICE
            if constexpr (Epi::PERM) { asm volatile("" ::: "memory"); E(acc, cur, wr, wc, fr, fq); }
#endif
            S.done(cur); }
        if (!has_next) break;
#pragma unroll
        for (int a = 0; a < 2; ++a)
#pragma unroll
            for (int b = 0; b < 2; ++b)
#pragma unroll
                for (int m = 0; m < 4; ++m)
#pragma unroll
                    for (int n = 0; n < 2; ++n) acc[a][b][m][n] = acc_t{};
        cur = nxt; cA = nA; cB = nB; ++ui;
        if constexpr (ALIGN_EPI) { if (wr == 1) PG8_BAR; }
    }
    PG8_WAIT_V(0);
    if constexpr (!ALIGN_EPI) { if (wr == 0) PG8_BAR; }
    PG8_BAR;
    if constexpr (Epi::AFTER_DRAIN) { E.fused(acc, cur, wr, wc, fr, fq, lds, wid, lane); S.done(cur); }
#undef PG8_SA
#undef PG8_SB
#undef PG8_STAGE
#undef PG8_LDA
#undef PG8_LDB
#undef PG8_MMA
#undef PG8_CAT8
#undef PG8_WAIT_V
#undef PG8_WAIT_L
#undef PG8_BAR
#undef PG8_SCHED
}
}
#ifndef PG8_SP2
#define PG8_SP2 true
#endif
#ifndef PG8_ALIGN
#define PG8_ALIGN true
#endif
#ifndef USE_I8
#define USE_I8 true
#endif
#ifndef I8_QKV
#define I8_QKV USE_I8
#endif
#ifndef I8_DSA
#define I8_DSA true
#endif
#ifndef I8_GU
#define I8_GU USE_I8
#endif
#ifndef OUT_MODE
#define OUT_MODE 2
#endif
#ifndef DN_MODE
#define DN_MODE 2
#endif
#define I8_DN (DN_MODE == 1)
#ifndef WGM_QKV
#define WGM_QKV 2
#endif
#ifndef WGM_DSA
#define WGM_DSA 4
#endif
#ifndef WGM_OUT
#define WGM_OUT 4
#endif
#ifndef WGM_GU
#define WGM_GU 4
#endif
#ifndef WGM_DN
#define WGM_DN 4
#endif
#ifndef DSA_MERGE_POST
#define DSA_MERGE_POST 1
#endif
#ifndef PRO_SINGLE
#define PRO_SINGLE 1
#endif
#ifndef DIL_SPLIT
#define DIL_SPLIT 1
#endif
#ifndef DIL_FUSED
#define DIL_FUSED 0
#endif
#ifndef MK_MULTI
#define MK_MULTI 0
#endif

constexpr int NWAVES = 8;
constexpr int BATCH = 8, SEQ = 2048, D = 2048, M = BATCH * SEQ, NH = 16, HD = 128, DFF = 5632, KVL = 256, TOPK = 256, DEPTH = 4;
constexpr int NIN_A = 6144, NIN_B = 4496, NIN_BP = 4608, NMOD = 6 * D;
constexpr float EPS = 1e-6f;
constexpr float LOG2E = 1.4426950408889634f;
constexpr float QSCALE = 0.08838834764831845f * LOG2E;

constexpr size_t MiB = 1u << 20;
constexpr size_t WS_CTL = 0, CTL_ZERO_BYTES = 1 * MiB;
constexpr size_t WS_MOD = 1 * MiB;
constexpr size_t WS_W = 4 * MiB, W_LAYER = 100 * MiB;
constexpr size_t WO_IN = 0, WO_OUT = 24 * MiB, WO_GU = 32 * MiB, WO_DN = 76 * MiB, WO_UK = 98 * MiB, WO_UV = 99 * MiB;
constexpr size_t WS_H = 404 * MiB;
constexpr size_t WS_R1 = 468 * MiB;
constexpr size_t WS_ATT = 660 * MiB;
constexpr size_t WS_R2 = 724 * MiB;
constexpr size_t WS_X16 = 900 * MiB;
constexpr size_t WS_END = 964 * MiB;
constexpr size_t R2_ATT8 = 16 * MiB;
constexpr size_t R1_Q = 0, R1_QI = 64 * MiB, R1_OLAT = 0, R1_CKVR = 128 * MiB, R1_KI = 144 * MiB, R1_WI = 148 * MiB, R1_CKV = 149 * MiB, R1_SEL = 157 * MiB;
constexpr int CW_BAR = 4096;
constexpr size_t CTL_CMAX = 65536;
constexpr size_t CTL_DILCNT = 524288;
constexpr int CM_LAYER = 21504, CM_GU = 6144, CM_DN = 17408, CM_OUT = 19456;
constexpr size_t WS_SA = 2 * MiB + 512 * 1024;
constexpr size_t WS_RMAX = WS_SA + 65536;
constexpr size_t WS_SA2 = WS_SA + 131072;
constexpr size_t WS_SB = 3 * MiB;

constexpr int RING_BYTES = 143360;
constexpr int MISC_OFF = RING_BYTES;
constexpr int LDS_BYTES = RING_BYTES + 256;

#define GAS __attribute__((address_space(1)))
#define LAS __attribute__((address_space(3)))
typedef unsigned short bf16;
typedef unsigned short u16;
typedef unsigned v4u __attribute__((ext_vector_type(4)));
typedef unsigned v2u __attribute__((ext_vector_type(2)));
typedef float f32x4 __attribute__((ext_vector_type(4)));
typedef short bf16x8 __attribute__((ext_vector_type(8)));
typedef short s16x4 __attribute__((ext_vector_type(4)));
typedef short v4i16_t __attribute__((ext_vector_type(4)));
typedef GAS unsigned gu32;
template <class T> __device__ __forceinline__ T* as_global(T* p) { return (T*)(GAS T*)p; }
#define RLX_AGENT __ATOMIC_RELAXED, __HIP_MEMORY_SCOPE_AGENT
#define LDS_WAIT() asm volatile("s_waitcnt lgkmcnt(0)" ::: "memory")
#define VM_WAIT() asm volatile("s_waitcnt vmcnt(0)" ::: "memory")
__device__ __forceinline__ unsigned cvtpk(float lo, float hi) { return pg8::cvt_pk_bf16(lo, hi); }
#define DPPF(v, ctrl) __builtin_bit_cast(float, __builtin_amdgcn_update_dpp(0, __builtin_bit_cast(int, (v)), (ctrl), 0xF, 0xF, true))
__device__ __forceinline__ float xmax16(float v) { const unsigned u = __float_as_uint(v); auto r = __builtin_amdgcn_permlane16_swap(u, u, false, false); return fmaxf(__uint_as_float(r[0]), __uint_as_float(r[1])); }
__device__ __forceinline__ float xmax32(float v) { const unsigned u = __float_as_uint(v); auto r = __builtin_amdgcn_permlane32_swap(u, u, false, false); return fmaxf(__uint_as_float(r[0]), __uint_as_float(r[1])); }
__device__ __forceinline__ float xsum16(float v) { const unsigned u = __float_as_uint(v); auto r = __builtin_amdgcn_permlane16_swap(u, u, false, false); return __uint_as_float(r[0]) + __uint_as_float(r[1]); }
__device__ __forceinline__ float xsum32(float v) { const unsigned u = __float_as_uint(v); auto r = __builtin_amdgcn_permlane32_swap(u, u, false, false); return __uint_as_float(r[0]) + __uint_as_float(r[1]); }
__device__ __forceinline__ float wave_sum(float v) {
    v += DPPF(v, 0xB1); v += DPPF(v, 0x4E); v += DPPF(v, 0x141); v += DPPF(v, 0x140);
    return xsum32(xsum16(v));
}
__device__ __forceinline__ float wave_max(float v) {
    v = fmaxf(v, DPPF(v, 0xB1)); v = fmaxf(v, DPPF(v, 0x4E)); v = fmaxf(v, DPPF(v, 0x141)); v = fmaxf(v, DPPF(v, 0x140));
    return xmax32(xmax16(v));
}
__device__ __forceinline__ s16x4 tr_read(LAS const unsigned char* p) { return __builtin_bit_cast(s16x4, __builtin_amdgcn_ds_read_tr16_b64_v4i16((LAS v4i16_t*)p)); }
__device__ __forceinline__ bf16x8 cat8(s16x4 a, s16x4 b) { bf16x8 r; r[0] = a[0]; r[1] = a[1]; r[2] = a[2]; r[3] = a[3]; r[4] = b[0]; r[5] = b[1]; r[6] = b[2]; r[7] = b[3]; return r; }
__device__ __forceinline__ unsigned mbcnt64(unsigned long long m) { return __builtin_amdgcn_mbcnt_hi((unsigned)(m >> 32), __builtin_amdgcn_mbcnt_lo((unsigned)m, 0u)); }

#define XB_TMO      128
#define XB_XCNT(j)  (256  + 64 * (j))
#define XB_XSUB(j)  (1280 + 64 * (j))
#define XB_XGEN(j)  (2304 + 64 * (j))
#define XB_TOP      3328
#define XB_TOPGEN   3392
#define XCD_BAR_WORDS 3456
#define XB_SPIN_CAP (1u << 18)

__device__ __forceinline__ unsigned xb_ld(unsigned* p)              { return __hip_atomic_load(p, __ATOMIC_RELAXED, __HIP_MEMORY_SCOPE_AGENT); }
__device__ __forceinline__ unsigned xb_add(unsigned* p, unsigned v) { return __hip_atomic_fetch_add(p, v, __ATOMIC_RELAXED, __HIP_MEMORY_SCOPE_AGENT); }
__device__ __forceinline__ unsigned xb_xcc_id() { return (unsigned)__builtin_amdgcn_s_getreg((3 << 11) | 20) & 0xFu; }
#define XB_SPIN(cond, bar) do { unsigned _sp = 0; while (cond) { __builtin_amdgcn_s_sleep(1); \
    if ((++_sp & 255u) == 0u) { if (xb_ld(&(bar)[XB_TMO])) break; if (_sp > XB_SPIN_CAP) { atomicAdd(&(bar)[XB_TMO], 1u); break; } } } } while (0)

struct XcdBarrier {
    unsigned* bar; unsigned x;
    volatile LAS unsigned* st;
};

__device__ __forceinline__ XcdBarrier xcd_barrier_post(unsigned* bar, volatile LAS unsigned* st) {
    XcdBarrier b; b.bar = bar; b.x = xb_xcc_id(); b.st = st;
    if (threadIdx.x == 0) (void)xb_add(&bar[XB_XCNT(b.x)], 1u);
    return b;
}
__device__ __forceinline__ void xcd_barrier_complete(unsigned* bar, unsigned x, unsigned& nloc, unsigned& nx) {
    const unsigned G = gridDim.x * gridDim.y * gridDim.z;
    unsigned sum, cnt, mine, sp = 0u;
    for (;;) {
        sum = 0u; cnt = 0u; mine = 0u;
#pragma unroll
        for (unsigned j = 0; j < 16; ++j) { const unsigned c = xb_ld(&bar[XB_XCNT(j)]); sum += c; cnt += (c > 0u) ? 1u : 0u; mine = (j == x) ? c : mine; }
        if (sum == G) break;
        __builtin_amdgcn_s_sleep(1);
        if ((++sp & 255u) == 0u) { if (xb_ld(&bar[XB_TMO])) break; if (sp > XB_SPIN_CAP) { atomicAdd(&bar[XB_TMO], 1u); break; } }
    }
    nloc = mine > 0u ? mine : 1u; nx = cnt > 0u ? cnt : 1u;
}

__device__ __forceinline__ void xcd_barrier_census(const XcdBarrier& b) { unsigned nloc, nx; xcd_barrier_complete(b.bar, b.x, nloc, nx); b.st[0] = nloc; b.st[1] = nx; }
__device__ __forceinline__ void xcd_barrier(const XcdBarrier& b, const bool thread0  ) {
    asm volatile("s_waitcnt vmcnt(0)" ::: "memory");
    __syncthreads();
    if (thread0) {
        unsigned* bar = b.bar;
        __builtin_amdgcn_s_waitcnt(0);
        unsigned nloc = b.st[0], nx = b.st[1];
        const unsigned old = xb_add(&bar[XB_XSUB(b.x)], 1u);
        const unsigned gen = old / nloc;
        if (old + 1u == (gen + 1u) * nloc) {
            __builtin_amdgcn_fence(__ATOMIC_RELEASE, "agent");
            asm volatile("s_waitcnt vmcnt(0)" ::: "memory");
            const unsigned og = xb_add(&bar[XB_TOP], 1u);
            const unsigned tg = og / nx;
            if (og + 1u == (tg + 1u) * nx) xb_add(&bar[XB_TOPGEN], 1u);
            else XB_SPIN(xb_ld(&bar[XB_TOPGEN]) == tg, bar);
            __builtin_amdgcn_fence(__ATOMIC_ACQUIRE, "agent");
            xb_add(&bar[XB_XGEN(b.x)], 1u);
            asm volatile("s_waitcnt vmcnt(0)" ::: "memory");
        } else {
            XB_SPIN(xb_ld(&bar[XB_XGEN(b.x)]) == gen, bar);
            __builtin_amdgcn_fence(__ATOMIC_ACQUIRE, "agent");
            asm volatile("s_waitcnt vmcnt(0)" ::: "memory");
        }
    }
    __syncthreads();
}
struct LayerW { const float *norm_attn, *ada_w, *ada_b, *w_in, *kv_norm, *w_uk, *w_uv, *w_out, *norm_ffn, *w_gu, *w_down; };
struct Args { const float* x; const float* c; const float* final_norm; LayerW L[DEPTH]; float* out; unsigned char* ws; int ph_lo, ph_hi; };

__device__ __forceinline__ void colmax_item(const float* W, int N, unsigned* cmax, int item, int lane) {
    const int nnb = (N + 255) / 256, kb = item / nnb, nb = item % nnb, col = 256 * nb + 4 * lane;
    if (col < N) { const float* p = W + (size_t)(64 * kb) * N + col; f32x4 m = (f32x4){0.f, 0.f, 0.f, 0.f};
#pragma unroll 8
        for (int kk = 0; kk < 64; ++kk) { const f32x4 v = *(const f32x4*)(p + (size_t)kk * N); m[0] = fmaxf(m[0], fabsf(v[0])); m[1] = fmaxf(m[1], fabsf(v[1])); m[2] = fmaxf(m[2], fabsf(v[2])); m[3] = fmaxf(m[3], fabsf(v[3])); }
#pragma unroll
        for (int j = 0; j < 4; ++j) atomicMax(cmax + col + j, __float_as_uint(m[j])); }
}
constexpr int CI_INA = (D / 64) * (NIN_A / 256), CI_INB = I8_DSA ? (D / 64) * ((NIN_B + 255) / 256) : 0, CI_GU = (D / 64) * (2 * DFF / 256), CI_DN = (DFF / 64) * (D / 256), CI_OUT = OUT_MODE ? (D / 64) * (D / 256) : 0;
constexpr int CI_DIL = CI_INA + CI_GU + CI_DN + CI_OUT, CI_DSA = CI_INB + CI_GU + CI_DN + CI_OUT, CI_ALL = 2 * CI_DIL + 2 * CI_DSA;
__device__ __forceinline__ void p0_colmax(const Args& a, int gw, int NGW, int lane) {
    unsigned* cm = (unsigned*)(as_global(a.ws) + WS_CTL + CTL_CMAX);
    for (int it = gw; it < CI_ALL; it += NGW) {
        int r = it; int l;
        if (r < CI_DIL) l = 0; else { r -= CI_DIL; if (r < CI_DSA) l = 1; else { r -= CI_DSA; if (r < CI_DIL) l = 2; else { r -= CI_DIL; l = 3; } } }
        const LayerW& w = a.L[l]; unsigned* cml = cm + l * CM_LAYER; const int nin = (l & 1) ? NIN_B : NIN_A, ci_in = (l & 1) ? CI_INB : CI_INA;
        if (r < ci_in) colmax_item(as_global(w.w_in), nin, cml, r, lane); else if (r < ci_in + CI_GU) colmax_item(as_global(w.w_gu), 2 * DFF, cml + CM_GU, r - ci_in, lane); else if (r < ci_in + CI_GU + CI_DN) colmax_item(as_global(w.w_down), D, cml + CM_DN, r - ci_in - CI_GU, lane); else colmax_item(as_global(w.w_out), D, cml + CM_OUT, r - ci_in - CI_GU - CI_DN, lane);
    }
}
constexpr int TSCR = 64 * 65 * 4;
struct TrItem { const float* W; int ldw, srccol0, nvalid, k0, K, destrow0, mode; void* WT; const unsigned* cmax; float* sB; LAS const float* cml; };
__device__ __forceinline__ void tr_load(const TrItem& T, int lane, f32x4 (&v)[16]) {
    const int c4 = lane & 15, r4 = lane >> 4; const bool ok = 4 * c4 < T.nvalid; const float* p = T.W + (size_t)(T.k0 + r4) * T.ldw + T.srccol0 + 4 * c4;
#pragma unroll
    for (int it = 0; it < 16; ++it) { v[it] = (f32x4){0.f, 0.f, 0.f, 0.f}; if (ok) v[it] = *(const f32x4*)(p + (size_t)(4 * it) * T.ldw); }
}
__device__ __forceinline__ void tr_fill(LAS float* scr, int lane, const f32x4 (&v)[16]) {
    const int c4 = lane & 15, r4 = lane >> 4;
#pragma unroll
    for (int it = 0; it < 16; ++it) { LAS float* d = scr + (4 * it + r4) * 65 + 4 * c4; d[0] = v[it][0]; d[1] = v[it][1]; d[2] = v[it][2]; d[3] = v[it][3]; }
}
__device__ __forceinline__ void tr_emit(const TrItem& T, LAS float* scr, int lane) {
    const int q = lane & 3, rr = lane >> 2;
#pragma unroll
    for (int j = 0; j < 4; ++j) { const int n = rr + 16 * j; const LAS float* sp = scr + (16 * q) * 65 + n; float v[16];
#pragma unroll
        for (int e = 0; e < 16; ++e) v[e] = sp[e * 65];
        if (T.mode == 2) { const float cmx = (n < T.nvalid) ? (T.cml ? T.cml[n] : __uint_as_float(T.cmax[T.srccol0 + n])) : 0.f; const float inv = cmx > 0.f ? 256.0f / cmx : 0.f; unsigned w[4];
#pragma unroll
            for (int e = 0; e < 4; ++e) { unsigned ww = 0u; ww = __builtin_amdgcn_cvt_pk_fp8_f32(v[4 * e] * inv, v[4 * e + 1] * inv, ww, false); ww = __builtin_amdgcn_cvt_pk_fp8_f32(v[4 * e + 2] * inv, v[4 * e + 3] * inv, ww, true); w[e] = ww; }
            *(v4u*)((signed char*)T.WT + (size_t)(T.destrow0 + n) * T.K + T.k0 + 16 * q) = (v4u){w[0], w[1], w[2], w[3]}; }
        else if (T.mode) { const float cmx = (n < T.nvalid) ? (T.cml ? T.cml[n] : __uint_as_float(T.cmax[T.srccol0 + n])) : 0.f; const float inv = cmx > 0.f ? 127.0f / cmx : 0.f; unsigned b[16];
#pragma unroll
            for (int e = 0; e < 16; ++e) b[e] = (unsigned)(int)rintf(v[e] * inv) & 0xFFu;
            v4u o; o.x = b[0] | (b[1] << 8) | (b[2] << 16) | (b[3] << 24); o.y = b[4] | (b[5] << 8) | (b[6] << 16) | (b[7] << 24); o.z = b[8] | (b[9] << 8) | (b[10] << 16) | (b[11] << 24); o.w = b[12] | (b[13] << 8) | (b[14] << 16) | (b[15] << 24);
            *(v4u*)((signed char*)T.WT + (size_t)(T.destrow0 + n) * T.K + T.k0 + 16 * q) = o; }
        else { v4u o0, o1; o0.x = cvtpk(v[0], v[1]); o0.y = cvtpk(v[2], v[3]); o0.z = cvtpk(v[4], v[5]); o0.w = cvtpk(v[6], v[7]); o1.x = cvtpk(v[8], v[9]); o1.y = cvtpk(v[10], v[11]); o1.z = cvtpk(v[12], v[13]); o1.w = cvtpk(v[14], v[15]);
            bf16* dp = (bf16*)T.WT + (size_t)(T.destrow0 + n) * T.K + T.k0 + 16 * q; *(v4u*)dp = o0; *(v4u*)(dp + 8) = o1; } }
    if (T.mode && T.k0 == 0 && !T.cml) T.sB[T.destrow0 + lane] = (lane < T.nvalid) ? __uint_as_float(T.cmax[T.srccol0 + lane]) * (T.mode == 2 ? (1.0f / 256.0f) : (1.0f / 127.0f)) : 0.f;
}
__device__ __forceinline__ void tr_set(TrItem& T, const float* W, int K, int N, int Ndest, void* WT, int mode, const unsigned* cmax, float* sB, int item) {
    const int nnb = Ndest / 64, kb = item / nnb, nb = item % nnb, n0 = 64 * nb; int nv = N - n0; nv = nv < 0 ? 0 : (nv > 64 ? 64 : nv);
    T.W = W; T.ldw = N; T.srccol0 = n0; T.nvalid = nv; T.k0 = 64 * kb; T.K = K; T.destrow0 = n0; T.mode = mode; T.WT = WT; T.cmax = cmax; T.sB = sB; T.cml = nullptr;
}
constexpr int IT_INA = (D / 64) * (NIN_A / 64), IT_INB = (D / 64) * (NIN_BP / 64), IT_OUT = (D / 64) * (D / 64), IT_GU = (D / 64) * (2 * DFF / 64), IT_DN = (DFF / 64) * (D / 64), IT_UK = 16 * 8, IT_UV = 16 * 8;
constexpr int IT_DIL = IT_INA + IT_OUT + IT_GU + IT_DN, IT_DSA = IT_INB + IT_OUT + IT_GU + IT_DN + IT_UK + IT_UV;
constexpr int IT_ALL = 2 * IT_DIL + 2 * IT_DSA;
__device__ __forceinline__ void tr_decode(const Args& a, int it, TrItem& T) {
    int r = it; int l;
    if (r < IT_DIL) l = 0; else { r -= IT_DIL; if (r < IT_DSA) l = 1; else { r -= IT_DSA; if (r < IT_DIL) l = 2; else { r -= IT_DIL; l = 3; } } }
    const LayerW& w = a.L[l]; unsigned char* wb = as_global(a.ws) + WS_W + (size_t)l * W_LAYER;
    const unsigned* cml = (const unsigned*)(as_global(a.ws) + WS_CTL + CTL_CMAX) + l * CM_LAYER; float* sbl = (float*)(as_global(a.ws) + WS_SB) + l * CM_LAYER;
    if (!(l & 1)) { if (r < IT_INA) { tr_set(T, as_global(w.w_in), D, NIN_A, NIN_A, wb + WO_IN, I8_QKV, cml, sbl, r); return; } r -= IT_INA; }
    else { if (r < IT_INB) { tr_set(T, as_global(w.w_in), D, NIN_B, NIN_BP, wb + WO_IN, I8_DSA, cml, sbl, r); return; } r -= IT_INB; }
    if (r < IT_OUT) { tr_set(T, as_global(w.w_out), D, D, D, wb + WO_OUT, OUT_MODE, cml + CM_OUT, sbl + CM_OUT, r); return; } r -= IT_OUT;
    if (r < IT_GU) {
        const int nnb = (2 * DFF) / 64, kb = r / nnb, nb = r % nnb, n0 = 64 * nb, pn = n0 >> 8, lc = n0 & 255;
        T.W = as_global(w.w_gu); T.ldw = 2 * DFF; T.srccol0 = ((lc < 128) ? 0 : DFF) + 128 * pn + (lc & 127); T.nvalid = 64; T.k0 = 64 * kb; T.K = D; T.destrow0 = n0; T.mode = I8_GU; T.WT = wb + WO_GU; T.cmax = cml + CM_GU; T.sB = sbl + CM_GU; T.cml = nullptr; return; }
    r -= IT_GU;
    if (r < IT_DN) { tr_set(T, as_global(w.w_down), DFF, D, D, wb + WO_DN, DN_MODE, cml + CM_DN, sbl + CM_DN, r); return; } r -= IT_DN;
    if (r < IT_UK) { const int h = r >> 3; tr_set(T, as_global(w.w_uk) + (size_t)h * HD * KVL, HD, KVL, KVL, (bf16*)(wb + WO_UK) + (size_t)h * KVL * HD, 0, cml, sbl, r & 7); return; } r -= IT_UK;
    { const int h = r >> 3; tr_set(T, as_global(w.w_uv) + (size_t)h * KVL * HD, KVL, HD, HD, (bf16*)(wb + WO_UV) + (size_t)h * HD * KVL, 0, cml, sbl, r & 7); }
}
__device__ __forceinline__ void p0_transposes(const Args& a, LAS unsigned char* lds, int gw, int NGW, int wave, int lane) {
    LAS float* scr = (LAS float*)(lds + wave * TSCR);
    int it = gw; if (it >= IT_ALL) return;
    TrItem T, Tn; f32x4 v[16];
    tr_decode(a, it, T); tr_load(T, lane, v);
    for (;;) {
        tr_fill(scr, lane, v);
        LDS_WAIT(); asm volatile("" ::: "memory");
        const int itn = it + NGW; const bool has = itn < IT_ALL;
        tr_decode(a, has ? itn : it, Tn); tr_load(Tn, lane, v);
        tr_emit(T, scr, lane);
        LDS_WAIT(); asm volatile("" ::: "memory");
        if (!has) break;
        it = itn; T = Tn;
    }
}
constexpr int ST_INA = NIN_A / 64, ST_INB = NIN_BP / 64, ST_OUT = D / 64, ST_GU = 2 * DFF / 64, ST_DN = D / 64;
constexpr int ST_DIL = (I8_QKV ? ST_INA : 0) + (OUT_MODE ? ST_OUT : 0) + (I8_GU ? ST_GU : 0) + (DN_MODE ? ST_DN : 0), ST_DSA = (I8_DSA ? ST_INB : 0) + (OUT_MODE ? ST_OUT : 0) + (I8_GU ? ST_GU : 0) + (DN_MODE ? ST_DN : 0);
constexpr int ST_ALL = 2 * ST_DIL + 2 * ST_DSA;
__device__ __forceinline__ void strip_decode(const Args& a, int sidx, TrItem& T) {
    int r = sidx; int l;
    if (DN_MODE && r < 4 * ST_DN) { l = r / ST_DN; r = r % ST_DN; const LayerW& w = a.L[l]; unsigned char* wb = as_global(a.ws) + WS_W + (size_t)l * W_LAYER; float* sbl = (float*)(as_global(a.ws) + WS_SB) + l * CM_LAYER;
        T.W = as_global(w.w_down); T.ldw = D; T.srccol0 = 64 * r; T.nvalid = 64; T.K = DFF; T.destrow0 = 64 * r; T.mode = DN_MODE; T.WT = wb + WO_DN; T.cmax = nullptr; T.sB = sbl + CM_DN; return; }
    if (DN_MODE) r -= 4 * ST_DN;
    const int per_dil = ST_DIL - (DN_MODE ? ST_DN : 0), per_dsa = ST_DSA - (DN_MODE ? ST_DN : 0);
    if (r < per_dil) l = 0; else { r -= per_dil; if (r < per_dsa) l = 1; else { r -= per_dsa; if (r < per_dil) l = 2; else { r -= per_dil; l = 3; } } }
    const LayerW& w = a.L[l]; unsigned char* wb = as_global(a.ws) + WS_W + (size_t)l * W_LAYER; float* sbl = (float*)(as_global(a.ws) + WS_SB) + l * CM_LAYER;
    const bool dsa = l & 1; const int st_in = dsa ? (I8_DSA ? ST_INB : 0) : (I8_QKV ? ST_INA : 0);
    T.cmax = nullptr; T.K = D;
    if (r < st_in) { const int N = dsa ? NIN_B : NIN_A; int nv = N - 64 * r; nv = nv < 0 ? 0 : (nv > 64 ? 64 : nv);
        T.W = as_global(w.w_in); T.ldw = N; T.srccol0 = 64 * r; T.nvalid = nv; T.destrow0 = 64 * r; T.mode = 1; T.WT = wb + WO_IN; T.sB = sbl; return; }
    r -= st_in;
    if (OUT_MODE && r < ST_OUT) { T.W = as_global(w.w_out); T.ldw = D; T.srccol0 = 64 * r; T.nvalid = 64; T.destrow0 = 64 * r; T.mode = OUT_MODE; T.WT = wb + WO_OUT; T.sB = sbl + CM_OUT; return; }
    if (OUT_MODE) r -= ST_OUT;
    { const int n0 = 64 * r, pn = n0 >> 8, lc = n0 & 255;
      T.W = as_global(w.w_gu); T.ldw = 2 * DFF; T.srccol0 = ((lc < 128) ? 0 : DFF) + 128 * pn + (lc & 127); T.nvalid = 64; T.destrow0 = n0; T.mode = 1; T.WT = wb + WO_GU; T.sB = sbl + CM_GU; }
}
__device__ __forceinline__ void p0_strips(const Args& a, LAS unsigned char* lds, int vcu, int G, int tid, int wave, int lane) {
    LAS float* scr = (LAS float*)(lds + wave * TSCR); LAS float* wm = (LAS float*)(lds + 8 * TSCR); LAS float* cmx = wm + 8 * 64;
    constexpr int ST_LONG = DN_MODE ? 4 * ST_DN : 0, ST_SHORT = ST_ALL - ST_LONG;
    const bool bal = (G == 256) && (ST_LONG == 128) && (ST_SHORT >= 1152);
    for (int i = 0;; ++i) {
        int sidx;
        if (bal) { if (vcu < 128) { if (i == 0) sidx = vcu; else if (i <= 3) sidx = ST_LONG + 3 * vcu + (i - 1); else break; }
                   else { const int c = vcu - 128; if (i < 6) sidx = ST_LONG + 384 + 6 * c + i; else if (i == 6 && 1152 + c < ST_SHORT) sidx = ST_LONG + 1152 + c; else break; } }
        else { sidx = vcu + i * G; if (sidx >= ST_ALL) break; }
        TrItem T; strip_decode(a, sidx, T); T.cml = cmx;
        const int nkb = T.K / 64; f32x4 v[16];
        f32x4 mx = (f32x4){0.f, 0.f, 0.f, 0.f};
        { int kb = wave; T.k0 = 64 * kb; if (kb < nkb) tr_load(T, lane, v);
          while (kb < nkb) { f32x4 m2 = (f32x4){0.f, 0.f, 0.f, 0.f};
#pragma unroll
              for (int it = 0; it < 16; ++it) { m2[0] = fmaxf(m2[0], fabsf(v[it][0])); m2[1] = fmaxf(m2[1], fabsf(v[it][1])); m2[2] = fmaxf(m2[2], fabsf(v[it][2])); m2[3] = fmaxf(m2[3], fabsf(v[it][3])); }
              const int kn = kb + 8; T.k0 = 64 * (kn < nkb ? kn : kb); tr_load(T, lane, v);
              mx[0] = fmaxf(mx[0], m2[0]); mx[1] = fmaxf(mx[1], m2[1]); mx[2] = fmaxf(mx[2], m2[2]); mx[3] = fmaxf(mx[3], m2[3]); kb = kn; } }
#pragma unroll
        for (int j = 0; j < 4; ++j) mx[j] = xmax32(xmax16(mx[j]));
        if (lane < 16) *(LAS f32x4*)(wm + wave * 64 + 4 * lane) = mx;
        __syncthreads();
        if (tid < 64) { float m = wm[tid];
#pragma unroll
            for (int w8 = 1; w8 < 8; ++w8) m = fmaxf(m, wm[w8 * 64 + tid]);
            cmx[tid] = m; T.sB[T.destrow0 + tid] = (tid < T.nvalid) ? m * (T.mode == 2 ? (1.0f / 256.0f) : (1.0f / 127.0f)) : 0.f; }
        __syncthreads();
        { int kb = wave; if (kb < nkb) { T.k0 = 64 * kb; tr_load(T, lane, v);
            for (;;) { tr_fill(scr, lane, v); LDS_WAIT(); asm volatile("" ::: "memory");
                const int kn = kb + 8; TrItem Tn = T; Tn.k0 = 64 * (kn < nkb ? kn : kb); tr_load(Tn, lane, v);
                tr_emit(T, scr, lane); LDS_WAIT(); asm volatile("" ::: "memory");
                if (kn >= nkb) break; kb = kn; T.k0 = 64 * kb; } } }
        __syncthreads();
    }
}
__device__ __forceinline__ void p0_bf16_items(const Args& a, LAS unsigned char* lds, int gw, int NGW, int wave, int lane) {
    LAS float* scr = (LAS float*)(lds + wave * TSCR); f32x4 v[16];
    if (I8_QKV && I8_DSA && OUT_MODE && I8_GU && DN_MODE) {
        for (int it2 = gw; it2 < 2 * (IT_UK + IT_UV); it2 += NGW) { const int l2 = it2 / (IT_UK + IT_UV), it = (l2 ? 2 * IT_DIL + 2 * IT_DSA : IT_DIL + IT_DSA) - (IT_UK + IT_UV) + it2 % (IT_UK + IT_UV);
            TrItem T; tr_decode(a, it, T); tr_load(T, lane, v); tr_fill(scr, lane, v); LDS_WAIT(); asm volatile("" ::: "memory"); tr_emit(T, scr, lane); LDS_WAIT(); asm volatile("" ::: "memory"); }
        return; }
    for (int it = gw; it < IT_ALL; it += NGW) { TrItem T; tr_decode(a, it, T); if (T.mode != 0) continue;
        tr_load(T, lane, v); tr_fill(scr, lane, v); LDS_WAIT(); asm volatile("" ::: "memory"); tr_emit(T, scr, lane); LDS_WAIT(); asm volatile("" ::: "memory"); }
}
constexpr int SC_STRIDE = 2112;
__device__ __forceinline__ void p0_adaln(const Args& a, LAS unsigned char* lds, int G, int tid, int wave, int lane) {
    LAS float* sc = (LAS float*)lds;
    LAS float* red = (LAS float*)(lds + 8 * SC_STRIDE * 4);
    float* mod = (float*)(as_global(a.ws) + WS_MOD); const float* cin = as_global(a.c);
    for (int i = tid; i < BATCH * D; i += NWAVES * 64) { const int b = i >> 11, k = i & 2047; const float v = cin[i]; sc[b * SC_STRIDE + k + (k >> 6)] = v / (1.0f + __expf(-v)); }
    __syncthreads();
    const int cg = tid & 15, ks = tid >> 4;
    for (int u = blockIdx.x; u < DEPTH * (NMOD / 64); u += G) {
        const int l = u / (NMOD / 64), col0 = 64 * (u % (NMOD / 64));
        const float* wp = as_global(a.L[l].ada_w) + (size_t)(64 * ks) * NMOD + col0 + 4 * cg;
        f32x4 acc[8];
#pragma unroll
        for (int b = 0; b < 8; ++b) acc[b] = (f32x4){0.f, 0.f, 0.f, 0.f};
#pragma unroll 4
        for (int kk = 0; kk < 64; ++kk) { const f32x4 w4 = *(const f32x4*)(wp + (size_t)kk * NMOD); const int kx = 64 * ks + kk + ks;
#pragma unroll
            for (int b = 0; b < 8; ++b) acc[b] += sc[b * SC_STRIDE + kx] * w4; }
#pragma unroll
        for (int b = 0; b < 8; ++b)
#pragma unroll
            for (int j = 0; j < 4; ++j) { acc[b][j] = xsum32(xsum16(acc[b][j])); }
        if (lane < 16) {
#pragma unroll
            for (int b = 0; b < 8; ++b) *(LAS f32x4*)(red + (wave * 8 + b) * 64 + 4 * cg) = acc[b]; }
        __syncthreads();
        { const int b = tid >> 6, col = tid & 63; float s = as_global(a.L[l].ada_b)[col0 + col];
#pragma unroll
          for (int w = 0; w < 8; ++w) s += red[(w * 8 + b) * 64 + col];
          mod[((size_t)l * BATCH + b) * NMOD + col0 + col] = s; }
        __syncthreads();
    }
}
__device__ __forceinline__ void ld8(const void* base, int is_f32, size_t idx, f32x4& a, f32x4& b) {
    if (is_f32) { const float* p = (const float*)base + idx; a = *(const f32x4*)p; b = *(const f32x4*)(p + 4); }
    else { const v4u w = *(const v4u*)((const bf16*)base + idx); a = (f32x4){__uint_as_float(w.x << 16), __uint_as_float(w.x & 0xFFFF0000u), __uint_as_float(w.y << 16), __uint_as_float(w.y & 0xFFFF0000u)};
        b = (f32x4){__uint_as_float(w.z << 16), __uint_as_float(w.z & 0xFFFF0000u), __uint_as_float(w.w << 16), __uint_as_float(w.w & 0xFFFF0000u)}; }
}
__device__ __forceinline__ void norm_mod_phase(const void* x, int xf32, const float* gain, const float* shift, const float* scale, bf16* h, int gw, int NGW, int lane) {
    for (int grp = gw; grp < M / 8; grp += NGW) {
        const int b = (grp * 8) >> 11;
        f32x4 A[8], B[8];
#pragma unroll
        for (int j = 0; j < 4; ++j)
#pragma unroll
            for (int e = 0; e < 2; ++e) { const int col = 8 * lane + 512 * j + 4 * e;
                const f32x4 g = *(const f32x4*)(gain + col), sc = *(const f32x4*)(scale + (size_t)b * NMOD + col); A[2 * j + e] = g * (sc + 1.0f); B[2 * j + e] = *(const f32x4*)(shift + (size_t)b * NMOD + col); }
        for (int rr = 0; rr < 8; ++rr) { const size_t row = (size_t)grp * 8 + rr;
            f32x4 v[8]; float ss = 0.f;
#pragma unroll
            for (int j = 0; j < 4; ++j) { ld8(x, xf32, row * D + 8 * lane + 512 * j, v[2 * j], v[2 * j + 1]);
#pragma unroll
                for (int e = 0; e < 2; ++e) { const f32x4 t = v[2 * j + e]; ss += (t[0] * t[0] + t[1] * t[1]) + (t[2] * t[2] + t[3] * t[3]); } }
            const float rstd = __builtin_amdgcn_rsqf(wave_sum(ss) * (1.0f / D) + EPS);
#pragma unroll
            for (int j = 0; j < 4; ++j) { const f32x4 y0 = v[2 * j] * rstd * A[2 * j] + B[2 * j], y1 = v[2 * j + 1] * rstd * A[2 * j + 1] + B[2 * j + 1];
                v4u o; o.x = cvtpk(y0[0], y0[1]); o.y = cvtpk(y0[2], y0[3]); o.z = cvtpk(y1[0], y1[1]); o.w = cvtpk(y1[2], y1[3]);
                *(v4u*)(h + row * D + 8 * lane + 512 * j) = o; }
        }
    }
}

__device__ __forceinline__ void norm_mod_phase_q(const void* x, int xf32, const float* gain, const float* shift, const float* scale, signed char* h, float* sA, unsigned* rmax0, int gw, int NGW, int lane) {
    for (int grp = gw; grp < M / 8; grp += NGW) {
        const int b = (grp * 8) >> 11;
        f32x4 A[8], B[8];
#pragma unroll
        for (int j = 0; j < 4; ++j)
#pragma unroll
            for (int e = 0; e < 2; ++e) { const int col = 8 * lane + 512 * j + 4 * e;
                const f32x4 g = *(const f32x4*)(gain + col), sc = *(const f32x4*)(scale + (size_t)b * NMOD + col); A[2 * j + e] = g * (sc + 1.0f); B[2 * j + e] = *(const f32x4*)(shift + (size_t)b * NMOD + col); }
        v4u pk[4][4];
#pragma unroll
        for (int rr = 0; rr < 8; ++rr) { const size_t row = (size_t)grp * 8 + rr;
            if (!xf32 && (rr & 3) == 0) {
#pragma unroll
                for (int r4 = 0; r4 < 4; ++r4)
#pragma unroll
                    for (int j = 0; j < 4; ++j) pk[r4][j] = *(const v4u*)((const bf16*)x + (row + r4) * D + 8 * lane + 512 * j); }
            f32x4 v[8]; float ss = 0.f;
#pragma unroll
            for (int j = 0; j < 4; ++j) { if (xf32) ld8(x, 1, row * D + 8 * lane + 512 * j, v[2 * j], v[2 * j + 1]);
                else { const v4u w = pk[rr & 3][j]; v[2 * j] = (f32x4){__uint_as_float(w.x << 16), __uint_as_float(w.x & 0xFFFF0000u), __uint_as_float(w.y << 16), __uint_as_float(w.y & 0xFFFF0000u)};
                    v[2 * j + 1] = (f32x4){__uint_as_float(w.z << 16), __uint_as_float(w.z & 0xFFFF0000u), __uint_as_float(w.w << 16), __uint_as_float(w.w & 0xFFFF0000u)}; }
#pragma unroll
                for (int e = 0; e < 2; ++e) { const f32x4 t = v[2 * j + e]; ss += (t[0] * t[0] + t[1] * t[1]) + (t[2] * t[2] + t[3] * t[3]); } }
            const float rstd = __builtin_amdgcn_rsqf(wave_sum(ss) * (1.0f / D) + EPS);
            float amax = 0.f;
#pragma unroll
            for (int j = 0; j < 8; ++j) { v[j] = v[j] * rstd * A[j] + B[j]; amax = fmaxf(fmaxf(amax, fmaxf(fabsf(v[j][0]), fabsf(v[j][1]))), fmaxf(fabsf(v[j][2]), fabsf(v[j][3]))); }
            amax = wave_max(amax);
            const float inv = amax > 0.f ? 127.0f / amax : 0.f;
#pragma unroll
            for (int j = 0; j < 4; ++j) { unsigned q[8];
#pragma unroll
                for (int e = 0; e < 4; ++e) { q[e] = (unsigned)(int)rintf(v[2 * j][e] * inv) & 0xFFu; q[4 + e] = (unsigned)(int)rintf(v[2 * j + 1][e] * inv) & 0xFFu; }
                v2u o; o.x = q[0] | (q[1] << 8) | (q[2] << 16) | (q[3] << 24); o.y = q[4] | (q[5] << 8) | (q[6] << 16) | (q[7] << 24);
                *(v2u*)(h + row * D + 8 * lane + 512 * j) = o; }
            if (lane == 0) { sA[row] = amax * (1.0f / 127.0f); if (rmax0) rmax0[row] = 0u; }
        }
    }
}

__device__ __forceinline__ void aq_load(const bf16* act, int row, int lane, v4u (&w)[11]) { const bf16* ar = act + (size_t)row * DFF + 8 * lane;
#pragma unroll
    for (int it = 0; it < 11; ++it) w[it] = *(const v4u*)(ar + 512 * it); }
__device__ __forceinline__ void aq_emit(const v4u (&w)[11], float mx, signed char* q, float* sA2, int row, int lane) {
    const float inv = mx > 0.f ? 127.0f / mx : 0.f; signed char* qr = q + (size_t)row * DFF + 8 * lane;
#pragma unroll
    for (int it = 0; it < 11; ++it) { unsigned o[8];
#pragma unroll
        for (int e = 0; e < 4; ++e) { const unsigned ww = w[it][e]; float lo = __uint_as_float(ww << 16) * inv, hi = __uint_as_float(ww & 0xFFFF0000u) * inv;
            lo = fminf(fmaxf(rintf(lo), -127.f), 127.f); hi = fminf(fmaxf(rintf(hi), -127.f), 127.f); o[2 * e] = (unsigned)(int)lo & 0xFFu; o[2 * e + 1] = (unsigned)(int)hi & 0xFFu; }
        v2u ov; ov.x = o[0] | (o[1] << 8) | (o[2] << 16) | (o[3] << 24); ov.y = o[4] | (o[5] << 8) | (o[6] << 16) | (o[7] << 24);
        *(v2u*)(qr + 512 * it) = ov; }
    if (lane == 0) sA2[row] = mx * (1.0f / 127.0f);
}
__device__ __forceinline__ void act_quant_phase(const bf16* act, const unsigned* rmax, signed char* q, float* sA2, int gw, int NGW, int lane) {
    int row = gw; if (row >= M) return;
    v4u wa[11], wb2[11]; float ma = __uint_as_float(rmax[row]); aq_load(act, row, lane, wa);
    for (;;) {
        const int r1 = row + NGW; const bool h1 = r1 < M; const int r1c = h1 ? r1 : row;
        const float mb = __uint_as_float(rmax[r1c]); aq_load(act, r1c, lane, wb2);
        aq_emit(wa, ma, q, sA2, row, lane);
        if (!h1) break;
        const int r2 = r1 + NGW; const bool h2 = r2 < M; const int r2c = h2 ? r2 : r1;
        ma = __uint_as_float(rmax[r2c]); aq_load(act, r2c, lane, wa);
        aq_emit(wb2, mb, q, sA2, r1, lane);
        if (!h2) break;
        row = r2;
    }
}
__device__ __forceinline__ void final_norm_phase(const bf16* x, float* out, const float* gain, int gw, int NGW, int lane) {
    f32x4 gv[8];
#pragma unroll
    for (int j = 0; j < 4; ++j)
#pragma unroll
        for (int e = 0; e < 2; ++e) gv[2 * j + e] = *(const f32x4*)(gain + 8 * lane + 512 * j + 4 * e);
    for (int grp = gw; grp < M / 4; grp += NGW) {
        v4u pk[4][4];
#pragma unroll
        for (int r4 = 0; r4 < 4; ++r4)
#pragma unroll
            for (int j = 0; j < 4; ++j) pk[r4][j] = *(const v4u*)(x + ((size_t)grp * 4 + r4) * D + 8 * lane + 512 * j);
#pragma unroll
        for (int r4 = 0; r4 < 4; ++r4) { const size_t row = (size_t)grp * 4 + r4;
            f32x4 v[8]; float ss = 0.f;
#pragma unroll
            for (int j = 0; j < 4; ++j) { const v4u w = pk[r4][j]; v[2 * j] = (f32x4){__uint_as_float(w.x << 16), __uint_as_float(w.x & 0xFFFF0000u), __uint_as_float(w.y << 16), __uint_as_float(w.y & 0xFFFF0000u)};
                v[2 * j + 1] = (f32x4){__uint_as_float(w.z << 16), __uint_as_float(w.z & 0xFFFF0000u), __uint_as_float(w.w << 16), __uint_as_float(w.w & 0xFFFF0000u)};
#pragma unroll
                for (int e = 0; e < 2; ++e) { const f32x4 t = v[2 * j + e]; ss += (t[0] * t[0] + t[1] * t[1]) + (t[2] * t[2] + t[3] * t[3]); } }
            const float rstd = __builtin_amdgcn_rsqf(wave_sum(ss) * (1.0f / D) + EPS); float* orow = out + row * D;
#pragma unroll
            for (int j = 0; j < 4; ++j)
#pragma unroll
                for (int e = 0; e < 2; ++e) *(f32x4*)(orow + 8 * lane + 512 * j + 4 * e) = v[2 * j + e] * rstd * gv[2 * j + e]; }
    }
}
constexpr int VROW = 272, VROW2 = 288;
constexpr int KV_LDS = 256 * VROW;
struct BAUnit { int b, h, qbase, qstride, kbase, kstride, first, dil; };
__device__ __forceinline__ BAUnit ba_decode(int pass, int u) {
    BAUnit U; const int bh = u >> 4, s = u & 15; U.b = bh >> 4; U.h = bh & 15;
    if (pass == 0) { U.qbase = 128 * s; U.qstride = 1; U.kbase = 128 * s - 128; U.kstride = 1; U.first = (s == 0); U.dil = 1; }
    else if (pass == 1) { const int rho = s >> 2, n = s & 3; U.qbase = 512 * n + rho; U.qstride = 4; U.kbase = 512 * n - 512 + rho; U.kstride = 4; U.first = (n == 0); U.dil = 4; }
    else { U.qbase = s; U.qstride = 16; U.kbase = s - 2048; U.kstride = 16; U.first = 1; U.dil = 16; }
    return U;
}
template <bool HALF = false> __device__ __forceinline__ void ba_load(const BAUnit& U, const bf16* K, const bf16* V, int tid, v4u (&kr)[8], v4u (&vr)[8]) {
    const int c = tid & 15, r0 = tid >> 4;
#pragma unroll
    for (int it = HALF ? 4 : 0; it < 8; ++it) { const int j = r0 + 32 * it; int p = U.kbase + U.kstride * j; p = p < 0 ? 0 : p;
        const size_t off = ((size_t)U.b * SEQ + p) * D + U.h * HD + 8 * c;
        kr[it] = *(const v4u*)(K + off); vr[it] = *(const v4u*)(V + off); }
}
template <bool HALF = false> __device__ __forceinline__ void ba_store(LAS unsigned char* lds, int tid, const v4u (&kr)[8], const v4u (&vr)[8]) {
    const int c = tid & 15, r0 = tid >> 4;
#pragma unroll
    for (int it = HALF ? 4 : 0; it < 8; ++it) { const int j = r0 + 32 * it; *(LAS v4u*)(lds + j * VROW + 16 * c) = kr[it]; *(LAS v4u*)(lds + KV_LDS + j * VROW2 + 16 * c) = vr[it]; }
}
__device__ __forceinline__ void ba_qload(const BAUnit& U, const bf16* Q, int w, int lane, bf16x8 (&qf)[4]) {
    const int i = lane & 15, g = lane >> 4, qi = 16 * w + i; const size_t qrow = (size_t)U.b * SEQ + U.qbase + U.qstride * qi;
#pragma unroll
    for (int kk = 0; kk < 4; ++kk) qf[kk] = *(const bf16x8*)(Q + qrow * D + U.h * HD + 32 * kk + 8 * g);
}
template <bool FUSED> __device__ __forceinline__ void ba_compute(const BAUnit& U, int pass, bf16x8 (&qf)[4], bf16* O, float* LSE, LAS unsigned char* lds, int w, int lane, unsigned* waitc, const v2u (&ppre)[8], float lpre, const BAUnit& Un, const bf16* Qn, unsigned char* O8 = nullptr) {
    const int i = lane & 15, g = lane >> 4, qi = 16 * w + i; const size_t qrow = (size_t)U.b * SEQ + U.qbase + U.qstride * qi;
    const float sl = __builtin_amdgcn_exp2f(-0.5f * (float)(U.h + 1)) * LOG2E * (float)U.dil;
    const int d0 = U.first ? (8 - w) : 0;
    f32x4 s[10];
#pragma unroll
    for (int d = 0; d < 9; ++d) { f32x4 acc = (f32x4){0.f, 0.f, 0.f, 0.f};
        if (d >= d0) { const LAS unsigned char* kp = lds + (16 * (w + d) + i) * VROW + 16 * g;
#pragma unroll
            for (int kk = 0; kk < 4; ++kk) { const bf16x8 kf = *(const LAS bf16x8*)(kp + 64 * kk); acc = __builtin_amdgcn_mfma_f32_16x16x32_bf16(kf, qf[kk], acc, 0, 0, 0); } }
        s[d] = acc; }
    if (Qn) ba_qload(Un, Qn, w, lane, qf);
    float cmax = -1e30f;
#pragma unroll
    for (int d = 0; d < 9; ++d)
#pragma unroll
        for (int r = 0; r < 4; ++r) { const int rel = i - (4 * g + r) + 16 * (8 - d);
            const bool ok = (d >= d0) && (rel >= 0) && (rel <= 128);
            const float v = ok ? (s[d][r] - sl * (float)rel) : -INFINITY; s[d][r] = v; cmax = fmaxf(cmax, v); }
    cmax = xmax32(xmax16(cmax));
    const float m = cmax; float l = 0.f;
#pragma unroll
    for (int d = 0; d < 9; ++d)
#pragma unroll
        for (int r = 0; r < 4; ++r) { const float pv = __builtin_amdgcn_exp2f(s[d][r] - m); s[d][r] = pv; l += pv; }
    l = xsum32(xsum16(l));
    s[9] = (f32x4){0.f, 0.f, 0.f, 0.f};
    f32x4 o[8];
#pragma unroll
    for (int c = 0; c < 8; ++c) o[c] = (f32x4){0.f, 0.f, 0.f, 0.f};
#pragma unroll
    for (int dp = 0; dp < 10; dp += 2) {
        if (dp + 1 >= d0) {
            bf16x8 pf; { const v4u t = (v4u){cvtpk(s[dp][0], s[dp][1]), cvtpk(s[dp][2], s[dp][3]), cvtpk(s[dp + 1][0], s[dp + 1][1]), cvtpk(s[dp + 1][2], s[dp + 1][3])}; pf = __builtin_bit_cast(bf16x8, t); }
            int t0 = w + dp, t1 = w + dp + 1; t0 = t0 > 15 ? 15 : t0; t1 = t1 > 15 ? 15 : t1;
            const LAS unsigned char* vb0 = lds + KV_LDS + (16 * t0 + 4 * g + (i >> 2)) * VROW2 + 8 * (i & 3);
            const LAS unsigned char* vb1 = lds + KV_LDS + (16 * t1 + 4 * g + (i >> 2)) * VROW2 + 8 * (i & 3);
#pragma unroll
            for (int c = 0; c < 8; ++c) { const s16x4 lo = tr_read(vb0 + 32 * c), hi = tr_read(vb1 + 32 * c); o[c] = __builtin_amdgcn_mfma_f32_16x16x32_bf16(cat8(lo, hi), pf, o[c], 0, 0, 0); }
        }
    }
    float inv = 1.0f / l; float lse = m + __builtin_amdgcn_logf(l);
    bf16* op = O + qrow * D + U.h * HD + 4 * g; float* lp = LSE + qrow * NH + U.h;
    if (FUSED && pass > 0) {
        if (threadIdx.x == 0) { unsigned sp = 0; while (__hip_atomic_load(waitc, RLX_AGENT) < 16u) { __builtin_amdgcn_s_sleep(2); if (++sp > (1u << 22)) break; }
            __builtin_amdgcn_fence(__ATOMIC_ACQUIRE, "agent"); asm volatile("s_waitcnt vmcnt(0)" ::: "memory"); }
        __syncthreads(); }
    if (pass > 0) { const float lprev = FUSED ? *lp : lpre; const float mx = fmaxf(lprev, lse); const float wa = __builtin_amdgcn_exp2f(lprev - mx), wb = __builtin_amdgcn_exp2f(lse - mx); const float wi = 1.0f / (wa + wb);
        const float fa = wa * wi, fb = wb * wi * inv;
#pragma unroll
        for (int c = 0; c < 8; ++c) { const v2u pw = FUSED ? *(const v2u*)(op + 16 * c) : ppre[c];
            const float p0 = __uint_as_float(pw.x << 16), p1 = __uint_as_float(pw.x & 0xFFFF0000u), p2 = __uint_as_float(pw.y << 16), p3 = __uint_as_float(pw.y & 0xFFFF0000u);
            o[c][0] = fa * p0 + fb * o[c][0]; o[c][1] = fa * p1 + fb * o[c][1]; o[c][2] = fa * p2 + fb * o[c][2]; o[c][3] = fa * p3 + fb * o[c][3]; }
        inv = 1.0f; lse = mx + __builtin_amdgcn_logf(wa + wb); }
#pragma unroll
    for (int c = 0; c < 8; ++c) { v2u w2; w2.x = cvtpk(o[c][0] * inv, o[c][1] * inv); w2.y = cvtpk(o[c][2] * inv, o[c][3] * inv);
        if (FUSED && pass < 2) __hip_atomic_store((unsigned long long*)(op + 16 * c), ((unsigned long long)w2.y << 32) | w2.x, RLX_AGENT);
        else if (pass == 2 && O8) { unsigned w8 = 0u; w8 = __builtin_amdgcn_cvt_pk_fp8_f32(o[c][0] * inv, o[c][1] * inv, w8, false); w8 = __builtin_amdgcn_cvt_pk_fp8_f32(o[c][2] * inv, o[c][3] * inv, w8, true);
            *(unsigned*)(O8 + qrow * D + U.h * HD + 4 * g + 16 * c) = w8; }
        else *(v2u*)(op + 16 * c) = w2; }
    if (pass < 2 && g == 0) { if (FUSED) __hip_atomic_store((unsigned*)lp, __float_as_uint(lse), RLX_AGENT); else *lp = lse; }
}
__device__ __forceinline__ void ba_pload(const BAUnit& U, const bf16* O, const float* LSE, int w, int lane, v2u (&pp)[8], float& lp) {
    const int i = lane & 15, g = lane >> 4, qi = 16 * w + i; const size_t qrow = (size_t)U.b * SEQ + U.qbase + U.qstride * qi;
    const bf16* op = O + qrow * D + U.h * HD + 4 * g;
#pragma unroll
    for (int c = 0; c < 8; ++c) pp[c] = *(const v2u*)(op + 16 * c);
    lp = LSE[qrow * NH + U.h];
}
template <int variant = 0, bool HALF = false  > __device__ __forceinline__ void dil_attn_pass(int pass, const bf16* Q, const bf16* K, const bf16* V, bf16* O, float* LSE, LAS unsigned char* lds, int vcu, int G, int tid, int wave, int lane, int u_lo = 0, int u_hi = BATCH * NH * 16, unsigned char* O8 = nullptr) {
    v4u kr[8], vr[8]; bf16x8 qf[4]; v2u pp[8]; float lp = 0.f;
#pragma unroll
    for (int c = 0; c < 8; ++c) pp[c] = (v2u){0u, 0u};
    int u = u_lo + vcu; const int NU = u_hi;
    if (u >= NU) return;
    BAUnit U = ba_decode(pass, u);
    ba_qload(U, Q, wave, lane, qf);
    ba_load<HALF>(U, K, V, tid, kr, vr);
    for (;;) {
        ba_store<HALF>(lds, tid, kr, vr);
        __syncthreads();
        const int un = u + G; const BAUnit Un = ba_decode(pass, un < NU ? un : u);
        if (pass > 0) ba_pload(U, O, LSE, wave, lane, pp, lp);
        asm volatile("" ::: "memory");
        ba_load<HALF>(Un, K, V, tid, kr, vr);
        ba_compute<false>(U, pass, qf, O, LSE, lds, wave, lane, nullptr, pp, lp, Un, Q, O8);
        __syncthreads();
        if (un >= NU) break;
        u = un; U = Un;
    }
}

__device__ __forceinline__ void dil_attn_fused(const bf16* Q, const bf16* K, const bf16* V, bf16* O, float* LSE, unsigned* cnt, LAS unsigned char* lds, int vcu, int G, int tid, int wave, int lane) {
    v4u kr[8], vr[8];
    const int team = vcu >> 4, sidx = vcu & 15, nteam = G >> 4, NBH = BATCH * NH;
    const int nit = ((NBH - team + nteam - 1) / nteam) * 3;
    if (nit <= 0) return;
    int it = 0; int bh = team, pass = 0;
    BAUnit U = ba_decode(pass, bh * 16 + sidx);
    ba_load(U, K, V, tid, kr, vr);
    for (;;) {
        ba_store(lds, tid, kr, vr);
        __syncthreads();
        bf16x8 qf[4]; ba_qload(U, Q, wave, lane, qf);
        asm volatile("" ::: "memory");
        const int itn = it + 1; int passn = pass + 1, bhn = bh; if (passn == 3) { passn = 0; bhn = bh + nteam; }
        const bool has = itn < nit;
        const BAUnit Un = ba_decode(has ? passn : pass, (has ? bhn : bh) * 16 + sidx); ba_load(Un, K, V, tid, kr, vr);
        { v2u ppd[8]; ba_compute<true>(U, pass, qf, O, LSE, lds, wave, lane, cnt + ((size_t)bh * 2 + (pass > 0 ? pass - 1 : 0)) * 16, ppd, 0.f, U, nullptr); }
        if (pass < 2) asm volatile("s_waitcnt vmcnt(0)" ::: "memory");
        __syncthreads();
        if (pass < 2 && tid == 0) __hip_atomic_fetch_add(cnt + ((size_t)bh * 2 + pass) * 16, 1u, RLX_AGENT);
        if (!has) break;
        it = itn; pass = passn; bh = bhn; U = Un;
    }
}

template <int KK  , int NT  , int TT  , bool OUT8 = false  >
__device__ __forceinline__ void head_gemm(const bf16* X, int ldx, int xcol0, const bf16* WT, bf16* Out, int ldo, int ocol0, int tok0, float scale, int lane) {
    const int i = lane & 15, g = lane >> 4;
    bf16x8 xf[TT][KK];
#pragma unroll
    for (int tt = 0; tt < TT; ++tt)
#pragma unroll
        for (int kk = 0; kk < KK; ++kk) xf[tt][kk] = *(const bf16x8*)(X + (size_t)(tok0 + 16 * tt + i) * ldx + xcol0 + 32 * kk + 8 * g);
    const bf16* wp = WT + (size_t)(8 * (i >> 2) + (i & 3)) * (32 * KK) + 8 * g;
    bf16x8 aA[2][KK], aB[2][KK];
#pragma unroll
    for (int h2 = 0; h2 < 2; ++h2)
#pragma unroll
        for (int kk = 0; kk < KK; ++kk) aA[h2][kk] = *(const bf16x8*)(wp + (size_t)(4 * h2) * (32 * KK) + 32 * kk);
#pragma unroll
    for (int tt = 0; tt < TT; ++tt)
#pragma unroll
        for (int kk = 0; kk < KK; ++kk) asm volatile("" : "+v"(xf[tt][kk]));
#define HG_PAIR(cur, nxt, p_) do { \
        _Pragma("unroll") for (int h2 = 0; h2 < 2; ++h2) _Pragma("unroll") for (int kk = 0; kk < KK; ++kk) asm volatile("" : "+v"(cur[h2][kk])); \
        if ((p_) + 1 < NT / 2) { _Pragma("unroll") for (int h2 = 0; h2 < 2; ++h2) _Pragma("unroll") for (int kk = 0; kk < KK; ++kk) nxt[h2][kk] = *(const bf16x8*)(wp + (size_t)(32 * ((p_) + 1) + 4 * h2) * (32 * KK) + 32 * kk); } \
        _Pragma("unroll") for (int tt = 0; tt < TT; ++tt) { f32x4 c0 = (f32x4){0.f, 0.f, 0.f, 0.f}, c1 = c0; \
            _Pragma("unroll") for (int kk = 0; kk < KK; ++kk) { c0 = __builtin_amdgcn_mfma_f32_16x16x32_bf16(cur[0][kk], xf[tt][kk], c0, 0, 0, 0); c1 = __builtin_amdgcn_mfma_f32_16x16x32_bf16(cur[1][kk], xf[tt][kk], c1, 0, 0, 0); } \
            const size_t oo = (size_t)(tok0 + 16 * tt + i) * ldo + ocol0 + 32 * (p_) + 8 * g; \
            if constexpr (OUT8) { unsigned w0 = 0u, w1 = 0u; w0 = __builtin_amdgcn_cvt_pk_fp8_f32(c0[0] * scale, c0[1] * scale, w0, false); w0 = __builtin_amdgcn_cvt_pk_fp8_f32(c0[2] * scale, c0[3] * scale, w0, true); \
                w1 = __builtin_amdgcn_cvt_pk_fp8_f32(c1[0] * scale, c1[1] * scale, w1, false); w1 = __builtin_amdgcn_cvt_pk_fp8_f32(c1[2] * scale, c1[3] * scale, w1, true); \
                *(v2u*)((unsigned char*)Out + oo) = (v2u){w0, w1}; } \
            else *(v4u*)(Out + oo) = (v4u){cvtpk(c0[0] * scale, c0[1] * scale), cvtpk(c0[2] * scale, c0[3] * scale), cvtpk(c1[0] * scale, c1[1] * scale), cvtpk(c1[2] * scale, c1[3] * scale)}; } } while (0)
    for (int p = 0; p < NT / 2; p += 2) { HG_PAIR(aA, aB, p); HG_PAIR(aB, aA, p + 1); }
#undef HG_PAIR
}
__device__ __forceinline__ void ckv_norm_phase(const float* raw, const float* gain, bf16* out, int gw, int NGW, int lane) {
    const f32x4 gv = *(const f32x4*)(gain + 4 * lane);
    for (int row = gw; row < M; row += NGW) { const f32x4 t = *(const f32x4*)(raw + (size_t)row * KVL + 4 * lane);
        const float ss = (t[0] * t[0] + t[1] * t[1]) + (t[2] * t[2] + t[3] * t[3]);
        const float rstd = __builtin_amdgcn_rsqf(wave_sum(ss) * (1.0f / KVL) + EPS); const f32x4 y = t * rstd * gv;
        v2u w2; w2.x = cvtpk(y[0], y[1]); w2.y = cvtpk(y[2], y[3]); *(v2u*)(out + (size_t)row * KVL + 4 * lane) = w2; }
}
constexpr int IX_KROW = 272, IX_KEYS = 256, IX_STAGE = IX_KEYS * IX_KROW, IX_SC_OFF = IX_STAGE;
__device__ __forceinline__ void ix_load(const bf16* KI, int b, int st, int tid, v4u (&kr)[8]) {
    const int c = tid & 15, r0 = tid >> 4;
#pragma unroll
    for (int it = 0; it < 8; ++it) kr[it] = *(const v4u*)(KI + ((size_t)b * SEQ + IX_KEYS * st + r0 + 32 * it) * 128 + 8 * c);
}
__device__ __forceinline__ void ix_store(LAS unsigned char* buf, int tid, const v4u (&kr)[8]) {
    const int c = tid & 15, r0 = tid >> 4;
#pragma unroll
    for (int it = 0; it < 8; ++it) *(LAS v4u*)(buf + (r0 + 32 * it) * IX_KROW + 16 * c) = kr[it];
}
__device__ __forceinline__ void ix_topk(const LAS u16* sc, u16* selr, int t, int lane) {
    if (t < TOPK) { for (int j = lane; j < TOPK; j += 64) selr[j] = (u16)(j <= t ? j : 0xFFFF); return; }
    const int ng = (t >> 9) + 1;
    unsigned key[32];
#pragma unroll
    for (int u = 0; u < 32; ++u) key[u] = 0u;
#pragma unroll
    for (int gq = 0; gq < 4; ++gq) if (gq < ng) {
#pragma unroll
        for (int u = 8 * gq; u < 8 * gq + 8; ++u) { const int idx = 64 * u + lane; const unsigned bits = sc[idx]; const unsigned k = (bits & 0x8000u) ? (~bits & 0xFFFFu) : (bits | 0x8000u); key[u] = (idx <= t) ? k : 0u; } }
    unsigned prefix = 0u;
    for (int bit = 15; bit >= 0; --bit) { const unsigned cand = prefix | (1u << bit); int cnt = 0;
#pragma unroll
        for (int gq = 0; gq < 4; ++gq) if (gq < ng) {
#pragma unroll
            for (int u = 8 * gq; u < 8 * gq + 8; ++u) cnt += __popcll(__ballot(key[u] >= cand)); }
        if (cnt >= TOPK) prefix = cand; }
    int cgt = 0;
#pragma unroll
    for (int gq = 0; gq < 4; ++gq) if (gq < ng) {
#pragma unroll
        for (int u = 8 * gq; u < 8 * gq + 8; ++u) cgt += __popcll(__ballot(key[u] > prefix)); }
    const int need_eq = TOPK - cgt; int base = 0, eqb = 0;
#pragma unroll
    for (int gq = 0; gq < 4; ++gq) if (gq < ng) {
#pragma unroll
        for (int u = 8 * gq; u < 8 * gq + 8; ++u) { const bool gt = key[u] > prefix, eq = key[u] == prefix; const unsigned long long meq = __ballot(eq);
            const bool take = gt || (eq && (int)(eqb + mbcnt64(meq)) < need_eq); const unsigned long long mt = __ballot(take);
            if (take) selr[base + mbcnt64(mt)] = (u16)(64 * u + lane);
            base += __popcll(mt); eqb += __popcll(meq); } }
}
__device__ __forceinline__ void dsa_index_unit(const bf16* QI, const bf16* KI, const float* WI, u16* SEL, LAS unsigned char* lds, int b, int qb, int tid, int w, int lane) {
    const int i = lane & 15, g = lane >> 4; const int t0 = 16 * qb + 2 * w;
    const size_t row0 = (size_t)b * SEQ + t0;
    LAS u16* sc0 = (LAS u16*)(lds + IX_SC_OFF + (2 * w) * 4096); LAS u16* sc1 = sc0 + 2048;
    bf16x8 a0[4], a1[4];
#pragma unroll
    for (int kk = 0; kk < 4; ++kk) { a0[kk] = *(const bf16x8*)(QI + row0 * D + i * 128 + 32 * kk + 8 * g); a1[kk] = *(const bf16x8*)(QI + (row0 + 1) * D + i * 128 + 32 * kk + 8 * g); }
    const f32x4 w0 = *(const f32x4*)(WI + row0 * 16 + 4 * g), w1 = *(const f32x4*)(WI + (row0 + 1) * 16 + 4 * g);
    const int nst = (16 * qb + 15) / IX_KEYS + 1;
    v4u kA[8], kB[8];
    ix_load(KI, b, 0, tid, kA); ix_load(KI, b, nst > 1 ? 1 : 0, tid, kB);
#define IX_STAGE_BODY(st_, kcur) do { \
        ix_store(lds, tid, kcur); \
        __syncthreads(); \
        { const int sn = (st_) + 2 < nst ? (st_) + 2 : nst - 1; ix_load(KI, b, sn, tid, kcur); } \
        int ntile = (t0 + 1 - IX_KEYS * (st_)) / 16 + 1; ntile = ntile > 16 ? 16 : ntile; \
        _Pragma("unroll 2") for (int tt = 0; tt < ntile; tt += 2) { const LAS unsigned char* kp = lds + (16 * tt + i) * IX_KROW + 16 * g; \
            f32x4 c0 = (f32x4){0.f, 0.f, 0.f, 0.f}, c1 = c0, e0 = c0, e1 = c0; \
            _Pragma("unroll") for (int kk = 0; kk < 4; ++kk) { const bf16x8 bfa = *(const LAS bf16x8*)(kp + 64 * kk), bfb = *(const LAS bf16x8*)(kp + 16 * IX_KROW + 64 * kk); \
                c0 = __builtin_amdgcn_mfma_f32_16x16x32_bf16(a0[kk], bfa, c0, 0, 0, 0); c1 = __builtin_amdgcn_mfma_f32_16x16x32_bf16(a1[kk], bfa, c1, 0, 0, 0); \
                e0 = __builtin_amdgcn_mfma_f32_16x16x32_bf16(a0[kk], bfb, e0, 0, 0, 0); e1 = __builtin_amdgcn_mfma_f32_16x16x32_bf16(a1[kk], bfb, e1, 0, 0, 0); } \
            float s0 = w0[0] * fmaxf(c0[0], 0.f) + w0[1] * fmaxf(c0[1], 0.f) + w0[2] * fmaxf(c0[2], 0.f) + w0[3] * fmaxf(c0[3], 0.f); \
            float s1 = w1[0] * fmaxf(c1[0], 0.f) + w1[1] * fmaxf(c1[1], 0.f) + w1[2] * fmaxf(c1[2], 0.f) + w1[3] * fmaxf(c1[3], 0.f); \
            float u0 = w0[0] * fmaxf(e0[0], 0.f) + w0[1] * fmaxf(e0[1], 0.f) + w0[2] * fmaxf(e0[2], 0.f) + w0[3] * fmaxf(e0[3], 0.f); \
            float u1 = w1[0] * fmaxf(e1[0], 0.f) + w1[1] * fmaxf(e1[1], 0.f) + w1[2] * fmaxf(e1[2], 0.f) + w1[3] * fmaxf(e1[3], 0.f); \
            s0 = xsum32(xsum16(s0)); s1 = xsum32(xsum16(s1)); u0 = xsum32(xsum16(u0)); u1 = xsum32(xsum16(u1)); \
            if (g == 0) { const int key = IX_KEYS * (st_) + 16 * tt + i; sc0[key] = __builtin_bit_cast(u16, (_Float16)s0); sc1[key] = __builtin_bit_cast(u16, (_Float16)s1); \
                          sc0[key + 16] = __builtin_bit_cast(u16, (_Float16)u0); sc1[key + 16] = __builtin_bit_cast(u16, (_Float16)u1); } } \
        __syncthreads();                                         \
    } while (0)
    for (int st = 0; st < nst; st += 2) { IX_STAGE_BODY(st, kA); if (st + 1 < nst) IX_STAGE_BODY(st + 1, kB); }
#undef IX_STAGE_BODY
    LDS_WAIT(); asm volatile("" ::: "memory");
#ifndef REPS4
#define REPS4 1
#endif
    for (int rk = 0; rk < REPS4; ++rk) {
    ix_topk(sc0, SEL + row0 * TOPK, t0, lane);
    ix_topk(sc1, SEL + (row0 + 1) * TOPK, t0 + 1, lane); }
    __syncthreads();
}
constexpr int CROW = 544;
constexpr int DSA_WAVE_LDS = 32 * CROW + 512;
__device__ __forceinline__ void dsa_attn_query(const bf16* QL, const bf16* CKV, const u16* SEL, bf16* OL, LAS unsigned char* wl, int b, int t, int lane) {
    const int i = lane & 15, g = lane >> 4; const size_t row = (size_t)b * SEQ + t;
    LAS u16* sl = (LAS u16*)(wl + 32 * CROW);
    *(LAS v2u*)(sl + 4 * lane) = *(const v2u*)(SEL + row * TOPK + 4 * lane);
    bf16x8 bq[8];
#pragma unroll
    for (int kk = 0; kk < 8; ++kk) bq[kk] = *(const bf16x8*)(QL + row * (NH * KVL) + i * KVL + 32 * kk + 8 * g);
    const float slope2 = __builtin_amdgcn_exp2f(-0.5f * (float)(i + 1)) * LOG2E;
    float m = -1e30f, l = 0.f; f32x4 o[16];
#pragma unroll
    for (int c = 0; c < 16; ++c) o[c] = (f32x4){0.f, 0.f, 0.f, 0.f};
    const int nvalid = (t + 1) < TOPK ? (t + 1) : TOPK, nch = (nvalid + 31) >> 5;
    const bf16* cb = CKV + (size_t)b * SEQ * KVL;
    LDS_WAIT(); asm volatile("" ::: "memory");
    v4u pre[16];
#pragma unroll
    for (int it = 0; it < 16; ++it) { const int r = 2 * it + (lane >> 5); unsigned key = sl[r]; key = (key == 0xFFFFu) ? 0u : key; pre[it] = *(const v4u*)(cb + (size_t)key * KVL + 8 * (lane & 31)); }
    for (int c = 0; c < nch; ++c) {
#pragma unroll
        for (int it = 0; it < 16; ++it) { const int r = 2 * it + (lane >> 5); *(LAS v4u*)(wl + r * CROW + 16 * (lane & 31)) = pre[it]; }
        if (c + 1 < nch) {
#pragma unroll
            for (int it = 0; it < 16; ++it) { const int r = 2 * it + (lane >> 5); unsigned key = sl[32 * (c + 1) + r]; key = (key == 0xFFFFu) ? 0u : key; pre[it] = *(const v4u*)(cb + (size_t)key * KVL + 8 * (lane & 31)); } }
        LDS_WAIT(); asm volatile("" ::: "memory");
        f32x4 s[2];
#pragma unroll
        for (int T = 0; T < 2; ++T) { const LAS unsigned char* ap = wl + (16 * T + i) * CROW + 16 * g; f32x4 acc = (f32x4){0.f, 0.f, 0.f, 0.f};
#pragma unroll
            for (int kk = 0; kk < 8; ++kk) { const bf16x8 af = *(const LAS bf16x8*)(ap + 64 * kk); acc = __builtin_amdgcn_mfma_f32_16x16x32_bf16(af, bq[kk], acc, 0, 0, 0); }
            s[T] = acc; }
        float cmax = -INFINITY;
#pragma unroll
        for (int T = 0; T < 2; ++T) { const v2u kw = *(const LAS v2u*)(sl + 32 * c + 16 * T + 4 * g);
#pragma unroll
            for (int r = 0; r < 4; ++r) { const unsigned key = ((r < 2 ? kw.x : kw.y) >> (16 * (r & 1))) & 0xFFFFu; const int dl = t - (int)key;
                const float v = (key != 0xFFFFu && dl >= 0) ? (s[T][r] - slope2 * (float)dl) : -INFINITY; s[T][r] = v; cmax = fmaxf(cmax, v); } }
        cmax = xmax32(xmax16(cmax));
        const float mn = fmaxf(m, cmax), alpha = __builtin_amdgcn_exp2f(m - mn); m = mn;
        float rs = 0.f;
#pragma unroll
        for (int T = 0; T < 2; ++T)
#pragma unroll
            for (int r = 0; r < 4; ++r) { const float pv = __builtin_amdgcn_exp2f(s[T][r] - mn); s[T][r] = pv; rs += pv; }
        rs = xsum32(xsum16(rs));
        l = l * alpha + rs;
        bf16x8 pf; { const unsigned a0 = cvtpk(s[0][0], s[0][1]), a1 = cvtpk(s[0][2], s[0][3]), a2 = cvtpk(s[1][0], s[1][1]), a3 = cvtpk(s[1][2], s[1][3]); const v4u tt = (v4u){a0, a1, a2, a3}; pf = __builtin_bit_cast(bf16x8, tt); }
        const LAS unsigned char* vb = wl + (4 * g + (i >> 2)) * CROW + 8 * (i & 3);
#pragma unroll
        for (int ct = 0; ct < 16; ++ct) { const s16x4 lo = tr_read(vb + 32 * ct), hi = tr_read(vb + 16 * CROW + 32 * ct);
            o[ct] = o[ct] * alpha; o[ct] = __builtin_amdgcn_mfma_f32_16x16x32_bf16(cat8(lo, hi), pf, o[ct], 0, 0, 0); }
        LDS_WAIT(); asm volatile("" ::: "memory");
    }
    const float inv = 1.0f / l;
    bf16* op = OL + row * (NH * KVL) + i * KVL + 4 * g;
#pragma unroll
    for (int ct = 0; ct < 16; ++ct) { v2u w2; w2.x = cvtpk(o[ct][0] * inv, o[ct][1] * inv); w2.y = cvtpk(o[ct][2] * inv, o[ct][3] * inv); *(v2u*)(op + 16 * ct) = w2; }
}
__device__ __forceinline__ void dsa_attn_query_p(const bf16* QL, const bf16* CKV, const u16* SEL, bf16* OL, LAS unsigned char* wl, int b, int t, int lane, bf16x8 (&bq)[8], size_t row_n, v2u& seln) {
    const int i = lane & 15, g = lane >> 4; const size_t row = (size_t)b * SEQ + t;
    LAS u16* sl = (LAS u16*)(wl + 32 * CROW);
    const float slope2 = __builtin_amdgcn_exp2f(-0.5f * (float)(i + 1)) * LOG2E;
    float m = -1e30f, l = 0.f; f32x4 o[16];
#pragma unroll
    for (int c = 0; c < 16; ++c) o[c] = (f32x4){0.f, 0.f, 0.f, 0.f};
    const int nvalid = (t + 1) < TOPK ? (t + 1) : TOPK, nch = (nvalid + 31) >> 5;
    const bf16* cb = CKV + (size_t)b * SEQ * KVL;
    LDS_WAIT(); asm volatile("" ::: "memory");
    v4u pre[16];
#pragma unroll
    for (int it = 0; it < 16; ++it) { const int r = 2 * it + (lane >> 5); unsigned key = sl[r]; key = (key == 0xFFFFu) ? 0u : key; pre[it] = *(const v4u*)(cb + (size_t)key * KVL + 8 * (lane & 31)); }
    seln = *(const v2u*)(SEL + row_n * TOPK + 4 * lane);
    bf16x8 bqn[8];
#pragma unroll
    for (int kk = 0; kk < 8; ++kk) bqn[kk] = *(const bf16x8*)(QL + row_n * (NH * KVL) + i * KVL + 32 * kk + 8 * g);
    for (int c = 0; c < nch; ++c) {
#pragma unroll
        for (int it = 0; it < 16; ++it) { const int r = 2 * it + (lane >> 5); *(LAS v4u*)(wl + r * CROW + 16 * (lane & 31)) = pre[it]; }
        if (c + 1 < nch) {
#pragma unroll
            for (int it = 0; it < 16; ++it) { const int r = 2 * it + (lane >> 5); unsigned key = sl[32 * (c + 1) + r]; key = (key == 0xFFFFu) ? 0u : key; pre[it] = *(const v4u*)(cb + (size_t)key * KVL + 8 * (lane & 31)); } }
        LDS_WAIT(); asm volatile("" ::: "memory");
        f32x4 s[2];
#pragma unroll
        for (int T = 0; T < 2; ++T) { const LAS unsigned char* ap = wl + (16 * T + i) * CROW + 16 * g; f32x4 acc = (f32x4){0.f, 0.f, 0.f, 0.f};
#pragma unroll
            for (int kk = 0; kk < 8; ++kk) { const bf16x8 af = *(const LAS bf16x8*)(ap + 64 * kk); acc = __builtin_amdgcn_mfma_f32_16x16x32_bf16(af, bq[kk], acc, 0, 0, 0); }
            s[T] = acc; }
        float cmax = -INFINITY;
#pragma unroll
        for (int T = 0; T < 2; ++T) { const v2u kw = *(const LAS v2u*)(sl + 32 * c + 16 * T + 4 * g);
#pragma unroll
            for (int r = 0; r < 4; ++r) { const unsigned key = ((r < 2 ? kw.x : kw.y) >> (16 * (r & 1))) & 0xFFFFu; const int dl = t - (int)key;
                const float v = (key != 0xFFFFu && dl >= 0) ? (s[T][r] - slope2 * (float)dl) : -INFINITY; s[T][r] = v; cmax = fmaxf(cmax, v); } }
        cmax = xmax32(xmax16(cmax));
        const float mn = fmaxf(m, cmax), alpha = __builtin_amdgcn_exp2f(m - mn); m = mn;
        float rs = 0.f;
#pragma unroll
        for (int T = 0; T < 2; ++T)
#pragma unroll
            for (int r = 0; r < 4; ++r) { const float pv = __builtin_amdgcn_exp2f(s[T][r] - mn); s[T][r] = pv; rs += pv; }
        rs = xsum32(xsum16(rs));
        l = l * alpha + rs;
        bf16x8 pf; { const unsigned a0 = cvtpk(s[0][0], s[0][1]), a1 = cvtpk(s[0][2], s[0][3]), a2 = cvtpk(s[1][0], s[1][1]), a3 = cvtpk(s[1][2], s[1][3]); const v4u tt = (v4u){a0, a1, a2, a3}; pf = __builtin_bit_cast(bf16x8, tt); }
        const LAS unsigned char* vb = wl + (4 * g + (i >> 2)) * CROW + 8 * (i & 3);
#pragma unroll
        for (int ct = 0; ct < 16; ++ct) { const s16x4 lo = tr_read(vb + 32 * ct), hi = tr_read(vb + 16 * CROW + 32 * ct);
            o[ct] = o[ct] * alpha; o[ct] = __builtin_amdgcn_mfma_f32_16x16x32_bf16(cat8(lo, hi), pf, o[ct], 0, 0, 0); }
        LDS_WAIT(); asm volatile("" ::: "memory");
    }
    const float inv = 1.0f / l;
    bf16* op = OL + row * (NH * KVL) + i * KVL + 4 * g;
#pragma unroll
    for (int ct = 0; ct < 16; ++ct) { v2u w2; w2.x = cvtpk(o[ct][0] * inv, o[ct][1] * inv); w2.y = cvtpk(o[ct][2] * inv, o[ct][3] * inv); *(v2u*)(op + 16 * ct) = w2; }
#pragma unroll
    for (int kk = 0; kk < 8; ++kk) bq[kk] = bqn[kk];
}
constexpr int PH_PER_LAYER = 10, PH_L0 = 2, PH_FINAL = PH_L0 + PH_PER_LAYER * DEPTH, PH_COUNT = PH_FINAL + 1;
__global__ void __launch_bounds__(NWAVES * 64, 2) mk_fwd(Args args) {
    extern __shared__ __attribute__((aligned(16))) unsigned char lds_raw[];
    LAS unsigned char* lds = (LAS unsigned char*)lds_raw;
    volatile LAS unsigned* MISC = (volatile LAS unsigned*)(lds + MISC_OFF);
    const int tid = threadIdx.x, lane = tid & 63, wave = __builtin_amdgcn_readfirstlane(tid >> 6);
    const int G = gridDim.x; const int bx = blockIdx.x; const int vcu = (G % 8 == 0) ? (bx % 8) * (G / 8) + bx / 8 : bx;
    const int gw = vcu * NWAVES + wave, NGW = G * NWAVES;
    unsigned char* ws = as_global(args.ws);
    gu32* ctl = (gu32*)(ws + WS_CTL);
    if (tid < 64) MISC[tid] = 0u;
    __syncthreads();
    const int lo = args.ph_lo, hi = args.ph_hi;
#ifdef DIAG_XCC
    if (tid == 0) ((unsigned*)(ws + WS_CTL + 700000))[bx] = xb_xcc_id() + 1u;
#endif
#ifdef PROBE_IDX
    if (bx == 0 && tid == 0) { unsigned long long* pt = (unsigned long long*)(ws + WS_CTL + 614400); pt[63] = wall_clock64(); }
#endif
    XcdBarrier bar; bar.bar = (unsigned*)(ctl + CW_BAR); bar.x = 0; bar.st = nullptr;
    if (hi - lo > 1) { bar = xcd_barrier_post((unsigned*)(ctl + CW_BAR), MISC + 8); if (tid == 0) xcd_barrier_census(bar); __syncthreads(); }
#define IN(k) (lo <= (k) && (k) < hi)
#ifdef REP_PHASE
#define REPN(k) (((k) == REP_PHASE) ? (1 + REP_N) : 1)
#else
#define REPN(k) 1
#endif
#ifndef REP_VARIANT
#define REP_VARIANT 0
#endif
#ifndef DIL_VARIANT
#define DIL_VARIANT 0
#endif
#ifndef REPS3
#define REPS3 1
#endif
#ifndef REPS1
#define REPS1 1
#endif
#ifndef REPS2
#define REPS2 1
#endif
#define REP_BEGIN(k) for (int rep_ = 0; rep_ < REPN(k); ++rep_) { if (rep_) GBAR();
#define REP_END }
#ifdef PROBE_IDX
#define PMARK(idx) do { if (bx == 0 && tid == 0) { unsigned long long* pt = (unsigned long long*)(ws + WS_CTL + 614400); const unsigned long long now_ = wall_clock64(); pt[(idx)] += now_ - pt[63]; pt[63] = now_; } } while (0)
#else
#define PMARK(idx) do {} while (0)
#endif
#define GBAR() do { XcdBarrier b_ = bar; GAS unsigned* bp_ = (GAS unsigned*)b_.bar; asm volatile("" : "+s"(bp_)); b_.bar = (unsigned*)bp_; xcd_barrier(b_, wave == 0 && ({ unsigned m_ = ~0u; asm volatile("" : "+s"(m_)); (int)__builtin_amdgcn_mbcnt_hi(m_, __builtin_amdgcn_mbcnt_lo(m_, 0u)); }) == 0); } while (0)
#define SEAM(k) do { if ((k) + 1 < hi) GBAR(); PMARK(((k) < PH_L0) ? (k) : (2 + (((k) - PH_L0) / PH_PER_LAYER & 1) * PH_PER_LAYER + ((k) - PH_L0) % PH_PER_LAYER)); } while (0)

#define LAUNDER_S(x) ({ int v_ = (x); asm volatile("" : "+s"(v_)); v_; })
#define Gv LAUNDER_S(G)
#define bxv LAUNDER_S(bx)
#define Kd LAUNDER_S(D)
#define Kf LAUNDER_S(DFF)
#define gwv LAUNDER_S(gw)
#define vcuv LAUNDER_S(vcu)
#define LANE_NOW ({ unsigned m_ = ~0u; asm volatile("" : "+s"(m_)); (int)__builtin_amdgcn_mbcnt_hi(m_, __builtin_amdgcn_mbcnt_lo(m_, 0u)); })
#define lanev LANE_NOW
#define tidv (LAUNDER_S(wave) * 64 + LANE_NOW)
    if (IN(0)) {
        if (!PRO_SINGLE) { REP_BEGIN(0) if (I8_QKV || I8_DSA || I8_GU) p0_colmax(args, gwv, NGW, lanev); REP_END SEAM(0); }
    }
    if (IN(1)) {
        REP_BEGIN(1)
        if (PRO_SINGLE) { p0_strips(args, lds, vcuv, Gv, tidv, wave, lanev); p0_bf16_items(args, lds, gwv, NGW, wave, lanev); }
        else p0_transposes(args, lds, gwv, NGW, wave, lanev);
        __syncthreads();
        for (int ra = 0; ra < REPS3; ++ra) { p0_adaln(args, lds, Gv, tidv, wave, lanev);
        __syncthreads(); }
        REP_END
        SEAM(1);
    }
    for (int l = 0; l < DEPTH; ++l) {
        const int pb = PH_L0 + PH_PER_LAYER * l;
        if (hi <= pb || lo >= pb + PH_PER_LAYER) continue;
        const LayerW& W = args.L[l];
#define wsv ({ GAS unsigned char* q_ = (GAS unsigned char*)ws; asm volatile("" : "+s"(q_)); (unsigned char*)q_; })
#define wb (wsv + WS_W + (size_t)l * W_LAYER)
#define Hb ((bf16*)(wsv + WS_H))
#define ATT ((bf16*)(wsv + WS_ATT))
#define r1 (wsv + WS_R1)
#define r2 (wsv + WS_R2)
#define modl ((const float*)(wsv + WS_MOD) + (size_t)l * BATCH * NMOD)
#define sAp ((float*)(wsv + WS_SA))
#define sBl ((const float*)(wsv + WS_SB) + l * CM_LAYER)
#define x16 ((bf16*)(wsv + WS_X16))
#define xin ((l == 0) ? (const void*)as_global(args.x) : (const void*)x16)
#define xin_f32 (l == 0)
#define xout x16
        const bool dsa = (l & 1) != 0;
        if (IN(pb + 0)) { REP_BEGIN(pb + 0)
            if (dsa ? I8_DSA : I8_QKV) norm_mod_phase_q(xin, xin_f32, as_global(W.norm_attn), modl + 0 * D, modl + 1 * D, (signed char*)Hb, sAp, nullptr, gwv, NGW, lanev);
            else norm_mod_phase(xin, xin_f32, as_global(W.norm_attn), modl + 0 * D, modl + 1 * D, Hb, gwv, NGW, lanev);
            REP_END SEAM(pb + 0); }
        if (IN(pb + 1)) { REP_BEGIN(pb + 1)
            if (!dsa) { pg8::Gemm g{Hb, (const bf16*)(wb + WO_IN), M, NIN_A, Kd}; pg8::StaticOrder S; S.init(M, NIN_A, Gv, bxv, WGM_QKV);
                pg8::EpiQKV<I8_QKV> E{(bf16*)r1, (size_t)M * D, QSCALE, sAp, sBl};
                pg8::gemm_phase<pg8::EpiQKV<I8_QKV>, pg8::StaticOrder, PG8_ALIGN, PG8_SP2>(lds, g, S, E, tidv); }
            else { pg8::Gemm g{Hb, (const bf16*)(wb + WO_IN), M, NIN_BP, Kd}; pg8::StaticOrder S; S.init(M, NIN_BP, Gv, bxv, WGM_DSA);
                pg8::EpiDsaProj<I8_DSA> E{(bf16*)(r1 + R1_Q), (float*)(r1 + R1_CKVR), (bf16*)(r1 + R1_QI), (bf16*)(r1 + R1_KI), (float*)(r1 + R1_WI), sAp, sBl};
                pg8::gemm_phase<pg8::EpiDsaProj<I8_DSA>, pg8::StaticOrder, PG8_ALIGN, PG8_SP2>(lds, g, S, E, tidv); }
            REP_END SEAM(pb + 1);
        }
        const bool dfused = DIL_FUSED && (Gv & 15) == 0;
#define DIL_ARGS (const bf16*)r1, (const bf16*)r1 + (size_t)M * D, (const bf16*)r1 + 2 * (size_t)M * D, ATT, (float*)r2
        if (!dsa) {
            if (dfused) { if (IN(pb + 2)) { dil_attn_fused(DIL_ARGS, (unsigned*)(wsv + WS_CTL + CTL_DILCNT) + (size_t)(l >> 1) * 128 * 2 * 16, lds, vcuv, Gv, tidv, wave, lanev); SEAM(pb + 4); } }
            else if (DIL_SPLIT > 1 && !MK_MULTI) {
                if (IN(pb + 2)) { for (int sp = 0; sp < DIL_SPLIT; ++sp) for (int ps = 0; ps < 3; ++ps) { if (sp + ps) GBAR();
                        dil_attn_pass(ps, DIL_ARGS, lds, vcuv, Gv, tidv, wave, lanev, sp * (BATCH * NH * 16 / DIL_SPLIT), (sp + 1) * (BATCH * NH * 16 / DIL_SPLIT)); }
                    SEAM(pb + 4); }
            } else {
                if (IN(pb + 2)) { REP_BEGIN(pb + 2) dil_attn_pass<DIL_VARIANT>(0, DIL_ARGS, lds, vcuv, Gv, tidv, wave, lanev); REP_END SEAM(pb + 2); }
                if (IN(pb + 3)) { dil_attn_pass(1, DIL_ARGS, lds, vcuv, Gv, tidv, wave, lanev); SEAM(pb + 3); }
                if (IN(pb + 4)) { dil_attn_pass<0, true>(2, DIL_ARGS, lds, vcuv, Gv, tidv, wave, lanev, 0, BATCH * NH * 16, OUT_MODE == 2 ? (unsigned char*)(r2 + R2_ATT8) : nullptr); SEAM(pb + 4); }
            }
        } else {
        if (IN(pb + 2)) { REP_BEGIN(pb + 2)
            for (int rs1 = 0; rs1 < REPS1; ++rs1) {
            ckv_norm_phase((const float*)(r1 + R1_CKVR), as_global(W.kv_norm), (bf16*)(r1 + R1_CKV), gwv, NGW, lanev);
            for (int wu = gwv; wu < (M / 64) * NH; wu += NGW) { const int h = wu & 15, tg = wu >> 4;
                head_gemm<4, 16, 4>((const bf16*)(r1 + R1_Q), D, h * HD, (const bf16*)(wb + WO_UK) + (size_t)h * KVL * HD, (bf16*)r2, NH * KVL, h * KVL, 64 * tg, QSCALE, lanev); }
            }
            for (int rs2 = 0; rs2 < REPS2; ++rs2)
            { const int vb = vcuv;
              for (int pi = vb; pi < BATCH * 64; pi += Gv) { const int b = pi >> 6, ql = pi & 63;
                  dsa_index_unit((const bf16*)(r1 + R1_QI), (const bf16*)(r1 + R1_KI), (const float*)(r1 + R1_WI), (u16*)(r1 + R1_SEL), lds, b, ql, tidv, wave, lanev);
                  dsa_index_unit((const bf16*)(r1 + R1_QI), (const bf16*)(r1 + R1_KI), (const float*)(r1 + R1_WI), (u16*)(r1 + R1_SEL), lds, b, 127 - ql, tidv, wave, lanev); } }
            REP_END SEAM(pb + 2);
        }
        if (IN(pb + 3)) { REP_BEGIN(pb + 3)
            LAS unsigned char* wl = lds + wave * DSA_WAVE_LDS;
            if (DSA_MERGE_POST) {
                for (int blk = vcuv; blk < M / 64; blk += Gv) { const int tokb = 64 * blk;
                    { const bf16* QLp = (const bf16*)r2; const u16* SELp = (const u16*)(r1 + R1_SEL); const int ln = lanev, q0 = tokb + 8 * wave; LAS u16* slp = (LAS u16*)(wl + 32 * CROW);
                      bf16x8 bq[8]; v2u seln = *(const v2u*)(SELp + (size_t)q0 * TOPK + 4 * ln);
#pragma unroll
                      for (int kk = 0; kk < 8; ++kk) bq[kk] = *(const bf16x8*)(QLp + (size_t)q0 * (NH * KVL) + (ln & 15) * KVL + 32 * kk + 8 * (ln >> 4));
                      for (int jj = 0; jj < 8; ++jj) { const int q = q0 + jj; const int qn = q0 + (jj < 7 ? jj + 1 : jj);
                          *(LAS v2u*)(slp + 4 * ln) = seln; LDS_WAIT(); asm volatile("" ::: "memory");
                          dsa_attn_query_p(QLp, (const bf16*)(r1 + R1_CKV), SELp, (bf16*)(r1 + R1_OLAT), wl, q >> 11, q & (SEQ - 1), ln, bq, (size_t)qn, seln); } }
                    asm volatile("s_waitcnt vmcnt(0)" ::: "memory"); __syncthreads();
                    __builtin_amdgcn_fence(__ATOMIC_ACQUIRE, "agent"); asm volatile("s_waitcnt vmcnt(0)" ::: "memory");
                    for (int wu = wave; wu < 2 * NH; wu += NWAVES) { const int h = wu & 15, tg = wu >> 4;
                        head_gemm<8, 8, 2, OUT_MODE == 2>((const bf16*)(r1 + R1_OLAT), NH * KVL, h * KVL, (const bf16*)(wb + WO_UV) + (size_t)h * HD * KVL, ATT  , D, h * HD, tokb + 32 * tg, 1.0f, lanev); }
                    __syncthreads(); }
            } else {
                for (int q = gwv; q < M; q += NGW) dsa_attn_query((const bf16*)r2, (const bf16*)(r1 + R1_CKV), (const u16*)(r1 + R1_SEL), (bf16*)(r1 + R1_OLAT), wl, q >> 11, q & (SEQ - 1), lanev); }
            REP_END SEAM(pb + 3);
        }
        if (!DSA_MERGE_POST && IN(pb + 4)) { REP_BEGIN(pb + 4)
            for (int wu = gwv; wu < (M / 32) * NH; wu += NGW) { const int h = wu & 15, tg = wu >> 4;
                head_gemm<8, 8, 2, OUT_MODE == 2>((const bf16*)(r1 + R1_OLAT), NH * KVL, h * KVL, (const bf16*)(wb + WO_UV) + (size_t)h * HD * KVL, ATT, D, h * HD, 32 * tg, 1.0f, lanev); }
            REP_END SEAM(pb + 4);
        }
        }
#undef DIL_ARGS
        if (IN(pb + 5)) { REP_BEGIN(pb + 5) pg8::Gemm g{(OUT_MODE == 2 && !dsa) ? (const bf16*)(r2 + R2_ATT8) : ATT, (const bf16*)(wb + WO_OUT), M, D, Kd}; pg8::StaticOrder S; S.init(M, D, Gv, bxv, WGM_OUT);
            pg8::EpiResid<OUT_MODE> E{xin, xin_f32, xout, modl + 2 * D, NMOD, nullptr, sBl + CM_OUT};
            pg8::gemm_phase<pg8::EpiResid<OUT_MODE>, pg8::StaticOrder, PG8_ALIGN, PG8_SP2>(lds, g, S, E, tidv); REP_END SEAM(pb + 5); }
        if (IN(pb + 6)) {
            if (I8_GU) norm_mod_phase_q(xout, 0, as_global(W.norm_ffn), modl + 3 * D, modl + 4 * D, (signed char*)Hb, sAp, I8_DN ? (unsigned*)(wsv + WS_RMAX) : nullptr, gwv, NGW, lanev);
            else norm_mod_phase(xout, 0, as_global(W.norm_ffn), modl + 3 * D, modl + 4 * D, Hb, gwv, NGW, lanev);
            SEAM(pb + 6); }
        if (IN(pb + 7)) { REP_BEGIN(pb + 7) pg8::Gemm g{Hb, (const bf16*)(wb + WO_GU), M, 2 * DFF, Kd}; pg8::StaticOrder S; S.init(M, 2 * DFF, Gv, bxv, WGM_GU);
            pg8::EpiSwiglu<I8_GU, DN_MODE == 2> E{(bf16*)r2, sAp, sBl + CM_GU, I8_DN ? (unsigned*)(wsv + WS_RMAX) : nullptr};
            pg8::gemm_phase<pg8::EpiSwiglu<I8_GU, DN_MODE == 2>, pg8::StaticOrder, PG8_ALIGN, PG8_SP2>(lds, g, S, E, tidv); REP_END SEAM(pb + 7); }
        if (I8_DN && IN(pb + 8)) { REP_BEGIN(pb + 8) act_quant_phase((const bf16*)r2, (const unsigned*)(wsv + WS_RMAX), (signed char*)r1, (float*)(wsv + WS_SA2), gwv, NGW, lanev); REP_END SEAM(pb + 8); }
        if (IN(pb + 9)) { pg8::Gemm g{(const bf16*)(I8_DN ? r1 : r2), (const bf16*)(wb + WO_DN), M, D, Kf}; pg8::StaticOrder S; S.init(M, D, Gv, bxv, WGM_DN);
            pg8::EpiResid<DN_MODE> E{xout, 0, xout, modl + 5 * D, NMOD, (const float*)(wsv + WS_SA2), sBl + CM_DN};
            pg8::gemm_phase<pg8::EpiResid<DN_MODE>, pg8::StaticOrder, PG8_ALIGN, PG8_SP2>(lds, g, S, E, tidv); SEAM(pb + 9); }
    }
#undef wsv
#undef wb
#undef Hb
#undef ATT
#undef r1
#undef r2
#undef modl
#undef sAp
#undef sBl
#undef x16
#undef xin
#undef xin_f32
#undef xout
    if (IN(PH_FINAL)) {
#ifdef DIAG_XCC
        { const unsigned* ids = (const unsigned*)(ws + WS_CTL + 700000); int bad = 0, distinct = 0;
          for (int b = 0; b < G; ++b) if (ids[b] != ids[b & 7]) bad++;
          for (int a = 0; a < 8; ++a) { int dup = 0; for (int c = 0; c < a; ++c) if (ids[a] == ids[c]) dup = 1; distinct += !dup; }
          const float cval = (bad ? 2.0f : 0.0f) + (distinct == 8 ? 0.0f : 1.0f); float* o = as_global(args.out);
          for (size_t e = (size_t)bx * 512 + tid; e < (size_t)M * D; e += (size_t)G * 512) o[e] = cval; }
#endif
#if defined(PROBE_IDX)
        { const unsigned long long* pt = (const unsigned long long*)(ws + WS_CTL + 614400); unsigned long long tt = 0; for (int q = PROBE_IDX; q <= PROBE_IDX_END; ++q) tt += pt[q];
          const float cval = (float)tt * 0.01f / (float)PROBE_DIV; float* o = as_global(args.out);
          for (size_t e = (size_t)bx * 512 + tid; e < (size_t)M * D; e += (size_t)G * 512) o[e] = cval; }
#elif !defined(DIAG_XCC)
        final_norm_phase((const bf16*)(ws + WS_X16), as_global(args.out), as_global(args.final_norm), gwv, NGW, lanev);
#endif
    }
#undef Gv
#undef bxv
#undef Kd
#undef Kf
#undef gwv
#undef vcuv
#undef lanev
#undef LANE_NOW
#undef tidv
#undef IN
#undef SEAM
}


#ifdef DIAG_PROBE
struct ProbeArgs { const unsigned* buf[4]; unsigned long long nwords[4]; int is_bf16[4]; int pad[4]; unsigned* cnt; float* out; };
__global__ void probe_kernel(ProbeArgs a) {
    for (int k = 0; k < 4; ++k) { if (!a.buf[k]) continue; unsigned bad = 0;
        for (unsigned long long i = (unsigned long long)blockIdx.x * blockDim.x + threadIdx.x; i < a.nwords[k]; i += (unsigned long long)gridDim.x * blockDim.x) { const unsigned w = a.buf[k][i];
            const int md = a.is_bf16[k];
            if (md == 1) { if ((w & 0x7F80u) == 0x7F80u || (w & 0x7F800000u) == 0x7F800000u) bad++; } else if (md == 0) { if ((w & 0x7F800000u) == 0x7F800000u) bad++; }
            else if (md == 4) { const unsigned lo = w & 0xFFFFu, hi = w >> 16; if ((lo > 2047u && lo != 0xFFFFu) || (hi > 2047u && hi != 0xFFFFu)) bad++; }
            else if (md == 2) { if ((w & 0x7F80u) >= 0x4680u || (w & 0x7F800000u) >= 0x46800000u) bad++; } else { if ((w & 0x7F800000u) >= 0x46000000u) bad++; } }
        if (bad) atomicAdd(a.cnt + k, bad); }
}
__global__ void probe_fill(ProbeArgs a) {
    float c = 0.f; for (int k = 0; k < 4; ++k) if (a.cnt[k]) c += 0.5f * (float)(1 << k);
    for (size_t i = (size_t)blockIdx.x * blockDim.x + threadIdx.x; i < (size_t)M * D; i += (size_t)gridDim.x * blockDim.x) a.out[i] = c;
}
#endif
extern "C" void kernel_launch(void* const* d_in, const int* in_sizes, int n_in, void* d_out, int out_size, void* d_ws, size_t ws_size, hipStream_t stream) {
    static int grid = 0;
    if (grid == 0) {
        if (n_in != 41 || in_sizes[0] != M * D || out_size != M * D || ws_size < WS_END) { fprintf(stderr, "kernel_launch: unexpected shapes (n_in %d, in0 %d, out %d, ws %zu)\n", n_in, n_in > 0 ? in_sizes[0] : -1, out_size, ws_size); grid = -1; return; }
        int dev = 0, cus = 0;
        if (hipGetDevice(&dev) != hipSuccess || hipDeviceGetAttribute(&cus, hipDeviceAttributeMultiprocessorCount, dev) != hipSuccess) { grid = -1; return; }
        if (hipFuncSetAttribute((const void*)mk_fwd, hipFuncAttributeMaxDynamicSharedMemorySize, LDS_BYTES) != hipSuccess) { fprintf(stderr, "kernel_launch: hipFuncSetAttribute failed\n"); grid = -1; return; }
        int per_cu = 0;
        if (hipOccupancyMaxActiveBlocksPerMultiprocessor(&per_cu, (const void*)mk_fwd, NWAVES * 64, LDS_BYTES) != hipSuccess || per_cu < 1) fprintf(stderr, "kernel_launch: occupancy query reports %d\n", per_cu);
        (void)hipGetLastError();
        grid = cus;
    }
    if (grid < 0) return;
    if (hipMemsetAsync((char*)d_ws + WS_CTL, 0, CTL_ZERO_BYTES, stream) != hipSuccess) return;
    Args a{};
    a.x = (const float*)d_in[0]; a.c = (const float*)d_in[1]; a.final_norm = (const float*)d_in[40];
    int k = 2;
    for (int l = 0; l < DEPTH; ++l) { LayerW& w = a.L[l];
        w.norm_attn = (const float*)d_in[k++]; w.ada_w = (const float*)d_in[k++]; w.ada_b = (const float*)d_in[k++]; w.w_in = (const float*)d_in[k++];
        if (l & 1) { w.kv_norm = (const float*)d_in[k++]; w.w_uk = (const float*)d_in[k++]; w.w_uv = (const float*)d_in[k++]; }
        else { w.kv_norm = nullptr; w.w_uk = nullptr; w.w_uv = nullptr; }
        w.w_out = (const float*)d_in[k++]; w.norm_ffn = (const float*)d_in[k++]; w.w_gu = (const float*)d_in[k++]; w.w_down = (const float*)d_in[k++]; }
    a.out = (float*)d_out; a.ws = (unsigned char*)d_ws;
#if MK_MULTI
    for (int p = 0; p < PH_COUNT; ++p) {

        a.ph_lo = p; a.ph_hi = p + 1;
#ifdef DIAG_PROBE
        if (p > DIAG_LAST) break;
#endif
        hipLaunchKernelGGL(mk_fwd, dim3(grid), dim3(NWAVES * 64), LDS_BYTES, stream, a);
    }
#ifdef DIAG_PROBE
    { ProbeArgs pa{}; unsigned char* ws = (unsigned char*)d_ws; DIAG_SETUP; pa.cnt = (unsigned*)(ws + WS_CTL) + 64; pa.out = (float*)d_out;
      hipLaunchKernelGGL(probe_kernel, dim3(1024), dim3(256), 0, stream, pa); hipLaunchKernelGGL(probe_fill, dim3(1024), dim3(256), 0, stream, pa); }
#endif
#else
    a.ph_lo = 0; a.ph_hi = PH_COUNT;
    hipLaunchKernelGGL(mk_fwd, dim3(grid), dim3(NWAVES * 64), LDS_BYTES, stream, a);
#endif
    const hipError_t le = hipPeekAtLastError();
    if (le != hipSuccess) fprintf(stderr, "kernel_launch: launch failed: %s\n", hipGetErrorName(le));
}
```

```cpp
#include <hip/hip_runtime.h>
#include <cstdio>
#include <cstdint>
#define MK_MULTI 0
namespace pg8 {
#define PG8_LAS __attribute__((address_space(3)))
typedef unsigned short bf16_t;
typedef short bf16x8 __attribute__((ext_vector_type(8)));
typedef float f32x4 __attribute__((ext_vector_type(4)));
typedef unsigned u32x4 __attribute__((ext_vector_type(4)));
constexpr int BM = 256, BK = 64, HALF = 128, HTB = HALF * BK * 2  , STAGE_BYTES = 8 * HTB, NXCD = 8, WGM = 8;

__host__ __device__ __forceinline__ int lds_byte(int r, int c) { const int st = (r >> 4) * 2 + (c >> 5), rr = r & 15, cc = c & 31, ob = rr * 64 + cc * 2; return st * 1024 + (ob ^ (((ob >> 9) & 1) << 5)); }
__host__ __device__ __forceinline__ void stage_rc(int b, int& R, int& C) { const int st = b / 1024, sb = b % 1024, swz = sb ^ (((sb >> 9) & 1) << 5); R = (st >> 1) * 16 + swz / 64; C = (st & 1) * 32 + (swz % 64) / 2; }
__host__ __device__ __forceinline__ int perm32(int rho) { const int n = rho >> 4, i = rho & 15; return 8 * (i >> 2) + 4 * n + (i & 3); }

struct Unit { int pm, pn; };
struct Gemm { const bf16_t* A; const bf16_t* Bt; int M, N, K; };

struct StaticOrder {
    int nM, nN, nwg, G, c, wgm;
    __host__ __device__ void init(int M, int N, int G_, int c_, int wgm_ = WGM) { nM = M / BM; nN = N / BM; nwg = nM * nN; G = G_; c = c_; wgm = wgm_; }
    __host__ __device__ bool next(int i, Unit& u) const {
        const long L = (long)i * G + c; if (L >= nwg) return false;
        int wgid = (int)L; { const int q = nwg / NXCD, r = nwg % NXCD, xcd = wgid % NXCD, off = wgid / NXCD; wgid = (xcd < r ? xcd * (q + 1) : r * (q + 1) + (xcd - r) * q) + off; }
        const int nig = wgm * nN, gid = wgid / nig, fm = gid * wgm, gsz = (nM - fm) < wgm ? (nM - fm) : wgm;
        u.pm = fm + ((wgid % nig) % gsz); u.pn = (wgid % nig) / gsz; return true;
    }
    __device__ __forceinline__ void a_ready(const Unit&) const {}
    __device__ __forceinline__ void done(const Unit&) const {}
};
typedef __bf16 bf16x2_cv __attribute__((ext_vector_type(2)));
typedef float f32x2_cv __attribute__((ext_vector_type(2)));
__device__ __forceinline__ unsigned cvt_pk_bf16(float lo, float hi) { const f32x2_cv v = {lo, hi}; const bf16x2_cv r = __builtin_convertvector(v, bf16x2_cv); return __builtin_bit_cast(unsigned, r); }
typedef float f32x2 __attribute__((ext_vector_type(2)));
__device__ __forceinline__ u32x4 pack8(const f32x4 v0, const f32x4 v1) { u32x4 w; w.x = cvt_pk_bf16(v0[0], v0[1]); w.y = cvt_pk_bf16(v0[2], v0[3]); w.z = cvt_pk_bf16(v1[0], v1[1]); w.w = cvt_pk_bf16(v1[2], v1[3]); return w; }

typedef int i32x4 __attribute__((ext_vector_type(4)));
template <bool I8_> struct AccT { typedef f32x4 type; };
template <> struct AccT<true> { typedef i32x4 type; };
template <bool I8_> __device__ __forceinline__ f32x4 deq(const typename AccT<I8_>::type a, float sa, const f32x4 sb) {
    if constexpr (I8_) { f32x4 r; r[0] = (float)a[0]; r[1] = (float)a[1]; r[2] = (float)a[2]; r[3] = (float)a[3]; return r * sa * sb; } else { (void)sa; (void)sb; return a; } }
template <bool I8_> __device__ __forceinline__ f32x4 deqg(const typename AccT<I8_>::type a, float sa, const f32x4 sb) { if constexpr (I8_) return deq<true>(a, sa, sb); else { (void)sa; return a * sb; } }
template <bool I8_> struct EpiQKV {
    static constexpr bool PERM = true, AFTER_DRAIN = false, I8 = I8_, FP8 = false; typedef typename AccT<I8_>::type acc_t;
    bf16_t* O; size_t split_stride; float qscale; const float* sA; const float* sB;
    __device__ __forceinline__ void operator()(const acc_t (&acc)[2][2][4][2], const Unit& u, int wr, int wc, int fr, int fq) const {
        const int row0 = u.pm * BM + wr * 64 + fr; const int t = u.pn >> 3; const int col0 = (u.pn & 7) * BM + wc * 32 + 8 * fq;
        bf16_t* base = O + (size_t)t * split_stride; const float sc = (t == 0) ? qscale : 1.f;
        f32x4 sb[2][2];
#pragma unroll
        for (int bj = 0; bj < 2; ++bj)
#pragma unroll
            for (int n = 0; n < 2; ++n) sb[bj][n] = I8_ ? *(const f32x4*)(sB + u.pn * BM + bj * HALF + wc * 32 + 8 * fq + 4 * n) : (f32x4){1.f, 1.f, 1.f, 1.f};
#pragma unroll
        for (int ai = 0; ai < 2; ++ai)
#pragma unroll
            for (int m = 0; m < 4; ++m) { const int r = row0 + ai * HALF + m * 16; bf16_t* rowp = base + (size_t)r * 2048 + col0; const float sa = (I8_ ? sA[r] : 1.f) * sc;
#pragma unroll
                for (int bj = 0; bj < 2; ++bj) { f32x4 v0 = deq<I8_>(acc[ai][bj][m][0], sa, sb[bj][0]), v1 = deq<I8_>(acc[ai][bj][m][1], sa, sb[bj][1]);
                    if (!I8_) { v0 = v0 * sc; v1 = v1 * sc; } *(u32x4*)(rowp + bj * HALF) = pack8(v0, v1); } }
    }
};
template <int MODE  > struct EpiResid {
    static constexpr bool PERM = false, AFTER_DRAIN = false, I8 = (MODE == 1), FP8 = (MODE == 2), I8_ = (MODE == 1); typedef typename AccT<(MODE == 1)>::type acc_t;
    const void* base; int base_f32; bf16_t* out; const float* gate; int gstride; const float* sA; const float* sB;
    __device__ __forceinline__ void operator()(const acc_t (&acc)[2][2][4][2], const Unit& u, int wr, int wc, int fr, int fq) const {
        typedef unsigned u32x2 __attribute__((ext_vector_type(2)));
        const int row0 = u.pm * BM + wr * 64 + fr, col0 = u.pn * BM + wc * 32 + 4 * fq;
        const float* gp = gate + (size_t)((u.pm * BM) >> 11) * gstride + col0;
        f32x4 gv[2][2];
#pragma unroll
        for (int bj = 0; bj < 2; ++bj)
#pragma unroll
            for (int n = 0; n < 2; ++n) { gv[bj][n] = *(const f32x4*)(gp + bj * HALF + n * 16); if (MODE != 0) gv[bj][n] = gv[bj][n] * *(const f32x4*)(sB + col0 + bj * HALF + n * 16); }
#pragma unroll
        for (int ai = 0; ai < 2; ++ai)
#pragma unroll
            for (int m = 0; m < 4; ++m) { const int r = row0 + ai * HALF + m * 16; const size_t off = (size_t)r * 2048 + col0; const float sa = I8_ ? sA[r] : 1.f;
                f32x4 bs[2][2];
                if (base_f32) {
#pragma unroll
                    for (int bj = 0; bj < 2; ++bj)
#pragma unroll
                        for (int n = 0; n < 2; ++n) bs[bj][n] = *(const f32x4*)((const float*)base + off + bj * HALF + n * 16);
                } else {
#pragma unroll
                    for (int bj = 0; bj < 2; ++bj)
#pragma unroll
                        for (int n = 0; n < 2; ++n) { const u32x2 w = *(const u32x2*)((const bf16_t*)base + off + bj * HALF + n * 16);
                            bs[bj][n] = (f32x4){__uint_as_float(w.x << 16), __uint_as_float(w.x & 0xFFFF0000u), __uint_as_float(w.y << 16), __uint_as_float(w.y & 0xFFFF0000u)}; }
                }
#pragma unroll
                for (int bj = 0; bj < 2; ++bj)
#pragma unroll
                    for (int n = 0; n < 2; ++n) { const f32x4 v = bs[bj][n] + deqg<I8_>(acc[ai][bj][m][n], sa, gv[bj][n]); *(u32x2*)(out + off + bj * HALF + n * 16) = (u32x2){cvt_pk_bf16(v[0], v[1]), cvt_pk_bf16(v[2], v[3])}; }
                asm volatile("" ::: "memory"); }
    }
};
template <bool I8_, bool OUT8  > struct EpiSwiglu {
    static constexpr bool PERM = true, AFTER_DRAIN = false, I8 = I8_, FP8 = false; typedef typename AccT<I8_>::type acc_t;
    bf16_t* O; const float* sA; const float* sB; unsigned* rmax;
    __device__ __forceinline__ static float silu(float x) { return x * __builtin_amdgcn_rcpf(1.0f + __builtin_amdgcn_exp2f(-1.44269504f * x)); }
    __device__ __forceinline__ void operator()(const acc_t (&acc)[2][2][4][2], const Unit& u, int wr, int wc, int fr, int fq) const {
        const int row0 = u.pm * BM + wr * 64 + fr; const int col0 = u.pn * HALF + wc * 32 + 8 * fq;
        f32x4 sb[2][2];
#pragma unroll
        for (int bj = 0; bj < 2; ++bj)
#pragma unroll
            for (int n = 0; n < 2; ++n) sb[bj][n] = I8_ ? *(const f32x4*)(sB + u.pn * BM + bj * HALF + wc * 32 + 8 * fq + 4 * n) : (f32x4){1.f, 1.f, 1.f, 1.f};
#pragma unroll
        for (int ai = 0; ai < 2; ++ai)
#pragma unroll
            for (int m = 0; m < 4; ++m) { const int r = row0 + ai * HALF + m * 16; bf16_t* rowp = O + (size_t)r * 5632 + col0; const float sa = I8_ ? sA[r] : 1.f;
                const f32x4 g0 = deq<I8_>(acc[ai][0][m][0], sa, sb[0][0]), g1 = deq<I8_>(acc[ai][0][m][1], sa, sb[0][1]), u0 = deq<I8_>(acc[ai][1][m][0], sa, sb[1][0]), u1 = deq<I8_>(acc[ai][1][m][1], sa, sb[1][1]);
                f32x4 v0, v1;
#pragma unroll
                for (int j = 0; j < 4; ++j) { v0[j] = silu(g0[j]) * u0[j]; v1[j] = silu(g1[j]) * u1[j]; }
                if constexpr (OUT8) { unsigned w0 = 0u, w1 = 0u; w0 = __builtin_amdgcn_cvt_pk_fp8_f32(v0[0], v0[1], w0, false); w0 = __builtin_amdgcn_cvt_pk_fp8_f32(v0[2], v0[3], w0, true);
                    w1 = __builtin_amdgcn_cvt_pk_fp8_f32(v1[0], v1[1], w1, false); w1 = __builtin_amdgcn_cvt_pk_fp8_f32(v1[2], v1[3], w1, true);
                    typedef unsigned u32x2 __attribute__((ext_vector_type(2))); *(u32x2*)((unsigned char*)O + (size_t)r * 5632 + col0) = (u32x2){w0, w1}; }
                else *(u32x4*)rowp = pack8(v0, v1);
                if (rmax) { float mx = fmaxf(fmaxf(fmaxf(fabsf(v0[0]), fabsf(v0[1])), fmaxf(fabsf(v0[2]), fabsf(v0[3]))), fmaxf(fmaxf(fabsf(v1[0]), fabsf(v1[1])), fmaxf(fabsf(v1[2]), fabsf(v1[3]))));
                    { unsigned uu = __float_as_uint(mx); auto r16 = __builtin_amdgcn_permlane16_swap(uu, uu, false, false); mx = fmaxf(__uint_as_float(r16[0]), __uint_as_float(r16[1])); uu = __float_as_uint(mx); auto r32 = __builtin_amdgcn_permlane32_swap(uu, uu, false, false); mx = fmaxf(__uint_as_float(r32[0]), __uint_as_float(r32[1])); }
                    if (fq == 0) atomicMax(rmax + r, __float_as_uint(mx)); } }
    }
};
template <bool I8_> struct EpiDsaProj {
    static constexpr bool PERM = true, AFTER_DRAIN = false, I8 = I8_, FP8 = false; typedef typename AccT<I8_>::type acc_t;
    bf16_t* Q; float* CKVR; bf16_t* QI; bf16_t* KI; float* WI; const float* sA; const float* sB;
    __device__ __forceinline__ void operator()(const acc_t (&acc)[2][2][4][2], const Unit& u, int wr, int wc, int fr, int fq) const {
        const int row0 = u.pm * BM + wr * 64 + fr; const int lc0 = wc * 32 + 8 * fq;
        f32x4 sb[2][2];
#pragma unroll
        for (int bj = 0; bj < 2; ++bj)
#pragma unroll
            for (int n = 0; n < 2; ++n) sb[bj][n] = I8_ ? *(const f32x4*)(sB + u.pn * BM + bj * HALF + lc0 + 4 * n) : (f32x4){1.f, 1.f, 1.f, 1.f};
#define DQ(ai, bj, m, n) deq<I8_>(acc[ai][bj][m][n], sa, sb[bj][n])
        if (u.pn < 8 || (u.pn >= 9 && u.pn < 17)) {
            bf16_t* base = (u.pn < 8) ? Q : QI; const int col0 = ((u.pn < 8) ? u.pn : (u.pn - 9)) * BM + lc0;
#pragma unroll
            for (int ai = 0; ai < 2; ++ai)
#pragma unroll
                for (int m = 0; m < 4; ++m) { const int r = row0 + ai * HALF + m * 16; const float sa = I8_ ? sA[r] : 1.f; bf16_t* rowp = base + (size_t)r * 2048 + col0;
#pragma unroll
                    for (int bj = 0; bj < 2; ++bj) *(u32x4*)(rowp + bj * HALF) = pack8(DQ(ai, bj, m, 0), DQ(ai, bj, m, 1)); }
        } else if (u.pn == 8) {
#pragma unroll
            for (int ai = 0; ai < 2; ++ai)
#pragma unroll
                for (int m = 0; m < 4; ++m) { const int r = row0 + ai * HALF + m * 16; const float sa = I8_ ? sA[r] : 1.f; float* rowp = CKVR + (size_t)r * 256 + lc0;
#pragma unroll
                    for (int bj = 0; bj < 2; ++bj) { *(f32x4*)(rowp + bj * HALF) = DQ(ai, bj, m, 0); *(f32x4*)(rowp + bj * HALF + 4) = DQ(ai, bj, m, 1); } }
        } else {
#pragma unroll
            for (int ai = 0; ai < 2; ++ai)
#pragma unroll
                for (int m = 0; m < 4; ++m) { const size_t r = (size_t)(row0 + ai * HALF + m * 16); const float sa = I8_ ? sA[r] : 1.f;
                    *(u32x4*)(KI + r * 128 + lc0) = pack8(DQ(ai, 0, m, 0), DQ(ai, 0, m, 1));
                    if (lc0 < 16) { *(f32x4*)(WI + r * 16 + lc0) = DQ(ai, 1, m, 0); *(f32x4*)(WI + r * 16 + lc0 + 4) = DQ(ai, 1, m, 1); } }
        }
#undef DQ
    }
};
template <class Epi, class Sched, bool ALIGN_EPI = false, bool SP2 = false>
__device__ __forceinline__ void gemm_phase(PG8_LAS unsigned char* lds, const Gemm g, const Sched& S, const Epi& E, int tid_in) {
    int tid_ = tid_in; asm volatile("" : "+v"(tid_));
    const int tid = tid_, wid = __builtin_amdgcn_readfirstlane(tid >> 6), lane = tid & 63, wr = wid >> 2, wc = wid & 3, fr = lane & 15, fq = lane >> 4;
    constexpr bool I8 = Epi::I8, F8 = Epi::FP8; typedef typename Epi::acc_t acc_t; typedef int i32x4_t __attribute__((ext_vector_type(4))); typedef int i32x8_t __attribute__((ext_vector_type(8)));
    const int K = g.K * ((I8 || F8) ? 1 : 2)  , nt = K / (BK * 2);
    unsigned voffA[2], voffB[2];
#pragma unroll
    for (int i = 0; i < 2; ++i) { int R, C; stage_rc(tid * 16 + i * 8192, R, C); const int Rb = Epi::PERM ? ((R & ~31) + perm32(R & 31)) : R;
        voffA[i] = (unsigned)(R * K + C * 2); voffB[i] = (unsigned)(Rb * K + C * 2); }
    const size_t kstep = (size_t)(BK * 2);
    const size_t hstep = (size_t)HALF * K;
    const size_t tstep = 2 * hstep;
    const unsigned ldsw = (unsigned)wid * 1024u;
    const int aoff = lds_byte(wr * 64 + fr, fq * 8), boff = lds_byte(wc * 32 + fr, fq * 8);
#define PG8_SA(b, h) (((b) * 2 + (h)) * HTB)
#define PG8_SB(b, h) ((4 + (b) * 2 + (h)) * HTB)
#define PG8_STAGE(bufoff, gbase, voff) do { _Pragma("unroll") for (int _i = 0; _i < 2; ++_i) \
        __builtin_amdgcn_global_load_lds((const unsigned*)((const char*)(gbase) + (voff)[_i]), (PG8_LAS unsigned*)(lds + (bufoff) + ldsw + _i * 8192), 16, 0, 0); } while (0)
#define PG8_LDA(dst, b, h) do { _Pragma("unroll") for (int m = 0; m < 4; ++m) _Pragma("unroll") for (int k = 0; k < 2; ++k) dst[m][k] = *(const PG8_LAS bf16x8*)(lds + PG8_SA(b, h) + aoff + m * 2048 + k * 1024); } while (0)
#define PG8_LDB(dst, b, h) do { _Pragma("unroll") for (int n = 0; n < 2; ++n) _Pragma("unroll") for (int k = 0; k < 2; ++k) dst[n][k] = *(const PG8_LAS bf16x8*)(lds + PG8_SB(b, h) + boff + n * 2048 + k * 1024); } while (0)
#define PG8_CAT8(x) ({ const i32x4_t lo_ = __builtin_bit_cast(i32x4_t, (x)[0]), hi_ = __builtin_bit_cast(i32x4_t, (x)[1]); (i32x8_t){lo_[0], lo_[1], lo_[2], lo_[3], hi_[0], hi_[1], hi_[2], hi_[3]}; })
#define PG8_MMA(ai, bj, At, Bt) do { __builtin_amdgcn_s_setprio(1); \
        if constexpr (F8) {   \
            _Pragma("unroll") for (int m = 0; m < 4; ++m) _Pragma("unroll") for (int n = 0; n < 2; ++n) \
                { const i32x8_t b8_ = PG8_CAT8(Bt[n]), a8_ = PG8_CAT8(At[m]); asm volatile("v_mfma_scale_f32_16x16x128_f8f6f4 %0, %1, %2, %0, %3, %3 op_sel_hi:[0,0,0]" : "+v"(acc[ai][bj][m][n]) : "v"(b8_), "v"(a8_), "v"(0x7F7F7F7F)); } \
        } else { _Pragma("unroll") for (int m = 0; m < 4; ++m) _Pragma("unroll") for (int n = 0; n < 2; ++n) _Pragma("unroll") for (int k = 0; k < 2; ++k) \
        { if constexpr (I8) acc[ai][bj][m][n] = __builtin_bit_cast(acc_t, __builtin_amdgcn_mfma_i32_16x16x64_i8(__builtin_bit_cast(i32x4_t, Bt[n][k]), __builtin_bit_cast(i32x4_t, At[m][k]), __builtin_bit_cast(i32x4_t, acc[ai][bj][m][n]), 0, 0, 0)); \
          else acc[ai][bj][m][n] = __builtin_bit_cast(acc_t, __builtin_amdgcn_mfma_f32_16x16x32_bf16(Bt[n][k], At[m][k], __builtin_bit_cast(f32x4, acc[ai][bj][m][n]), 0, 0, 0)); } } __builtin_amdgcn_s_setprio(0); } while (0)
#define PG8_WAIT_V(n) asm volatile("s_waitcnt vmcnt(" #n ")" ::: "memory")
#define PG8_WAIT_L(n) asm volatile("s_waitcnt lgkmcnt(" #n ")" ::: "memory")
#define PG8_BAR __builtin_amdgcn_s_barrier()
#define PG8_SCHED __builtin_amdgcn_sched_barrier(0)
    Unit cur, nxt; int ui = 0;
    if (!S.next(0, cur)) return;
    acc_t acc[2][2][4][2];
#pragma unroll
    for (int a = 0; a < 2; ++a)
#pragma unroll
        for (int b = 0; b < 2; ++b)
#pragma unroll
            for (int m = 0; m < 4; ++m)
#pragma unroll
                for (int n = 0; n < 2; ++n) acc[a][b][m][n] = acc_t{};
    bf16x8 At[4][2], B0[2][2], B1[2][2];
    const char* cA = (const char*)g.A + (size_t)cur.pm * tstep; const char* cB = (const char*)g.Bt + (size_t)cur.pn * tstep;
    S.a_ready(cur);
    if constexpr (SP2) {
        PG8_STAGE(PG8_SB(0, 0), cB, voffB); PG8_STAGE(PG8_SB(0, 1), cB + hstep, voffB); PG8_STAGE(PG8_SA(0, 0), cA, voffA); PG8_STAGE(PG8_SA(0, 1), cA + hstep, voffA);
        if (wr == 1) PG8_BAR;
        PG8_WAIT_V(2); PG8_BAR;
        PG8_STAGE(PG8_SB(1, 0), cB + kstep, voffB); PG8_STAGE(PG8_SA(1, 0), cA + kstep, voffA); PG8_STAGE(PG8_SB(1, 1), cB + hstep + kstep, voffB);
        PG8_WAIT_V(6); PG8_BAR;
    } else {
        PG8_STAGE(PG8_SB(0, 0), cB, voffB); PG8_STAGE(PG8_SA(0, 0), cA, voffA); PG8_STAGE(PG8_SB(0, 1), cB + hstep, voffB); PG8_STAGE(PG8_SA(0, 1), cA + hstep, voffA);
        if (wr == 1) PG8_BAR;
        PG8_WAIT_V(4); PG8_BAR;
        PG8_STAGE(PG8_SB(1, 0), cB + kstep, voffB); PG8_STAGE(PG8_SA(1, 0), cA + kstep, voffA); PG8_STAGE(PG8_SB(1, 1), cB + hstep + kstep, voffB);
        PG8_WAIT_V(6); PG8_BAR;
    }
    for (;;) {
        const bool has_next = S.next(ui + 1, nxt);
        const char* nA = has_next ? (const char*)g.A + (size_t)nxt.pm * tstep : cA; const char* nB = has_next ? (const char*)g.Bt + (size_t)nxt.pn * tstep : cB;
        for (int t = 0; t < nt; t += 2) {
            const bool last = (t == nt - 2);
            const char* a1 = cA + (size_t)(t + 1) * kstep;
            const char* a2 = last ? nA : cA + (size_t)(t + 2) * kstep; const char* b2 = last ? nB : cB + (size_t)(t + 2) * kstep;
            const char* a3 = a2 + kstep; const char* b3 = b2 + kstep;
            if (last && has_next) S.a_ready(nxt);
            if constexpr (SP2) {
            PG8_LDB(B0, 0, 0); PG8_LDB(B1, 0, 1); PG8_SCHED; PG8_LDA(At, 0, 0); PG8_STAGE(PG8_SA(1, 1), a1 + hstep, voffA);
            PG8_WAIT_V(8); PG8_WAIT_L(0); PG8_BAR; PG8_MMA(0, 0, At, B0); PG8_MMA(0, 1, At, B1); PG8_BAR; PG8_SCHED;
            PG8_LDA(At, 0, 1); PG8_STAGE(PG8_SB(0, 0), b2, voffB); PG8_STAGE(PG8_SB(0, 1), b2 + hstep, voffB); PG8_STAGE(PG8_SA(0, 0), a2, voffA);
            PG8_WAIT_V(8); PG8_WAIT_L(0); PG8_BAR; PG8_MMA(1, 0, At, B0); PG8_MMA(1, 1, At, B1); PG8_BAR; PG8_SCHED;
            PG8_LDB(B0, 1, 0); PG8_LDB(B1, 1, 1); PG8_SCHED; PG8_LDA(At, 1, 0); PG8_STAGE(PG8_SA(0, 1), a2 + hstep, voffA);
            PG8_WAIT_V(8); PG8_WAIT_L(0); PG8_BAR; PG8_MMA(0, 0, At, B0); PG8_MMA(0, 1, At, B1); PG8_BAR; PG8_SCHED;
            PG8_LDA(At, 1, 1); PG8_STAGE(PG8_SB(1, 0), b3, voffB); PG8_STAGE(PG8_SB(1, 1), b3 + hstep, voffB); PG8_STAGE(PG8_SA(1, 0), a3, voffA);
            PG8_WAIT_V(8); PG8_WAIT_L(0); PG8_BAR; PG8_MMA(1, 0, At, B0); PG8_MMA(1, 1, At, B1); PG8_BAR; PG8_SCHED;
            } else {
            PG8_LDB(B0, 0, 0); PG8_SCHED; PG8_LDA(At, 0, 0); PG8_STAGE(PG8_SA(1, 1), a1 + hstep, voffA);
            PG8_WAIT_L(8); PG8_BAR; PG8_WAIT_L(0); PG8_MMA(0, 0, At, B0); PG8_BAR; PG8_SCHED;
            PG8_LDB(B1, 0, 1); PG8_STAGE(PG8_SB(0, 0), b2, voffB);
            PG8_BAR; PG8_WAIT_L(0); PG8_MMA(0, 1, At, B1); PG8_BAR;
            PG8_LDA(At, 0, 1); PG8_STAGE(PG8_SA(0, 0), a2, voffA);
            PG8_BAR; PG8_WAIT_L(0); PG8_MMA(1, 0, At, B0); PG8_BAR; PG8_SCHED;
            PG8_STAGE(PG8_SB(0, 1), b2 + hstep, voffB);
            PG8_WAIT_V(6); PG8_BAR; PG8_MMA(1, 1, At, B1); PG8_BAR;
            PG8_LDB(B0, 1, 0); PG8_SCHED; PG8_LDA(At, 1, 0); PG8_STAGE(PG8_SA(0, 1), a2 + hstep, voffA);
            PG8_WAIT_L(8); PG8_BAR; PG8_WAIT_L(0); PG8_MMA(0, 0, At, B0); PG8_BAR; PG8_SCHED;
            PG8_LDB(B1, 1, 1); PG8_STAGE(PG8_SB(1, 0), b3, voffB);
            PG8_BAR; PG8_WAIT_L(0); PG8_MMA(0, 1, At, B1); PG8_BAR;
            PG8_LDA(At, 1, 1); PG8_STAGE(PG8_SA(1, 0), a3, voffA);
            PG8_BAR; PG8_WAIT_L(0); PG8_MMA(1, 0, At, B0); PG8_BAR; PG8_SCHED;
            PG8_STAGE(PG8_SB(1, 1), b3 + hstep, voffB);
            PG8_WAIT_V(6); PG8_BAR; PG8_MMA(1, 1, At, B1); PG8_BAR;
            }
        }
        if constexpr (ALIGN_EPI) { if (wr == 0) PG8_BAR; }
        if constexpr (!Epi::AFTER_DRAIN) { E(acc, cur, wr, wc, fr, fq);
#ifdef EPI_TWICE
            if constexpr (Epi::PERM) { asm volatile("" ::: "memory"); E(acc, cur, wr, wc, fr, fq); }
#endif
            S.done(cur); }
        if (!has_next) break;
#pragma unroll
        for (int a = 0; a < 2; ++a)
#pragma unroll
            for (int b = 0; b < 2; ++b)
#pragma unroll
                for (int m = 0; m < 4; ++m)
#pragma unroll
                    for (int n = 0; n < 2; ++n) acc[a][b][m][n] = acc_t{};
        cur = nxt; cA = nA; cB = nB; ++ui;
        if constexpr (ALIGN_EPI) { if (wr == 1) PG8_BAR; }
    }
    PG8_WAIT_V(0);
    if constexpr (!ALIGN_EPI) { if (wr == 0) PG8_BAR; }
    PG8_BAR;
    if constexpr (Epi::AFTER_DRAIN) { E.fused(acc, cur, wr, wc, fr, fq, lds, wid, lane); S.done(cur); }
#undef PG8_SA
#undef PG8_SB
#undef PG8_STAGE
#undef PG8_LDA
#undef PG8_LDB
#undef PG8_MMA
#undef PG8_CAT8
#undef PG8_WAIT_V
#undef PG8_WAIT_L
#undef PG8_BAR
#undef PG8_SCHED
}
}
#ifndef PG8_SP2
#define PG8_SP2 true
#endif
#ifndef PG8_ALIGN
#define PG8_ALIGN true
#endif
#ifndef USE_I8
#define USE_I8 true
#endif
#ifndef I8_QKV
#define I8_QKV USE_I8
#endif
#ifndef I8_DSA
#define I8_DSA true
#endif
#ifndef I8_GU
#define I8_GU USE_I8
#endif
#ifndef OUT_MODE
#define OUT_MODE 2
#endif
#ifndef DN_MODE
#define DN_MODE 2
#endif
#define I8_DN (DN_MODE == 1)
#ifndef WGM_QKV
#define WGM_QKV 2
#endif
#ifndef WGM_DSA
#define WGM_DSA 2
#endif
#ifndef WGM_OUT
#define WGM_OUT 2
#endif
#ifndef WGM_GU
#define WGM_GU 8
#endif
#ifndef WGM_DN
#define WGM_DN 2
#endif
#ifndef DSA_MERGE_POST
#define DSA_MERGE_POST 1
#endif
#ifndef PRO_SINGLE
#define PRO_SINGLE 1
#endif
#ifndef DIL_SPLIT
#define DIL_SPLIT 1
#endif
#ifndef DIL_FUSED
#define DIL_FUSED 0
#endif
#ifndef MK_MULTI
#define MK_MULTI 0
#endif

constexpr int NWAVES = 8;
constexpr int BATCH = 8, SEQ = 2048, D = 2048, M = BATCH * SEQ, NH = 16, HD = 128, DFF = 5632, KVL = 256, TOPK = 256, DEPTH = 4;
constexpr int NIN_A = 6144, NIN_B = 4496, NIN_BP = 4608, NMOD = 6 * D;
constexpr float EPS = 1e-6f;
constexpr float LOG2E = 1.4426950408889634f;
constexpr float QSCALE = 0.08838834764831845f * LOG2E;

constexpr size_t MiB = 1u << 20;
constexpr size_t WS_CTL = 0, CTL_ZERO_BYTES = 1 * MiB;
constexpr size_t WS_MOD = 1 * MiB;
constexpr size_t WS_W = 4 * MiB, W_LAYER = 100 * MiB;
constexpr size_t WO_IN = 0, WO_OUT = 24 * MiB, WO_GU = 32 * MiB, WO_DN = 76 * MiB, WO_UK = 98 * MiB, WO_UV = 99 * MiB;
constexpr size_t WS_H = 404 * MiB;
constexpr size_t WS_R1 = 468 * MiB;
constexpr size_t WS_ATT = 660 * MiB;
constexpr size_t WS_R2 = 724 * MiB;
constexpr size_t WS_X16 = 900 * MiB;
constexpr size_t WS_END = 964 * MiB;
constexpr size_t R2_ATT8 = 16 * MiB;
constexpr size_t R1_Q = 0, R1_QI = 64 * MiB, R1_OLAT = 0, R1_CKVR = 128 * MiB, R1_KI = 144 * MiB, R1_WI = 148 * MiB, R1_CKV = 149 * MiB, R1_SEL = 157 * MiB;
constexpr int CW_BAR = 4096;
constexpr size_t CTL_CMAX = 65536;
constexpr size_t CTL_DILCNT = 524288;
constexpr int CM_LAYER = 21504, CM_GU = 6144, CM_DN = 17408, CM_OUT = 19456;
constexpr size_t WS_SA = 2 * MiB + 512 * 1024;
constexpr size_t WS_RMAX = WS_SA + 65536;
constexpr size_t WS_SA2 = WS_SA + 131072;
constexpr size_t WS_SB = 3 * MiB;

constexpr int RING_BYTES = 143360;
constexpr int MISC_OFF = RING_BYTES;
constexpr int LDS_BYTES = RING_BYTES + 256;

#define GAS __attribute__((address_space(1)))
#define LAS __attribute__((address_space(3)))
typedef unsigned short bf16;
typedef unsigned short u16;
typedef unsigned v4u __attribute__((ext_vector_type(4)));
typedef unsigned v2u __attribute__((ext_vector_type(2)));
typedef float f32x4 __attribute__((ext_vector_type(4)));
typedef short bf16x8 __attribute__((ext_vector_type(8)));
typedef short s16x4 __attribute__((ext_vector_type(4)));
typedef short v4i16_t __attribute__((ext_vector_type(4)));
typedef GAS unsigned gu32;
template <class T> __device__ __forceinline__ T* as_global(T* p) { return (T*)(GAS T*)p; }
#define RLX_AGENT __ATOMIC_RELAXED, __HIP_MEMORY_SCOPE_AGENT
#define LDS_WAIT() asm volatile("s_waitcnt lgkmcnt(0)" ::: "memory")
#define VM_WAIT() asm volatile("s_waitcnt vmcnt(0)" ::: "memory")
__device__ __forceinline__ unsigned cvtpk(float lo, float hi) { return pg8::cvt_pk_bf16(lo, hi); }
#define DPPF(v, ctrl) __builtin_bit_cast(float, __builtin_amdgcn_update_dpp(0, __builtin_bit_cast(int, (v)), (ctrl), 0xF, 0xF, true))
__device__ __forceinline__ float xmax16(float v) { const unsigned u = __float_as_uint(v); auto r = __builtin_amdgcn_permlane16_swap(u, u, false, false); return fmaxf(__uint_as_float(r[0]), __uint_as_float(r[1])); }
__device__ __forceinline__ float xmax32(float v) { const unsigned u = __float_as_uint(v); auto r = __builtin_amdgcn_permlane32_swap(u, u, false, false); return fmaxf(__uint_as_float(r[0]), __uint_as_float(r[1])); }
__device__ __forceinline__ float xsum16(float v) { const unsigned u = __float_as_uint(v); auto r = __builtin_amdgcn_permlane16_swap(u, u, false, false); return __uint_as_float(r[0]) + __uint_as_float(r[1]); }
__device__ __forceinline__ float xsum32(float v) { const unsigned u = __float_as_uint(v); auto r = __builtin_amdgcn_permlane32_swap(u, u, false, false); return __uint_as_float(r[0]) + __uint_as_float(r[1]); }
__device__ __forceinline__ float wave_sum(float v) {
    v += DPPF(v, 0xB1); v += DPPF(v, 0x4E); v += DPPF(v, 0x141); v += DPPF(v, 0x140);
    return xsum32(xsum16(v));
}
__device__ __forceinline__ float wave_max(float v) {
    v = fmaxf(v, DPPF(v, 0xB1)); v = fmaxf(v, DPPF(v, 0x4E)); v = fmaxf(v, DPPF(v, 0x141)); v = fmaxf(v, DPPF(v, 0x140));
    return xmax32(xmax16(v));
}
__device__ __forceinline__ s16x4 tr_read(LAS const unsigned char* p) { return __builtin_bit_cast(s16x4, __builtin_amdgcn_ds_read_tr16_b64_v4i16((LAS v4i16_t*)p)); }
__device__ __forceinline__ bf16x8 cat8(s16x4 a, s16x4 b) { bf16x8 r; r[0] = a[0]; r[1] = a[1]; r[2] = a[2]; r[3] = a[3]; r[4] = b[0]; r[5] = b[1]; r[6] = b[2]; r[7] = b[3]; return r; }
__device__ __forceinline__ unsigned mbcnt64(unsigned long long m) { return __builtin_amdgcn_mbcnt_hi((unsigned)(m >> 32), __builtin_amdgcn_mbcnt_lo((unsigned)m, 0u)); }

#define XB_TMO      128
#define XB_XCNT(j)  (256  + 64 * (j))
#define XB_XSUB(j)  (1280 + 64 * (j))
#define XB_XGEN(j)  (2304 + 64 * (j))
#define XB_TOP      3328
#define XB_TOPGEN   3392
#define XCD_BAR_WORDS 3456
#define XB_SPIN_CAP (1u << 18)

__device__ __forceinline__ unsigned xb_ld(unsigned* p)              { return __hip_atomic_load(p, __ATOMIC_RELAXED, __HIP_MEMORY_SCOPE_AGENT); }
__device__ __forceinline__ unsigned xb_add(unsigned* p, unsigned v) { return __hip_atomic_fetch_add(p, v, __ATOMIC_RELAXED, __HIP_MEMORY_SCOPE_AGENT); }
__device__ __forceinline__ unsigned xb_xcc_id() { return (unsigned)__builtin_amdgcn_s_getreg((3 << 11) | 20) & 0xFu; }
#define XB_SPIN(cond, bar) do { unsigned _sp = 0; while (cond) { __builtin_amdgcn_s_sleep(1); \
    if ((++_sp & 255u) == 0u) { if (xb_ld(&(bar)[XB_TMO])) break; if (_sp > XB_SPIN_CAP) { atomicAdd(&(bar)[XB_TMO], 1u); break; } } } } while (0)

struct XcdBarrier {
    unsigned* bar; unsigned x;
    volatile LAS unsigned* st;
};

__device__ __forceinline__ XcdBarrier xcd_barrier_post(unsigned* bar, volatile LAS unsigned* st) {
    XcdBarrier b; b.bar = bar; b.x = xb_xcc_id(); b.st = st;
    if (threadIdx.x == 0) (void)xb_add(&bar[XB_XCNT(b.x)], 1u);
    return b;
}
__device__ __forceinline__ void xcd_barrier_complete(unsigned* bar, unsigned x, unsigned& nloc, unsigned& nx) {
    const unsigned G = gridDim.x * gridDim.y * gridDim.z;
    unsigned sum, cnt, mine, sp = 0u;
    for (;;) {
        sum = 0u; cnt = 0u; mine = 0u;
#pragma unroll
        for (unsigned j = 0; j < 16; ++j) { const unsigned c = xb_ld(&bar[XB_XCNT(j)]); sum += c; cnt += (c > 0u) ? 1u : 0u; mine = (j == x) ? c : mine; }
        if (sum == G) break;
        __builtin_amdgcn_s_sleep(1);
        if ((++sp & 255u) == 0u) { if (xb_ld(&bar[XB_TMO])) break; if (sp > XB_SPIN_CAP) { atomicAdd(&bar[XB_TMO], 1u); break; } }
    }
    nloc = mine > 0u ? mine : 1u; nx = cnt > 0u ? cnt : 1u;
}

__device__ __forceinline__ void xcd_barrier_census(const XcdBarrier& b) { unsigned nloc, nx; xcd_barrier_complete(b.bar, b.x, nloc, nx); b.st[0] = nloc; b.st[1] = nx; }
__device__ __forceinline__ void xcd_barrier(const XcdBarrier& b, const bool thread0  ) {
    asm volatile("s_waitcnt vmcnt(0)" ::: "memory");
    __syncthreads();
    if (thread0) {
        unsigned* bar = b.bar;
        __builtin_amdgcn_s_waitcnt(0);
        unsigned nloc = b.st[0], nx = b.st[1];
        const unsigned old = xb_add(&bar[XB_XSUB(b.x)], 1u);
        const unsigned gen = old / nloc;
        if (old + 1u == (gen + 1u) * nloc) {
            __builtin_amdgcn_fence(__ATOMIC_RELEASE, "agent");
            asm volatile("s_waitcnt vmcnt(0)" ::: "memory");
            const unsigned og = xb_add(&bar[XB_TOP], 1u);
            const unsigned tg = og / nx;
            if (og + 1u == (tg + 1u) * nx) xb_add(&bar[XB_TOPGEN], 1u);
            else XB_SPIN(xb_ld(&bar[XB_TOPGEN]) == tg, bar);
            __builtin_amdgcn_fence(__ATOMIC_ACQUIRE, "agent");
            xb_add(&bar[XB_XGEN(b.x)], 1u);
            asm volatile("s_waitcnt vmcnt(0)" ::: "memory");
        } else {
            XB_SPIN(xb_ld(&bar[XB_XGEN(b.x)]) == gen, bar);
            __builtin_amdgcn_fence(__ATOMIC_ACQUIRE, "agent");
            asm volatile("s_waitcnt vmcnt(0)" ::: "memory");
        }
    }
    __syncthreads();
}
struct LayerW { const float *norm_attn, *ada_w, *ada_b, *w_in, *kv_norm, *w_uk, *w_uv, *w_out, *norm_ffn, *w_gu, *w_down; };
struct Args { const float* x; const float* c; const float* final_norm; LayerW L[DEPTH]; float* out; unsigned char* ws; int ph_lo, ph_hi; };

__device__ __forceinline__ void colmax_item(const float* W, int N, unsigned* cmax, int item, int lane) {
    const int nnb = (N + 255) / 256, kb = item / nnb, nb = item % nnb, col = 256 * nb + 4 * lane;
    if (col < N) { const float* p = W + (size_t)(64 * kb) * N + col; f32x4 m = (f32x4){0.f, 0.f, 0.f, 0.f};
#pragma unroll 8
        for (int kk = 0; kk < 64; ++kk) { const f32x4 v = *(const f32x4*)(p + (size_t)kk * N); m[0] = fmaxf(m[0], fabsf(v[0])); m[1] = fmaxf(m[1], fabsf(v[1])); m[2] = fmaxf(m[2], fabsf(v[2])); m[3] = fmaxf(m[3], fabsf(v[3])); }
#pragma unroll
        for (int j = 0; j < 4; ++j) atomicMax(cmax + col + j, __float_as_uint(m[j])); }
}
constexpr int CI_INA = (D / 64) * (NIN_A / 256), CI_INB = I8_DSA ? (D / 64) * ((NIN_B + 255) / 256) : 0, CI_GU = (D / 64) * (2 * DFF / 256), CI_DN = (DFF / 64) * (D / 256), CI_OUT = OUT_MODE ? (D / 64) * (D / 256) : 0;
constexpr int CI_DIL = CI_INA + CI_GU + CI_DN + CI_OUT, CI_DSA = CI_INB + CI_GU + CI_DN + CI_OUT, CI_ALL = 2 * CI_DIL + 2 * CI_DSA;
__device__ __forceinline__ void p0_colmax(const Args& a, int gw, int NGW, int lane) {
    unsigned* cm = (unsigned*)(as_global(a.ws) + WS_CTL + CTL_CMAX);
    for (int it = gw; it < CI_ALL; it += NGW) {
        int r = it; int l;
        if (r < CI_DIL) l = 0; else { r -= CI_DIL; if (r < CI_DSA) l = 1; else { r -= CI_DSA; if (r < CI_DIL) l = 2; else { r -= CI_DIL; l = 3; } } }
        const LayerW& w = a.L[l]; unsigned* cml = cm + l * CM_LAYER; const int nin = (l & 1) ? NIN_B : NIN_A, ci_in = (l & 1) ? CI_INB : CI_INA;
        if (r < ci_in) colmax_item(as_global(w.w_in), nin, cml, r, lane); else if (r < ci_in + CI_GU) colmax_item(as_global(w.w_gu), 2 * DFF, cml + CM_GU, r - ci_in, lane); else if (r < ci_in + CI_GU + CI_DN) colmax_item(as_global(w.w_down), D, cml + CM_DN, r - ci_in - CI_GU, lane); else colmax_item(as_global(w.w_out), D, cml + CM_OUT, r - ci_in - CI_GU - CI_DN, lane);
    }
}
constexpr int TSCR = 64 * 65 * 4;
struct TrItem { const float* W; int ldw, srccol0, nvalid, k0, K, destrow0, mode; void* WT; const unsigned* cmax; float* sB; LAS const float* cml; };
__device__ __forceinline__ void tr_load(const TrItem& T, int lane, f32x4 (&v)[16]) {
    const int c4 = lane & 15, r4 = lane >> 4; const bool ok = 4 * c4 < T.nvalid; const float* p = T.W + (size_t)(T.k0 + r4) * T.ldw + T.srccol0 + 4 * c4;
#pragma unroll
    for (int it = 0; it < 16; ++it) { v[it] = (f32x4){0.f, 0.f, 0.f, 0.f}; if (ok) v[it] = *(const f32x4*)(p + (size_t)(4 * it) * T.ldw); }
}
__device__ __forceinline__ void tr_fill(LAS float* scr, int lane, const f32x4 (&v)[16]) {
    const int c4 = lane & 15, r4 = lane >> 4;
#pragma unroll
    for (int it = 0; it < 16; ++it) { LAS float* d = scr + (4 * it + r4) * 65 + 4 * c4; d[0] = v[it][0]; d[1] = v[it][1]; d[2] = v[it][2]; d[3] = v[it][3]; }
}
__device__ __forceinline__ void tr_emit(const TrItem& T, LAS float* scr, int lane) {
    const int q = lane & 3, rr = lane >> 2;
#pragma unroll
    for (int j = 0; j < 4; ++j) { const int n = rr + 16 * j; const LAS float* sp = scr + (16 * q) * 65 + n; float v[16];
#pragma unroll
        for (int e = 0; e < 16; ++e) v[e] = sp[e * 65];
        if (T.mode == 2) { const float cmx = (n < T.nvalid) ? (T.cml ? T.cml[n] : __uint_as_float(T.cmax[T.srccol0 + n])) : 0.f; const float inv = cmx > 0.f ? 256.0f / cmx : 0.f; unsigned w[4];
#pragma unroll
            for (int e = 0; e < 4; ++e) { unsigned ww = 0u; ww = __builtin_amdgcn_cvt_pk_fp8_f32(v[4 * e] * inv, v[4 * e + 1] * inv, ww, false); ww = __builtin_amdgcn_cvt_pk_fp8_f32(v[4 * e + 2] * inv, v[4 * e + 3] * inv, ww, true); w[e] = ww; }
            *(v4u*)((signed char*)T.WT + (size_t)(T.destrow0 + n) * T.K + T.k0 + 16 * q) = (v4u){w[0], w[1], w[2], w[3]}; }
        else if (T.mode) { const float cmx = (n < T.nvalid) ? (T.cml ? T.cml[n] : __uint_as_float(T.cmax[T.srccol0 + n])) : 0.f; const float inv = cmx > 0.f ? 127.0f / cmx : 0.f; unsigned b[16];
#pragma unroll
            for (int e = 0; e < 16; ++e) b[e] = (unsigned)(int)rintf(v[e] * inv) & 0xFFu;
            v4u o; o.x = b[0] | (b[1] << 8) | (b[2] << 16) | (b[3] << 24); o.y = b[4] | (b[5] << 8) | (b[6] << 16) | (b[7] << 24); o.z = b[8] | (b[9] << 8) | (b[10] << 16) | (b[11] << 24); o.w = b[12] | (b[13] << 8) | (b[14] << 16) | (b[15] << 24);
            *(v4u*)((signed char*)T.WT + (size_t)(T.destrow0 + n) * T.K + T.k0 + 16 * q) = o; }
        else { v4u o0, o1; o0.x = cvtpk(v[0], v[1]); o0.y = cvtpk(v[2], v[3]); o0.z = cvtpk(v[4], v[5]); o0.w = cvtpk(v[6], v[7]); o1.x = cvtpk(v[8], v[9]); o1.y = cvtpk(v[10], v[11]); o1.z = cvtpk(v[12], v[13]); o1.w = cvtpk(v[14], v[15]);
            bf16* dp = (bf16*)T.WT + (size_t)(T.destrow0 + n) * T.K + T.k0 + 16 * q; *(v4u*)dp = o0; *(v4u*)(dp + 8) = o1; } }
    if (T.mode && T.k0 == 0 && !T.cml) T.sB[T.destrow0 + lane] = (lane < T.nvalid) ? __uint_as_float(T.cmax[T.srccol0 + lane]) * (T.mode == 2 ? (1.0f / 256.0f) : (1.0f / 127.0f)) : 0.f;
}
__device__ __forceinline__ void tr_set(TrItem& T, const float* W, int K, int N, int Ndest, void* WT, int mode, const unsigned* cmax, float* sB, int item) {
    const int nnb = Ndest / 64, kb = item / nnb, nb = item % nnb, n0 = 64 * nb; int nv = N - n0; nv = nv < 0 ? 0 : (nv > 64 ? 64 : nv);
    T.W = W; T.ldw = N; T.srccol0 = n0; T.nvalid = nv; T.k0 = 64 * kb; T.K = K; T.destrow0 = n0; T.mode = mode; T.WT = WT; T.cmax = cmax; T.sB = sB; T.cml = nullptr;
}
constexpr int IT_INA = (D / 64) * (NIN_A / 64), IT_INB = (D / 64) * (NIN_BP / 64), IT_OUT = (D / 64) * (D / 64), IT_GU = (D / 64) * (2 * DFF / 64), IT_DN = (DFF / 64) * (D / 64), IT_UK = 16 * 8, IT_UV = 16 * 8;
constexpr int IT_DIL = IT_INA + IT_OUT + IT_GU + IT_DN, IT_DSA = IT_INB + IT_OUT + IT_GU + IT_DN + IT_UK + IT_UV;
constexpr int IT_ALL = 2 * IT_DIL + 2 * IT_DSA;
__device__ __forceinline__ void tr_decode(const Args& a, int it, TrItem& T) {
    int r = it; int l;
    if (r < IT_DIL) l = 0; else { r -= IT_DIL; if (r < IT_DSA) l = 1; else { r -= IT_DSA; if (r < IT_DIL) l = 2; else { r -= IT_DIL; l = 3; } } }
    const LayerW& w = a.L[l]; unsigned char* wb = as_global(a.ws) + WS_W + (size_t)l * W_LAYER;
    const unsigned* cml = (const unsigned*)(as_global(a.ws) + WS_CTL + CTL_CMAX) + l * CM_LAYER; float* sbl = (float*)(as_global(a.ws) + WS_SB) + l * CM_LAYER;
    if (!(l & 1)) { if (r < IT_INA) { tr_set(T, as_global(w.w_in), D, NIN_A, NIN_A, wb + WO_IN, I8_QKV, cml, sbl, r); return; } r -= IT_INA; }
    else { if (r < IT_INB) { tr_set(T, as_global(w.w_in), D, NIN_B, NIN_BP, wb + WO_IN, I8_DSA, cml, sbl, r); return; } r -= IT_INB; }
    if (r < IT_OUT) { tr_set(T, as_global(w.w_out), D, D, D, wb + WO_OUT, OUT_MODE, cml + CM_OUT, sbl + CM_OUT, r); return; } r -= IT_OUT;
    if (r < IT_GU) {
        const int nnb = (2 * DFF) / 64, kb = r / nnb, nb = r % nnb, n0 = 64 * nb, pn = n0 >> 8, lc = n0 & 255;
        T.W = as_global(w.w_gu); T.ldw = 2 * DFF; T.srccol0 = ((lc < 128) ? 0 : DFF) + 128 * pn + (lc & 127); T.nvalid = 64; T.k0 = 64 * kb; T.K = D; T.destrow0 = n0; T.mode = I8_GU; T.WT = wb + WO_GU; T.cmax = cml + CM_GU; T.sB = sbl + CM_GU; T.cml = nullptr; return; }
    r -= IT_GU;
    if (r < IT_DN) { tr_set(T, as_global(w.w_down), DFF, D, D, wb + WO_DN, DN_MODE, cml + CM_DN, sbl + CM_DN, r); return; } r -= IT_DN;
    if (r < IT_UK) { const int h = r >> 3; tr_set(T, as_global(w.w_uk) + (size_t)h * HD * KVL, HD, KVL, KVL, (bf16*)(wb + WO_UK) + (size_t)h * KVL * HD, 0, cml, sbl, r & 7); return; } r -= IT_UK;
    { const int h = r >> 3; tr_set(T, as_global(w.w_uv) + (size_t)h * KVL * HD, KVL, HD, HD, (bf16*)(wb + WO_UV) + (size_t)h * HD * KVL, 0, cml, sbl, r & 7); }
}
__device__ __forceinline__ void p0_transposes(const Args& a, LAS unsigned char* lds, int gw, int NGW, int wave, int lane) {
    LAS float* scr = (LAS float*)(lds + wave * TSCR);
    int it = gw; if (it >= IT_ALL) return;
    TrItem T, Tn; f32x4 v[16];
    tr_decode(a, it, T); tr_load(T, lane, v);
    for (;;) {
        tr_fill(scr, lane, v);
        LDS_WAIT(); asm volatile("" ::: "memory");
        const int itn = it + NGW; const bool has = itn < IT_ALL;
        tr_decode(a, has ? itn : it, Tn); tr_load(Tn, lane, v);
        tr_emit(T, scr, lane);
        LDS_WAIT(); asm volatile("" ::: "memory");
        if (!has) break;
        it = itn; T = Tn;
    }
}
constexpr int ST_INA = NIN_A / 64, ST_INB = NIN_BP / 64, ST_OUT = D / 64, ST_GU = 2 * DFF / 64, ST_DN = D / 64;
constexpr int ST_DIL = (I8_QKV ? ST_INA : 0) + (OUT_MODE ? ST_OUT : 0) + (I8_GU ? ST_GU : 0) + (DN_MODE ? ST_DN : 0), ST_DSA = (I8_DSA ? ST_INB : 0) + (OUT_MODE ? ST_OUT : 0) + (I8_GU ? ST_GU : 0) + (DN_MODE ? ST_DN : 0);
constexpr int ST_ALL = 2 * ST_DIL + 2 * ST_DSA;
__device__ __forceinline__ void strip_decode(const Args& a, int sidx, TrItem& T) {
    int r = sidx; int l;
    if (DN_MODE && r < 4 * ST_DN) { l = r / ST_DN; r = r % ST_DN; const LayerW& w = a.L[l]; unsigned char* wb = as_global(a.ws) + WS_W + (size_t)l * W_LAYER; float* sbl = (float*)(as_global(a.ws) + WS_SB) + l * CM_LAYER;
        T.W = as_global(w.w_down); T.ldw = D; T.srccol0 = 64 * r; T.nvalid = 64; T.K = DFF; T.destrow0 = 64 * r; T.mode = DN_MODE; T.WT = wb + WO_DN; T.cmax = nullptr; T.sB = sbl + CM_DN; return; }
    if (DN_MODE) r -= 4 * ST_DN;
    const int per_dil = ST_DIL - (DN_MODE ? ST_DN : 0), per_dsa = ST_DSA - (DN_MODE ? ST_DN : 0);
    if (r < per_dil) l = 0; else { r -= per_dil; if (r < per_dsa) l = 1; else { r -= per_dsa; if (r < per_dil) l = 2; else { r -= per_dil; l = 3; } } }
    const LayerW& w = a.L[l]; unsigned char* wb = as_global(a.ws) + WS_W + (size_t)l * W_LAYER; float* sbl = (float*)(as_global(a.ws) + WS_SB) + l * CM_LAYER;
    const bool dsa = l & 1; const int st_in = dsa ? (I8_DSA ? ST_INB : 0) : (I8_QKV ? ST_INA : 0);
    T.cmax = nullptr; T.K = D;
    if (r < st_in) { const int N = dsa ? NIN_B : NIN_A; int nv = N - 64 * r; nv = nv < 0 ? 0 : (nv > 64 ? 64 : nv);
        T.W = as_global(w.w_in); T.ldw = N; T.srccol0 = 64 * r; T.nvalid = nv; T.destrow0 = 64 * r; T.mode = 1; T.WT = wb + WO_IN; T.sB = sbl; return; }
    r -= st_in;
    if (OUT_MODE && r < ST_OUT) { T.W = as_global(w.w_out); T.ldw = D; T.srccol0 = 64 * r; T.nvalid = 64; T.destrow0 = 64 * r; T.mode = OUT_MODE; T.WT = wb + WO_OUT; T.sB = sbl + CM_OUT; return; }
    if (OUT_MODE) r -= ST_OUT;
    { const int n0 = 64 * r, pn = n0 >> 8, lc = n0 & 255;
      T.W = as_global(w.w_gu); T.ldw = 2 * DFF; T.srccol0 = ((lc < 128) ? 0 : DFF) + 128 * pn + (lc & 127); T.nvalid = 64; T.destrow0 = n0; T.mode = 1; T.WT = wb + WO_GU; T.sB = sbl + CM_GU; }
}
__device__ __forceinline__ void p0_strips(const Args& a, LAS unsigned char* lds, int vcu, int G, int tid, int wave, int lane) {
    LAS float* scr = (LAS float*)(lds + wave * TSCR); LAS float* wm = (LAS float*)(lds + 8 * TSCR); LAS float* cmx = wm + 8 * 64;
    constexpr int ST_LONG = DN_MODE ? 4 * ST_DN : 0, ST_SHORT = ST_ALL - ST_LONG;
    const bool bal = (G == 256) && (ST_LONG == 128) && (ST_SHORT >= 1152);
    for (int i = 0;; ++i) {
        int sidx;
        if (bal) { if (vcu < 128) { if (i == 0) sidx = vcu; else if (i <= 3) sidx = ST_LONG + 3 * vcu + (i - 1); else break; }
                   else { const int c = vcu - 128; if (i < 6) sidx = ST_LONG + 384 + 6 * c + i; else if (i == 6 && 1152 + c < ST_SHORT) sidx = ST_LONG + 1152 + c; else break; } }
        else { sidx = vcu + i * G; if (sidx >= ST_ALL) break; }
        TrItem T; strip_decode(a, sidx, T); T.cml = cmx;
        const int nkb = T.K / 64; f32x4 v[16];
        f32x4 mx = (f32x4){0.f, 0.f, 0.f, 0.f};
        { int kb = wave; T.k0 = 64 * kb; if (kb < nkb) tr_load(T, lane, v);
          while (kb < nkb) { f32x4 m2 = (f32x4){0.f, 0.f, 0.f, 0.f};
#pragma unroll
              for (int it = 0; it < 16; ++it) { m2[0] = fmaxf(m2[0], fabsf(v[it][0])); m2[1] = fmaxf(m2[1], fabsf(v[it][1])); m2[2] = fmaxf(m2[2], fabsf(v[it][2])); m2[3] = fmaxf(m2[3], fabsf(v[it][3])); }
              const int kn = kb + 8; T.k0 = 64 * (kn < nkb ? kn : kb); tr_load(T, lane, v);
              mx[0] = fmaxf(mx[0], m2[0]); mx[1] = fmaxf(mx[1], m2[1]); mx[2] = fmaxf(mx[2], m2[2]); mx[3] = fmaxf(mx[3], m2[3]); kb = kn; } }
#pragma unroll
        for (int j = 0; j < 4; ++j) mx[j] = xmax32(xmax16(mx[j]));
        if (lane < 16) *(LAS f32x4*)(wm + wave * 64 + 4 * lane) = mx;
        __syncthreads();
        if (tid < 64) { float m = wm[tid];
#pragma unroll
            for (int w8 = 1; w8 < 8; ++w8) m = fmaxf(m, wm[w8 * 64 + tid]);
            cmx[tid] = m; T.sB[T.destrow0 + tid] = (tid < T.nvalid) ? m * (T.mode == 2 ? (1.0f / 256.0f) : (1.0f / 127.0f)) : 0.f; }
        __syncthreads();
        { int kb = wave; if (kb < nkb) { T.k0 = 64 * kb; tr_load(T, lane, v);
            for (;;) { tr_fill(scr, lane, v); LDS_WAIT(); asm volatile("" ::: "memory");
                const int kn = kb + 8; TrItem Tn = T; Tn.k0 = 64 * (kn < nkb ? kn : kb); tr_load(Tn, lane, v);
                tr_emit(T, scr, lane); LDS_WAIT(); asm volatile("" ::: "memory");
                if (kn >= nkb) break; kb = kn; T.k0 = 64 * kb; } } }
        __syncthreads();
    }
}
__device__ __forceinline__ void p0_bf16_items(const Args& a, LAS unsigned char* lds, int gw, int NGW, int wave, int lane) {
    LAS float* scr = (LAS float*)(lds + wave * TSCR); f32x4 v[16];
    if (I8_QKV && I8_DSA && OUT_MODE && I8_GU && DN_MODE) {
        for (int it2 = gw; it2 < 2 * (IT_UK + IT_UV); it2 += NGW) { const int l2 = it2 / (IT_UK + IT_UV), it = (l2 ? 2 * IT_DIL + 2 * IT_DSA : IT_DIL + IT_DSA) - (IT_UK + IT_UV) + it2 % (IT_UK + IT_UV);
            TrItem T; tr_decode(a, it, T); tr_load(T, lane, v); tr_fill(scr, lane, v); LDS_WAIT(); asm volatile("" ::: "memory"); tr_emit(T, scr, lane); LDS_WAIT(); asm volatile("" ::: "memory"); }
        return; }
    for (int it = gw; it < IT_ALL; it += NGW) { TrItem T; tr_decode(a, it, T); if (T.mode != 0) continue;
        tr_load(T, lane, v); tr_fill(scr, lane, v); LDS_WAIT(); asm volatile("" ::: "memory"); tr_emit(T, scr, lane); LDS_WAIT(); asm volatile("" ::: "memory"); }
}
constexpr int SC_STRIDE = 2112;
__device__ __forceinline__ void p0_adaln(const Args& a, LAS unsigned char* lds, int G, int tid, int wave, int lane) {
    LAS float* sc = (LAS float*)lds;
    LAS float* red = (LAS float*)(lds + 8 * SC_STRIDE * 4);
    float* mod = (float*)(as_global(a.ws) + WS_MOD); const float* cin = as_global(a.c);
    for (int i = tid; i < BATCH * D; i += NWAVES * 64) { const int b = i >> 11, k = i & 2047; const float v = cin[i]; sc[b * SC_STRIDE + k + (k >> 6)] = v / (1.0f + __expf(-v)); }
    __syncthreads();
    const int cg = tid & 15, ks = tid >> 4;
    for (int u = blockIdx.x; u < DEPTH * (NMOD / 64); u += G) {
        const int l = u / (NMOD / 64), col0 = 64 * (u % (NMOD / 64));
        const float* wp = as_global(a.L[l].ada_w) + (size_t)(64 * ks) * NMOD + col0 + 4 * cg;
        f32x4 acc[8];
#pragma unroll
        for (int b = 0; b < 8; ++b) acc[b] = (f32x4){0.f, 0.f, 0.f, 0.f};
#pragma unroll 16
        for (int kk = 0; kk < 64; ++kk) { const f32x4 w4 = __builtin_nontemporal_load((const f32x4*)(wp + (size_t)kk * NMOD));     const int kx = 64 * ks + kk + ks;
#pragma unroll
            for (int b = 0; b < 8; ++b) acc[b] += sc[b * SC_STRIDE + kx] * w4; }
#pragma unroll
        for (int b = 0; b < 8; ++b)
#pragma unroll
            for (int j = 0; j < 4; ++j) { acc[b][j] = xsum32(xsum16(acc[b][j])); }
        if (lane < 16) {
#pragma unroll
            for (int b = 0; b < 8; ++b) *(LAS f32x4*)(red + (wave * 8 + b) * 64 + 4 * cg) = acc[b]; }
        __syncthreads();
        { const int b = tid >> 6, col = tid & 63; float s = as_global(a.L[l].ada_b)[col0 + col];
#pragma unroll
          for (int w = 0; w < 8; ++w) s += red[(w * 8 + b) * 64 + col];
          mod[((size_t)l * BATCH + b) * NMOD + col0 + col] = s; }
        __syncthreads();
    }
}
__device__ __forceinline__ void ld8(const void* base, int is_f32, size_t idx, f32x4& a, f32x4& b) {
    if (is_f32) { const float* p = (const float*)base + idx; a = *(const f32x4*)p; b = *(const f32x4*)(p + 4); }
    else { const v4u w = *(const v4u*)((const bf16*)base + idx); a = (f32x4){__uint_as_float(w.x << 16), __uint_as_float(w.x & 0xFFFF0000u), __uint_as_float(w.y << 16), __uint_as_float(w.y & 0xFFFF0000u)};
        b = (f32x4){__uint_as_float(w.z << 16), __uint_as_float(w.z & 0xFFFF0000u), __uint_as_float(w.w << 16), __uint_as_float(w.w & 0xFFFF0000u)}; }
}
__device__ __forceinline__ void norm_mod_phase(const void* x, int xf32, const float* gain, const float* shift, const float* scale, bf16* h, int gw, int NGW, int lane) {
    for (int grp = gw; grp < M / 8; grp += NGW) {
        const int b = (grp * 8) >> 11;
        f32x4 A[8], B[8];
#pragma unroll
        for (int j = 0; j < 4; ++j)
#pragma unroll
            for (int e = 0; e < 2; ++e) { const int col = 8 * lane + 512 * j + 4 * e;
                const f32x4 g = *(const f32x4*)(gain + col), sc = *(const f32x4*)(scale + (size_t)b * NMOD + col); A[2 * j + e] = g * (sc + 1.0f); B[2 * j + e] = *(const f32x4*)(shift + (size_t)b * NMOD + col); }
        for (int rr = 0; rr < 8; ++rr) { const size_t row = (size_t)grp * 8 + rr;
            f32x4 v[8]; float ss = 0.f;
#pragma unroll
            for (int j = 0; j < 4; ++j) { ld8(x, xf32, row * D + 8 * lane + 512 * j, v[2 * j], v[2 * j + 1]);
#pragma unroll
                for (int e = 0; e < 2; ++e) { const f32x4 t = v[2 * j + e]; ss += (t[0] * t[0] + t[1] * t[1]) + (t[2] * t[2] + t[3] * t[3]); } }
            const float rstd = __builtin_amdgcn_rsqf(wave_sum(ss) * (1.0f / D) + EPS);
#pragma unroll
            for (int j = 0; j < 4; ++j) { const f32x4 y0 = v[2 * j] * rstd * A[2 * j] + B[2 * j], y1 = v[2 * j + 1] * rstd * A[2 * j + 1] + B[2 * j + 1];
                v4u o; o.x = cvtpk(y0[0], y0[1]); o.y = cvtpk(y0[2], y0[3]); o.z = cvtpk(y1[0], y1[1]); o.w = cvtpk(y1[2], y1[3]);
                *(v4u*)(h + row * D + 8 * lane + 512 * j) = o; }
        }
    }
}

__device__ __forceinline__ void norm_mod_phase_q(const void* x, int xf32, const float* gain, const float* shift, const float* scale, signed char* h, float* sA, unsigned* rmax0, int gw, int NGW, int lane) {
    for (int grp = gw; grp < M / 8; grp += NGW) {
        const int b = (grp * 8) >> 11;
        f32x4 A[8], B[8];
#pragma unroll
        for (int j = 0; j < 4; ++j)
#pragma unroll
            for (int e = 0; e < 2; ++e) { const int col = 8 * lane + 512 * j + 4 * e;
                const f32x4 g = *(const f32x4*)(gain + col), sc = *(const f32x4*)(scale + (size_t)b * NMOD + col); A[2 * j + e] = g * (sc + 1.0f); B[2 * j + e] = *(const f32x4*)(shift + (size_t)b * NMOD + col); }
        v4u pk[4][4];
#pragma unroll
        for (int rr = 0; rr < 8; ++rr) { const size_t row = (size_t)grp * 8 + rr;
            if (!xf32 && (rr & 3) == 0) {
#pragma unroll
                for (int r4 = 0; r4 < 4; ++r4)
#pragma unroll
                    for (int j = 0; j < 4; ++j) pk[r4][j] = *(const v4u*)((const bf16*)x + (row + r4) * D + 8 * lane + 512 * j); }
            f32x4 v[8]; float ss = 0.f;
#pragma unroll
            for (int j = 0; j < 4; ++j) { if (xf32) ld8(x, 1, row * D + 8 * lane + 512 * j, v[2 * j], v[2 * j + 1]);
                else { const v4u w = pk[rr & 3][j]; v[2 * j] = (f32x4){__uint_as_float(w.x << 16), __uint_as_float(w.x & 0xFFFF0000u), __uint_as_float(w.y << 16), __uint_as_float(w.y & 0xFFFF0000u)};
                    v[2 * j + 1] = (f32x4){__uint_as_float(w.z << 16), __uint_as_float(w.z & 0xFFFF0000u), __uint_as_float(w.w << 16), __uint_as_float(w.w & 0xFFFF0000u)}; }
#pragma unroll
                for (int e = 0; e < 2; ++e) { const f32x4 t = v[2 * j + e]; ss += (t[0] * t[0] + t[1] * t[1]) + (t[2] * t[2] + t[3] * t[3]); } }
            const float rstd = __builtin_amdgcn_rsqf(wave_sum(ss) * (1.0f / D) + EPS);
            float amax = 0.f;
#pragma unroll
            for (int j = 0; j < 8; ++j) { v[j] = v[j] * rstd * A[j] + B[j]; amax = fmaxf(fmaxf(amax, fmaxf(fabsf(v[j][0]), fabsf(v[j][1]))), fmaxf(fabsf(v[j][2]), fabsf(v[j][3]))); }
            amax = wave_max(amax);
            const float inv = amax > 0.f ? 127.0f / amax : 0.f;
#pragma unroll
            for (int j = 0; j < 4; ++j) { unsigned q[8];
#pragma unroll
                for (int e = 0; e < 4; ++e) { q[e] = (unsigned)(int)rintf(v[2 * j][e] * inv) & 0xFFu; q[4 + e] = (unsigned)(int)rintf(v[2 * j + 1][e] * inv) & 0xFFu; }
                v2u o; o.x = q[0] | (q[1] << 8) | (q[2] << 16) | (q[3] << 24); o.y = q[4] | (q[5] << 8) | (q[6] << 16) | (q[7] << 24);
                *(v2u*)(h + row * D + 8 * lane + 512 * j) = o; }
            if (lane == 0) { sA[row] = amax * (1.0f / 127.0f); if (rmax0) rmax0[row] = 0u; }
        }
    }
}

__device__ __forceinline__ void aq_load(const bf16* act, int row, int lane, v4u (&w)[11]) { const bf16* ar = act + (size_t)row * DFF + 8 * lane;
#pragma unroll
    for (int it = 0; it < 11; ++it) w[it] = *(const v4u*)(ar + 512 * it); }
__device__ __forceinline__ void aq_emit(const v4u (&w)[11], float mx, signed char* q, float* sA2, int row, int lane) {
    const float inv = mx > 0.f ? 127.0f / mx : 0.f; signed char* qr = q + (size_t)row * DFF + 8 * lane;
#pragma unroll
    for (int it = 0; it < 11; ++it) { unsigned o[8];
#pragma unroll
        for (int e = 0; e < 4; ++e) { const unsigned ww = w[it][e]; float lo = __uint_as_float(ww << 16) * inv, hi = __uint_as_float(ww & 0xFFFF0000u) * inv;
            lo = fminf(fmaxf(rintf(lo), -127.f), 127.f); hi = fminf(fmaxf(rintf(hi), -127.f), 127.f); o[2 * e] = (unsigned)(int)lo & 0xFFu; o[2 * e + 1] = (unsigned)(int)hi & 0xFFu; }
        v2u ov; ov.x = o[0] | (o[1] << 8) | (o[2] << 16) | (o[3] << 24); ov.y = o[4] | (o[5] << 8) | (o[6] << 16) | (o[7] << 24);
        *(v2u*)(qr + 512 * it) = ov; }
    if (lane == 0) sA2[row] = mx * (1.0f / 127.0f);
}
__device__ __forceinline__ void act_quant_phase(const bf16* act, const unsigned* rmax, signed char* q, float* sA2, int gw, int NGW, int lane) {
    int row = gw; if (row >= M) return;
    v4u wa[11], wb2[11]; float ma = __uint_as_float(rmax[row]); aq_load(act, row, lane, wa);
    for (;;) {
        const int r1 = row + NGW; const bool h1 = r1 < M; const int r1c = h1 ? r1 : row;
        const float mb = __uint_as_float(rmax[r1c]); aq_load(act, r1c, lane, wb2);
        aq_emit(wa, ma, q, sA2, row, lane);
        if (!h1) break;
        const int r2 = r1 + NGW; const bool h2 = r2 < M; const int r2c = h2 ? r2 : r1;
        ma = __uint_as_float(rmax[r2c]); aq_load(act, r2c, lane, wa);
        aq_emit(wb2, mb, q, sA2, r1, lane);
        if (!h2) break;
        row = r2;
    }
}
__device__ __forceinline__ void final_norm_phase(const bf16* x, float* out, const float* gain, int gw, int NGW, int lane) {
    f32x4 gv[8];
#pragma unroll
    for (int j = 0; j < 4; ++j)
#pragma unroll
        for (int e = 0; e < 2; ++e) gv[2 * j + e] = *(const f32x4*)(gain + 8 * lane + 512 * j + 4 * e);
    for (int grp = gw; grp < M / 4; grp += NGW) {
        v4u pk[4][4];
#pragma unroll
        for (int r4 = 0; r4 < 4; ++r4)
#pragma unroll
            for (int j = 0; j < 4; ++j) pk[r4][j] = *(const v4u*)(x + ((size_t)grp * 4 + r4) * D + 8 * lane + 512 * j);
#pragma unroll
        for (int r4 = 0; r4 < 4; ++r4) { const size_t row = (size_t)grp * 4 + r4;
            f32x4 v[8]; float ss = 0.f;
#pragma unroll
            for (int j = 0; j < 4; ++j) { const v4u w = pk[r4][j]; v[2 * j] = (f32x4){__uint_as_float(w.x << 16), __uint_as_float(w.x & 0xFFFF0000u), __uint_as_float(w.y << 16), __uint_as_float(w.y & 0xFFFF0000u)};
                v[2 * j + 1] = (f32x4){__uint_as_float(w.z << 16), __uint_as_float(w.z & 0xFFFF0000u), __uint_as_float(w.w << 16), __uint_as_float(w.w & 0xFFFF0000u)};
#pragma unroll
                for (int e = 0; e < 2; ++e) { const f32x4 t = v[2 * j + e]; ss += (t[0] * t[0] + t[1] * t[1]) + (t[2] * t[2] + t[3] * t[3]); } }
            const float rstd = __builtin_amdgcn_rsqf(wave_sum(ss) * (1.0f / D) + EPS); float* orow = out + row * D;
#pragma unroll
            for (int j = 0; j < 4; ++j)
#pragma unroll
                for (int e = 0; e < 2; ++e) *(f32x4*)(orow + 8 * lane + 512 * j + 4 * e) = v[2 * j + e] * rstd * gv[2 * j + e]; }
    }
}
constexpr int VROW = 272, VROW2 = 288;
constexpr int KV_LDS = 256 * VROW;
struct BAUnit { int b, h, qbase, qstride, kbase, kstride, first, dil; };
__device__ __forceinline__ BAUnit ba_decode(int pass, int u) {
    BAUnit U; const int bh = u >> 4, s = u & 15; U.b = bh >> 4; U.h = bh & 15;
    if (pass == 0) { U.qbase = 128 * s; U.qstride = 1; U.kbase = 128 * s - 128; U.kstride = 1; U.first = (s == 0); U.dil = 1; }
    else if (pass == 1) { const int rho = s >> 2, n = s & 3; U.qbase = 512 * n + rho; U.qstride = 4; U.kbase = 512 * n - 512 + rho; U.kstride = 4; U.first = (n == 0); U.dil = 4; }
    else { U.qbase = s; U.qstride = 16; U.kbase = s - 2048; U.kstride = 16; U.first = 1; U.dil = 16; }
    return U;
}
template <bool HALF = false> __device__ __forceinline__ void ba_load(const BAUnit& U, const bf16* K, const bf16* V, int tid, v4u (&kr)[8], v4u (&vr)[8]) {
    const int c = tid & 15, r0 = tid >> 4;
#pragma unroll
    for (int it = HALF ? 4 : 0; it < 8; ++it) { const int j = r0 + 32 * it; int p = U.kbase + U.kstride * j; p = p < 0 ? 0 : p;
        const size_t off = ((size_t)U.b * SEQ + p) * D + U.h * HD + 8 * c;
        kr[it] = *(const v4u*)(K + off); vr[it] = *(const v4u*)(V + off); }
}
template <bool HALF = false> __device__ __forceinline__ void ba_store(LAS unsigned char* lds, int tid, const v4u (&kr)[8], const v4u (&vr)[8]) {
    const int c = tid & 15, r0 = tid >> 4;
#pragma unroll
    for (int it = HALF ? 4 : 0; it < 8; ++it) { const int j = r0 + 32 * it; *(LAS v4u*)(lds + j * VROW + 16 * c) = kr[it]; *(LAS v4u*)(lds + KV_LDS + j * VROW2 + 16 * c) = vr[it]; }
}
__device__ __forceinline__ void ba_qload(const BAUnit& U, const bf16* Q, int w, int lane, bf16x8 (&qf)[4]) {
    const int i = lane & 15, g = lane >> 4, qi = 16 * w + i; const size_t qrow = (size_t)U.b * SEQ + U.qbase + U.qstride * qi;
#pragma unroll
    for (int kk = 0; kk < 4; ++kk) qf[kk] = *(const bf16x8*)(Q + qrow * D + U.h * HD + 32 * kk + 8 * g);
}
template <bool FUSED> __device__ __forceinline__ void ba_compute(const BAUnit& U, int pass, bf16x8 (&qf)[4], bf16* O, float* LSE, LAS unsigned char* lds, int w, int lane, unsigned* waitc, const v2u (&ppre)[8], float lpre, const BAUnit& Un, const bf16* Qn, unsigned char* O8 = nullptr) {
    const int i = lane & 15, g = lane >> 4, qi = 16 * w + i; const size_t qrow = (size_t)U.b * SEQ + U.qbase + U.qstride * qi;
    const float sl = __builtin_amdgcn_exp2f(-0.5f * (float)(U.h + 1)) * LOG2E * (float)U.dil;
    const int d0 = U.first ? (8 - w) : 0;
    f32x4 s[10];
#pragma unroll
    for (int d = 0; d < 9; ++d) { f32x4 acc = (f32x4){0.f, 0.f, 0.f, 0.f};
        if (d >= d0) { const LAS unsigned char* kp = lds + (16 * (w + d) + i) * VROW + 16 * g;
#pragma unroll
            for (int kk = 0; kk < 4; ++kk) { const bf16x8 kf = *(const LAS bf16x8*)(kp + 64 * kk); acc = __builtin_amdgcn_mfma_f32_16x16x32_bf16(kf, qf[kk], acc, 0, 0, 0); } }
        s[d] = acc; }
    if (Qn) ba_qload(Un, Qn, w, lane, qf);
    float cmax = -1e30f;
#pragma unroll
    for (int d = 0; d < 9; ++d)
#pragma unroll
        for (int r = 0; r < 4; ++r) { const int rel = i - (4 * g + r) + 16 * (8 - d);
            const bool ok = (d >= d0) && (rel >= 0) && (rel <= 128);
            const float v = ok ? (s[d][r] - sl * (float)rel) : -INFINITY; s[d][r] = v; cmax = fmaxf(cmax, v); }
    cmax = xmax32(xmax16(cmax));
    const float m = cmax; float l = 0.f;
#pragma unroll
    for (int d = 0; d < 9; ++d)
#pragma unroll
        for (int r = 0; r < 4; ++r) { const float pv = __builtin_amdgcn_exp2f(s[d][r] - m); s[d][r] = pv; l += pv; }
    l = xsum32(xsum16(l));
    s[9] = (f32x4){0.f, 0.f, 0.f, 0.f};
    f32x4 o[8];
#pragma unroll
    for (int c = 0; c < 8; ++c) o[c] = (f32x4){0.f, 0.f, 0.f, 0.f};
#pragma unroll
    for (int dp = 0; dp < 10; dp += 2) {
        if (dp + 1 >= d0) {
            bf16x8 pf; { const v4u t = (v4u){cvtpk(s[dp][0], s[dp][1]), cvtpk(s[dp][2], s[dp][3]), cvtpk(s[dp + 1][0], s[dp + 1][1]), cvtpk(s[dp + 1][2], s[dp + 1][3])}; pf = __builtin_bit_cast(bf16x8, t); }
            int t0 = w + dp, t1 = w + dp + 1; t0 = t0 > 15 ? 15 : t0; t1 = t1 > 15 ? 15 : t1;
            const LAS unsigned char* vb0 = lds + KV_LDS + (16 * t0 + 4 * g + (i >> 2)) * VROW2 + 8 * (i & 3);
            const LAS unsigned char* vb1 = lds + KV_LDS + (16 * t1 + 4 * g + (i >> 2)) * VROW2 + 8 * (i & 3);
#pragma unroll
            for (int c = 0; c < 8; ++c) { const s16x4 lo = tr_read(vb0 + 32 * c), hi = tr_read(vb1 + 32 * c); o[c] = __builtin_amdgcn_mfma_f32_16x16x32_bf16(cat8(lo, hi), pf, o[c], 0, 0, 0); }
        }
    }
    float inv = 1.0f / l; float lse = m + __builtin_amdgcn_logf(l);
    bf16* op = O + qrow * D + U.h * HD + 4 * g; float* lp = LSE + qrow * NH + U.h;
    if (FUSED && pass > 0) {
        if (threadIdx.x == 0) { unsigned sp = 0; while (__hip_atomic_load(waitc, RLX_AGENT) < 16u) { __builtin_amdgcn_s_sleep(2); if (++sp > (1u << 22)) break; }
            __builtin_amdgcn_fence(__ATOMIC_ACQUIRE, "agent"); asm volatile("s_waitcnt vmcnt(0)" ::: "memory"); }
        __syncthreads(); }
    if (pass > 0) { const float lprev = FUSED ? *lp : lpre; const float mx = fmaxf(lprev, lse); const float wa = __builtin_amdgcn_exp2f(lprev - mx), wb = __builtin_amdgcn_exp2f(lse - mx); const float wi = 1.0f / (wa + wb);
        const float fa = wa * wi, fb = wb * wi * inv;
#pragma unroll
        for (int c = 0; c < 8; ++c) { const v2u pw = FUSED ? *(const v2u*)(op + 16 * c) : ppre[c];
            const float p0 = __uint_as_float(pw.x << 16), p1 = __uint_as_float(pw.x & 0xFFFF0000u), p2 = __uint_as_float(pw.y << 16), p3 = __uint_as_float(pw.y & 0xFFFF0000u);
            o[c][0] = fa * p0 + fb * o[c][0]; o[c][1] = fa * p1 + fb * o[c][1]; o[c][2] = fa * p2 + fb * o[c][2]; o[c][3] = fa * p3 + fb * o[c][3]; }
        inv = 1.0f; lse = mx + __builtin_amdgcn_logf(wa + wb); }
#pragma unroll
    for (int c = 0; c < 8; ++c) { v2u w2; w2.x = cvtpk(o[c][0] * inv, o[c][1] * inv); w2.y = cvtpk(o[c][2] * inv, o[c][3] * inv);
        if (FUSED && pass < 2) __hip_atomic_store((unsigned long long*)(op + 16 * c), ((unsigned long long)w2.y << 32) | w2.x, RLX_AGENT);
        else if (pass == 2 && O8) { unsigned w8 = 0u; w8 = __builtin_amdgcn_cvt_pk_fp8_f32(o[c][0] * inv, o[c][1] * inv, w8, false); w8 = __builtin_amdgcn_cvt_pk_fp8_f32(o[c][2] * inv, o[c][3] * inv, w8, true);
            *(unsigned*)(O8 + qrow * D + U.h * HD + 4 * g + 16 * c) = w8; }
        else *(v2u*)(op + 16 * c) = w2; }
    if (pass < 2 && g == 0) { if (FUSED) __hip_atomic_store((unsigned*)lp, __float_as_uint(lse), RLX_AGENT); else *lp = lse; }
}
__device__ __forceinline__ void ba_pload(const BAUnit& U, const bf16* O, const float* LSE, int w, int lane, v2u (&pp)[8], float& lp) {
    const int i = lane & 15, g = lane >> 4, qi = 16 * w + i; const size_t qrow = (size_t)U.b * SEQ + U.qbase + U.qstride * qi;
    const bf16* op = O + qrow * D + U.h * HD + 4 * g;
#pragma unroll
    for (int c = 0; c < 8; ++c) pp[c] = *(const v2u*)(op + 16 * c);
    lp = LSE[qrow * NH + U.h];
}
template <int variant = 0, bool HALF = false  > __device__ __forceinline__ void dil_attn_pass(int pass, const bf16* Q, const bf16* K, const bf16* V, bf16* O, float* LSE, LAS unsigned char* lds, int vcu, int G, int tid, int wave, int lane, int u_lo = 0, int u_hi = BATCH * NH * 16, unsigned char* O8 = nullptr) {
    v4u kr[8], vr[8]; bf16x8 qf[4]; v2u pp[8]; float lp = 0.f;
#pragma unroll
    for (int c = 0; c < 8; ++c) pp[c] = (v2u){0u, 0u};
    int u = u_lo + vcu; const int NU = u_hi;
    if (u >= NU) return;
    BAUnit U = ba_decode(pass, u);
    ba_qload(U, Q, wave, lane, qf);
    ba_load<HALF>(U, K, V, tid, kr, vr);
    for (;;) {
        ba_store<HALF>(lds, tid, kr, vr);
        __syncthreads();
        const int un = u + G; const BAUnit Un = ba_decode(pass, un < NU ? un : u);
        if (pass > 0) ba_pload(U, O, LSE, wave, lane, pp, lp);
        asm volatile("" ::: "memory");
        ba_load<HALF>(Un, K, V, tid, kr, vr);
        ba_compute<false>(U, pass, qf, O, LSE, lds, wave, lane, nullptr, pp, lp, Un, Q, O8);
        __syncthreads();
        if (un >= NU) break;
        u = un; U = Un;
    }
}

__device__ __forceinline__ void dil_attn_fused(const bf16* Q, const bf16* K, const bf16* V, bf16* O, float* LSE, unsigned* cnt, LAS unsigned char* lds, int vcu, int G, int tid, int wave, int lane) {
    v4u kr[8], vr[8];
    const int team = vcu >> 4, sidx = vcu & 15, nteam = G >> 4, NBH = BATCH * NH;
    const int nit = ((NBH - team + nteam - 1) / nteam) * 3;
    if (nit <= 0) return;
    int it = 0; int bh = team, pass = 0;
    BAUnit U = ba_decode(pass, bh * 16 + sidx);
    ba_load(U, K, V, tid, kr, vr);
    for (;;) {
        ba_store(lds, tid, kr, vr);
        __syncthreads();
        bf16x8 qf[4]; ba_qload(U, Q, wave, lane, qf);
        asm volatile("" ::: "memory");
        const int itn = it + 1; int passn = pass + 1, bhn = bh; if (passn == 3) { passn = 0; bhn = bh + nteam; }
        const bool has = itn < nit;
        const BAUnit Un = ba_decode(has ? passn : pass, (has ? bhn : bh) * 16 + sidx); ba_load(Un, K, V, tid, kr, vr);
        { v2u ppd[8]; ba_compute<true>(U, pass, qf, O, LSE, lds, wave, lane, cnt + ((size_t)bh * 2 + (pass > 0 ? pass - 1 : 0)) * 16, ppd, 0.f, U, nullptr); }
        if (pass < 2) asm volatile("s_waitcnt vmcnt(0)" ::: "memory");
        __syncthreads();
        if (pass < 2 && tid == 0) __hip_atomic_fetch_add(cnt + ((size_t)bh * 2 + pass) * 16, 1u, RLX_AGENT);
        if (!has) break;
        it = itn; pass = passn; bh = bhn; U = Un;
    }
}

template <int KK  , int NT  , int TT  , bool OUT8 = false  >
__device__ __forceinline__ void head_gemm(const bf16* X, int ldx, int xcol0, const bf16* WT, bf16* Out, int ldo, int ocol0, int tok0, float scale, int lane) {
    const int i = lane & 15, g = lane >> 4;
    bf16x8 xf[TT][KK];
#pragma unroll
    for (int tt = 0; tt < TT; ++tt)
#pragma unroll
        for (int kk = 0; kk < KK; ++kk) xf[tt][kk] = *(const bf16x8*)(X + (size_t)(tok0 + 16 * tt + i) * ldx + xcol0 + 32 * kk + 8 * g);
    const bf16* wp = WT + (size_t)(8 * (i >> 2) + (i & 3)) * (32 * KK) + 8 * g;
    bf16x8 aA[2][KK], aB[2][KK];
#pragma unroll
    for (int h2 = 0; h2 < 2; ++h2)
#pragma unroll
        for (int kk = 0; kk < KK; ++kk) aA[h2][kk] = *(const bf16x8*)(wp + (size_t)(4 * h2) * (32 * KK) + 32 * kk);
#pragma unroll
    for (int tt = 0; tt < TT; ++tt)
#pragma unroll
        for (int kk = 0; kk < KK; ++kk) asm volatile("" : "+v"(xf[tt][kk]));
#define HG_PAIR(cur, nxt, p_) do { \
        _Pragma("unroll") for (int h2 = 0; h2 < 2; ++h2) _Pragma("unroll") for (int kk = 0; kk < KK; ++kk) asm volatile("" : "+v"(cur[h2][kk])); \
        if ((p_) + 1 < NT / 2) { _Pragma("unroll") for (int h2 = 0; h2 < 2; ++h2) _Pragma("unroll") for (int kk = 0; kk < KK; ++kk) nxt[h2][kk] = *(const bf16x8*)(wp + (size_t)(32 * ((p_) + 1) + 4 * h2) * (32 * KK) + 32 * kk); } \
        _Pragma("unroll") for (int tt = 0; tt < TT; ++tt) { f32x4 c0 = (f32x4){0.f, 0.f, 0.f, 0.f}, c1 = c0; \
            _Pragma("unroll") for (int kk = 0; kk < KK; ++kk) { c0 = __builtin_amdgcn_mfma_f32_16x16x32_bf16(cur[0][kk], xf[tt][kk], c0, 0, 0, 0); c1 = __builtin_amdgcn_mfma_f32_16x16x32_bf16(cur[1][kk], xf[tt][kk], c1, 0, 0, 0); } \
            const size_t oo = (size_t)(tok0 + 16 * tt + i) * ldo + ocol0 + 32 * (p_) + 8 * g; \
            if constexpr (OUT8) { unsigned w0 = 0u, w1 = 0u; w0 = __builtin_amdgcn_cvt_pk_fp8_f32(c0[0] * scale, c0[1] * scale, w0, false); w0 = __builtin_amdgcn_cvt_pk_fp8_f32(c0[2] * scale, c0[3] * scale, w0, true); \
                w1 = __builtin_amdgcn_cvt_pk_fp8_f32(c1[0] * scale, c1[1] * scale, w1, false); w1 = __builtin_amdgcn_cvt_pk_fp8_f32(c1[2] * scale, c1[3] * scale, w1, true); \
                *(v2u*)((unsigned char*)Out + oo) = (v2u){w0, w1}; } \
            else *(v4u*)(Out + oo) = (v4u){cvtpk(c0[0] * scale, c0[1] * scale), cvtpk(c0[2] * scale, c0[3] * scale), cvtpk(c1[0] * scale, c1[1] * scale), cvtpk(c1[2] * scale, c1[3] * scale)}; } } while (0)
    for (int p = 0; p < NT / 2; p += 2) { HG_PAIR(aA, aB, p); HG_PAIR(aB, aA, p + 1); }
#undef HG_PAIR
}
template <bool OUT8> __device__ __forceinline__ void dsa_post_block(const bf16* OLp, const bf16* WUV, bf16* Out, int tokb, LAS unsigned char* lds, int tid) {
    const int wid = __builtin_amdgcn_readfirstlane(tid >> 6), lane = tid & 63, fr = lane & 15, fq = lane >> 4, tt = wid & 3, nh = wid >> 2;
    unsigned voff[2];
#pragma unroll
    for (int i = 0; i < 2; ++i) { int R, C; pg8::stage_rc(tid * 16 + i * 8192, R, C); voff[i] = (unsigned)(R * (KVL * 2) + C * 2); }
    const unsigned ldsw = (unsigned)wid * 1024u;
#define DP_STAGE(h_) do { const char* wsrc = (const char*)WUV + (size_t)(h_) * HD * KVL * 2; const unsigned bb = ((h_) & 1) * 65536u; \
        _Pragma("unroll") for (int kt = 0; kt < 4; ++kt) _Pragma("unroll") for (int i = 0; i < 2; ++i) \
            __builtin_amdgcn_global_load_lds((const unsigned*)(wsrc + kt * 128 + voff[i]), (LAS unsigned*)(lds + bb + kt * 16384 + ldsw + i * 8192), 16, 0, 0); } while (0)
    const bf16* xrow = OLp + (size_t)(tokb + 16 * tt + fr) * (NH * KVL) + 8 * fq;
    bf16x8 xa[8], xn[8];
    DP_STAGE(0);
#pragma unroll
    for (int j = 0; j < 8; ++j) xa[j] = *(const bf16x8*)(xrow + 32 * j);
    int boff[2][2];
#pragma unroll
    for (int p = 0; p < 2; ++p)
#pragma unroll
        for (int e = 0; e < 2; ++e) boff[p][e] = pg8::lds_byte(nh * 64 + 32 * p + 8 * (fr >> 2) + (fr & 3) + 4 * e, 8 * fq);
    for (int h = 0; h < NH; ++h) {
        asm volatile("s_waitcnt vmcnt(0)" ::: "memory");
        __syncthreads();
        if (h + 1 < NH) { DP_STAGE(h + 1);
#pragma unroll
            for (int j = 0; j < 8; ++j) xn[j] = *(const bf16x8*)(xrow + (h + 1) * KVL + 32 * j); }
        f32x4 acc[2][2];
#pragma unroll
        for (int p = 0; p < 2; ++p)
#pragma unroll
            for (int e = 0; e < 2; ++e) acc[p][e] = (f32x4){0.f, 0.f, 0.f, 0.f};
        const LAS unsigned char* bb = lds + (h & 1) * 65536;
#pragma unroll
        for (int j = 0; j < 8; ++j)
#pragma unroll
            for (int p = 0; p < 2; ++p)
#pragma unroll
                for (int e = 0; e < 2; ++e) { const bf16x8 wf = *(const LAS bf16x8*)(bb + (j >> 1) * 16384 + (j & 1) * 1024 + boff[p][e]); acc[p][e] = __builtin_amdgcn_mfma_f32_16x16x32_bf16(wf, xa[j], acc[p][e], 0, 0, 0); }
#pragma unroll
        for (int p = 0; p < 2; ++p) { const f32x4 c0 = acc[p][0], c1 = acc[p][1]; const size_t oo = (size_t)(tokb + 16 * tt + fr) * D + h * HD + nh * 64 + 32 * p + 8 * fq;
            if constexpr (OUT8) { unsigned w0 = 0u, w1 = 0u; w0 = __builtin_amdgcn_cvt_pk_fp8_f32(c0[0], c0[1], w0, false); w0 = __builtin_amdgcn_cvt_pk_fp8_f32(c0[2], c0[3], w0, true);
                w1 = __builtin_amdgcn_cvt_pk_fp8_f32(c1[0], c1[1], w1, false); w1 = __builtin_amdgcn_cvt_pk_fp8_f32(c1[2], c1[3], w1, true);
                *(v2u*)((unsigned char*)Out + oo) = (v2u){w0, w1}; }
            else *(v4u*)(Out + oo) = (v4u){cvtpk(c0[0], c0[1]), cvtpk(c0[2], c0[3]), cvtpk(c1[0], c1[1]), cvtpk(c1[2], c1[3])}; }
        if (h + 1 < NH) {
#pragma unroll
            for (int j = 0; j < 8; ++j) xa[j] = xn[j]; }
    }
    asm volatile("s_waitcnt vmcnt(0)" ::: "memory");
#undef DP_STAGE
}
__device__ __forceinline__ void ckv_norm_phase(const float* raw, const float* gain, bf16* out, int gw, int NGW, int lane) {
    const f32x4 gv = *(const f32x4*)(gain + 4 * lane);
    for (int row = gw; row < M; row += NGW) { const f32x4 t = *(const f32x4*)(raw + (size_t)row * KVL + 4 * lane);
        const float ss = (t[0] * t[0] + t[1] * t[1]) + (t[2] * t[2] + t[3] * t[3]);
        const float rstd = __builtin_amdgcn_rsqf(wave_sum(ss) * (1.0f / KVL) + EPS); const f32x4 y = t * rstd * gv;
        v2u w2; w2.x = cvtpk(y[0], y[1]); w2.y = cvtpk(y[2], y[3]); *(v2u*)(out + (size_t)row * KVL + 4 * lane) = w2; }
}
constexpr int IX_KROW = 272, IX_KEYS = 256, IX_STAGE = IX_KEYS * IX_KROW, IX_SC_OFF = IX_STAGE;
__device__ __forceinline__ void ix_load(const bf16* KI, int b, int st, int tid, v4u (&kr)[8]) {
    const int c = tid & 15, r0 = tid >> 4;
#pragma unroll
    for (int it = 0; it < 8; ++it) kr[it] = *(const v4u*)(KI + ((size_t)b * SEQ + IX_KEYS * st + r0 + 32 * it) * 128 + 8 * c);
}
__device__ __forceinline__ void ix_store(LAS unsigned char* buf, int tid, const v4u (&kr)[8]) {
    const int c = tid & 15, r0 = tid >> 4;
#pragma unroll
    for (int it = 0; it < 8; ++it) *(LAS v4u*)(buf + (r0 + 32 * it) * IX_KROW + 16 * c) = kr[it];
}
__device__ __forceinline__ void ix_topk(const LAS u16* sc, u16* selr, int t, int lane) {
    if (t < TOPK) { for (int j = lane; j < TOPK; j += 64) selr[j] = (u16)(j <= t ? j : 0xFFFF); return; }
    const int ng = (t >> 9) + 1;
    unsigned key[32];
#pragma unroll
    for (int u = 0; u < 32; ++u) key[u] = 0u;
#pragma unroll
    for (int gq = 0; gq < 4; ++gq) if (gq < ng) {
#pragma unroll
        for (int u = 8 * gq; u < 8 * gq + 8; ++u) { const int idx = 64 * u + lane; const unsigned bits = sc[idx]; const unsigned k = (bits & 0x8000u) ? (~bits & 0xFFFFu) : (bits | 0x8000u); key[u] = (idx <= t) ? k : 0u; } }
    unsigned prefix = 0u;
    for (int bit = 15; bit >= 0; --bit) { const unsigned cand = prefix | (1u << bit); int cnt = 0;
#pragma unroll
        for (int gq = 0; gq < 4; ++gq) if (gq < ng) {
#pragma unroll
            for (int u = 8 * gq; u < 8 * gq + 8; ++u) cnt += __popcll(__ballot(key[u] >= cand)); }
        if (cnt >= TOPK) prefix = cand; }
    int cgt = 0;
#pragma unroll
    for (int gq = 0; gq < 4; ++gq) if (gq < ng) {
#pragma unroll
        for (int u = 8 * gq; u < 8 * gq + 8; ++u) cgt += __popcll(__ballot(key[u] > prefix)); }
    const int need_eq = TOPK - cgt; int base = 0, eqb = 0;
#pragma unroll
    for (int gq = 0; gq < 4; ++gq) if (gq < ng) {
#pragma unroll
        for (int u = 8 * gq; u < 8 * gq + 8; ++u) { const bool gt = key[u] > prefix, eq = key[u] == prefix; const unsigned long long meq = __ballot(eq);
            const bool take = gt || (eq && (int)(eqb + mbcnt64(meq)) < need_eq); const unsigned long long mt = __ballot(take);
            if (take) selr[base + mbcnt64(mt)] = (u16)(64 * u + lane);
            base += __popcll(mt); eqb += __popcll(meq); } }
}
__device__ __forceinline__ void dsa_index_unit(const bf16* QI, const bf16* KI, const float* WI, u16* SEL, LAS unsigned char* lds, int b, int qb, int tid, int w, int lane) {
    const int i = lane & 15, g = lane >> 4; const int t0 = 16 * qb + 2 * w;
    const size_t row0 = (size_t)b * SEQ + t0;
    LAS u16* sc0 = (LAS u16*)(lds + IX_SC_OFF + (2 * w) * 4096); LAS u16* sc1 = sc0 + 2048;
    bf16x8 a0[4], a1[4];
#pragma unroll
    for (int kk = 0; kk < 4; ++kk) { a0[kk] = *(const bf16x8*)(QI + row0 * D + i * 128 + 32 * kk + 8 * g); a1[kk] = *(const bf16x8*)(QI + (row0 + 1) * D + i * 128 + 32 * kk + 8 * g); }
    const f32x4 w0 = *(const f32x4*)(WI + row0 * 16 + 4 * g), w1 = *(const f32x4*)(WI + (row0 + 1) * 16 + 4 * g);
    const int nst = (16 * qb + 15) / IX_KEYS + 1;
    v4u kA[8], kB[8];
    ix_load(KI, b, 0, tid, kA); ix_load(KI, b, nst > 1 ? 1 : 0, tid, kB);
#define IX_STAGE_BODY(st_, kcur) do { \
        ix_store(lds, tid, kcur); \
        __syncthreads(); \
        { const int sn = (st_) + 2 < nst ? (st_) + 2 : nst - 1; ix_load(KI, b, sn, tid, kcur); } \
        int ntile = (t0 + 1 - IX_KEYS * (st_)) / 16 + 1; ntile = ntile > 16 ? 16 : ntile; \
        _Pragma("unroll 2") for (int tt = 0; tt < ntile; tt += 2) { const LAS unsigned char* kp = lds + (16 * tt + i) * IX_KROW + 16 * g; \
            f32x4 c0 = (f32x4){0.f, 0.f, 0.f, 0.f}, c1 = c0, e0 = c0, e1 = c0; \
            _Pragma("unroll") for (int kk = 0; kk < 4; ++kk) { const bf16x8 bfa = *(const LAS bf16x8*)(kp + 64 * kk), bfb = *(const LAS bf16x8*)(kp + 16 * IX_KROW + 64 * kk); \
                c0 = __builtin_amdgcn_mfma_f32_16x16x32_bf16(a0[kk], bfa, c0, 0, 0, 0); c1 = __builtin_amdgcn_mfma_f32_16x16x32_bf16(a1[kk], bfa, c1, 0, 0, 0); \
                e0 = __builtin_amdgcn_mfma_f32_16x16x32_bf16(a0[kk], bfb, e0, 0, 0, 0); e1 = __builtin_amdgcn_mfma_f32_16x16x32_bf16(a1[kk], bfb, e1, 0, 0, 0); } \
            float s0 = w0[0] * fmaxf(c0[0], 0.f) + w0[1] * fmaxf(c0[1], 0.f) + w0[2] * fmaxf(c0[2], 0.f) + w0[3] * fmaxf(c0[3], 0.f); \
            float s1 = w1[0] * fmaxf(c1[0], 0.f) + w1[1] * fmaxf(c1[1], 0.f) + w1[2] * fmaxf(c1[2], 0.f) + w1[3] * fmaxf(c1[3], 0.f); \
            float u0 = w0[0] * fmaxf(e0[0], 0.f) + w0[1] * fmaxf(e0[1], 0.f) + w0[2] * fmaxf(e0[2], 0.f) + w0[3] * fmaxf(e0[3], 0.f); \
            float u1 = w1[0] * fmaxf(e1[0], 0.f) + w1[1] * fmaxf(e1[1], 0.f) + w1[2] * fmaxf(e1[2], 0.f) + w1[3] * fmaxf(e1[3], 0.f); \
              \
              \
            { auto ra = __builtin_amdgcn_permlane16_swap(__float_as_uint(s0), __float_as_uint(u0), false, false); const float pq0 = __uint_as_float(ra[0]) + __uint_as_float(ra[1]); \
              auto rb = __builtin_amdgcn_permlane16_swap(__float_as_uint(s1), __float_as_uint(u1), false, false); const float pq1 = __uint_as_float(rb[0]) + __uint_as_float(rb[1]); \
              auto rc = __builtin_amdgcn_permlane32_swap(__float_as_uint(pq0), __float_as_uint(pq1), false, false); const float tot = __uint_as_float(rc[0]) + __uint_as_float(rc[1]); \
              const int key = IX_KEYS * (st_) + 16 * tt + i + 16 * (g & 1); LAS u16* scp = (g & 2) ? sc1 : sc0; scp[key] = __builtin_bit_cast(u16, (_Float16)tot); } } \
        __syncthreads();                                         \
    } while (0)
    for (int st = 0; st < nst; st += 2) { IX_STAGE_BODY(st, kA); if (st + 1 < nst) IX_STAGE_BODY(st + 1, kB); }
#undef IX_STAGE_BODY
    LDS_WAIT(); asm volatile("" ::: "memory");
#ifndef REPS4
#define REPS4 1
#endif
    for (int rk = 0; rk < REPS4; ++rk) {
    ix_topk(sc0, SEL + row0 * TOPK, t0, lane);
    ix_topk(sc1, SEL + (row0 + 1) * TOPK, t0 + 1, lane); }
    __syncthreads();
}
constexpr int CROW = 544;
constexpr int DSA_WAVE_LDS = 32 * CROW + 512;
__device__ __forceinline__ void dsa_attn_query(const bf16* QL, const bf16* CKV, const u16* SEL, bf16* OL, LAS unsigned char* wl, int b, int t, int lane) {
    const int i = lane & 15, g = lane >> 4; const size_t row = (size_t)b * SEQ + t;
    LAS u16* sl = (LAS u16*)(wl + 32 * CROW);
    *(LAS v2u*)(sl + 4 * lane) = *(const v2u*)(SEL + row * TOPK + 4 * lane);
    bf16x8 bq[8];
#pragma unroll
    for (int kk = 0; kk < 8; ++kk) bq[kk] = *(const bf16x8*)(QL + row * (NH * KVL) + i * KVL + 32 * kk + 8 * g);
    const float slope2 = __builtin_amdgcn_exp2f(-0.5f * (float)(i + 1)) * LOG2E;
    float m = -1e30f, l = 0.f; f32x4 o[16];
#pragma unroll
    for (int c = 0; c < 16; ++c) o[c] = (f32x4){0.f, 0.f, 0.f, 0.f};
    const int nvalid = (t + 1) < TOPK ? (t + 1) : TOPK, nch = (nvalid + 31) >> 5;
    const bf16* cb = CKV + (size_t)b * SEQ * KVL;
    LDS_WAIT(); asm volatile("" ::: "memory");
    v4u pre[16];
#pragma unroll
    for (int it = 0; it < 16; ++it) { const int r = 2 * it + (lane >> 5); unsigned key = sl[r]; key = (key == 0xFFFFu) ? 0u : key; pre[it] = *(const v4u*)(cb + (size_t)key * KVL + 8 * (lane & 31)); }
    for (int c = 0; c < nch; ++c) {
#pragma unroll
        for (int it = 0; it < 16; ++it) { const int r = 2 * it + (lane >> 5); *(LAS v4u*)(wl + r * CROW + 16 * (lane & 31)) = pre[it]; }
        if (c + 1 < nch) {
#pragma unroll
            for (int it = 0; it < 16; ++it) { const int r = 2 * it + (lane >> 5); unsigned key = sl[32 * (c + 1) + r]; key = (key == 0xFFFFu) ? 0u : key; pre[it] = *(const v4u*)(cb + (size_t)key * KVL + 8 * (lane & 31)); } }
        LDS_WAIT(); asm volatile("" ::: "memory");
        f32x4 s[2];
#pragma unroll
        for (int T = 0; T < 2; ++T) { const LAS unsigned char* ap = wl + (16 * T + i) * CROW + 16 * g; f32x4 acc = (f32x4){0.f, 0.f, 0.f, 0.f};
#pragma unroll
            for (int kk = 0; kk < 8; ++kk) { const bf16x8 af = *(const LAS bf16x8*)(ap + 64 * kk); acc = __builtin_amdgcn_mfma_f32_16x16x32_bf16(af, bq[kk], acc, 0, 0, 0); }
            s[T] = acc; }
        float cmax = -INFINITY;
#pragma unroll
        for (int T = 0; T < 2; ++T) { const v2u kw = *(const LAS v2u*)(sl + 32 * c + 16 * T + 4 * g);
#pragma unroll
            for (int r = 0; r < 4; ++r) { const unsigned key = ((r < 2 ? kw.x : kw.y) >> (16 * (r & 1))) & 0xFFFFu; const int dl = t - (int)key;
                const float v = (key != 0xFFFFu && dl >= 0) ? (s[T][r] - slope2 * (float)dl) : -INFINITY; s[T][r] = v; cmax = fmaxf(cmax, v); } }
        cmax = xmax32(xmax16(cmax));
        const float mn = fmaxf(m, cmax), alpha = __builtin_amdgcn_exp2f(m - mn); m = mn;
        float rs = 0.f;
#pragma unroll
        for (int T = 0; T < 2; ++T)
#pragma unroll
            for (int r = 0; r < 4; ++r) { const float pv = __builtin_amdgcn_exp2f(s[T][r] - mn); s[T][r] = pv; rs += pv; }
        rs = xsum32(xsum16(rs));
        l = l * alpha + rs;
        bf16x8 pf; { const unsigned a0 = cvtpk(s[0][0], s[0][1]), a1 = cvtpk(s[0][2], s[0][3]), a2 = cvtpk(s[1][0], s[1][1]), a3 = cvtpk(s[1][2], s[1][3]); const v4u tt = (v4u){a0, a1, a2, a3}; pf = __builtin_bit_cast(bf16x8, tt); }
        const LAS unsigned char* vb = wl + (4 * g + (i >> 2)) * CROW + 8 * (i & 3);
#pragma unroll
        for (int ct = 0; ct < 16; ++ct) { const s16x4 lo = tr_read(vb + 32 * ct), hi = tr_read(vb + 16 * CROW + 32 * ct);
            o[ct] = o[ct] * alpha; o[ct] = __builtin_amdgcn_mfma_f32_16x16x32_bf16(cat8(lo, hi), pf, o[ct], 0, 0, 0); }
        LDS_WAIT(); asm volatile("" ::: "memory");
    }
    const float inv = 1.0f / l;
    bf16* op = OL + row * (NH * KVL) + i * KVL + 4 * g;
#pragma unroll
    for (int ct = 0; ct < 16; ++ct) { v2u w2; w2.x = cvtpk(o[ct][0] * inv, o[ct][1] * inv); w2.y = cvtpk(o[ct][2] * inv, o[ct][3] * inv); *(v2u*)(op + 16 * ct) = w2; }
}
__device__ __forceinline__ void dsa_attn_query_p(const bf16* QL, const bf16* CKV, const u16* SEL, bf16* OL, LAS unsigned char* wl, int b, int t, int lane, bf16x8 (&bq)[8], size_t row_n, v2u& seln) {
    const int i = lane & 15, g = lane >> 4; const size_t row = (size_t)b * SEQ + t;
    LAS u16* sl = (LAS u16*)(wl + 32 * CROW);
    const float slope2 = __builtin_amdgcn_exp2f(-0.5f * (float)(i + 1)) * LOG2E;
    float m = -1e30f, l = 0.f; f32x4 o[16];
#pragma unroll
    for (int c = 0; c < 16; ++c) o[c] = (f32x4){0.f, 0.f, 0.f, 0.f};
    const int nvalid = (t + 1) < TOPK ? (t + 1) : TOPK, nch = (nvalid + 31) >> 5;
    const bf16* cb = CKV + (size_t)b * SEQ * KVL;
    LDS_WAIT(); asm volatile("" ::: "memory");
    v4u pre[16];
#pragma unroll
    for (int it = 0; it < 16; ++it) { const int r = 2 * it + (lane >> 5); unsigned key = sl[r]; key = (key == 0xFFFFu) ? 0u : key; pre[it] = *(const v4u*)(cb + (size_t)key * KVL + 8 * (lane & 31)); }
    bf16x8 bqn[8];
    for (int c = 0; c + 1 < nch; ++c) {
#pragma unroll
        for (int it = 0; it < 16; ++it) { const int r = 2 * it + (lane >> 5); *(LAS v4u*)(wl + r * CROW + 16 * (lane & 31)) = pre[it]; }
        {
#pragma unroll
            for (int it = 0; it < 16; ++it) { const int r = 2 * it + (lane >> 5); unsigned key = sl[32 * (c + 1) + r]; key = (key == 0xFFFFu) ? 0u : key; pre[it] = *(const v4u*)(cb + (size_t)key * KVL + 8 * (lane & 31)); } }
        LDS_WAIT(); asm volatile("" ::: "memory");
        f32x4 s[2];
        {
            const LAS unsigned char* ap = wl + i * CROW + 16 * g; bf16x8 af[4];
#pragma unroll
            for (int u = 0; u < 4; ++u) af[u] = *(const LAS bf16x8*)(ap + 64 * u);
            __builtin_amdgcn_sched_barrier(0);
            s[0] = (f32x4){0.f, 0.f, 0.f, 0.f}; s[1] = s[0];
#pragma unroll
            for (int u = 0; u < 16; ++u) { const int T = u >> 3, kk = u & 7;
                s[T] = __builtin_amdgcn_mfma_f32_16x16x32_bf16(af[u & 3], bq[kk], s[T], 0, 0, 0);
                if (u + 4 < 16) af[u & 3] = *(const LAS bf16x8*)(ap + ((u + 4) >> 3) * 16 * CROW + 64 * ((u + 4) & 7));
                __builtin_amdgcn_sched_barrier(0); } }
        float cmax = -INFINITY;
#pragma unroll
        for (int T = 0; T < 2; ++T) { const v2u kw = *(const LAS v2u*)(sl + 32 * c + 16 * T + 4 * g);
#pragma unroll
            for (int r = 0; r < 4; ++r) { const unsigned key = ((r < 2 ? kw.x : kw.y) >> (16 * (r & 1))) & 0xFFFFu; const int dl = t - (int)key;
                const float v = (dl >= 0)     ? (s[T][r] - slope2 * (float)dl) : -INFINITY; s[T][r] = v; cmax = fmaxf(cmax, v); } }
        cmax = xmax32(xmax16(cmax));
        const bool any_up = __builtin_amdgcn_ballot_w64(cmax > m + 8.0f) != 0ull; float alpha = 1.0f;
        if (any_up) { const float mn_ = fmaxf(m, cmax); alpha = __builtin_amdgcn_exp2f(m - mn_); m = mn_; }
        const float mn = m;
        float rs = 0.f;
#pragma unroll
        for (int T = 0; T < 2; ++T)
#pragma unroll
            for (int r = 0; r < 4; ++r) { const float pv = __builtin_amdgcn_exp2f(s[T][r] - mn); s[T][r] = pv; rs += pv; }
        l = l * alpha + rs;
        bf16x8 pf; { const unsigned a0 = cvtpk(s[0][0], s[0][1]), a1 = cvtpk(s[0][2], s[0][3]), a2 = cvtpk(s[1][0], s[1][1]), a3 = cvtpk(s[1][2], s[1][3]); const v4u tt = (v4u){a0, a1, a2, a3}; pf = __builtin_bit_cast(bf16x8, tt); }
        const LAS unsigned char* vb = wl + (4 * g + (i >> 2)) * CROW + 8 * (i & 3);
        if (any_up) {
#pragma unroll
            for (int ct = 0; ct < 16; ++ct) o[ct] = o[ct] * alpha; }
        {   s16x4 lo[4], hi[4];
#pragma unroll
            for (int u = 0; u < 4; ++u) { lo[u] = tr_read(vb + 32 * u); hi[u] = tr_read(vb + 16 * CROW + 32 * u); }
            __builtin_amdgcn_sched_barrier(0);
#pragma unroll
            for (int ct = 0; ct < 16; ++ct) { o[ct] = __builtin_amdgcn_mfma_f32_16x16x32_bf16(cat8(lo[ct & 3], hi[ct & 3]), pf, o[ct], 0, 0, 0);
                if (ct + 4 < 16) { lo[ct & 3] = tr_read(vb + 32 * (ct + 4)); hi[ct & 3] = tr_read(vb + 16 * CROW + 32 * (ct + 4)); }
                __builtin_amdgcn_sched_barrier(0); } }
        LDS_WAIT(); asm volatile("" ::: "memory");
    }
    seln = *(const v2u*)(SEL + row_n * TOPK + 4 * lane);
#pragma unroll
    for (int kk = 0; kk < 8; ++kk) bqn[kk] = *(const bf16x8*)(QL + row_n * (NH * KVL) + i * KVL + 32 * kk + 8 * g);
    { const int c = nch - 1;
#pragma unroll
        for (int it = 0; it < 16; ++it) { const int r = 2 * it + (lane >> 5); *(LAS v4u*)(wl + r * CROW + 16 * (lane & 31)) = pre[it]; }
        LDS_WAIT(); asm volatile("" ::: "memory");
        f32x4 s[2];
        {
            const LAS unsigned char* ap = wl + i * CROW + 16 * g; bf16x8 af[4];
#pragma unroll
            for (int u = 0; u < 4; ++u) af[u] = *(const LAS bf16x8*)(ap + 64 * u);
            __builtin_amdgcn_sched_barrier(0);
            s[0] = (f32x4){0.f, 0.f, 0.f, 0.f}; s[1] = s[0];
#pragma unroll
            for (int u = 0; u < 16; ++u) { const int T = u >> 3, kk = u & 7;
                s[T] = __builtin_amdgcn_mfma_f32_16x16x32_bf16(af[u & 3], bq[kk], s[T], 0, 0, 0);
                if (u + 4 < 16) af[u & 3] = *(const LAS bf16x8*)(ap + ((u + 4) >> 3) * 16 * CROW + 64 * ((u + 4) & 7));
                __builtin_amdgcn_sched_barrier(0); } }
        float cmax = -INFINITY;
#pragma unroll
        for (int T = 0; T < 2; ++T) { const v2u kw = *(const LAS v2u*)(sl + 32 * c + 16 * T + 4 * g);
#pragma unroll
            for (int r = 0; r < 4; ++r) { const unsigned key = ((r < 2 ? kw.x : kw.y) >> (16 * (r & 1))) & 0xFFFFu; const int dl = t - (int)key;
                const float v = (dl >= 0)     ? (s[T][r] - slope2 * (float)dl) : -INFINITY; s[T][r] = v; cmax = fmaxf(cmax, v); } }
        cmax = xmax32(xmax16(cmax));
        const bool any_up = __builtin_amdgcn_ballot_w64(cmax > m + 8.0f) != 0ull; float alpha = 1.0f;
        if (any_up) { const float mn_ = fmaxf(m, cmax); alpha = __builtin_amdgcn_exp2f(m - mn_); m = mn_; }
        const float mn = m;
        float rs = 0.f;
#pragma unroll
        for (int T = 0; T < 2; ++T)
#pragma unroll
            for (int r = 0; r < 4; ++r) { const float pv = __builtin_amdgcn_exp2f(s[T][r] - mn); s[T][r] = pv; rs += pv; }
        l = l * alpha + rs;
        bf16x8 pf; { const unsigned a0 = cvtpk(s[0][0], s[0][1]), a1 = cvtpk(s[0][2], s[0][3]), a2 = cvtpk(s[1][0], s[1][1]), a3 = cvtpk(s[1][2], s[1][3]); const v4u tt = (v4u){a0, a1, a2, a3}; pf = __builtin_bit_cast(bf16x8, tt); }
        const LAS unsigned char* vb = wl + (4 * g + (i >> 2)) * CROW + 8 * (i & 3);
        if (any_up) {
#pragma unroll
            for (int ct = 0; ct < 16; ++ct) o[ct] = o[ct] * alpha; }
        {   s16x4 lo[4], hi[4];
#pragma unroll
            for (int u = 0; u < 4; ++u) { lo[u] = tr_read(vb + 32 * u); hi[u] = tr_read(vb + 16 * CROW + 32 * u); }
            __builtin_amdgcn_sched_barrier(0);
#pragma unroll
            for (int ct = 0; ct < 16; ++ct) { o[ct] = __builtin_amdgcn_mfma_f32_16x16x32_bf16(cat8(lo[ct & 3], hi[ct & 3]), pf, o[ct], 0, 0, 0);
                if (ct + 4 < 16) { lo[ct & 3] = tr_read(vb + 32 * (ct + 4)); hi[ct & 3] = tr_read(vb + 16 * CROW + 32 * (ct + 4)); }
                __builtin_amdgcn_sched_barrier(0); } }
        LDS_WAIT(); asm volatile("" ::: "memory");
    }
    l = xsum32(xsum16(l));
    const float inv = 1.0f / l;
    bf16* op = OL + row * (NH * KVL) + i * KVL + 4 * g;
#pragma unroll
    for (int ct = 0; ct < 16; ++ct) { v2u w2; w2.x = cvtpk(o[ct][0] * inv, o[ct][1] * inv); w2.y = cvtpk(o[ct][2] * inv, o[ct][3] * inv); *(v2u*)(op + 16 * ct) = w2; }
#pragma unroll
    for (int kk = 0; kk < 8; ++kk) bq[kk] = bqn[kk];
}
constexpr int PH_PER_LAYER = 10, PH_L0 = 2, PH_FINAL = PH_L0 + PH_PER_LAYER * DEPTH, PH_COUNT = PH_FINAL + 1;
__global__ void __launch_bounds__(NWAVES * 64, 2) mk_fwd(Args args) {
    extern __shared__ __attribute__((aligned(16))) unsigned char lds_raw[];
    LAS unsigned char* lds = (LAS unsigned char*)lds_raw;
    volatile LAS unsigned* MISC = (volatile LAS unsigned*)(lds + MISC_OFF);
    const int tid = threadIdx.x, lane = tid & 63, wave = __builtin_amdgcn_readfirstlane(tid >> 6);
    const int G = gridDim.x; const int bx = blockIdx.x; const int vcu = (G % 8 == 0) ? (bx % 8) * (G / 8) + bx / 8 : bx;
    const int gw = vcu * NWAVES + wave, NGW = G * NWAVES;
    unsigned char* ws = as_global(args.ws);
    gu32* ctl = (gu32*)(ws + WS_CTL);
    if (tid < 64) MISC[tid] = 0u;
    __syncthreads();
    const int lo = args.ph_lo, hi = args.ph_hi;
#ifdef DIAG_XCC
    if (tid == 0) ((unsigned*)(ws + WS_CTL + 700000))[bx] = xb_xcc_id() + 1u;
#endif
#ifdef PROBE_IDX
    if (bx == 0 && tid == 0) { unsigned long long* pt = (unsigned long long*)(ws + WS_CTL + 614400); pt[63] = wall_clock64(); }
#endif
    XcdBarrier bar; bar.bar = (unsigned*)(ctl + CW_BAR); bar.x = 0; bar.st = nullptr;
    if (hi - lo > 1) { bar = xcd_barrier_post((unsigned*)(ctl + CW_BAR), MISC + 8); if (tid == 0) xcd_barrier_census(bar); __syncthreads(); }
#define IN(k) (lo <= (k) && (k) < hi)
#ifdef REP_PHASE
#define REPN(k) (((k) == REP_PHASE) ? (1 + REP_N) : 1)
#else
#define REPN(k) 1
#endif
#ifndef REP_VARIANT
#define REP_VARIANT 0
#endif
#ifndef DIL_VARIANT
#define DIL_VARIANT 0
#endif
#ifndef REPS3
#define REPS3 1
#endif
#ifndef REPS1
#define REPS1 1
#endif
#ifndef REPS2
#define REPS2 1
#endif
#define REP_BEGIN(k) for (int rep_ = 0; rep_ < REPN(k); ++rep_) { if (rep_) GBAR();
#define REP_END }
#ifdef PROBE_IDX
#define PMARK(idx) do { if (bx == 0 && tid == 0) { unsigned long long* pt = (unsigned long long*)(ws + WS_CTL + 614400); const unsigned long long now_ = wall_clock64(); pt[(idx)] += now_ - pt[63]; pt[63] = now_; } } while (0)
#else
#define PMARK(idx) do {} while (0)
#endif
#define GBAR() do { XcdBarrier b_ = bar; GAS unsigned* bp_ = (GAS unsigned*)b_.bar; asm volatile("" : "+s"(bp_)); b_.bar = (unsigned*)bp_; xcd_barrier(b_, wave == 0 && ({ unsigned m_ = ~0u; asm volatile("" : "+s"(m_)); (int)__builtin_amdgcn_mbcnt_hi(m_, __builtin_amdgcn_mbcnt_lo(m_, 0u)); }) == 0); } while (0)
#define SEAM(k) do { if ((k) + 1 < hi) GBAR(); PMARK(((k) < PH_L0) ? (k) : (2 + (((k) - PH_L0) / PH_PER_LAYER & 1) * PH_PER_LAYER + ((k) - PH_L0) % PH_PER_LAYER)); } while (0)

#define LAUNDER_S(x) ({ int v_ = (x); asm volatile("" : "+s"(v_)); v_; })
#define Gv LAUNDER_S(G)
#define bxv LAUNDER_S(bx)
#define Kd LAUNDER_S(D)
#define Kf LAUNDER_S(DFF)
#define gwv LAUNDER_S(gw)
#define vcuv LAUNDER_S(vcu)
#define LANE_NOW ({ unsigned m_ = ~0u; asm volatile("" : "+s"(m_)); (int)__builtin_amdgcn_mbcnt_hi(m_, __builtin_amdgcn_mbcnt_lo(m_, 0u)); })
#define lanev LANE_NOW
#define tidv (LAUNDER_S(wave) * 64 + LANE_NOW)
    if (IN(0)) {
        if (!PRO_SINGLE) { REP_BEGIN(0) if (I8_QKV || I8_DSA || I8_GU) p0_colmax(args, gwv, NGW, lanev); REP_END SEAM(0); }
    }
    if (IN(1)) {
        REP_BEGIN(1)
        if (PRO_SINGLE) { p0_strips(args, lds, vcuv, Gv, tidv, wave, lanev); p0_bf16_items(args, lds, gwv, NGW, wave, lanev); }
        else p0_transposes(args, lds, gwv, NGW, wave, lanev);
        __syncthreads();
        for (int ra = 0; ra < REPS3; ++ra) { p0_adaln(args, lds, Gv, tidv, wave, lanev);
        __syncthreads(); }
        REP_END
        SEAM(1);
    }
    for (int l = 0; l < DEPTH; ++l) {
        const int pb = PH_L0 + PH_PER_LAYER * l;
        if (hi <= pb || lo >= pb + PH_PER_LAYER) continue;
        const LayerW& W = args.L[l];
#define wsv ({ GAS unsigned char* q_ = (GAS unsigned char*)ws; asm volatile("" : "+s"(q_)); (unsigned char*)q_; })
#define wb (wsv + WS_W + (size_t)l * W_LAYER)
#define Hb ((bf16*)(wsv + WS_H))
#define ATT ((bf16*)(wsv + WS_ATT))
#define r1 (wsv + WS_R1)
#define r2 (wsv + WS_R2)
#define modl ((const float*)(wsv + WS_MOD) + (size_t)l * BATCH * NMOD)
#define sAp ((float*)(wsv + WS_SA))
#define sBl ((const float*)(wsv + WS_SB) + l * CM_LAYER)
#define x16 ((bf16*)(wsv + WS_X16))
#define xin ((l == 0) ? (const void*)as_global(args.x) : (const void*)x16)
#define xin_f32 (l == 0)
#define xout x16
        const bool dsa = (l & 1) != 0;
        if (IN(pb + 0)) { REP_BEGIN(pb + 0)
            if (dsa ? I8_DSA : I8_QKV) norm_mod_phase_q(xin, xin_f32, as_global(W.norm_attn), modl + 0 * D, modl + 1 * D, (signed char*)Hb, sAp, nullptr, gwv, NGW, lanev);
            else norm_mod_phase(xin, xin_f32, as_global(W.norm_attn), modl + 0 * D, modl + 1 * D, Hb, gwv, NGW, lanev);
            REP_END SEAM(pb + 0); }
        if (IN(pb + 1)) { REP_BEGIN(pb + 1)
            if (!dsa) { pg8::Gemm g{Hb, (const bf16*)(wb + WO_IN), M, NIN_A, Kd}; pg8::StaticOrder S; S.init(M, NIN_A, Gv, bxv, WGM_QKV);
                pg8::EpiQKV<I8_QKV> E{(bf16*)r1, (size_t)M * D, QSCALE, sAp, sBl};
                pg8::gemm_phase<pg8::EpiQKV<I8_QKV>, pg8::StaticOrder, PG8_ALIGN, PG8_SP2>(lds, g, S, E, tidv); }
            else { pg8::Gemm g{Hb, (const bf16*)(wb + WO_IN), M, NIN_BP, Kd}; pg8::StaticOrder S; S.init(M, NIN_BP, Gv, bxv, WGM_DSA);
                pg8::EpiDsaProj<I8_DSA> E{(bf16*)(r1 + R1_Q), (float*)(r1 + R1_CKVR), (bf16*)(r1 + R1_QI), (bf16*)(r1 + R1_KI), (float*)(r1 + R1_WI), sAp, sBl};
                pg8::gemm_phase<pg8::EpiDsaProj<I8_DSA>, pg8::StaticOrder, PG8_ALIGN, PG8_SP2>(lds, g, S, E, tidv); }
            REP_END SEAM(pb + 1);
        }
        const bool dfused = DIL_FUSED && (Gv & 15) == 0;
#define DIL_ARGS (const bf16*)r1, (const bf16*)r1 + (size_t)M * D, (const bf16*)r1 + 2 * (size_t)M * D, ATT, (float*)r2
        if (!dsa) {
            if (dfused) { if (IN(pb + 2)) { dil_attn_fused(DIL_ARGS, (unsigned*)(wsv + WS_CTL + CTL_DILCNT) + (size_t)(l >> 1) * 128 * 2 * 16, lds, vcuv, Gv, tidv, wave, lanev); SEAM(pb + 4); } }
            else if (DIL_SPLIT > 1 && !MK_MULTI) {
                if (IN(pb + 2)) { for (int sp = 0; sp < DIL_SPLIT; ++sp) for (int ps = 0; ps < 3; ++ps) { if (sp + ps) GBAR();
                        dil_attn_pass(ps, DIL_ARGS, lds, vcuv, Gv, tidv, wave, lanev, sp * (BATCH * NH * 16 / DIL_SPLIT), (sp + 1) * (BATCH * NH * 16 / DIL_SPLIT)); }
                    SEAM(pb + 4); }
            } else {
                if (IN(pb + 2)) { REP_BEGIN(pb + 2) dil_attn_pass<DIL_VARIANT>(0, DIL_ARGS, lds, vcuv, Gv, tidv, wave, lanev); REP_END SEAM(pb + 2); }
                if (IN(pb + 3)) { dil_attn_pass(1, DIL_ARGS, lds, vcuv, Gv, tidv, wave, lanev); SEAM(pb + 3); }
                if (IN(pb + 4)) { dil_attn_pass<0, true>(2, DIL_ARGS, lds, vcuv, Gv, tidv, wave, lanev, 0, BATCH * NH * 16, OUT_MODE == 2 ? (unsigned char*)(r2 + R2_ATT8) : nullptr); SEAM(pb + 4); }
            }
        } else {
        if (IN(pb + 2)) { REP_BEGIN(pb + 2)
            for (int rs1 = 0; rs1 < REPS1; ++rs1) {
            ckv_norm_phase((const float*)(r1 + R1_CKVR), as_global(W.kv_norm), (bf16*)(r1 + R1_CKV), gwv, NGW, lanev);
            for (int wu = gwv; wu < (M / 64) * NH; wu += NGW) { const int h = wu & 15, tg = wu >> 4;
                head_gemm<4, 16, 4>((const bf16*)(r1 + R1_Q), D, h * HD, (const bf16*)(wb + WO_UK) + (size_t)h * KVL * HD, (bf16*)r2, NH * KVL, h * KVL, 64 * tg, QSCALE, lanev); }
            }
            for (int rs2 = 0; rs2 < REPS2; ++rs2)
            { const int vb = vcuv;
              for (int pi = vb; pi < BATCH * 64; pi += Gv) { const int b = pi >> 6, ql = pi & 63;
                  dsa_index_unit((const bf16*)(r1 + R1_QI), (const bf16*)(r1 + R1_KI), (const float*)(r1 + R1_WI), (u16*)(r1 + R1_SEL), lds, b, ql, tidv, wave, lanev);
                  dsa_index_unit((const bf16*)(r1 + R1_QI), (const bf16*)(r1 + R1_KI), (const float*)(r1 + R1_WI), (u16*)(r1 + R1_SEL), lds, b, 127 - ql, tidv, wave, lanev); } }
            REP_END SEAM(pb + 2);
        }
        if (IN(pb + 3)) { REP_BEGIN(pb + 3)
            LAS unsigned char* wl = lds + wave * DSA_WAVE_LDS;
            if (DSA_MERGE_POST) {
                for (int blk = vcuv; blk < M / 64; blk += Gv) { const int tokb = 64 * blk;
                    { const bf16* QLp = (const bf16*)r2; const u16* SELp = (const u16*)(r1 + R1_SEL); const int ln = lanev, q0 = tokb + 8 * wave; LAS u16* slp = (LAS u16*)(wl + 32 * CROW);
                      bf16x8 bq[8]; v2u seln = *(const v2u*)(SELp + (size_t)q0 * TOPK + 4 * ln);
#pragma unroll
                      for (int kk = 0; kk < 8; ++kk) bq[kk] = *(const bf16x8*)(QLp + (size_t)q0 * (NH * KVL) + (ln & 15) * KVL + 32 * kk + 8 * (ln >> 4));
                      for (int jj = 0; jj < 8; ++jj) { const int q = q0 + jj; const int qn = q0 + (jj < 7 ? jj + 1 : jj);
                          *(LAS v2u*)(slp + 4 * ln) = seln; LDS_WAIT(); asm volatile("" ::: "memory");
                          dsa_attn_query_p(QLp, (const bf16*)(r1 + R1_CKV), SELp, (bf16*)(r1 + R1_OLAT), wl, q >> 11, q & (SEQ - 1), ln, bq, (size_t)qn, seln); } }
                    asm volatile("s_waitcnt vmcnt(0)" ::: "memory"); __syncthreads();
                    __builtin_amdgcn_fence(__ATOMIC_ACQUIRE, "agent"); asm volatile("s_waitcnt vmcnt(0)" ::: "memory");
                    dsa_post_block<OUT_MODE == 2>((const bf16*)(r1 + R1_OLAT), (const bf16*)(wb + WO_UV), ATT  , tokb, lds, tidv);
                    __syncthreads(); }
            } else {
                for (int q = gwv; q < M; q += NGW) dsa_attn_query((const bf16*)r2, (const bf16*)(r1 + R1_CKV), (const u16*)(r1 + R1_SEL), (bf16*)(r1 + R1_OLAT), wl, q >> 11, q & (SEQ - 1), lanev); }
            REP_END SEAM(pb + 3);
        }
        if (!DSA_MERGE_POST && IN(pb + 4)) { REP_BEGIN(pb + 4)
            for (int wu = gwv; wu < (M / 32) * NH; wu += NGW) { const int h = wu & 15, tg = wu >> 4;
                head_gemm<8, 8, 2, OUT_MODE == 2>((const bf16*)(r1 + R1_OLAT), NH * KVL, h * KVL, (const bf16*)(wb + WO_UV) + (size_t)h * HD * KVL, ATT, D, h * HD, 32 * tg, 1.0f, lanev); }
            REP_END SEAM(pb + 4);
        }
        }
#undef DIL_ARGS
        if (IN(pb + 5)) { REP_BEGIN(pb + 5) pg8::Gemm g{(OUT_MODE == 2 && !dsa) ? (const bf16*)(r2 + R2_ATT8) : ATT, (const bf16*)(wb + WO_OUT), M, D, Kd}; pg8::StaticOrder S; S.init(M, D, Gv, bxv, WGM_OUT);
            pg8::EpiResid<OUT_MODE> E{xin, xin_f32, xout, modl + 2 * D, NMOD, nullptr, sBl + CM_OUT};
            pg8::gemm_phase<pg8::EpiResid<OUT_MODE>, pg8::StaticOrder, PG8_ALIGN, PG8_SP2>(lds, g, S, E, tidv); REP_END SEAM(pb + 5); }
        if (IN(pb + 6)) {
            if (I8_GU) norm_mod_phase_q(xout, 0, as_global(W.norm_ffn), modl + 3 * D, modl + 4 * D, (signed char*)Hb, sAp, I8_DN ? (unsigned*)(wsv + WS_RMAX) : nullptr, gwv, NGW, lanev);
            else norm_mod_phase(xout, 0, as_global(W.norm_ffn), modl + 3 * D, modl + 4 * D, Hb, gwv, NGW, lanev);
            SEAM(pb + 6); }
        if (IN(pb + 7)) { REP_BEGIN(pb + 7) pg8::Gemm g{Hb, (const bf16*)(wb + WO_GU), M, 2 * DFF, Kd}; pg8::StaticOrder S; S.init(M, 2 * DFF, Gv, bxv, WGM_GU);
            pg8::EpiSwiglu<I8_GU, DN_MODE == 2> E{(bf16*)r2, sAp, sBl + CM_GU, I8_DN ? (unsigned*)(wsv + WS_RMAX) : nullptr};
            pg8::gemm_phase<pg8::EpiSwiglu<I8_GU, DN_MODE == 2>, pg8::StaticOrder, PG8_ALIGN, PG8_SP2>(lds, g, S, E, tidv); REP_END SEAM(pb + 7); }
        if (I8_DN && IN(pb + 8)) { REP_BEGIN(pb + 8) act_quant_phase((const bf16*)r2, (const unsigned*)(wsv + WS_RMAX), (signed char*)r1, (float*)(wsv + WS_SA2), gwv, NGW, lanev); REP_END SEAM(pb + 8); }
        if (IN(pb + 9)) { pg8::Gemm g{(const bf16*)(I8_DN ? r1 : r2), (const bf16*)(wb + WO_DN), M, D, Kf}; pg8::StaticOrder S; S.init(M, D, Gv, bxv, WGM_DN);
            pg8::EpiResid<DN_MODE> E{xout, 0, xout, modl + 5 * D, NMOD, (const float*)(wsv + WS_SA2), sBl + CM_DN};
            pg8::gemm_phase<pg8::EpiResid<DN_MODE>, pg8::StaticOrder, PG8_ALIGN, PG8_SP2>(lds, g, S, E, tidv); SEAM(pb + 9); }
    }
#undef wsv
#undef wb
#undef Hb
#undef ATT
#undef r1
#undef r2
#undef modl
#undef sAp
#undef sBl
#undef x16
#undef xin
#undef xin_f32
#undef xout
    if (IN(PH_FINAL)) {
#ifdef DIAG_XCC
        { const unsigned* ids = (const unsigned*)(ws + WS_CTL + 700000); int bad = 0, distinct = 0;
          for (int b = 0; b < G; ++b) if (ids[b] != ids[b & 7]) bad++;
          for (int a = 0; a < 8; ++a) { int dup = 0; for (int c = 0; c < a; ++c) if (ids[a] == ids[c]) dup = 1; distinct += !dup; }
          const float cval = (bad ? 2.0f : 0.0f) + (distinct == 8 ? 0.0f : 1.0f); float* o = as_global(args.out);
          for (size_t e = (size_t)bx * 512 + tid; e < (size_t)M * D; e += (size_t)G * 512) o[e] = cval; }
#endif
#if defined(PROBE_IDX)
        { const unsigned long long* pt = (const unsigned long long*)(ws + WS_CTL + 614400); unsigned long long tt = 0; for (int q = PROBE_IDX; q <= PROBE_IDX_END; ++q) tt += pt[q];
          const float cval = (float)tt * 0.01f / (float)PROBE_DIV; float* o = as_global(args.out);
          for (size_t e = (size_t)bx * 512 + tid; e < (size_t)M * D; e += (size_t)G * 512) o[e] = cval; }
#elif !defined(DIAG_XCC)
        final_norm_phase((const bf16*)(ws + WS_X16), as_global(args.out), as_global(args.final_norm), gwv, NGW, lanev);
#endif
    }
#undef Gv
#undef bxv
#undef Kd
#undef Kf
#undef gwv
#undef vcuv
#undef lanev
#undef LANE_NOW
#undef tidv
#undef IN
#undef SEAM
}


#ifdef DIAG_PROBE
struct ProbeArgs { const unsigned* buf[4]; unsigned long long nwords[4]; int is_bf16[4]; int pad[4]; unsigned* cnt; float* out; };
__global__ void probe_kernel(ProbeArgs a) {
    for (int k = 0; k < 4; ++k) { if (!a.buf[k]) continue; unsigned bad = 0;
        for (unsigned long long i = (unsigned long long)blockIdx.x * blockDim.x + threadIdx.x; i < a.nwords[k]; i += (unsigned long long)gridDim.x * blockDim.x) { const unsigned w = a.buf[k][i];
            const int md = a.is_bf16[k];
            if (md == 1) { if ((w & 0x7F80u) == 0x7F80u || (w & 0x7F800000u) == 0x7F800000u) bad++; } else if (md == 0) { if ((w & 0x7F800000u) == 0x7F800000u) bad++; }
            else if (md == 4) { const unsigned lo = w & 0xFFFFu, hi = w >> 16; if ((lo > 2047u && lo != 0xFFFFu) || (hi > 2047u && hi != 0xFFFFu)) bad++; }
            else if (md == 2) { if ((w & 0x7F80u) >= 0x4680u || (w & 0x7F800000u) >= 0x46800000u) bad++; } else { if ((w & 0x7F800000u) >= 0x46000000u) bad++; } }
        if (bad) atomicAdd(a.cnt + k, bad); }
}
__global__ void probe_fill(ProbeArgs a) {
    float c = 0.f; for (int k = 0; k < 4; ++k) if (a.cnt[k]) c += 0.5f * (float)(1 << k);
    for (size_t i = (size_t)blockIdx.x * blockDim.x + threadIdx.x; i < (size_t)M * D; i += (size_t)gridDim.x * blockDim.x) a.out[i] = c;
}
#endif
extern "C" void kernel_launch(void* const* d_in, const int* in_sizes, int n_in, void* d_out, int out_size, void* d_ws, size_t ws_size, hipStream_t stream) {
    static int grid = 0;
    if (grid == 0) {
        if (n_in != 41 || in_sizes[0] != M * D || out_size != M * D || ws_size < WS_END) { fprintf(stderr, "kernel_launch: unexpected shapes (n_in %d, in0 %d, out %d, ws %zu)\n", n_in, n_in > 0 ? in_sizes[0] : -1, out_size, ws_size); grid = -1; return; }
        int dev = 0, cus = 0;
        if (hipGetDevice(&dev) != hipSuccess || hipDeviceGetAttribute(&cus, hipDeviceAttributeMultiprocessorCount, dev) != hipSuccess) { grid = -1; return; }
        if (hipFuncSetAttribute((const void*)mk_fwd, hipFuncAttributeMaxDynamicSharedMemorySize, LDS_BYTES) != hipSuccess) { fprintf(stderr, "kernel_launch: hipFuncSetAttribute failed\n"); grid = -1; return; }
        int per_cu = 0;
        if (hipOccupancyMaxActiveBlocksPerMultiprocessor(&per_cu, (const void*)mk_fwd, NWAVES * 64, LDS_BYTES) != hipSuccess || per_cu < 1) fprintf(stderr, "kernel_launch: occupancy query reports %d\n", per_cu);
        (void)hipGetLastError();
        grid = cus;
    }
    if (grid < 0) return;
    if (hipMemsetAsync((char*)d_ws + WS_CTL, 0, CTL_ZERO_BYTES, stream) != hipSuccess) return;
    Args a{};
    a.x = (const float*)d_in[0]; a.c = (const float*)d_in[1]; a.final_norm = (const float*)d_in[40];
    int k = 2;
    for (int l = 0; l < DEPTH; ++l) { LayerW& w = a.L[l];
        w.norm_attn = (const float*)d_in[k++]; w.ada_w = (const float*)d_in[k++]; w.ada_b = (const float*)d_in[k++]; w.w_in = (const float*)d_in[k++];
        if (l & 1) { w.kv_norm = (const float*)d_in[k++]; w.w_uk = (const float*)d_in[k++]; w.w_uv = (const float*)d_in[k++]; }
        else { w.kv_norm = nullptr; w.w_uk = nullptr; w.w_uv = nullptr; }
        w.w_out = (const float*)d_in[k++]; w.norm_ffn = (const float*)d_in[k++]; w.w_gu = (const float*)d_in[k++]; w.w_down = (const float*)d_in[k++]; }
    a.out = (float*)d_out; a.ws = (unsigned char*)d_ws;
#if MK_MULTI
    for (int p = 0; p < PH_COUNT; ++p) {

        a.ph_lo = p; a.ph_hi = p + 1;
#ifdef DIAG_PROBE
        if (p > DIAG_LAST) break;
#endif
        hipLaunchKernelGGL(mk_fwd, dim3(grid), dim3(NWAVES * 64), LDS_BYTES, stream, a);
    }
#ifdef DIAG_PROBE
    { ProbeArgs pa{}; unsigned char* ws = (unsigned char*)d_ws; DIAG_SETUP; pa.cnt = (unsigned*)(ws + WS_CTL) + 64; pa.out = (float*)d_out;
      hipLaunchKernelGGL(probe_kernel, dim3(1024), dim3(256), 0, stream, pa); hipLaunchKernelGGL(probe_fill, dim3(1024), dim3(256), 0, stream, pa); }
#endif
#else
    a.ph_lo = 0; a.ph_hi = PH_COUNT;
    hipLaunchKernelGGL(mk_fwd, dim3(grid), dim3(NWAVES * 64), LDS_BYTES, stream, a);
#endif
    const hipError_t le = hipPeekAtLastError();
    if (le != hipSuccess) fprintf(stderr, "kernel_launch: launch failed: %s\n", hipGetErrorName(le));
}
```
